# Optimizing an MI355X kernel written in HIP

```python
import math
import jax, jax.numpy as jnp
from jax import lax
import numpy as np

D_MODEL = 2048
BATCH = 2
SEQ = 4096
DEPTH = 2

GRID_W = 64
CTX_LEN = 256
HEAD_DIM = 128
ROT_AXIS = HEAD_DIM // 2
ROPE_THETA = 10000.0
EPS = 1e-6
Q_BLOCK = 128
NEG_INF = -1e30
N_MOD = 6

A_HEADS = 8
A_KV_HEADS = 2
WINDOW = 128
B_HEADS = 4
B_DIM = HEAD_DIM
B_VDIM = 2 * HEAD_DIM
C_HEADS = D_MODEL // HEAD_DIM
C_KV_HEADS = 4

A_Q = A_HEADS * HEAD_DIM
A_KV = A_KV_HEADS * HEAD_DIM
B_QK = B_HEADS * 2 * B_DIM
B_V = B_HEADS * B_VDIM
EVEN_IN = A_Q + 2 * A_KV + 2 * B_QK + B_V
EVEN_SPLITS = [A_Q, A_Q + A_KV, A_Q + 2 * A_KV, A_Q + 2 * A_KV + B_QK, A_Q + 2 * A_KV + 2 * B_QK]
EVEN_MIX = A_Q + B_V
C_Q = C_HEADS * HEAD_DIM
C_KV = C_KV_HEADS * HEAD_DIM
ODD_IN = C_Q + 2 * C_KV
ODD_SPLITS = [C_Q, C_Q + C_KV]
ODD_MIX = C_Q

D_FF = 5632
N_EXPERTS = 8
TOP_K = 2
D_FF_EXPERT = 7168
MOE_BLOCK = 128

N_EVEN = (DEPTH + 1) // 2
N_ODD = DEPTH // 2

kernel_name = 'hybrid_diffusion_trunk_window_diff_gqa_moe'


def rms_norm(x, g):
    xf = x.astype(jnp.float32)
    y = xf * lax.rsqrt(jnp.mean(xf * xf, axis=-1, keepdims=True) + EPS)
    return (y * g.astype(jnp.float32)).astype(x.dtype)


def modulate(h, shift, scale):
    return h * (1 + scale) + shift


def heads(t, n):
    b, s, _ = t.shape
    return t.reshape(b, s, n, -1).transpose(0, 2, 1, 3)


def merge_heads(t):
    b, h, s, d = t.shape
    return t.transpose(0, 2, 1, 3).reshape(b, s, h * d)


def axial_rope_tables(rows, dtype):
    row = jnp.repeat(jnp.arange(rows, dtype=jnp.float32), GRID_W)
    col = jnp.tile(jnp.arange(GRID_W, dtype=jnp.float32), rows)
    inv = ROPE_THETA ** (-jnp.arange(0, ROT_AXIS, 2, dtype=jnp.float32) / ROT_AXIS)
    ang = jnp.concatenate([row[:, None] * inv, col[:, None] * inv], axis=-1)
    return jnp.cos(ang).astype(dtype), jnp.sin(ang).astype(dtype)


def apply_rope(x, cos, sin):
    h = ROT_AXIS // 2
    r1, r2, c1, c2 = jnp.split(x, 4, axis=-1)
    cr, cc = cos[:, :h], cos[:, h:]
    sr, sc = sin[:, :h], sin[:, h:]
    return jnp.concatenate([r1 * cr - r2 * sr, r2 * cr + r1 * sr, c1 * cc - c2 * sc, c2 * cc + c1 * sc], axis=-1)


def sweep_query_blocks(fn, *qs):
    L = qs[0].shape[-2]
    nb = L // Q_BLOCK
    blocks = tuple(jnp.moveaxis(t.reshape(t.shape[:-2] + (nb, Q_BLOCK, t.shape[-1])), -3, 0) for t in qs)
    out = lax.map(lambda bl: fn(*bl), blocks)
    out = jnp.moveaxis(out, 0, -3)
    return out.reshape(out.shape[:-3] + (L, out.shape[-1]))


def window_sink_attention(q, k, v, kc, vc, sink):
    b, _, L, d = q.shape
    nb = L // Q_BLOCK
    g = A_HEADS // A_KV_HEADS
    scale = d ** -0.5
    qb = q.reshape(b, A_KV_HEADS, g, nb, Q_BLOCK, d)
    pad = ((0, 0), (0, 0), (Q_BLOCK, Q_BLOCK), (0, 0))

    def band(t):
        tb = jnp.pad(t, pad).reshape(b, A_KV_HEADS, nb + 2, Q_BLOCK, d)
        return jnp.concatenate([tb[:, :, :-2], tb[:, :, 1:-1], tb[:, :, 2:]], axis=3)

    kw, vw = band(k), band(v)
    s_loc = jnp.einsum('bkgnqd,bknsd->bkgnqs', qb, kw).astype(jnp.float32) * scale
    s_ctx = jnp.einsum('bkgnqd,bkcd->bkgnqc', qb, kc).astype(jnp.float32) * scale
    blk = jnp.arange(nb)[:, None, None] * Q_BLOCK
    qpos = blk + jnp.arange(Q_BLOCK)[None, :, None]
    kpos = blk - Q_BLOCK + jnp.arange(3 * Q_BLOCK)[None, None, :]
    mask = (jnp.abs(qpos - kpos) <= WINDOW) & (kpos >= 0) & (kpos < L)
    s_loc = jnp.where(mask, s_loc, NEG_INF)
    s_sink = jnp.broadcast_to(sink.astype(jnp.float32).reshape(1, A_KV_HEADS, g, 1, 1, 1), s_ctx.shape[:-1] + (1,))
    p = jax.nn.softmax(jnp.concatenate([s_loc, s_ctx, s_sink], axis=-1), axis=-1)
    nw = 3 * Q_BLOCK
    nc = kc.shape[2]
    o = (jnp.einsum('bkgnqs,bknsd->bkgnqd', p[..., :nw].astype(v.dtype), vw)
         + jnp.einsum('bkgnqc,bkcd->bkgnqd', p[..., nw:nw + nc].astype(vc.dtype), vc))
    return o.reshape(b, A_HEADS, L, d)


def context_sink_attention(qc, kc, vc, sink):
    b, _, n, d = qc.shape
    g = A_HEADS // A_KV_HEADS
    qg = qc.reshape(b, A_KV_HEADS, g, n, d)
    s = jnp.einsum('bkgqd,bkcd->bkgqc', qg, kc).astype(jnp.float32) * (d ** -0.5)
    s_sink = jnp.broadcast_to(sink.astype(jnp.float32).reshape(1, A_KV_HEADS, g, 1, 1), s.shape[:-1] + (1,))
    p = jax.nn.softmax(jnp.concatenate([s, s_sink], axis=-1), axis=-1)
    o = jnp.einsum('bkgqc,bkcd->bkgqd', p[..., :n].astype(vc.dtype), vc)
    return o.reshape(b, A_HEADS, n, d)


def diff_core(q1, q2, k1, k2, v, lam):
    scale = q1.shape[-1] ** -0.5
    a1 = jax.nn.softmax(jnp.einsum('bhqd,bhkd->bhqk', q1, k1).astype(jnp.float32) * scale, axis=-1)
    a2 = jax.nn.softmax(jnp.einsum('bhqd,bhkd->bhqk', q2, k2).astype(jnp.float32) * scale, axis=-1)
    att = a1 - lam[None, :, None, None] * a2
    return jnp.einsum('bhqk,bhkd->bhqd', att.astype(v.dtype), v)


def gqa_core(q, k, v):
    s = jnp.einsum('bkgqd,bksd->bkgqs', q, k).astype(jnp.float32) * (q.shape[-1] ** -0.5)
    p = jax.nn.softmax(s, axis=-1)
    return jnp.einsum('bkgqs,bksd->bkgqd', p.astype(v.dtype), v)


def swiglu(h, w_in, w_down):
    g_, u_ = jnp.split(h @ w_in, 2, axis=-1)
    return (jax.nn.silu(g_) * u_) @ w_down


def moe_swiglu(h, w_router, exp_w_in, exp_w_down, layer):
    bq, s, d = h.shape
    T = bq * s
    xt = h.reshape(T, d)
    logits = (xt @ w_router).astype(jnp.float32)
    top_v, top_i = lax.top_k(logits, TOP_K)
    gates = jax.nn.softmax(top_v, axis=-1)
    tk = T * TOP_K
    flat_e = top_i.reshape(tk)
    flat_tok = jnp.arange(tk, dtype=jnp.int32) // TOP_K
    flat_g = gates.reshape(tk)
    counts = jnp.zeros((N_EXPERTS,), jnp.int32).at[flat_e].add(1)
    padded = (counts + MOE_BLOCK - 1) // MOE_BLOCK * MOE_BLOCK
    pad_end = jnp.cumsum(padded)
    pad_start = pad_end - padded
    start = jnp.cumsum(counts) - counts
    order = jnp.argsort(flat_e)
    se = flat_e[order]
    dest = pad_start[se] + jnp.arange(tk, dtype=jnp.int32) - start[se]
    n_rows = (tk + MOE_BLOCK - 1) // MOE_BLOCK * MOE_BLOCK + N_EXPERTS * MOE_BLOCK
    row_tok = jnp.full((n_rows,), T, jnp.int32).at[dest].set(flat_tok[order])
    row_gate = jnp.zeros((n_rows,), jnp.float32).at[dest].set(flat_g[order])
    nblk = n_rows // MOE_BLOCK
    blk_e = jnp.minimum(jnp.sum(jnp.arange(nblk)[:, None] * MOE_BLOCK >= pad_end[None, :], axis=1), N_EXPERTS - 1)
    xs = jnp.concatenate([xt, jnp.zeros((1, d), xt.dtype)], axis=0)[row_tok].reshape(nblk, MOE_BLOCK, d)

    def expert_block(args):
        xb, e = args
        g_, u_ = jnp.split(xb @ exp_w_in[layer, e], 2, axis=-1)
        return (jax.nn.silu(g_) * u_) @ exp_w_down[layer, e]

    ys = lax.map(expert_block, (xs, blk_e)).reshape(n_rows, d)
    ys = ys * row_gate[:, None].astype(ys.dtype)
    out = jax.ops.segment_sum(ys, row_tok, num_segments=T + 1)[:T]
    return out.reshape(bq, s, d)


def modulation(c, c_ctx, w_mod, b_mod):
    m = jax.nn.silu(c) @ w_mod + b_mod
    mc = jax.nn.silu(c_ctx) @ w_mod + b_mod
    return jnp.split(m[:, None, :], N_MOD, axis=-1), jnp.split(mc, N_MOD, axis=-1)


def even_mixer(h, hc, need_ctx, layer_idx, cos, sin, w_in, w_out, a_qn, a_kn, a_sink,
               b_qn, b_kn, lq1, lk1, lq2, lk2, b_subln):
    z = jnp.split(h @ w_in, EVEN_SPLITS, axis=-1)
    zc = jnp.split(hc @ w_in, EVEN_SPLITS, axis=-1)

    def a_qkv(parts, rope):
        q = rms_norm(heads(parts[0], A_HEADS), a_qn)
        k = rms_norm(heads(parts[1], A_KV_HEADS), a_kn)
        v = heads(parts[2], A_KV_HEADS)
        if rope:
            q, k = apply_rope(q, cos, sin), apply_rope(k, cos, sin)
        return q, k, v

    def b_qkv(parts, rope):
        q1, q2 = jnp.split(heads(parts[3], B_HEADS), 2, axis=-1)
        k1, k2 = jnp.split(heads(parts[4], B_HEADS), 2, axis=-1)
        v = heads(parts[5], B_HEADS)
        q1, q2 = rms_norm(q1, b_qn), rms_norm(q2, b_qn)
        k1, k2 = rms_norm(k1, b_kn), rms_norm(k2, b_kn)
        if rope:
            q1, q2 = apply_rope(q1, cos, sin), apply_rope(q2, cos, sin)
            k1, k2 = apply_rope(k1, cos, sin), apply_rope(k2, cos, sin)
        return q1, q2, k1, k2, v

    qa, ka, va = a_qkv(z, True)
    qac, kac, vac = a_qkv(zc, False)
    oa = window_sink_attention(qa, ka, va, kac, vac, a_sink)
    q1, q2, k1, k2, vb = b_qkv(z, True)
    q1c, q2c, k1c, k2c, vbc = b_qkv(zc, False)
    lam_init = 0.8 - 0.6 * math.exp(-0.3 * layer_idx)
    f32 = jnp.float32
    lam = (jnp.exp(jnp.sum(lq1.astype(f32) * lk1.astype(f32), axis=-1))
           - jnp.exp(jnp.sum(lq2.astype(f32) * lk2.astype(f32), axis=-1)) + lam_init)
    k1a = jnp.concatenate([k1, k1c], axis=2)
    k2a = jnp.concatenate([k2, k2c], axis=2)
    va_all = jnp.concatenate([vb, vbc], axis=2)
    ob = sweep_query_blocks(lambda a1, a2: diff_core(a1, a2, k1a, k2a, va_all, lam), q1, q2)
    ob = rms_norm(ob, b_subln) * (1 - lam_init)
    y = jnp.concatenate([merge_heads(oa), merge_heads(ob)], axis=-1) @ w_out
    yc = None
    if need_ctx:
        oac = context_sink_attention(qac, kac, vac, a_sink)
        obc = rms_norm(diff_core(q1c, q2c, k1c, k2c, vbc, lam), b_subln) * (1 - lam_init)
        yc = jnp.concatenate([merge_heads(oac), merge_heads(obc)], axis=-1) @ w_out
    return y, yc


def odd_mixer(h, hc, need_ctx, cos, sin, w_in, w_out, c_qn, c_kn):
    z = jnp.split(h @ w_in, ODD_SPLITS, axis=-1)
    zc = jnp.split(hc @ w_in, ODD_SPLITS, axis=-1)
    b, L, _ = h.shape
    g = C_HEADS // C_KV_HEADS
    q = apply_rope(rms_norm(heads(z[0], C_HEADS), c_qn), cos, sin)
    k = apply_rope(rms_norm(heads(z[1], C_KV_HEADS), c_kn), cos, sin)
    v = heads(z[2], C_KV_HEADS)
    qc = rms_norm(heads(zc[0], C_HEADS), c_qn)
    kc = rms_norm(heads(zc[1], C_KV_HEADS), c_kn)
    vc = heads(zc[2], C_KV_HEADS)
    k_all = jnp.concatenate([k, kc], axis=2)
    v_all = jnp.concatenate([v, vc], axis=2)
    qg = q.reshape(b, C_KV_HEADS, g, L, HEAD_DIM)
    o = sweep_query_blocks(lambda qb: gqa_core(qb, k_all, v_all), qg).reshape(b, C_HEADS, L, HEAD_DIM)
    y = merge_heads(o) @ w_out
    yc = None
    if need_ctx:
        n = hc.shape[1]
        oc = gqa_core(qc.reshape(b, C_KV_HEADS, g, n, HEAD_DIM), kc, vc).reshape(b, C_HEADS, n, HEAD_DIM)
        yc = merge_heads(oc) @ w_out
    return y, yc


def setup_inputs(seed: int = 0) -> dict:
    key = jax.random.key(seed)
    ks = iter(jax.random.split(key, 40))

    def nrm(shape, s):
        return jax.random.normal(next(ks), shape, jnp.float32) * s

    def gain(shape):
        return 1.0 + nrm(shape, 0.02)

    D = D_MODEL
    E, O = N_EVEN, N_ODD
    return {
        'x': nrm((BATCH, SEQ, D), 1.0),
        'c': nrm((BATCH, D), 1.0),
        'ctx': nrm((BATCH, CTX_LEN, D), 1.0),
        'c_ctx': nrm((D,), 1.0),
        'e_norm1': gain((E, D)),
        'e_norm2': gain((E, D)),
        'e_w_mod': nrm((E, D, N_MOD * D), 0.5 * D ** -0.5),
        'e_b_mod': nrm((E, N_MOD * D), 0.02),
        'e_w_in': nrm((E, D, EVEN_IN), D ** -0.5),
        'e_w_out': nrm((E, EVEN_MIX, D), EVEN_MIX ** -0.5),
        'e_a_qnorm': gain((E, HEAD_DIM)),
        'e_a_knorm': gain((E, HEAD_DIM)),
        'e_a_sink': nrm((E, A_HEADS), 0.5),
        'e_b_qnorm': gain((E, HEAD_DIM)),
        'e_b_knorm': gain((E, HEAD_DIM)),
        'e_b_lam_q1': nrm((E, B_HEADS, B_DIM), 0.1),
        'e_b_lam_k1': nrm((E, B_HEADS, B_DIM), 0.1),
        'e_b_lam_q2': nrm((E, B_HEADS, B_DIM), 0.1),
        'e_b_lam_k2': nrm((E, B_HEADS, B_DIM), 0.1),
        'e_b_subln': gain((E, B_VDIM)),
        'e_ffn_w_in': nrm((E, D, 2 * D_FF), D ** -0.5),
        'e_ffn_w_down': nrm((E, D_FF, D), D_FF ** -0.5),
        'o_norm1': gain((O, D)),
        'o_norm2': gain((O, D)),
        'o_w_mod': nrm((O, D, N_MOD * D), 0.5 * D ** -0.5),
        'o_b_mod': nrm((O, N_MOD * D), 0.02),
        'o_w_in': nrm((O, D, ODD_IN), D ** -0.5),
        'o_w_out': nrm((O, ODD_MIX, D), ODD_MIX ** -0.5),
        'o_c_qnorm': gain((O, HEAD_DIM)),
        'o_c_knorm': gain((O, HEAD_DIM)),
        'o_router': nrm((O, D, N_EXPERTS), D ** -0.5),
        'o_exp_w_in': nrm((O, N_EXPERTS, D, 2 * D_FF_EXPERT), D ** -0.5),
        'o_exp_w_down': nrm((O, N_EXPERTS, D_FF_EXPERT, D), D_FF_EXPERT ** -0.5),
    }


def reference(x, c, ctx, c_ctx, e_norm1, e_norm2, e_w_mod, e_b_mod, e_w_in, e_w_out, e_a_qnorm, e_a_knorm,
              e_a_sink, e_b_qnorm, e_b_knorm, e_b_lam_q1, e_b_lam_k1, e_b_lam_q2, e_b_lam_k2, e_b_subln,
              e_ffn_w_in, e_ffn_w_down, o_norm1, o_norm2, o_w_mod, o_b_mod, o_w_in, o_w_out, o_c_qnorm,
              o_c_knorm, o_router, o_exp_w_in, o_exp_w_down):
    L = x.shape[1]
    rows = L // GRID_W
    cos, sin = axial_rope_tables(rows, x.dtype)
    xc = ctx
    for l in range(DEPTH):
        need_ctx = l < DEPTH - 1
        i = l // 2
        if l % 2 == 0:
            (sh1, sc1, g1, sh2, sc2, g2), (csh1, csc1, cg1, csh2, csc2, cg2) = modulation(c, c_ctx, e_w_mod[i], e_b_mod[i])
            h = modulate(rms_norm(x, e_norm1[i]), sh1, sc1)
            hc = modulate(rms_norm(xc, e_norm1[i]), csh1, csc1)
            y, yc = even_mixer(h, hc, need_ctx, l, cos, sin, e_w_in[i], e_w_out[i], e_a_qnorm[i], e_a_knorm[i],
                               e_a_sink[i], e_b_qnorm[i], e_b_knorm[i], e_b_lam_q1[i], e_b_lam_k1[i],
                               e_b_lam_q2[i], e_b_lam_k2[i], e_b_subln[i])
            x = x + g1 * y
            x = x + g2 * swiglu(modulate(rms_norm(x, e_norm2[i]), sh2, sc2), e_ffn_w_in[i], e_ffn_w_down[i])
            if need_ctx:
                xc = xc + cg1 * yc
                xc = xc + cg2 * swiglu(modulate(rms_norm(xc, e_norm2[i]), csh2, csc2), e_ffn_w_in[i], e_ffn_w_down[i])
        else:
            (sh1, sc1, g1, sh2, sc2, g2), (csh1, csc1, cg1, csh2, csc2, cg2) = modulation(c, c_ctx, o_w_mod[i], o_b_mod[i])
            h = modulate(rms_norm(x, o_norm1[i]), sh1, sc1)
            hc = modulate(rms_norm(xc, o_norm1[i]), csh1, csc1)
            y, yc = odd_mixer(h, hc, need_ctx, cos, sin, o_w_in[i], o_w_out[i], o_c_qnorm[i], o_c_knorm[i])
            x = x + g1 * y
            x = x + g2 * moe_swiglu(modulate(rms_norm(x, o_norm2[i]), sh2, sc2), o_router[i], o_exp_w_in, o_exp_w_down, i)
            if need_ctx:
                xc = xc + cg1 * yc
                xc = xc + cg2 * moe_swiglu(modulate(rms_norm(xc, o_norm2[i]), csh2, csc2), o_router[i], o_exp_w_in, o_exp_w_down, i)
    return x
```

```cpp
#include <hip/hip_runtime.h>
#include <hip/hip_bf16.h>
#include <cstdio>
#include <cstdint>

namespace pg8 {
#define PG8_LAS __attribute__((address_space(3)))
typedef unsigned short bf16_t;
typedef short bf16x8 __attribute__((ext_vector_type(8)));
typedef float f32x4 __attribute__((ext_vector_type(4)));
typedef unsigned u32x4 __attribute__((ext_vector_type(4)));
constexpr int BM = 256, BK = 64, HALF = 128, HTB = HALF * BK * 2  , STAGE_BYTES = 8 * HTB, NXCD = 8, WGM = 8;

__host__ __device__ __forceinline__ int lds_byte(int r, int c) { const int st = (r >> 4) * 2 + (c >> 5), rr = r & 15, cc = c & 31, ob = rr * 64 + cc * 2; return st * 1024 + (ob ^ (((ob >> 9) & 1) << 5)); }
__host__ __device__ __forceinline__ void stage_rc(int b, int& R, int& C) { const int st = b / 1024, sb = b % 1024, swz = sb ^ (((sb >> 9) & 1) << 5); R = (st >> 1) * 16 + swz / 64; C = (st & 1) * 32 + (swz % 64) / 2; }
__host__ __device__ __forceinline__ int perm32(int rho) { const int n = rho >> 4, i = rho & 15; return 8 * (i >> 2) + 4 * n + (i & 3); }

struct Unit { int pm, pn, pnb; };
struct Gemm { const bf16_t* A; const bf16_t* Bt; int M, N, K; };

struct StaticOrder {
    int nM, nN, nwg, G, c;
    __host__ __device__ void init(int M, int N, int G_, int c_) { nM = M / BM; nN = N / BM; nwg = nM * nN; G = G_; c = c_; }
    __host__ __device__ bool next(int i, Unit& u) const {
        const long L = (long)i * G + c; if (L >= nwg) return false;
        int wgid = (int)L; { const int q = nwg / NXCD, r = nwg % NXCD, xcd = wgid % NXCD, off = wgid / NXCD; wgid = (xcd < r ? xcd * (q + 1) : r * (q + 1) + (xcd - r) * q) + off; }
        const int nig = WGM * nN, gid = wgid / nig, fm = gid * WGM, gsz = (nM - fm) < WGM ? (nM - fm) : WGM;
        u.pm = fm + ((wgid % nig) % gsz); u.pn = (wgid % nig) / gsz; u.pnb = u.pn; return true;
    }
    __device__ __forceinline__ void a_ready(const Unit&) const {}
    __device__ __forceinline__ void done(const Unit&) const {}
};
struct MoeOrder {
    StaticOrder so; const int* tile_e;
    __device__ void init(int ntiles, int nN, int G_, int c_, const int* te) { so.nM = ntiles; so.nN = nN; so.nwg = ntiles * nN; so.G = G_; so.c = c_; tile_e = te; }
    __device__ bool next(int i, Unit& u) const { if (!so.next(i, u)) return false; u.pnb = tile_e[u.pm] * so.nN + u.pn; return true; }
    __device__ __forceinline__ void a_ready(const Unit&) const {}
    __device__ __forceinline__ void done(const Unit&) const {}
};

__device__ __forceinline__ unsigned cvt_pk_bf16(float lo, float hi) { unsigned r; asm volatile("v_cvt_pk_bf16_f32 %0, %1, %2" : "=v"(r) : "v"(lo), "v"(hi)); return r; }

struct EpiBf16 {
    static constexpr bool PERM = true, AFTER_DRAIN = false;
    bf16_t* O; int ldc;
    __device__ __forceinline__ void operator()(const f32x4 (&acc)[2][2][4][2], const Unit& u, int wr, int wc, int fr, int fq) const {
        const int row0 = u.pm * BM + wr * 64 + fr; const int col0 = u.pn * BM + wc * 32 + 8 * fq;
#pragma unroll
        for (int ai = 0; ai < 2; ++ai)
#pragma unroll
            for (int m = 0; m < 4; ++m) { bf16_t* rowp = O + (size_t)(row0 + ai * HALF + m * 16) * ldc + col0;
#pragma unroll
                for (int bj = 0; bj < 2; ++bj) { const f32x4 v0 = acc[ai][bj][m][0], v1 = acc[ai][bj][m][1];
                    u32x4 w; w.x = cvt_pk_bf16(v0[0], v0[1]); w.y = cvt_pk_bf16(v0[2], v0[3]); w.z = cvt_pk_bf16(v1[0], v1[1]); w.w = cvt_pk_bf16(v1[2], v1[3]);
                    *(u32x4*)(rowp + bj * HALF) = w; } }
    }
};
__device__ __forceinline__ float silu_mul(float g, float u) { return g * u * __builtin_amdgcn_rcpf(1.0f + __builtin_amdgcn_exp2f(-1.4426950408889634f * g)); }
struct EpiSwiglu {
    static constexpr bool PERM = true, AFTER_DRAIN = false;
    bf16_t* O; int ldc;
    __device__ __forceinline__ void operator()(const f32x4 (&acc)[2][2][4][2], const Unit& u, int wr, int wc, int fr, int fq) const {
        const int row0 = u.pm * BM + wr * 64 + fr; const int col0 = u.pn * HALF + wc * 32 + 8 * fq;
#pragma unroll
        for (int ai = 0; ai < 2; ++ai)
#pragma unroll
            for (int m = 0; m < 4; ++m) { bf16_t* rowp = O + (size_t)(row0 + ai * HALF + m * 16) * ldc + col0;
                const f32x4 g0 = acc[ai][0][m][0], g1 = acc[ai][0][m][1], u0 = acc[ai][1][m][0], u1 = acc[ai][1][m][1];
                u32x4 w; w.x = cvt_pk_bf16(silu_mul(g0[0], u0[0]), silu_mul(g0[1], u0[1])); w.y = cvt_pk_bf16(silu_mul(g0[2], u0[2]), silu_mul(g0[3], u0[3]));
                w.z = cvt_pk_bf16(silu_mul(g1[0], u1[0]), silu_mul(g1[1], u1[1])); w.w = cvt_pk_bf16(silu_mul(g1[2], u1[2]), silu_mul(g1[3], u1[3]));
                *(u32x4*)rowp = w; }
    }
};
struct EpiRes {
    static constexpr bool PERM = false, AFTER_DRAIN = false;
    const float* base_lat; const float* base_ctx; float* out; int ldc; const float* gate; int gate_stride;
    __device__ __forceinline__ void operator()(const f32x4 (&acc)[2][2][4][2], const Unit& u, int wr, int wc, int fr, int fq) const {
        const int prow = u.pm * BM; const int cond = prow < 4096 ? 0 : (prow < 8192 ? 1 : 2);
        const float* bp = prow < 8192 ? base_lat + (size_t)prow * ldc : base_ctx + (size_t)(prow - 8192) * ldc;
        float* op = out + (size_t)prow * ldc; const float* gp = gate + (size_t)cond * gate_stride;
        const int rl0 = wr * 64 + fr, col0 = u.pn * BM + wc * 32 + 4 * fq;
        f32x4 gv[2][2];
#pragma unroll
        for (int bj = 0; bj < 2; ++bj)
#pragma unroll
            for (int n = 0; n < 2; ++n) gv[bj][n] = *(const f32x4*)(gp + col0 + bj * HALF + 16 * n);
#pragma unroll
        for (int ai = 0; ai < 2; ++ai)
#pragma unroll
            for (int m = 0; m < 4; ++m) { const size_t ro = (size_t)(rl0 + ai * HALF + m * 16) * ldc;
#pragma unroll
                for (int bj = 0; bj < 2; ++bj)
#pragma unroll
                    for (int n = 0; n < 2; ++n) { const int col = col0 + bj * HALF + 16 * n; const f32x4 b = *(const f32x4*)(bp + ro + col);
                        *(f32x4*)(op + ro + col) = b + gv[bj][n] * acc[ai][bj][m][n]; } }
    }
};
struct EpiRowScale {
    static constexpr bool PERM = false, AFTER_DRAIN = false;
    float* out; int ldc; const float* rs;
    __device__ __forceinline__ void operator()(const f32x4 (&acc)[2][2][4][2], const Unit& u, int wr, int wc, int fr, int fq) const {
        const int row0 = u.pm * BM + wr * 64 + fr, col0 = u.pn * BM + wc * 32 + 4 * fq;
#pragma unroll
        for (int ai = 0; ai < 2; ++ai)
#pragma unroll
            for (int m = 0; m < 4; ++m) { const int row = row0 + ai * HALF + m * 16; const float s = rs[row]; float* rp = out + (size_t)row * ldc + col0;
#pragma unroll
                for (int bj = 0; bj < 2; ++bj)
#pragma unroll
                    for (int n = 0; n < 2; ++n) *(f32x4*)(rp + bj * HALF + 16 * n) = acc[ai][bj][m][n] * s; }
    }
};

template <class Epi, class Sched, bool ALIGN_EPI = false, bool SP2 = false>
__device__ __forceinline__ void gemm_phase(PG8_LAS unsigned char* lds, const Gemm g, const Sched& S, const Epi& E) {
    const int tid = threadIdx.x, wid = __builtin_amdgcn_readfirstlane(tid >> 6), lane = tid & 63, wr = wid >> 2, wc = wid & 3, fr = lane & 15, fq = lane >> 4;
    const int K = g.K, nt = K / BK;
    unsigned voffA[2], voffB[2];
#pragma unroll
    for (int i = 0; i < 2; ++i) { int R, C; stage_rc(tid * 16 + i * 8192, R, C); const int Rb = Epi::PERM ? ((R & ~31) + perm32(R & 31)) : R;
        voffA[i] = (unsigned)(R * K + C) * 2u; voffB[i] = (unsigned)(Rb * K + C) * 2u; }
    const size_t kstep = (size_t)(BK * 2);
    const size_t hstep = (size_t)HALF * K * 2;
    const size_t tstep = 2 * hstep;
    const unsigned ldsw = (unsigned)wid * 1024u;
    const int aoff = lds_byte(wr * 64 + fr, fq * 8), boff = lds_byte(wc * 32 + fr, fq * 8);
#define PG8_SA(b, h) (((b) * 2 + (h)) * HTB)
#define PG8_SB(b, h) ((4 + (b) * 2 + (h)) * HTB)
#define PG8_STAGE(bufoff, gbase, voff) do { _Pragma("unroll") for (int _i = 0; _i < 2; ++_i) \
        __builtin_amdgcn_global_load_lds((const unsigned*)((const char*)(gbase) + (voff)[_i]), (PG8_LAS unsigned*)(lds + (bufoff) + ldsw + _i * 8192), 16, 0, 0); } while (0)
#define PG8_LDA(dst, b, h) do { _Pragma("unroll") for (int m = 0; m < 4; ++m) _Pragma("unroll") for (int k = 0; k < 2; ++k) dst[m][k] = *(const PG8_LAS bf16x8*)(lds + PG8_SA(b, h) + aoff + m * 2048 + k * 1024); } while (0)
#define PG8_LDB(dst, b, h) do { _Pragma("unroll") for (int n = 0; n < 2; ++n) _Pragma("unroll") for (int k = 0; k < 2; ++k) dst[n][k] = *(const PG8_LAS bf16x8*)(lds + PG8_SB(b, h) + boff + n * 2048 + k * 1024); } while (0)
#define PG8_MMA(ai, bj, At, Bt) do { __builtin_amdgcn_s_setprio(1); _Pragma("unroll") for (int m = 0; m < 4; ++m) _Pragma("unroll") for (int n = 0; n < 2; ++n) _Pragma("unroll") for (int k = 0; k < 2; ++k) \
        acc[ai][bj][m][n] = __builtin_amdgcn_mfma_f32_16x16x32_bf16(Bt[n][k], At[m][k], acc[ai][bj][m][n], 0, 0, 0); __builtin_amdgcn_s_setprio(0); } while (0)
#define PG8_WAIT_V(n) asm volatile("s_waitcnt vmcnt(" #n ")" ::: "memory")
#define PG8_WAIT_L(n) asm volatile("s_waitcnt lgkmcnt(" #n ")" ::: "memory")
#define PG8_BAR __builtin_amdgcn_s_barrier()
#define PG8_SCHED __builtin_amdgcn_sched_barrier(0)
    Unit cur, nxt; int ui = 0;
    if (!S.next(0, cur)) return;
    f32x4 acc[2][2][4][2];
#pragma unroll
    for (int a = 0; a < 2; ++a)
#pragma unroll
        for (int b = 0; b < 2; ++b)
#pragma unroll
            for (int m = 0; m < 4; ++m)
#pragma unroll
                for (int n = 0; n < 2; ++n) acc[a][b][m][n] = (f32x4){0.f, 0.f, 0.f, 0.f};
    bf16x8 At[4][2], B0[2][2], B1[2][2];
    const char* cA = (const char*)g.A + (size_t)cur.pm * tstep; const char* cB = (const char*)g.Bt + (size_t)cur.pnb * tstep;
    S.a_ready(cur);
    if constexpr (SP2) {
        PG8_STAGE(PG8_SB(0, 0), cB, voffB); PG8_STAGE(PG8_SB(0, 1), cB + hstep, voffB); PG8_STAGE(PG8_SA(0, 0), cA, voffA); PG8_STAGE(PG8_SA(0, 1), cA + hstep, voffA);
        if (wr == 1) PG8_BAR;
        PG8_WAIT_V(2); PG8_BAR;
        PG8_STAGE(PG8_SB(1, 0), cB + kstep, voffB); PG8_STAGE(PG8_SA(1, 0), cA + kstep, voffA); PG8_STAGE(PG8_SB(1, 1), cB + hstep + kstep, voffB);
        PG8_WAIT_V(6); PG8_BAR;
    } else {
        PG8_STAGE(PG8_SB(0, 0), cB, voffB); PG8_STAGE(PG8_SA(0, 0), cA, voffA); PG8_STAGE(PG8_SB(0, 1), cB + hstep, voffB); PG8_STAGE(PG8_SA(0, 1), cA + hstep, voffA);
        if (wr == 1) PG8_BAR;
        PG8_WAIT_V(4); PG8_BAR;
        PG8_STAGE(PG8_SB(1, 0), cB + kstep, voffB); PG8_STAGE(PG8_SA(1, 0), cA + kstep, voffA); PG8_STAGE(PG8_SB(1, 1), cB + hstep + kstep, voffB);
        PG8_WAIT_V(6); PG8_BAR;
    }
    for (;;) {
        const bool has_next = S.next(ui + 1, nxt);
        const char* nA = has_next ? (const char*)g.A + (size_t)nxt.pm * tstep : cA; const char* nB = has_next ? (const char*)g.Bt + (size_t)nxt.pnb * tstep : cB;
        for (int t = 0; t < nt; t += 2) {
            const bool last = (t == nt - 2);
            const char* a1 = cA + (size_t)(t + 1) * kstep;
            const char* a2 = last ? nA : cA + (size_t)(t + 2) * kstep; const char* b2 = last ? nB : cB + (size_t)(t + 2) * kstep;
            const char* a3 = a2 + kstep; const char* b3 = b2 + kstep;
            if (last && has_next) S.a_ready(nxt);
            if constexpr (SP2) {
            PG8_LDB(B0, 0, 0); PG8_LDB(B1, 0, 1); PG8_SCHED; PG8_LDA(At, 0, 0); PG8_STAGE(PG8_SA(1, 1), a1 + hstep, voffA);
            PG8_WAIT_V(8); PG8_WAIT_L(0); PG8_BAR; PG8_MMA(0, 0, At, B0); PG8_MMA(0, 1, At, B1); PG8_BAR; PG8_SCHED;
            PG8_LDA(At, 0, 1); PG8_STAGE(PG8_SB(0, 0), b2, voffB); PG8_STAGE(PG8_SB(0, 1), b2 + hstep, voffB); PG8_STAGE(PG8_SA(0, 0), a2, voffA);
            PG8_WAIT_V(8); PG8_WAIT_L(0); PG8_BAR; PG8_MMA(1, 0, At, B0); PG8_MMA(1, 1, At, B1); PG8_BAR; PG8_SCHED;
            PG8_LDB(B0, 1, 0); PG8_LDB(B1, 1, 1); PG8_SCHED; PG8_LDA(At, 1, 0); PG8_STAGE(PG8_SA(0, 1), a2 + hstep, voffA);
            PG8_WAIT_V(8); PG8_WAIT_L(0); PG8_BAR; PG8_MMA(0, 0, At, B0); PG8_MMA(0, 1, At, B1); PG8_BAR; PG8_SCHED;
            PG8_LDA(At, 1, 1); PG8_STAGE(PG8_SB(1, 0), b3, voffB); PG8_STAGE(PG8_SB(1, 1), b3 + hstep, voffB); PG8_STAGE(PG8_SA(1, 0), a3, voffA);
            PG8_WAIT_V(8); PG8_WAIT_L(0); PG8_BAR; PG8_MMA(1, 0, At, B0); PG8_MMA(1, 1, At, B1); PG8_BAR; PG8_SCHED;
            } else {
            PG8_LDB(B0, 0, 0); PG8_SCHED; PG8_LDA(At, 0, 0); PG8_STAGE(PG8_SA(1, 1), a1 + hstep, voffA);
            PG8_WAIT_L(8); PG8_BAR; PG8_WAIT_L(0); PG8_MMA(0, 0, At, B0); PG8_BAR; PG8_SCHED;
            PG8_LDB(B1, 0, 1); PG8_STAGE(PG8_SB(0, 0), b2, voffB);
            PG8_BAR; PG8_WAIT_L(0); PG8_MMA(0, 1, At, B1); PG8_BAR;
            PG8_LDA(At, 0, 1); PG8_STAGE(PG8_SA(0, 0), a2, voffA);
            PG8_BAR; PG8_WAIT_L(0); PG8_MMA(1, 0, At, B0); PG8_BAR; PG8_SCHED;
            PG8_STAGE(PG8_SB(0, 1), b2 + hstep, voffB);
            PG8_WAIT_V(6); PG8_BAR; PG8_MMA(1, 1, At, B1); PG8_BAR;
            PG8_LDB(B0, 1, 0); PG8_SCHED; PG8_LDA(At, 1, 0); PG8_STAGE(PG8_SA(0, 1), a2 + hstep, voffA);
            PG8_WAIT_L(8); PG8_BAR; PG8_WAIT_L(0); PG8_MMA(0, 0, At, B0); PG8_BAR; PG8_SCHED;
            PG8_LDB(B1, 1, 1); PG8_STAGE(PG8_SB(1, 0), b3, voffB);
            PG8_BAR; PG8_WAIT_L(0); PG8_MMA(0, 1, At, B1); PG8_BAR;
            PG8_LDA(At, 1, 1); PG8_STAGE(PG8_SA(1, 0), a3, voffA);
            PG8_BAR; PG8_WAIT_L(0); PG8_MMA(1, 0, At, B0); PG8_BAR; PG8_SCHED;
            PG8_STAGE(PG8_SB(1, 1), b3 + hstep, voffB);
            PG8_WAIT_V(6); PG8_BAR; PG8_MMA(1, 1, At, B1); PG8_BAR;
            }
        }
        if constexpr (ALIGN_EPI) { if (wr == 0) PG8_BAR; }
        if constexpr (!Epi::AFTER_DRAIN) { E(acc, cur, wr, wc, fr, fq); S.done(cur); }
        if (!has_next) break;
#pragma unroll
        for (int a = 0; a < 2; ++a)
#pragma unroll
            for (int b = 0; b < 2; ++b)
#pragma unroll
                for (int m = 0; m < 4; ++m)
#pragma unroll
                    for (int n = 0; n < 2; ++n) acc[a][b][m][n] = (f32x4){0.f, 0.f, 0.f, 0.f};
        cur = nxt; cA = nA; cB = nB; ++ui;
        if constexpr (ALIGN_EPI) { if (wr == 1) PG8_BAR; }
    }
    PG8_WAIT_V(0);
    if constexpr (!ALIGN_EPI) { if (wr == 0) PG8_BAR; }
    PG8_BAR;
    if constexpr (Epi::AFTER_DRAIN) { E.fused(acc, cur, wr, wc, fr, fq, lds, wid, lane); S.done(cur); }
#undef PG8_SA
#undef PG8_SB
#undef PG8_STAGE
#undef PG8_LDA
#undef PG8_LDB
#undef PG8_MMA
#undef PG8_WAIT_V
#undef PG8_WAIT_L
#undef PG8_BAR
#undef PG8_SCHED
}
}


namespace att {
using bf16 = __hip_bfloat16;
constexpr int   D = 128, NW = 8, QBLK = 32, KVBLK = 64;
constexpr float SCALE = 0.088388347648318440f;
constexpr float THR = 8.f;
constexpr int LDQ = 128, LDK = 128;
constexpr size_t SHM_V = KVBLK * D * 2, SHM_K = KVBLK * D * 2, SHM_ATTN = 2 * SHM_V + 2 * SHM_K + NW * 64 * 4;
using bf16x8 = __attribute__((ext_vector_type(8))) short;
using s16x4  = __attribute__((ext_vector_type(4))) short;
using f32x16 = __attribute__((ext_vector_type(16))) float;
using u32x4  = __attribute__((ext_vector_type(4))) unsigned;
#define KSWZ(row, colB) ((row) * 256 + ((colB) ^ (((row) & 7) << 4)))
#define SBAR() __builtin_amdgcn_sched_barrier(0)
__device__ __forceinline__ int crow(int r, int hi) { return (r & 3) + 8 * (r >> 2) + 4 * hi; }
__device__ __forceinline__ unsigned cvtpk(float lo, float hi) {
  unsigned r; asm volatile("v_cvt_pk_bf16_f32 %0, %1, %2" : "=v"(r) : "v"(lo), "v"(hi)); return r;
}
__device__ __forceinline__ void partialSM(f32x16& p0, f32x16& p1, float& m_reg, float& mn, float& alpha) {
  constexpr float C = SCALE * 1.4426950408889634f;
  float pmax = p0[0];
#pragma unroll
  for (int r = 1; r < 16; ++r) pmax = fmaxf(pmax, p0[r]);
#pragma unroll
  for (int r = 0; r < 16; ++r) pmax = fmaxf(pmax, p1[r]);
  { auto rr = __builtin_amdgcn_permlane32_swap(__float_as_uint(pmax), __float_as_uint(pmax), false, false);
    pmax = fmaxf(__uint_as_float(rr[0]), __uint_as_float(rr[1])); }
  if (__builtin_expect(__all(pmax - m_reg <= THR / SCALE), 1)) { mn = m_reg; alpha = 1.f; }
  else { mn = fmaxf(m_reg, pmax); alpha = __builtin_amdgcn_exp2f((m_reg - mn) * C); m_reg = mn; }
  float mnC = -mn * C;
#pragma unroll
  for (int r = 0; r < 16; ++r) p0[r] = fmaf(p0[r], C, mnC);
#pragma unroll
  for (int r = 0; r < 16; ++r) p1[r] = fmaf(p1[r], C, mnC);
#pragma unroll
  for (int r = 0; r < 16; ++r) p0[r] = __builtin_amdgcn_exp2f(p0[r]);
}
__device__ __forceinline__ void finishSM(f32x16& p0, f32x16& p1, float alpha, float& l_reg, bf16x8& pa0, bf16x8& pa1, bf16x8& pa2, bf16x8& pa3) {
#pragma unroll
  for (int r = 0; r < 16; ++r) p1[r] = __builtin_amdgcn_exp2f(p1[r]);
  float ps = 0;
#pragma unroll
  for (int r = 0; r < 16; ++r) ps += p0[r];
#pragma unroll
  for (int r = 0; r < 16; ++r) ps += p1[r];
  { auto rr = __builtin_amdgcn_permlane32_swap(__float_as_uint(ps), __float_as_uint(ps), false, false);
    ps = __uint_as_float(rr[0]) + __uint_as_float(rr[1]); }
  l_reg = l_reg * alpha + ps;
#define PK4(P, BASE, OUT) do { unsigned a0 = cvtpk(P[BASE + 0], P[BASE + 1]), a1 = cvtpk(P[BASE + 2], P[BASE + 3]);   \
    unsigned b0 = cvtpk(P[BASE + 4], P[BASE + 5]), b1 = cvtpk(P[BASE + 6], P[BASE + 7]);                              \
    auto r0 = __builtin_amdgcn_permlane32_swap(a0, b0, false, false); auto r1 = __builtin_amdgcn_permlane32_swap(a1, b1, false, false); \
    u32x4 w = {r0[0], r1[0], r0[1], r1[1]}; OUT = *reinterpret_cast<bf16x8*>(&w); } while (0)
  PK4(p0, 0, pa0); PK4(p0, 8, pa1); PK4(p1, 0, pa2); PK4(p1, 8, pa3);
#undef PK4
}
__device__ __forceinline__ void qkt(f32x16& p0, f32x16& p1, const bf16* Ks, const bf16x8* qr, int r32, int hi) {
  p0 = f32x16{}; p1 = f32x16{};
#pragma unroll
  for (int d0 = 0; d0 < 8; ++d0) { int cb = (d0 * 16 + hi * 8) * 2;
    bf16x8 b0 = *reinterpret_cast<const bf16x8*>((const char*)Ks + KSWZ(r32, cb));
    bf16x8 b1 = *reinterpret_cast<const bf16x8*>((const char*)Ks + KSWZ(32 + r32, cb));
    p0 = __builtin_amdgcn_mfma_f32_32x32x16_bf16(b0, qr[d0], p0, 0, 0, 0);
    p1 = __builtin_amdgcn_mfma_f32_32x32x16_bf16(b1, qr[d0], p1, 0, 0, 0); }
}
__device__ __forceinline__ void maskt(f32x16& p0, f32x16& p1, int kbase, int qpos, int hi) {
#pragma unroll
  for (int r = 0; r < 16; ++r) { const int d0 = qpos - (kbase + crow(r, hi)); const int d1 = d0 - 32;
    if (d0 > 128 || d0 < -128) p0[r] = -1e30f;
    if (d1 > 128 || d1 < -128) p1[r] = -1e30f; }
}
__device__ __forceinline__ int v_st(int k, int c) { const int kk = (k & ~0xC) | ((k & 4) << 1) | ((k & 8) >> 1); return ((kk >> 3) * 4 + (c >> 5)) * 512 + ((kk & 7) * 32 + (c & 31)) * 2; }
__device__ __forceinline__ int v_rd_base(int lane) { return ((lane & 3) << 3) | (((lane >> 2) & 3) << 6) | (((lane >> 4) & 1) << 5) | (((lane >> 5) & 1) << 8); }
constexpr int v_rd_off(int d0, int ks, int half) { return d0 * 512 + ks * 4096 + half * 2048; }
template <int OFF> __device__ __forceinline__ s16x4 tr_read(int vb) {
  s16x4 r; asm volatile("ds_read_b64_tr_b16 %0, %1 offset:%2" : "=&v"(r) : "v"(vb), "i"(OFF) : "memory"); return r;
}
template <int D0> __device__ __forceinline__ void pv_one(f32x16& od, int vb, bf16x8 pa0, bf16x8 pa1, bf16x8 pa2, bf16x8 pa3) {
  const s16x4 l0 = tr_read<v_rd_off(D0, 0, 0)>(vb), h0 = tr_read<v_rd_off(D0, 0, 1)>(vb), l1 = tr_read<v_rd_off(D0, 1, 0)>(vb), h1 = tr_read<v_rd_off(D0, 1, 1)>(vb);
  const s16x4 l2 = tr_read<v_rd_off(D0, 2, 0)>(vb), h2 = tr_read<v_rd_off(D0, 2, 1)>(vb), l3 = tr_read<v_rd_off(D0, 3, 0)>(vb), h3 = tr_read<v_rd_off(D0, 3, 1)>(vb);
  asm volatile("s_waitcnt lgkmcnt(0)" ::: "memory"); SBAR();
#define PK(L, H) (bf16x8){L[0], L[1], L[2], L[3], H[0], H[1], H[2], H[3]}
  od = __builtin_amdgcn_mfma_f32_32x32x16_bf16(pa0, PK(l0, h0), od, 0, 0, 0);
  od = __builtin_amdgcn_mfma_f32_32x32x16_bf16(pa1, PK(l1, h1), od, 0, 0, 0);
  od = __builtin_amdgcn_mfma_f32_32x32x16_bf16(pa2, PK(l2, h2), od, 0, 0, 0);
  od = __builtin_amdgcn_mfma_f32_32x32x16_bf16(pa3, PK(l3, h3), od, 0, 0, 0);
#undef PK
}
__device__ __forceinline__ void pv_d0(f32x16* o, int vb, bf16x8 pa0, bf16x8 pa1, bf16x8 pa2, bf16x8 pa3) {
  pv_one<0>(o[0], vb, pa0, pa1, pa2, pa3); pv_one<1>(o[1], vb, pa0, pa1, pa2, pa3); pv_one<2>(o[2], vb, pa0, pa1, pa2, pa3); pv_one<3>(o[3], vb, pa0, pa1, pa2, pa3);
}

template <bool MASK, bool OUT_BF16>
__device__ __forceinline__ void attn_unit(const bf16* __restrict__ Qb, const bf16* __restrict__ Kh, const bf16* __restrict__ Vh, void* __restrict__ Ob, int ldo,
                                          int klo, int nt1, int NT, int qpos0, float m_init, float l_init, char* lds) {
  const int tid = threadIdx.x, wid = tid >> 6, lane = tid & 63, r32 = lane & 31, hi = lane >> 5;
  bf16* V_lds = (bf16*)lds; bf16* K_lds = (bf16*)(lds + 2 * SHM_V);
  float* ws = (float*)(lds + 2 * SHM_V + 2 * SHM_K) + wid * 64; float* li_l = ws; float* al_l = ws + 32;
  float m_reg = m_init, l_reg = l_init; f32x16 o[4] = {}; bf16x8 qr[8];
  const bf16* Qw = Qb + (long)(wid * QBLK + r32) * LDQ + hi * 8;
#pragma unroll
  for (int d0 = 0; d0 < 8; ++d0) qr[d0] = *reinterpret_cast<const bf16x8*>(Qw + d0 * 16);
  const int sr = tid >> 4, sc = (tid & 15) * 8, vst0 = v_st(sr, sc), vst1 = v_st(32 + sr, sc);
  const int vb0 = (int)(uintptr_t)V_lds + v_rd_base(lane);
  const int qpos = qpos0 + wid * QBLK + r32;
  struct { bf16x8 vs0, vs1, ks0, ks1; } sr_[2];
#define KROW(t) ((t) < nt1 ? klo + (t) * KVBLK : 4096 + ((t) - nt1) * KVBLK)
#define SLOAD(i, t) do { const int k0_ = KROW(t); sr_[i].vs0 = *reinterpret_cast<const bf16x8*>(&Vh[(long)(k0_ + sr) * LDK + sc]); sr_[i].vs1 = *reinterpret_cast<const bf16x8*>(&Vh[(long)(k0_ + 32 + sr) * LDK + sc]); \
    sr_[i].ks0 = *reinterpret_cast<const bf16x8*>(&Kh[(long)(k0_ + sr) * LDK + sc]); sr_[i].ks1 = *reinterpret_cast<const bf16x8*>(&Kh[(long)(k0_ + 32 + sr) * LDK + sc]); } while (0)
#define SWRITE(b, i) do { *(bf16x8*)((char*)V_lds + (b) * SHM_V + vst0) = sr_[i].vs0;          \
    *(bf16x8*)((char*)V_lds + (b) * SHM_V + vst1) = sr_[i].vs1; int kc = sc * 2;               \
    *(bf16x8*)((char*)K_lds + (b) * SHM_K + KSWZ(sr, kc)) = sr_[i].ks0;                       \
    *(bf16x8*)((char*)K_lds + (b) * SHM_K + KSWZ(32 + sr, kc)) = sr_[i].ks1; } while (0)
#define SWAIT() asm volatile("s_waitcnt vmcnt(4)" ::: "memory")
#define RESC(a) do { if (__any((a) < 1.f)) { if (hi == 0) al_l[r32] = (a); asm volatile("s_waitcnt lgkmcnt(0)" ::: "memory"); \
    _Pragma("unroll") for (int d = 0; d < 4; ++d) _Pragma("unroll") for (int r = 0; r < 16; ++r) o[d][r] *= al_l[crow(r, hi)]; } } while (0)
#define MASKT(P0, P1, t) do { if (MASK) { if ((t) < nt1) maskt(P0, P1, klo + (t) * KVBLK, qpos, hi); } } while (0)
  f32x16 pA0, pA1, pB0, pB1; float mnA, mnB, alA, alB; bf16x8 pa0, pa1, pa2, pa3;
  constexpr int SE = 0, SO = 1;
  SLOAD(SE, 0); asm volatile("s_waitcnt vmcnt(0)" ::: "memory"); SWRITE(0, SE); __syncthreads();
  qkt(pA0, pA1, K_lds, qr, r32, hi); MASKT(pA0, pA1, 0); partialSM(pA0, pA1, m_reg, mnA, alA);
  SLOAD(SO, 1); if (2 < NT) SLOAD(SE, 2);
  SWAIT(); SWRITE(1, SO); __syncthreads();
  for (int j = 1; j + 1 < NT; j += 2) {
    SBAR(); qkt(pB0, pB1, (bf16*)((char*)K_lds + SHM_K), qr, r32, hi);
    finishSM(pA0, pA1, alA, l_reg, pa0, pa1, pa2, pa3); SBAR();
    SLOAD(SO, j + 2); SBAR();
    pv_d0(o, vb0, pa0, pa1, pa2, pa3); MASKT(pB0, pB1, j); partialSM(pB0, pB1, m_reg, mnB, alB);
    __syncthreads(); SWAIT(); SWRITE(0, SE);
    RESC(alB); __syncthreads();
    SBAR(); qkt(pA0, pA1, K_lds, qr, r32, hi);
    finishSM(pB0, pB1, alB, l_reg, pa0, pa1, pa2, pa3); SBAR();
    if (j + 3 < NT) SLOAD(SE, j + 3); SBAR();
    pv_d0(o, vb0 + (int)SHM_V, pa0, pa1, pa2, pa3); MASKT(pA0, pA1, j + 1); partialSM(pA0, pA1, m_reg, mnA, alA);
    __syncthreads(); SWAIT(); SWRITE(1, SO);
    RESC(alA); __syncthreads();
  }
  SBAR(); qkt(pB0, pB1, (bf16*)((char*)K_lds + SHM_K), qr, r32, hi);
  finishSM(pA0, pA1, alA, l_reg, pa0, pa1, pa2, pa3); SBAR();
  pv_d0(o, vb0, pa0, pa1, pa2, pa3); MASKT(pB0, pB1, NT - 1); partialSM(pB0, pB1, m_reg, mnB, alB);
  __syncthreads(); RESC(alB);
  finishSM(pB0, pB1, alB, l_reg, pa0, pa1, pa2, pa3); SBAR();
  pv_d0(o, vb0 + (int)SHM_V, pa0, pa1, pa2, pa3);
  if (hi == 0) li_l[r32] = l_reg; asm volatile("s_waitcnt lgkmcnt(0)" ::: "memory");
  float rli[16];
#pragma unroll
  for (int r = 0; r < 16; ++r) rli[r] = __builtin_amdgcn_rcpf(li_l[crow(r, hi)]);
  if constexpr (OUT_BF16) {
    bf16* Ow = (bf16*)Ob + (long)(wid * QBLK) * ldo;
#pragma unroll
    for (int r = 0; r < 16; ++r) { int orow = crow(r, hi);
#pragma unroll
      for (int d0 = 0; d0 < 4; ++d0) { const float ov = o[d0][r] * rli[r]; ((unsigned short*)Ow)[(long)orow * ldo + d0 * 32 + r32] = (unsigned short)cvtpk(ov, ov); } }
  } else {
    float* Ow = (float*)Ob + (long)(wid * QBLK) * ldo;
#pragma unroll
    for (int r = 0; r < 16; ++r) { int orow = crow(r, hi);
#pragma unroll
      for (int d0 = 0; d0 < 4; ++d0) Ow[(long)orow * ldo + d0 * 32 + r32] = o[d0][r] * rli[r]; }
  }
  __syncthreads();
#undef KROW
#undef SLOAD
#undef SWRITE
#undef SWAIT
#undef RESC
#undef MASKT
}
#undef KSWZ
#undef SBAR
}

constexpr int NWAVES = 8;
constexpr int D = 2048, NB = 2, SEQ = 4096, CTXL = 256;
constexpr int TL = NB * SEQ, TC = NB * CTXL, MR = TL + TC;
constexpr int KVR = SEQ + CTXL;
constexpr int EVEN_IN = 4608, ODD_IN = 3072, DFF = 5632, DFE = 7168, NE = 8, MODW = 6 * D;
constexpr int NSLOT0 = 36, NSLOT1 = 24;
constexpr int MAXT = 72, XROWS = MAXT * 256;
constexpr float EPS = 1e-6f;
constexpr float LAM_INIT = 0.2f;

constexpr size_t MiB = 1u << 20;
constexpr size_t WS_CTL = 0, CTL_ZERO_BYTES = 1 * MiB;
constexpr size_t WS_MODS = 1 * MiB;
constexpr size_t WS_LAM = WS_MODS + 512 * 1024;
constexpr size_t WS_ROUTE = 2 * MiB;
constexpr size_t RT_EID = WS_ROUTE, RT_GATE = WS_ROUTE + 64 * 1024, RT_POS = WS_ROUTE + 128 * 1024, RT_ROWTOK = WS_ROUTE + 192 * 1024, RT_ROWGATE = WS_ROUTE + 272 * 1024,
                 RT_TILE_E = WS_ROUTE + 352 * 1024, RT_NTILES = WS_ROUTE + 353 * 1024;
constexpr size_t WS_WT_EIN = 4 * MiB, WS_WT_EOUT = 22 * MiB, WS_WT_EF1 = 30 * MiB, WS_WT_EF2 = 74 * MiB, WS_WT_OIN = 96 * MiB, WS_WT_OOUT = 108 * MiB,
                 WS_WT_X1 = 116 * MiB, WS_WT_X2 = 564 * MiB;
constexpr size_t WS_H = 788 * MiB, WS_Z = 822 * MiB, WS_QKV = 900 * MiB, WS_PB = 978 * MiB, WS_OALL = 1046 * MiB, WS_X1 = 1080 * MiB, WS_X3 = 1148 * MiB,
                 WS_ACT = 1212 * MiB, WS_XS = 1306 * MiB, WS_ACT2 = 1378 * MiB, WS_YS = 1630 * MiB, WS_END = 1774 * MiB;
static_assert(WS_WT_EIN + (size_t)EVEN_IN * D * 2 <= WS_WT_EOUT && WS_WT_EF1 + (size_t)2 * DFF * D * 2 <= WS_WT_EF2 && WS_WT_EF2 + (size_t)D * DFF * 2 <= WS_WT_OIN &&
              WS_WT_OIN + (size_t)ODD_IN * D * 2 <= WS_WT_OOUT && WS_WT_X1 + (size_t)NE * 2 * DFE * D * 2 <= WS_WT_X2 && WS_WT_X2 + (size_t)NE * D * DFE * 2 <= WS_H &&
              WS_H + (size_t)MR * D * 2 <= WS_Z && WS_Z + (size_t)MR * EVEN_IN * 2 <= WS_QKV && WS_QKV + (size_t)NB * NSLOT0 * KVR * 128 * 2 <= WS_PB &&
              WS_PB + (size_t)NB * 16 * KVR * 128 * 4 <= WS_OALL && WS_OALL + (size_t)MR * D * 2 <= WS_X1 && WS_X1 + (size_t)MR * D * 4 <= WS_X3 && WS_X3 + (size_t)TL * D * 4 <= WS_ACT &&
              WS_ACT + (size_t)MR * DFF * 2 <= WS_XS && WS_XS + (size_t)XROWS * D * 2 <= WS_ACT2 && WS_ACT2 + (size_t)XROWS * DFE * 2 <= WS_YS && WS_YS + (size_t)XROWS * D * 4 <= WS_END, "d_ws map");
constexpr int CW_BAR = 4096;

constexpr int RING_BYTES = 131072;
constexpr int LDSCTL_OFF = 143360, MISC_OFF = LDSCTL_OFF + 320;
constexpr int LDS_BYTES = 147456;

#define GAS __attribute__((address_space(1)))
#define LAS __attribute__((address_space(3)))
typedef unsigned short bf16;
typedef unsigned v4u __attribute__((ext_vector_type(4)));
typedef unsigned v2u __attribute__((ext_vector_type(2)));
typedef float f32x4 __attribute__((ext_vector_type(4)));
typedef GAS unsigned gu32;
#define RLX_AGENT __ATOMIC_RELAXED, __HIP_MEMORY_SCOPE_AGENT
#define LDS_WAIT() asm volatile("s_waitcnt lgkmcnt(0)" ::: "memory")
#define VM_WAIT() asm volatile("s_waitcnt vmcnt(0)" ::: "memory")
__device__ __forceinline__ unsigned f2bf(float f) { unsigned u = __builtin_bit_cast(unsigned, f); return (u + 0x7fffu + ((u >> 16) & 1u)) >> 16; }
__device__ __forceinline__ unsigned pk2(float lo, float hi) { return f2bf(lo) | (f2bf(hi) << 16); }
__device__ __forceinline__ float bflo(unsigned w) { return __builtin_bit_cast(float, w << 16); }
__device__ __forceinline__ float bfhi(unsigned w) { return __builtin_bit_cast(float, w & 0xffff0000u); }
__device__ __forceinline__ float wave_sum(float v) {
#pragma unroll
    for (int o = 1; o < 64; o <<= 1) v += __shfl_xor(v, o);
    return v;
}

#define XB_TMO      128
#define XB_XCNT(j)  (256  + 64 * (j))
#define XB_XSUB(j)  (1280 + 64 * (j))
#define XB_XGEN(j)  (2304 + 64 * (j))
#define XB_TOP      3328
#define XB_TOPGEN   3392
#define XCD_BAR_WORDS 3456
#define XB_SPIN_CAP (1u << 18)

__device__ __forceinline__ unsigned xb_ld(unsigned* p)              { return __hip_atomic_load(p, __ATOMIC_RELAXED, __HIP_MEMORY_SCOPE_AGENT); }
__device__ __forceinline__ unsigned xb_add(unsigned* p, unsigned v) { return __hip_atomic_fetch_add(p, v, __ATOMIC_RELAXED, __HIP_MEMORY_SCOPE_AGENT); }
__device__ __forceinline__ unsigned xb_xcc_id() { return (unsigned)__builtin_amdgcn_s_getreg((3 << 11) | 20) & 0xFu; }
#define XB_SPIN(cond, bar) do { unsigned _sp = 0; while (cond) { __builtin_amdgcn_s_sleep(1); \
    if ((++_sp & 255u) == 0u) { if (xb_ld(&(bar)[XB_TMO])) break; if (_sp > XB_SPIN_CAP) { atomicAdd(&(bar)[XB_TMO], 1u); break; } } } } while (0)

struct XcdBarrier {
    unsigned* bar; unsigned x;
    volatile LAS unsigned* st;
};

__device__ __forceinline__ XcdBarrier xcd_barrier_post(unsigned* bar, volatile LAS unsigned* st) {
    XcdBarrier b; b.bar = bar; b.x = xb_xcc_id(); b.st = st;
    if (threadIdx.x == 0) (void)xb_add(&bar[XB_XCNT(b.x)], 1u);
    return b;
}
__device__ __forceinline__ void xcd_barrier_complete(unsigned* bar, unsigned x, unsigned& nloc, unsigned& nx) {
    const unsigned G = gridDim.x * gridDim.y * gridDim.z;
    unsigned sum, cnt, mine, sp = 0u;
    for (;;) {
        sum = 0u; cnt = 0u; mine = 0u;
#pragma unroll
        for (unsigned j = 0; j < 16; ++j) { const unsigned c = xb_ld(&bar[XB_XCNT(j)]); sum += c; cnt += (c > 0u) ? 1u : 0u; mine = (j == x) ? c : mine; }
        if (sum == G) break;
        __builtin_amdgcn_s_sleep(1);
        if ((++sp & 255u) == 0u) { if (xb_ld(&bar[XB_TMO])) break; if (sp > XB_SPIN_CAP) { atomicAdd(&bar[XB_TMO], 1u); break; } }
    }
    nloc = mine > 0u ? mine : 1u; nx = cnt > 0u ? cnt : 1u;
}

__device__ __forceinline__ void xcd_barrier(const XcdBarrier& b) {
    asm volatile("s_waitcnt vmcnt(0)" ::: "memory");
    __syncthreads();
    if (threadIdx.x == 0) {
        unsigned* bar = b.bar;
        __builtin_amdgcn_s_waitcnt(0);
        unsigned nloc = b.st[0], nx = b.st[1];
        if (nloc == 0u) { xcd_barrier_complete(bar, b.x, nloc, nx); b.st[0] = nloc; b.st[1] = nx; }
        const unsigned old = xb_add(&bar[XB_XSUB(b.x)], 1u);
        const unsigned gen = old / nloc;
        if (old + 1u == (gen + 1u) * nloc) {
            __builtin_amdgcn_fence(__ATOMIC_RELEASE, "agent");
            asm volatile("s_waitcnt vmcnt(0)" ::: "memory");
            const unsigned og = xb_add(&bar[XB_TOP], 1u);
            const unsigned tg = og / nx;
            if (og + 1u == (tg + 1u) * nx) xb_add(&bar[XB_TOPGEN], 1u);
            else XB_SPIN(xb_ld(&bar[XB_TOPGEN]) == tg, bar);
            __builtin_amdgcn_fence(__ATOMIC_ACQUIRE, "agent");
            xb_add(&bar[XB_XGEN(b.x)], 1u);
            asm volatile("s_waitcnt vmcnt(0)" ::: "memory");
        } else {
            XB_SPIN(xb_ld(&bar[XB_XGEN(b.x)]) == gen, bar);
            __builtin_amdgcn_fence(__ATOMIC_ACQUIRE, "agent");
            asm volatile("s_waitcnt vmcnt(0)" ::: "memory");
        }
    }
    __syncthreads();
}


struct Ctx {
    LAS unsigned char* lds; int tid, lane, wave, G, c, gw, NGW;
};

__device__ __forceinline__ void transpose_item(const float* __restrict__ W, int K, int N, bf16* __restrict__ WT, int q, int kind, LAS float* scr, int lane) {
    const int nblk = N >> 6, kb = q / nblk, nb = q - kb * nblk, k0 = kb * 64, n0 = nb * 64;
    int dest0 = n0;
    if (kind) { const int hf = N >> 1; const int j = n0 < hf ? n0 : n0 - hf; dest0 = (j >> 7) * 256 + (j & 127) + (n0 < hf ? 0 : 128); }
    const int l16 = lane & 15, kq = lane >> 4;
    f32x4 v[16];
#pragma unroll
    for (int i = 0; i < 16; ++i) v[i] = *(const f32x4*)(W + (size_t)(k0 + 4 * i + kq) * N + n0 + 4 * l16);
#pragma unroll
    for (int i = 0; i < 16; ++i) { LAS float* p = scr + (4 * i + kq) * 65 + 4 * l16; p[0] = v[i].x; p[1] = v[i].y; p[2] = v[i].z; p[3] = v[i].w; }
    LDS_WAIT(); asm volatile("" ::: "memory");
    const int c = lane & 7, nn = lane >> 3;
#pragma unroll
    for (int jj = 0; jj < 8; ++jj) { const int n = nn + 8 * jj; const LAS float* s = scr + (8 * c) * 65 + n;
        v4u o; o.x = pk2(s[0 * 65], s[1 * 65]); o.y = pk2(s[2 * 65], s[3 * 65]); o.z = pk2(s[4 * 65], s[5 * 65]); o.w = pk2(s[6 * 65], s[7 * 65]);
        *(v4u*)(WT + (size_t)(dest0 + n) * K + k0 + 8 * c) = o; }
    LDS_WAIT(); asm volatile("" ::: "memory");
}

__device__ __forceinline__ void mod_task(const Ctx& X, int task, const float* cvec, const float* cctx, const float* Wm, const float* bm, float* mods_l) {
    const int ch = task % 48;
    LAS float* S = (LAS float*)X.lds;
    LAS float* R = S + 3 * 2048;
    for (int idx = X.tid; idx < 3 * 2048; idx += NWAVES * 64) { const int i = idx >> 11, k = idx & 2047; const float cv = i < 2 ? cvec[i * 2048 + k] : cctx[k]; S[idx] = cv / (1.f + expf(-cv)); }
    __syncthreads();
    f32x4 a0 = {0.f, 0.f, 0.f, 0.f}, a1 = a0, a2 = a0;
    const float* wp = Wm + (size_t)(X.wave * 256) * MODW + ch * 256 + 4 * X.lane;
    for (int k = 0; k < 256; k += 8) {
        f32x4 w[8];
#pragma unroll
        for (int u = 0; u < 8; ++u) w[u] = *(const f32x4*)(wp + (size_t)(k + u) * MODW);
#pragma unroll
        for (int u = 0; u < 8; ++u) { const int kk = X.wave * 256 + k + u; a0 += w[u] * S[kk]; a1 += w[u] * S[2048 + kk]; a2 += w[u] * S[4096 + kk]; }
    }
#pragma unroll
    for (int j = 0; j < 4; ++j) { R[(X.wave * 3 + 0) * 256 + 4 * X.lane + j] = a0[j]; R[(X.wave * 3 + 1) * 256 + 4 * X.lane + j] = a1[j]; R[(X.wave * 3 + 2) * 256 + 4 * X.lane + j] = a2[j]; }
    __syncthreads();
    for (int idx = X.tid; idx < 768; idx += NWAVES * 64) { const int i = idx >> 8, col = idx & 255; float s = 0.f;
#pragma unroll
        for (int w = 0; w < 8; ++w) s += R[(w * 3 + i) * 256 + col];
        mods_l[(size_t)i * MODW + ch * 256 + col] = s + bm[ch * 256 + col]; }
    __syncthreads();
}

template <bool ROUTER>
__device__ __forceinline__ void norm_mod_rows(const Ctx& X, const float* src_lat, const float* src_ctx, int nrows, const float* gain, const float* mods_l, int sh_i, int sc_i, bf16* H,
                                              const float* wrouter, int* eid, float* egate) {
    LAS float* WR = (LAS float*)X.lds;
    if (ROUTER) { for (int idx = X.tid; idx < 8 * 2048; idx += NWAVES * 64) { const int k = idx >> 3, e = idx & 7; WR[e * 2048 + k] = wrouter[idx]; } __syncthreads(); }
    for (int row = X.gw; row < nrows; row += X.NGW) {
        const float* xr = row < TL ? src_lat + (size_t)row * D : src_ctx + (size_t)(row - TL) * D;
        const int cond = row < SEQ ? 0 : (row < TL ? 1 : 2);
        const float* shp = mods_l + (size_t)cond * MODW + sh_i * D; const float* scp = mods_l + (size_t)cond * MODW + sc_i * D;
        f32x4 v[8]; float ss = 0.f;
#pragma unroll
        for (int j = 0; j < 8; ++j) { v[j] = *(const f32x4*)(xr + 4 * X.lane + 256 * j); ss += (v[j].x * v[j].x + v[j].y * v[j].y) + (v[j].z * v[j].z + v[j].w * v[j].w); }
        const float rstd = 1.0f / sqrtf(wave_sum(ss) * (1.f / D) + EPS);
#pragma unroll
        for (int j = 0; j < 8; ++j) { const int col = 4 * X.lane + 256 * j; const f32x4 g = *(const f32x4*)(gain + col), sc = *(const f32x4*)(scp + col), sh = *(const f32x4*)(shp + col);
            v[j] = (v[j] * rstd * g) * (sc + 1.0f) + sh;
            v2u o; o.x = pk2(v[j].x, v[j].y); o.y = pk2(v[j].z, v[j].w); *(v2u*)(H + (size_t)row * D + col) = o; }
        if (ROUTER) {
            float v1 = -3.0e38f, v2 = -3.0e38f; int i1 = 0, i2 = 0;
#pragma unroll 1
            for (int e = 0; e < 8; ++e) { float a = 0.f;
#pragma unroll
                for (int j = 0; j < 8; ++j) { const f32x4 w = *(const LAS f32x4*)(WR + e * 2048 + 4 * X.lane + 256 * j); a += (v[j].x * w.x + v[j].y * w.y) + (v[j].z * w.z + v[j].w * w.w); }
                const float s = wave_sum(a);
                if (s > v1) { v2 = v1; i2 = i1; v1 = s; i1 = e; } else if (s > v2) { v2 = s; i2 = e; } }
            const float ex = expf(v2 - v1), g1 = 1.f / (1.f + ex), g2 = ex / (1.f + ex);
            if (X.lane == 0) { eid[row * 2] = i1; eid[row * 2 + 1] = i2; egate[row * 2] = g1; egate[row * 2 + 1] = g2; }
        }
    }
}

template <int NG>
__device__ __forceinline__ void qkv_post(const Ctx& X, const bf16* z, bf16* QKV, const float* qn_a, const float* kn_a, const float* qn_b, const float* kn_b) {
    typedef float f32x2 __attribute__((ext_vector_type(2)));
    LAS f32x2* CS = (LAS f32x2*)X.lds;
    for (int idx = X.tid; idx < 2048; idx += NWAVES * 64) { const int p = idx >> 5, i = idx & 31; const float inv = exp2f(-(float)i * (13.287712379549449f / 32.0f)); const float a = (float)p * inv;
        float sn, cs; sincosf(a, &sn, &cs); CS[idx] = (f32x2){cs, sn}; }
    __syncthreads();
    const int l16 = X.lane & 15, gq = X.lane >> 4, chunk = l16 >> 2;
    for (int row = X.gw; row < MR; row += X.NGW) {
        const bool lat = row < TL; const int b = lat ? (row >> 12) : ((row - TL) >> 8); const int pos = lat ? (row & 4095) : (SEQ + ((row - TL) & 255));
        const int p = (chunk < 2) ? (pos >> 6) : (pos & 63);
#pragma unroll 1
        for (int it = 0; it < NG / 4; ++it) {
            const int g = it * 4 + gq;
            const float* gp; bool hn;
            if (NG == NSLOT0) { hn = !(g == 10 || g == 11 || g >= 28); gp = g < 8 ? qn_a : (g < 12 ? kn_a : (g < 20 ? qn_b : kn_b)); }
            else { hn = g < 20; gp = g < 16 ? qn_a : kn_a; }
            const v4u raw = *(const v4u*)(z + (size_t)row * (NG * 128) + g * 128 + 8 * l16);
            float v[8] = {bflo(raw.x), bfhi(raw.x), bflo(raw.y), bfhi(raw.y), bflo(raw.z), bfhi(raw.z), bflo(raw.w), bfhi(raw.w)};
            float ss = 0.f;
#pragma unroll
            for (int j = 0; j < 8; ++j) ss += v[j] * v[j];
            ss += __shfl_xor(ss, 1); ss += __shfl_xor(ss, 2); ss += __shfl_xor(ss, 4); ss += __shfl_xor(ss, 8);
            const float rs = 1.0f / sqrtf(ss * (1.f / 128.f) + EPS);
            const f32x4 ga = *(const f32x4*)(gp + 8 * l16), gb = *(const f32x4*)(gp + 8 * l16 + 4);
            const float gg[8] = {ga.x, ga.y, ga.z, ga.w, gb.x, gb.y, gb.z, gb.w};
#pragma unroll
            for (int j = 0; j < 8; ++j) v[j] = hn ? v[j] * rs * gg[j] : v[j];
            float o[8];
#pragma unroll
            for (int j = 0; j < 8; ++j) { const float pv = __shfl_xor(v[j], 4); const f32x2 cs = CS[p * 32 + 8 * (l16 & 3) + j];
                const float rot = (chunk & 1) ? (v[j] * cs.x + pv * cs.y) : (v[j] * cs.x - pv * cs.y); o[j] = (hn && lat) ? rot : v[j]; }
            v4u w; w.x = pk2(o[0], o[1]); w.y = pk2(o[2], o[3]); w.z = pk2(o[4], o[5]); w.w = pk2(o[6], o[7]);
            *(v4u*)(QKV + ((size_t)(b * NG + g) * KVR + pos) * 128 + 8 * l16) = w;
        }
    }
}

__device__ __forceinline__ void b_combine(const Ctx& X, const float* PB, const float* lamv, const float* subln, bf16* OALL) {
    const int half = X.lane >> 5, d4 = (X.lane & 31) * 4;
    for (int item = X.gw; item < MR * 4; item += X.NGW) {
        const int row = item >> 2, hb = item & 3; const bool lat = row < TL; const int b = lat ? (row >> 12) : ((row - TL) >> 8); const int pos = lat ? (row & 4095) : (SEQ + ((row - TL) & 255));
        const f32x4 o1 = *(const f32x4*)(PB + ((size_t)(b * 16 + (hb * 2 + 0) * 2 + half) * KVR + pos) * 128 + d4);
        const f32x4 o2 = *(const f32x4*)(PB + ((size_t)(b * 16 + (hb * 2 + 1) * 2 + half) * KVR + pos) * 128 + d4);
        const float lam = lamv[hb];
        const f32x4 v = o1 - o2 * lam;
        const float ss = wave_sum((v.x * v.x + v.y * v.y) + (v.z * v.z + v.w * v.w));
        const float rs = (1.0f - LAM_INIT) / sqrtf(ss * (1.f / 256.f) + EPS);
        const f32x4 g = *(const f32x4*)(subln + half * 128 + d4);
        const f32x4 y = v * rs * g;
        v2u o; o.x = pk2(y.x, y.y); o.y = pk2(y.z, y.w);
        *(v2u*)(OALL + (size_t)row * D + 1024 + hb * 256 + half * 128 + d4) = o;
    }
}

__device__ __forceinline__ void moe_route(const Ctx& X, const int* eid, const float* egate, const bf16* H, bf16* XS, int* pos, int* rowtok, float* rowgate, int* tile_e, int* ntiles) {
    LAS int* tot = (LAS int*)X.lds;
    LAS int* pre = tot + 8;
    LAS int* base = tot + 16;
    LAS int* dst = tot + 64;
    const int tpw = (TL + X.G - 1) / X.G, t0 = X.c * tpw, t1 = (t0 + tpw) < TL ? (t0 + tpw) : TL;
    if (X.tid < 16) tot[X.tid] = 0;
    __syncthreads();
    for (int idx = X.tid; idx < 2 * TL; idx += NWAVES * 64) { const int e = eid[idx]; __hip_atomic_fetch_add(&tot[e], 1, __ATOMIC_RELAXED, __HIP_MEMORY_SCOPE_WORKGROUP); if ((idx >> 1) < t0) __hip_atomic_fetch_add(&pre[e], 1, __ATOMIC_RELAXED, __HIP_MEMORY_SCOPE_WORKGROUP); }
    __syncthreads();
    if (X.tid == 0) { int acc = 0; for (int e = 0; e < 8; ++e) { base[e] = acc; acc += (tot[e] + 255) & ~255; }
        if (X.c == 0) { *ntiles = acc >> 8; for (int e = 0; e < 8; ++e) { const int nt = (tot[e] + 255) >> 8; for (int i = 0; i < nt; ++i) tile_e[(base[e] >> 8) + i] = e; } } }
    __syncthreads();
    if (X.wave == 0) {
        int run[8];
#pragma unroll
        for (int e = 0; e < 8; ++e) run[e] = 0;
        const int n_ent = 2 * (t1 - t0);
        for (int b0 = 0; b0 < n_ent; b0 += 64) {
            const int li = b0 + X.lane; const bool valid = li < n_ent; const int idx = 2 * t0 + li; const int e = valid ? eid[idx] : -1;
            int rank = 0;
#pragma unroll
            for (int ee = 0; ee < 8; ++ee) { const unsigned long long m = __ballot(e == ee); if (e == ee) rank = run[ee] + __popcll(m & ((1ull << X.lane) - 1ull)); run[ee] += __popcll(m); }
            if (valid) { const int d = base[e] + pre[e] + rank; dst[li] = d; pos[idx] = d; rowtok[d] = idx >> 1; rowgate[d] = egate[idx]; }
        }
    }
    __syncthreads();
    { const int n_ent = 2 * (t1 - t0);
      for (int li = X.wave; li < n_ent; li += NWAVES) { const int tok = t0 + (li >> 1); const int d = dst[li];
          const v4u* s = (const v4u*)(H + (size_t)tok * D) + X.lane; v4u* o = (v4u*)(XS + (size_t)d * D) + X.lane;
#pragma unroll
          for (int j = 0; j < 4; ++j) o[64 * j] = s[64 * j]; } }
    if (X.c < 8) { const int e = X.c; const int r0 = base[e] + tot[e], r1 = base[e] + ((tot[e] + 255) & ~255);
        for (int r = r0 + X.wave; r < r1; r += NWAVES) { if (X.lane == 0) { rowtok[r] = -1; rowgate[r] = 0.f; }
            v4u* o = (v4u*)(XS + (size_t)r * D) + X.lane; const v4u zz = {0u, 0u, 0u, 0u};
#pragma unroll
            for (int j = 0; j < 4; ++j) o[64 * j] = zz; } }
    __syncthreads();
}

__device__ __forceinline__ void moe_final(const Ctx& X, const float* X3, const float* YS, const int* pos, const float* mods_l, float* out) {
    for (int row = X.gw; row < TL; row += X.NGW) {
        const int p0 = pos[2 * row], p1 = pos[2 * row + 1]; const float* gp = mods_l + (size_t)(row >> 12) * MODW + 5 * D;
#pragma unroll
        for (int j = 0; j < 8; ++j) { const int col = 4 * X.lane + 256 * j;
            const f32x4 a = *(const f32x4*)(YS + (size_t)p0 * D + col), b = *(const f32x4*)(YS + (size_t)p1 * D + col), x = *(const f32x4*)(X3 + (size_t)row * D + col), g = *(const f32x4*)(gp + col);
            *(f32x4*)(out + (size_t)row * D + col) = x + g * (a + b); }
    }
}

__device__ __forceinline__ const float* arg_in(int i) {
    auto kp = __builtin_amdgcn_kernarg_segment_ptr();
    asm volatile("" : "+s"(kp));
    return ((const float* const __attribute__((address_space(4)))*)kp)[i];
}
#define AIN(i) arg_in(i)
constexpr int NPHASE = 20;
#ifndef PHMASK
#define PHMASK 0xFFFFFu
#endif
#ifndef MK_CUTS
#define MK_CUTS {0, NPHASE}
#endif
constexpr int kCuts[] = MK_CUTS;
struct Args { const float* in[33]; float* out; unsigned char* ws; int ph_lo, ph_hi, li, pad; };
__global__ void __launch_bounds__(NWAVES * 64, 2) fwd_kernel(Args args) {
    extern __shared__ __attribute__((aligned(16))) unsigned char lds[];
    Ctx X;
    X.lds = (LAS unsigned char*)lds; X.tid = threadIdx.x; X.lane = X.tid & 63; X.wave = __builtin_amdgcn_readfirstlane(X.tid >> 6);
    X.G = gridDim.x; X.c = blockIdx.x; X.gw = X.c * NWAVES + X.wave; X.NGW = X.G * NWAVES;
    unsigned char* ws = args.ws;
    gu32* ctl = (gu32*)(ws + WS_CTL);
    volatile LAS unsigned* MISC = (volatile LAS unsigned*)(X.lds + MISC_OFF);
    for (int u = X.tid; u < (LDS_BYTES - LDSCTL_OFF) / 4; u += NWAVES * 64) ((LAS unsigned*)(X.lds + LDSCTL_OFF))[u] = 0u;
    __syncthreads();
    const int lo = args.ph_lo, hi = args.ph_hi;
    XcdBarrier bar; bar.bar = (unsigned*)(ctl + CW_BAR) + args.li * XCD_BAR_WORDS; bar.x = 0; bar.st = nullptr;
    if (hi - lo > 1) bar = xcd_barrier_post((unsigned*)(ctl + CW_BAR) + args.li * XCD_BAR_WORDS, MISC + 8);
#define GRID_BAR() xcd_barrier(bar)
#define IN(k) ((((PHMASK) >> (k)) & 1u) && lo <= (k) && (k) < hi)
#define BOTH(k) (IN(k) && ((k) + 1) < hi)

#define x_in (AIN(0))
#define c_in (AIN(1))
#define ctx_in (AIN(2))
#define cctx_in (AIN(3))
#define mods0 ((float*)(ws + WS_MODS))
#define mods1 ((float*)(ws + WS_MODS) + 3 * MODW)
#define lamv ((float*)(ws + WS_LAM))
#define WT_EIN ((bf16*)(ws + WS_WT_EIN))
#define WT_EOUT ((bf16*)(ws + WS_WT_EOUT))
#define WT_EF1 ((bf16*)(ws + WS_WT_EF1))
#define WT_EF2 ((bf16*)(ws + WS_WT_EF2))
#define WT_OIN ((bf16*)(ws + WS_WT_OIN))
#define WT_OOUT ((bf16*)(ws + WS_WT_OOUT))
#define WT_X1 ((bf16*)(ws + WS_WT_X1))
#define WT_X2 ((bf16*)(ws + WS_WT_X2))
#define H ((bf16*)(ws + WS_H))
#define Z ((bf16*)(ws + WS_Z))
#define QKV ((bf16*)(ws + WS_QKV))
#define PB ((float*)(ws + WS_PB))
#define OALL ((bf16*)(ws + WS_OALL))
#define X1 ((float*)(ws + WS_X1))
#define X3 ((float*)(ws + WS_X3))
#define ACT ((bf16*)(ws + WS_ACT))
#define XS ((bf16*)(ws + WS_XS))
#define ACT2 ((bf16*)(ws + WS_ACT2))
#define YS ((float*)(ws + WS_YS))
#define EID ((int*)(ws + RT_EID))
#define EGATE ((float*)(ws + RT_GATE))
#define POS ((int*)(ws + RT_POS))
#define ROWTOK ((int*)(ws + RT_ROWTOK))
#define ROWGATE ((float*)(ws + RT_ROWGATE))
#define TILE_E ((int*)(ws + RT_TILE_E))
#define NTILES ((int*)(ws + RT_NTILES))

    if (IN(0)) {
    {
        for (int task = X.c; task < 96; task += X.G) { const int l = task / 48; mod_task(X, task, c_in, cctx_in, l ? AIN(24) : AIN(6), l ? AIN(25) : AIN(7), l ? mods1 : mods0); }
        if (X.c == X.G - 1 && X.wave == 0) {
            for (int h = 0; h < 4; ++h) { const float* q1 = AIN(15) + h * 128; const float* k1 = AIN(16) + h * 128; const float* q2 = AIN(17) + h * 128; const float* k2 = AIN(18) + h * 128;
                const float s1 = wave_sum(q1[X.lane] * k1[X.lane] + q1[X.lane + 64] * k1[X.lane + 64]); const float s2 = wave_sum(q2[X.lane] * k2[X.lane] + q2[X.lane + 64] * k2[X.lane + 64]);
                if (X.lane == 0) lamv[h] = expf(s1) - expf(s2) + LAM_INIT; }
        }
        LAS float* scr = (LAS float*)(X.lds + X.wave * 16896);
        int tbase = 0;
#define TPASS(Wp, K_, N_, WTp, kind_, nexp) { constexpr int per_ = ((K_) / 64) * ((N_) / 64), tot_ = per_ * (nexp); int j_ = (X.gw - tbase) % X.NGW; if (j_ < 0) j_ += X.NGW; \
            for (; j_ < tot_; j_ += X.NGW) { const int e_ = j_ / per_, q_ = j_ - e_ * per_; transpose_item((Wp) + (size_t)e_ * (K_) * (N_), (K_), (N_), (WTp) + (size_t)e_ * (N_) * (K_), q_, (kind_), scr, X.lane); } tbase += tot_; }
        TPASS(AIN(8), D, EVEN_IN, WT_EIN, 0, 1)
        TPASS(AIN(9), D, D, WT_EOUT, 0, 1)
        TPASS(AIN(20), D, 2 * DFF, WT_EF1, 1, 1)
        TPASS(AIN(21), DFF, D, WT_EF2, 0, 1)
        TPASS(AIN(26), D, ODD_IN, WT_OIN, 0, 1)
        TPASS(AIN(27), D, D, WT_OOUT, 0, 1)
        TPASS(AIN(31), D, 2 * DFE, WT_X1, 1, NE)
        TPASS(AIN(32), DFE, D, WT_X2, 0, NE)
#undef TPASS
    }
    if (BOTH(0)) GRID_BAR();
    }
    if (IN(1)) {
    norm_mod_rows<false>(X, x_in, ctx_in, MR, AIN(4), mods0, 0, 1, H, nullptr, nullptr, nullptr);
    if (BOTH(1)) GRID_BAR();
    }
    if (IN(2)) {
    { pg8::Gemm g{H, WT_EIN, MR, EVEN_IN, D}; pg8::StaticOrder S; S.init(MR, EVEN_IN, X.G, X.c); pg8::EpiBf16 E{Z, EVEN_IN};
      pg8::gemm_phase<pg8::EpiBf16, pg8::StaticOrder, true, true>(X.lds, g, S, E); }
    if (BOTH(2)) GRID_BAR();
    }
    if (IN(3)) {
    qkv_post<NSLOT0>(X, Z, QKV, AIN(10), AIN(11), AIN(13), AIN(14));
    if (BOTH(3)) GRID_BAR();
    }
    if (IN(4)) {
    {
        const att::bf16* Q0 = (const att::bf16*)QKV;
        for (int u = X.c; u < 544; u += X.G) {
            const bool isl = u < 512; const int b = isl ? (u >> 8) : ((u - 512) >> 4), vh = isl ? ((u >> 4) & 15) : ((u - 512) & 15), qb = isl ? (u & 15) : 16;
            const int hb = vh >> 2, map = (vh >> 1) & 1, half = vh & 1;
            const att::bf16* Qp = Q0 + ((size_t)(b * NSLOT0 + 12 + 2 * hb + map) * KVR + qb * 256) * 128;
            const att::bf16* Kp = Q0 + ((size_t)(b * NSLOT0 + 20 + 2 * hb + map) * KVR) * 128;
            const att::bf16* Vp = Q0 + ((size_t)(b * NSLOT0 + 28 + 2 * hb + half) * KVR) * 128;
            float* Op = PB + ((size_t)(b * 16 + vh) * KVR + qb * 256) * 128;
            att::attn_unit<false, false>(Qp, Kp, Vp, (void*)Op, 128, 0, isl ? 68 : 0, isl ? 68 : 4, 0, -1e30f, 0.f, (char*)lds);
        }
        const int ca = (X.c + X.G - 32) % X.G;
        for (int u = ca; u < 272; u += X.G) {
            const bool isl = u < 256; const int b = isl ? (u >> 7) : ((u - 256) >> 3), h = isl ? ((u >> 4) & 7) : ((u - 256) & 7), qb = isl ? (u & 15) : 16;
            const int q0 = qb * 256; const int klo = isl ? (q0 >= 128 ? q0 - 128 : 0) : 0; const int khi = (q0 + 384) < SEQ ? (q0 + 384) : SEQ; const int nt1 = isl ? ((khi - klo) >> 6) : 0;
            const att::bf16* Qp = Q0 + ((size_t)(b * NSLOT0 + h) * KVR + q0) * 128;
            const att::bf16* Kp = Q0 + ((size_t)(b * NSLOT0 + 8 + (h >> 2)) * KVR) * 128;
            const att::bf16* Vp = Q0 + ((size_t)(b * NSLOT0 + 10 + (h >> 2)) * KVR) * 128;
            bf16* Op = OALL + (size_t)(isl ? (b * SEQ + q0) : (TL + b * CTXL)) * D + h * 128;
            const float sink = AIN(12)[h];
            att::attn_unit<true, true>(Qp, Kp, Vp, (void*)Op, D, klo, nt1, nt1 + 4, q0, sink * (1.0f / att::SCALE), 1.f, (char*)lds);
        }
    }
    if (BOTH(4)) GRID_BAR();
    }
    if (IN(5)) {
    b_combine(X, PB, lamv, AIN(19), OALL);
    if (BOTH(5)) GRID_BAR();
    }
    if (IN(6)) {
    { pg8::Gemm g{OALL, WT_EOUT, MR, D, D}; pg8::StaticOrder S; S.init(MR, D, X.G, X.c); pg8::EpiRes E{x_in, ctx_in, X1, D, mods0 + 2 * D, MODW};
      pg8::gemm_phase<pg8::EpiRes, pg8::StaticOrder, true, true>(X.lds, g, S, E); }
    if (BOTH(6)) GRID_BAR();
    }
    if (IN(7)) {
    norm_mod_rows<false>(X, X1, X1 + (size_t)TL * D, MR, AIN(5), mods0, 3, 4, H, nullptr, nullptr, nullptr);
    if (BOTH(7)) GRID_BAR();
    }
    if (IN(8)) {
    { pg8::Gemm g{H, WT_EF1, MR, 2 * DFF, D}; pg8::StaticOrder S; S.init(MR, 2 * DFF, X.G, X.c); pg8::EpiSwiglu E{ACT, DFF};
      pg8::gemm_phase<pg8::EpiSwiglu, pg8::StaticOrder, true, true>(X.lds, g, S, E); }
    if (BOTH(8)) GRID_BAR();
    }
    if (IN(9)) {
    { pg8::Gemm g{ACT, WT_EF2, MR, D, DFF}; pg8::StaticOrder S; S.init(MR, D, X.G, X.c); pg8::EpiRes E{X1, X1 + (size_t)TL * D, X1, D, mods0 + 5 * D, MODW};
      pg8::gemm_phase<pg8::EpiRes, pg8::StaticOrder, true, true>(X.lds, g, S, E); }
    if (BOTH(9)) GRID_BAR();
    }
    if (IN(10)) {
    norm_mod_rows<false>(X, X1, X1 + (size_t)TL * D, MR, AIN(22), mods1, 0, 1, H, nullptr, nullptr, nullptr);
    if (BOTH(10)) GRID_BAR();
    }
    if (IN(11)) {
    { pg8::Gemm g{H, WT_OIN, MR, ODD_IN, D}; pg8::StaticOrder S; S.init(MR, ODD_IN, X.G, X.c); pg8::EpiBf16 E{Z, ODD_IN};
      pg8::gemm_phase<pg8::EpiBf16, pg8::StaticOrder, true, true>(X.lds, g, S, E); }
    if (BOTH(11)) GRID_BAR();
    }
    if (IN(12)) {
    qkv_post<NSLOT1>(X, Z, QKV, AIN(28), AIN(29), nullptr, nullptr);
    if (BOTH(12)) GRID_BAR();
    }
    if (IN(13)) {
    {
        const att::bf16* Q0 = (const att::bf16*)QKV;
        for (int u = X.c; u < 512; u += X.G) {
            const int b = u >> 8, h = (u >> 4) & 15, qb = u & 15;
            const att::bf16* Qp = Q0 + ((size_t)(b * NSLOT1 + h) * KVR + qb * 256) * 128;
            const att::bf16* Kp = Q0 + ((size_t)(b * NSLOT1 + 16 + (h >> 2)) * KVR) * 128;
            const att::bf16* Vp = Q0 + ((size_t)(b * NSLOT1 + 20 + (h >> 2)) * KVR) * 128;
            bf16* Op = OALL + (size_t)(b * SEQ + qb * 256) * D + h * 128;
            const int ntc = 68 + (X.G >> 20);
            att::attn_unit<false, true>(Qp, Kp, Vp, (void*)Op, D, 0, ntc, ntc, 0, -1e30f, 0.f, (char*)lds);
        }
    }
    if (BOTH(13)) GRID_BAR();
    }
    if (IN(14)) {
    { pg8::Gemm g{OALL, WT_OOUT, TL, D, D}; pg8::StaticOrder S; S.init(TL, D, X.G, X.c); pg8::EpiRes E{X1, X1, X3, D, mods1 + 2 * D, MODW};
      pg8::gemm_phase<pg8::EpiRes, pg8::StaticOrder, true, true>(X.lds, g, S, E); }
    if (BOTH(14)) GRID_BAR();
    }
    if (IN(15)) {
    norm_mod_rows<true>(X, X3, X3, TL, AIN(23), mods1, 3, 4, H, AIN(30), EID, EGATE);
    if (BOTH(15)) GRID_BAR();
    }
    if (IN(16)) {
    moe_route(X, EID, EGATE, H, XS, POS, ROWTOK, ROWGATE, TILE_E, NTILES);
    if (BOTH(16)) GRID_BAR();
    }
    if (IN(17)) {
    { const int nt = *(volatile int*)NTILES; pg8::Gemm g{XS, WT_X1, XROWS, 2 * DFE, D}; pg8::MoeOrder S; S.init(nt, 2 * DFE / 256, X.G, X.c, TILE_E); pg8::EpiSwiglu E{ACT2, DFE};
      pg8::gemm_phase<pg8::EpiSwiglu, pg8::MoeOrder, true, true>(X.lds, g, S, E); }
    if (BOTH(17)) GRID_BAR();
    }
    if (IN(18)) {
    { const int nt = *(volatile int*)NTILES; pg8::Gemm g{ACT2, WT_X2, XROWS, D, DFE}; pg8::MoeOrder S; S.init(nt, D / 256, X.G, X.c, TILE_E); pg8::EpiRowScale E{YS, D, ROWGATE};
      pg8::gemm_phase<pg8::EpiRowScale, pg8::MoeOrder, true, true>(X.lds, g, S, E); }
    if (BOTH(18)) GRID_BAR();
    }
    if (IN(19)) {
    moe_final(X, X3, YS, POS, mods1, args.out);
    }
}

extern "C" void kernel_launch(void* const* d_in, const int* in_sizes, int n_in, void* d_out, int out_size, void* d_ws, size_t ws_size, hipStream_t stream) {
    static int grid = 0;
    if (grid == 0) {
        if (n_in != 33 || in_sizes[0] != TL * D || out_size != TL * D || ws_size < WS_END) { fprintf(stderr, "kernel_launch: unexpected shapes (n_in %d, in0 %d, out %d, ws %zu)\n", n_in, n_in > 0 ? in_sizes[0] : -1, out_size, ws_size); grid = -1; return; }
        int dev = 0, cus = 0, per_cu = 0;
        if (hipGetDevice(&dev) != hipSuccess || hipDeviceGetAttribute(&cus, hipDeviceAttributeMultiprocessorCount, dev) != hipSuccess) { grid = -1; return; }
        if (hipFuncSetAttribute((const void*)fwd_kernel, hipFuncAttributeMaxDynamicSharedMemorySize, LDS_BYTES) != hipSuccess) { fprintf(stderr, "kernel_launch: hipFuncSetAttribute failed\n"); grid = -1; return; }
        if (hipOccupancyMaxActiveBlocksPerMultiprocessor(&per_cu, (const void*)fwd_kernel, NWAVES * 64, LDS_BYTES) != hipSuccess || per_cu < 1) { fprintf(stderr, "kernel_launch: occupancy query says %d blocks per CU\n", per_cu); }
        (void)hipGetLastError();
        grid = cus;
    }
    if (grid < 0) return;
    if (hipMemsetAsync((char*)d_ws + WS_CTL, 0, CTL_ZERO_BYTES, stream) != hipSuccess) return;
    Args a{};
    for (int i = 0; i < 33; ++i) a.in[i] = (const float*)d_in[i];
    a.out = (float*)d_out; a.ws = (unsigned char*)d_ws;
    constexpr int NCUT = sizeof(kCuts) / sizeof(kCuts[0]);
    for (int li = 0; li + 1 < NCUT; ++li) {
        a.ph_lo = kCuts[li]; a.ph_hi = kCuts[li + 1]; a.li = li; a.pad = 0;
        hipLaunchKernelGGL(fwd_kernel, dim3(grid), dim3(NWAVES * 64), LDS_BYTES, stream, a);
        const hipError_t le = hipPeekAtLastError();
        if (le != hipSuccess) { fprintf(stderr, "kernel_launch: launch %d failed: %s\n", li, hipGetErrorName(le)); break; }
    }
}
```

```cpp
#include <hip/hip_runtime.h>
#include <hip/hip_bf16.h>
#include <cstdio>
#include <cstdint>

namespace pg8 {
#define PG8_LAS __attribute__((address_space(3)))
typedef unsigned short bf16_t;
typedef short bf16x8 __attribute__((ext_vector_type(8)));
typedef float f32x4 __attribute__((ext_vector_type(4)));
typedef unsigned u32x4 __attribute__((ext_vector_type(4)));
constexpr int BM = 256, BK = 64, HALF = 128, HTB = HALF * BK * 2  , STAGE_BYTES = 8 * HTB, NXCD = 8, WGM = 8;

__host__ __device__ __forceinline__ int lds_byte(int r, int c) { const int st = (r >> 4) * 2 + (c >> 5), rr = r & 15, cc = c & 31, ob = rr * 64 + cc * 2; return st * 1024 + (ob ^ (((ob >> 9) & 1) << 5)); }
__host__ __device__ __forceinline__ void stage_rc(int b, int& R, int& C) { const int st = b / 1024, sb = b % 1024, swz = sb ^ (((sb >> 9) & 1) << 5); R = (st >> 1) * 16 + swz / 64; C = (st & 1) * 32 + (swz % 64) / 2; }
__host__ __device__ __forceinline__ int perm32(int rho) { const int n = rho >> 4, i = rho & 15; return 8 * (i >> 2) + 4 * n + (i & 3); }

struct Unit { int pm, pn, pnb, kt0, nkt, part; };
struct Gemm { const bf16_t* A; const bf16_t* Bt; int M, N, K; };

struct StaticOrder {
    int nM, nN, nwg, G, c, KT;
    __host__ __device__ __forceinline__ void init(int M, int N, int K, int G_, int c_) { nM = M / BM; nN = N / BM; nwg = nM * nN; G = G_; c = c_; KT = K / BK; }
    __host__ __device__ __forceinline__ bool next(int i, Unit& u) const {
        const long L = (long)i * G + c; if (L >= nwg) return false;
        int wgid = (int)L; { const int q = nwg / NXCD, r = nwg % NXCD, xcd = wgid % NXCD, off = wgid / NXCD; wgid = (xcd < r ? xcd * (q + 1) : r * (q + 1) + (xcd - r) * q) + off; }
        const int nig = WGM * nN, gid = wgid / nig, fm = gid * WGM, gsz = (nM - fm) < WGM ? (nM - fm) : WGM;
        u.pm = fm + ((wgid % nig) % gsz); u.pn = (wgid % nig) / gsz; u.pnb = u.pn; u.kt0 = 0; u.nkt = KT; u.part = -1; return true;
    }
    __device__ __forceinline__ void a_ready(const Unit&) const {}
    __device__ __forceinline__ void done(const Unit&) const {}
};
__host__ __device__ __forceinline__ void tail_split(int G, int T, int KT, int& Sp, int& ppair) {
    if (T <= 0) { Sp = 0; ppair = 0; return; }
    int S = G / T; if (S < 1) S = 1; const int pairs = KT >> 1; ppair = (pairs + S - 1) / S; if (ppair < 2) ppair = 2; Sp = (pairs + ppair - 1) / ppair;
}
struct TailOrder {
    StaticOrder so; int T, Sp, ppair; const int* tile_e;
    __device__ __forceinline__ void init(int nMm, int nTm, int nN, int KT, int G_, int c_, const int* te) { so.nM = nMm; so.nN = nN; so.nwg = nMm * nN; so.G = G_; so.c = c_; so.KT = KT; T = nTm * nN; tile_e = te; tail_split(G_, T, KT, Sp, ppair); }
    __device__ __forceinline__ bool next(int i, Unit& u) const {
        const int nm = so.c < so.nwg ? (so.nwg - so.c + so.G - 1) / so.G : 0;
        const int cc = so.G - 1 - so.c;
        int pm, pn, kt0 = 0, nkt = so.KT, part = -1;
        if (i < nm) { Unit t; so.next(i, t); pm = t.pm; pn = t.pn; }
        else if (i == nm && cc < T * Sp) { const int tu = cc / Sp, j = cc - tu * Sp; pm = so.nM + tu / so.nN; pn = tu % so.nN; kt0 = 2 * ppair * j; nkt = (so.KT - kt0) < 2 * ppair ? (so.KT - kt0) : 2 * ppair; part = j; }
        else return false;
        int e = 0; if (tile_e) e = __builtin_amdgcn_readfirstlane(tile_e[pm]);
        u.pm = pm; u.pn = pn; u.pnb = e * so.nN + pn; u.kt0 = kt0; u.nkt = nkt; u.part = part; return true;
    }
    __device__ __forceinline__ void a_ready(const Unit&) const {}
    __device__ __forceinline__ void done(const Unit&) const {}
};

__device__ __forceinline__ unsigned cvt_pk_bf16(float lo, float hi) { unsigned r; asm volatile("v_cvt_pk_bf16_f32 %0, %1, %2" : "=v"(r) : "v"(lo), "v"(hi)); return r; }

struct EpiBf16 {
    static constexpr bool PERM = true, AFTER_DRAIN = false;
    bf16_t* O; int ldc;
    __device__ __forceinline__ void operator()(const f32x4 (&acc)[2][2][4][2], const Unit& u, int wr, int wc, int fr, int fq) const {
        const int row0 = u.pm * BM + wr * 64 + fr; const int col0 = u.pn * BM + wc * 32 + 8 * fq;
#pragma unroll
        for (int ai = 0; ai < 2; ++ai)
#pragma unroll
            for (int m = 0; m < 4; ++m) { bf16_t* rowp = O + (size_t)(row0 + ai * HALF + m * 16) * ldc + col0;
#pragma unroll
                for (int bj = 0; bj < 2; ++bj) { const f32x4 v0 = acc[ai][bj][m][0], v1 = acc[ai][bj][m][1];
                    u32x4 w; w.x = cvt_pk_bf16(v0[0], v0[1]); w.y = cvt_pk_bf16(v0[2], v0[3]); w.z = cvt_pk_bf16(v1[0], v1[1]); w.w = cvt_pk_bf16(v1[2], v1[3]);
                    *(u32x4*)(rowp + bj * HALF) = w; } }
    }
};
__device__ __forceinline__ float silu_mul(float g, float u) { return g * u * __builtin_amdgcn_rcpf(1.0f + __builtin_amdgcn_exp2f(-1.4426950408889634f * g)); }
struct EpiSwiglu {
    static constexpr bool PERM = true, AFTER_DRAIN = false;
    bf16_t* O; int ldc;
    __device__ __forceinline__ void operator()(const f32x4 (&acc)[2][2][4][2], const Unit& u, int wr, int wc, int fr, int fq) const {
        const int row0 = u.pm * BM + wr * 64 + fr; const int col0 = u.pn * HALF + wc * 32 + 8 * fq;
#pragma unroll
        for (int ai = 0; ai < 2; ++ai)
#pragma unroll
            for (int m = 0; m < 4; ++m) { bf16_t* rowp = O + (size_t)(row0 + ai * HALF + m * 16) * ldc + col0;
                const f32x4 g0 = acc[ai][0][m][0], g1 = acc[ai][0][m][1], u0 = acc[ai][1][m][0], u1 = acc[ai][1][m][1];
                u32x4 w; w.x = cvt_pk_bf16(silu_mul(g0[0], u0[0]), silu_mul(g0[1], u0[1])); w.y = cvt_pk_bf16(silu_mul(g0[2], u0[2]), silu_mul(g0[3], u0[3]));
                w.z = cvt_pk_bf16(silu_mul(g1[0], u1[0]), silu_mul(g1[1], u1[1])); w.w = cvt_pk_bf16(silu_mul(g1[2], u1[2]), silu_mul(g1[3], u1[3]));
                *(u32x4*)rowp = w; }
    }
};
struct EpiRes {
    static constexpr bool PERM = false, AFTER_DRAIN = false;
    const float* base_lat; const float* base_ctx; float* out; int ldc; const float* gate; int gate_stride;
    float* part; int part_row0, part_rows;
    __device__ __forceinline__ void operator()(const f32x4 (&acc)[2][2][4][2], const Unit& u, int wr, int wc, int fr, int fq) const {
        if (u.part >= 0) {
            float* pp = part + ((long)u.part * part_rows + (u.pm * BM - part_row0)) * (long)ldc; const int rl0 = wr * 64 + fr, col0 = u.pn * BM + wc * 32 + 4 * fq;
#pragma unroll
            for (int ai = 0; ai < 2; ++ai)
#pragma unroll
                for (int m = 0; m < 4; ++m) { const size_t ro = (size_t)(rl0 + ai * HALF + m * 16) * ldc;
#pragma unroll
                    for (int bj = 0; bj < 2; ++bj)
#pragma unroll
                        for (int n = 0; n < 2; ++n) *(f32x4*)(pp + ro + col0 + bj * HALF + 16 * n) = acc[ai][bj][m][n]; }
            return;
        }
        const int prow = u.pm * BM; const int cond = prow < 4096 ? 0 : (prow < 8192 ? 1 : 2);
        const float* bp = prow < 8192 ? base_lat + (size_t)prow * ldc : base_ctx + (size_t)(prow - 8192) * ldc;
        float* op = out + (size_t)prow * ldc; const float* gp = gate + (size_t)cond * gate_stride;
        const int rl0 = wr * 64 + fr, col0 = u.pn * BM + wc * 32 + 4 * fq;
        f32x4 gv[2][2];
#pragma unroll
        for (int bj = 0; bj < 2; ++bj)
#pragma unroll
            for (int n = 0; n < 2; ++n) gv[bj][n] = *(const f32x4*)(gp + col0 + bj * HALF + 16 * n);
#pragma unroll
        for (int ai = 0; ai < 2; ++ai)
#pragma unroll
            for (int m = 0; m < 4; ++m) { const size_t ro = (size_t)(rl0 + ai * HALF + m * 16) * ldc;
#pragma unroll
                for (int bj = 0; bj < 2; ++bj)
#pragma unroll
                    for (int n = 0; n < 2; ++n) { const int col = col0 + bj * HALF + 16 * n; const f32x4 b = *(const f32x4*)(bp + ro + col);
                        *(f32x4*)(op + ro + col) = b + gv[bj][n] * acc[ai][bj][m][n]; } }
    }
};
struct EpiRowScale {
    static constexpr bool PERM = false, AFTER_DRAIN = false;
    float* out; int ldc; const float* rs; float* part; int part_row0, part_rows;
    __device__ __forceinline__ void operator()(const f32x4 (&acc)[2][2][4][2], const Unit& u, int wr, int wc, int fr, int fq) const {
        const int row0 = u.pm * BM + wr * 64 + fr, col0 = u.pn * BM + wc * 32 + 4 * fq;
        float* ob = u.part >= 0 ? part + ((long)u.part * part_rows - part_row0) * (long)ldc : out;
#pragma unroll
        for (int ai = 0; ai < 2; ++ai)
#pragma unroll
            for (int m = 0; m < 4; ++m) { const int row = row0 + ai * HALF + m * 16; const float s = rs[row]; float* rp = ob + (size_t)row * ldc + col0;
#pragma unroll
                for (int bj = 0; bj < 2; ++bj)
#pragma unroll
                    for (int n = 0; n < 2; ++n) *(f32x4*)(rp + bj * HALF + 16 * n) = acc[ai][bj][m][n] * s; }
    }
};

template <class Epi, class Sched, bool ALIGN_EPI = false, bool SP2 = false>
__device__ __forceinline__ void gemm_phase(PG8_LAS unsigned char* lds, const Gemm g, const Sched& S, const Epi& E) {
    const int tid = threadIdx.x, wid = __builtin_amdgcn_readfirstlane(tid >> 6), lane = tid & 63, wr = wid >> 2, wc = wid & 3, fr = lane & 15, fq = lane >> 4;
    const int K = g.K;
    unsigned voffA[2], voffB[2];
#pragma unroll
    for (int i = 0; i < 2; ++i) { int R, C; stage_rc(tid * 16 + i * 8192, R, C); const int Rb = Epi::PERM ? ((R & ~31) + perm32(R & 31)) : R;
        voffA[i] = (unsigned)(R * K + C) * 2u; voffB[i] = (unsigned)(Rb * K + C) * 2u; }
    const size_t kstep = (size_t)(BK * 2);
    const size_t hstep = (size_t)HALF * K * 2;
    const size_t tstep = 2 * hstep;
    const unsigned ldsw = (unsigned)wid * 1024u;
    const int aoff = lds_byte(wr * 64 + fr, fq * 8), boff = lds_byte(wc * 32 + fr, fq * 8);
#define PG8_SA(b, h) (((b) * 2 + (h)) * HTB)
#define PG8_SB(b, h) ((4 + (b) * 2 + (h)) * HTB)
#define PG8_STAGE(bufoff, gbase, voff) do { _Pragma("unroll") for (int _i = 0; _i < 2; ++_i) \
        __builtin_amdgcn_global_load_lds((const unsigned*)((const char*)(gbase) + (voff)[_i]), (PG8_LAS unsigned*)(lds + (bufoff) + ldsw + _i * 8192), 16, 0, 0); } while (0)
#define PG8_LDA(dst, b, h) do { _Pragma("unroll") for (int m = 0; m < 4; ++m) _Pragma("unroll") for (int k = 0; k < 2; ++k) dst[m][k] = *(const PG8_LAS bf16x8*)(lds + PG8_SA(b, h) + aoff + m * 2048 + k * 1024); } while (0)
#define PG8_LDB(dst, b, h) do { _Pragma("unroll") for (int n = 0; n < 2; ++n) _Pragma("unroll") for (int k = 0; k < 2; ++k) dst[n][k] = *(const PG8_LAS bf16x8*)(lds + PG8_SB(b, h) + boff + n * 2048 + k * 1024); } while (0)
#define PG8_MMA(ai, bj, At, Bt) do { __builtin_amdgcn_s_setprio(1); _Pragma("unroll") for (int m = 0; m < 4; ++m) _Pragma("unroll") for (int n = 0; n < 2; ++n) _Pragma("unroll") for (int k = 0; k < 2; ++k) \
        acc[ai][bj][m][n] = __builtin_amdgcn_mfma_f32_16x16x32_bf16(Bt[n][k], At[m][k], acc[ai][bj][m][n], 0, 0, 0); __builtin_amdgcn_s_setprio(0); } while (0)
#define PG8_WAIT_V(n) asm volatile("s_waitcnt vmcnt(" #n ")" ::: "memory")
#define PG8_WAIT_L(n) asm volatile("s_waitcnt lgkmcnt(" #n ")" ::: "memory")
#define PG8_BAR __builtin_amdgcn_s_barrier()
#define PG8_SCHED __builtin_amdgcn_sched_barrier(0)
    Unit cur, nxt; int ui = 0;
    if (!S.next(0, cur)) return;
    f32x4 acc[2][2][4][2];
#pragma unroll
    for (int a = 0; a < 2; ++a)
#pragma unroll
        for (int b = 0; b < 2; ++b)
#pragma unroll
            for (int m = 0; m < 4; ++m)
#pragma unroll
                for (int n = 0; n < 2; ++n) acc[a][b][m][n] = (f32x4){0.f, 0.f, 0.f, 0.f};
    bf16x8 At[4][2], B0[2][2], B1[2][2];
    const char* cA = (const char*)g.A + (size_t)cur.pm * tstep + (size_t)cur.kt0 * kstep; const char* cB = (const char*)g.Bt + (size_t)cur.pnb * tstep + (size_t)cur.kt0 * kstep;
    S.a_ready(cur);
    if constexpr (SP2) {
        PG8_STAGE(PG8_SB(0, 0), cB, voffB); PG8_STAGE(PG8_SB(0, 1), cB + hstep, voffB); PG8_STAGE(PG8_SA(0, 0), cA, voffA); PG8_STAGE(PG8_SA(0, 1), cA + hstep, voffA);
        if (wr == 1) PG8_BAR;
        PG8_WAIT_V(2); PG8_BAR;
        PG8_STAGE(PG8_SB(1, 0), cB + kstep, voffB); PG8_STAGE(PG8_SA(1, 0), cA + kstep, voffA); PG8_STAGE(PG8_SB(1, 1), cB + hstep + kstep, voffB);
        PG8_WAIT_V(6); PG8_BAR;
    } else {
        PG8_STAGE(PG8_SB(0, 0), cB, voffB); PG8_STAGE(PG8_SA(0, 0), cA, voffA); PG8_STAGE(PG8_SB(0, 1), cB + hstep, voffB); PG8_STAGE(PG8_SA(0, 1), cA + hstep, voffA);
        if (wr == 1) PG8_BAR;
        PG8_WAIT_V(4); PG8_BAR;
        PG8_STAGE(PG8_SB(1, 0), cB + kstep, voffB); PG8_STAGE(PG8_SA(1, 0), cA + kstep, voffA); PG8_STAGE(PG8_SB(1, 1), cB + hstep + kstep, voffB);
        PG8_WAIT_V(6); PG8_BAR;
    }
    for (;;) {
        const bool has_next = S.next(ui + 1, nxt);
        const char* nA = has_next ? (const char*)g.A + (size_t)nxt.pm * tstep + (size_t)nxt.kt0 * kstep : cA; const char* nB = has_next ? (const char*)g.Bt + (size_t)nxt.pnb * tstep + (size_t)nxt.kt0 * kstep : cB;
        const int nt = cur.nkt;
        for (int t = 0; t < nt; t += 2) {
            const bool last = (t == nt - 2);
            const char* a1 = cA + (size_t)(t + 1) * kstep;
            const char* a2 = last ? nA : cA + (size_t)(t + 2) * kstep; const char* b2 = last ? nB : cB + (size_t)(t + 2) * kstep;
            const char* a3 = a2 + kstep; const char* b3 = b2 + kstep;
            if (last && has_next) S.a_ready(nxt);
            if constexpr (SP2) {
            PG8_LDB(B0, 0, 0); PG8_LDB(B1, 0, 1); PG8_SCHED; PG8_LDA(At, 0, 0); PG8_STAGE(PG8_SA(1, 1), a1 + hstep, voffA);
            PG8_WAIT_V(8); PG8_WAIT_L(0); PG8_BAR; PG8_MMA(0, 0, At, B0); PG8_MMA(0, 1, At, B1); PG8_BAR; PG8_SCHED;
            PG8_LDA(At, 0, 1); PG8_STAGE(PG8_SB(0, 0), b2, voffB); PG8_STAGE(PG8_SB(0, 1), b2 + hstep, voffB); PG8_STAGE(PG8_SA(0, 0), a2, voffA);
            PG8_WAIT_V(8); PG8_WAIT_L(0); PG8_BAR; PG8_MMA(1, 0, At, B0); PG8_MMA(1, 1, At, B1); PG8_BAR; PG8_SCHED;
            PG8_LDB(B0, 1, 0); PG8_LDB(B1, 1, 1); PG8_SCHED; PG8_LDA(At, 1, 0); PG8_STAGE(PG8_SA(0, 1), a2 + hstep, voffA);
            PG8_WAIT_V(8); PG8_WAIT_L(0); PG8_BAR; PG8_MMA(0, 0, At, B0); PG8_MMA(0, 1, At, B1); PG8_BAR; PG8_SCHED;
            PG8_LDA(At, 1, 1); PG8_STAGE(PG8_SB(1, 0), b3, voffB); PG8_STAGE(PG8_SB(1, 1), b3 + hstep, voffB); PG8_STAGE(PG8_SA(1, 0), a3, voffA);
            PG8_WAIT_V(8); PG8_WAIT_L(0); PG8_BAR; PG8_MMA(1, 0, At, B0); PG8_MMA(1, 1, At, B1); PG8_BAR; PG8_SCHED;
            } else {
            PG8_LDB(B0, 0, 0); PG8_SCHED; PG8_LDA(At, 0, 0); PG8_STAGE(PG8_SA(1, 1), a1 + hstep, voffA);
            PG8_WAIT_L(8); PG8_BAR; PG8_WAIT_L(0); PG8_MMA(0, 0, At, B0); PG8_BAR; PG8_SCHED;
            PG8_LDB(B1, 0, 1); PG8_STAGE(PG8_SB(0, 0), b2, voffB);
            PG8_BAR; PG8_WAIT_L(0); PG8_MMA(0, 1, At, B1); PG8_BAR;
            PG8_LDA(At, 0, 1); PG8_STAGE(PG8_SA(0, 0), a2, voffA);
            PG8_BAR; PG8_WAIT_L(0); PG8_MMA(1, 0, At, B0); PG8_BAR; PG8_SCHED;
            PG8_STAGE(PG8_SB(0, 1), b2 + hstep, voffB);
            PG8_WAIT_V(6); PG8_BAR; PG8_MMA(1, 1, At, B1); PG8_BAR;
            PG8_LDB(B0, 1, 0); PG8_SCHED; PG8_LDA(At, 1, 0); PG8_STAGE(PG8_SA(0, 1), a2 + hstep, voffA);
            PG8_WAIT_L(8); PG8_BAR; PG8_WAIT_L(0); PG8_MMA(0, 0, At, B0); PG8_BAR; PG8_SCHED;
            PG8_LDB(B1, 1, 1); PG8_STAGE(PG8_SB(1, 0), b3, voffB);
            PG8_BAR; PG8_WAIT_L(0); PG8_MMA(0, 1, At, B1); PG8_BAR;
            PG8_LDA(At, 1, 1); PG8_STAGE(PG8_SA(1, 0), a3, voffA);
            PG8_BAR; PG8_WAIT_L(0); PG8_MMA(1, 0, At, B0); PG8_BAR; PG8_SCHED;
            PG8_STAGE(PG8_SB(1, 1), b3 + hstep, voffB);
            PG8_WAIT_V(6); PG8_BAR; PG8_MMA(1, 1, At, B1); PG8_BAR;
            }
        }
        if constexpr (ALIGN_EPI) { if (wr == 0) PG8_BAR; }
        if constexpr (!Epi::AFTER_DRAIN) { E(acc, cur, wr, wc, fr, fq); S.done(cur); }
        if (!has_next) break;
#pragma unroll
        for (int a = 0; a < 2; ++a)
#pragma unroll
            for (int b = 0; b < 2; ++b)
#pragma unroll
                for (int m = 0; m < 4; ++m)
#pragma unroll
                    for (int n = 0; n < 2; ++n) acc[a][b][m][n] = (f32x4){0.f, 0.f, 0.f, 0.f};
        cur = nxt; cA = nA; cB = nB; ++ui;
        if constexpr (ALIGN_EPI) { if (wr == 1) PG8_BAR; }
    }
    PG8_WAIT_V(0);
    if constexpr (!ALIGN_EPI) { if (wr == 0) PG8_BAR; }
    PG8_BAR;
    if constexpr (Epi::AFTER_DRAIN) { E.fused(acc, cur, wr, wc, fr, fq, lds, wid, lane); S.done(cur); }
#undef PG8_SA
#undef PG8_SB
#undef PG8_STAGE
#undef PG8_LDA
#undef PG8_LDB
#undef PG8_MMA
#undef PG8_WAIT_V
#undef PG8_WAIT_L
#undef PG8_BAR
#undef PG8_SCHED
}
}


namespace att {
using bf16 = __hip_bfloat16;
constexpr int   D = 128, NW = 8, QBLK = 32, KVBLK = 64;
constexpr float SCALE = 0.088388347648318440f;
constexpr float THR = 8.f;
constexpr int LDQ = 128, LDK = 128;
constexpr size_t SHM_V = KVBLK * D * 2, SHM_K = KVBLK * D * 2, SHM_ATTN = 2 * SHM_V + 2 * SHM_K + NW * 64 * 4;
using bf16x8 = __attribute__((ext_vector_type(8))) short;
using s16x4  = __attribute__((ext_vector_type(4))) short;
using f32x16 = __attribute__((ext_vector_type(16))) float;
using u32x4  = __attribute__((ext_vector_type(4))) unsigned;
#define KSWZ(row, colB) ((row) * 256 + ((colB) ^ (((row) & 7) << 4)))
#define SBAR() __builtin_amdgcn_sched_barrier(0)
__device__ __forceinline__ int crow(int r, int hi) { return (r & 3) + 8 * (r >> 2) + 4 * hi; }
__device__ __forceinline__ unsigned cvtpk(float lo, float hi) {
  unsigned r; asm volatile("v_cvt_pk_bf16_f32 %0, %1, %2" : "=v"(r) : "v"(lo), "v"(hi)); return r;
}
__device__ __forceinline__ void partialSM(f32x16& p0, f32x16& p1, float& m_reg, float& mn, float& alpha) {
  constexpr float C = SCALE * 1.4426950408889634f;
  float pmax = p0[0];
#pragma unroll
  for (int r = 1; r < 16; ++r) pmax = fmaxf(pmax, p0[r]);
#pragma unroll
  for (int r = 0; r < 16; ++r) pmax = fmaxf(pmax, p1[r]);
  { auto rr = __builtin_amdgcn_permlane32_swap(__float_as_uint(pmax), __float_as_uint(pmax), false, false);
    pmax = fmaxf(__uint_as_float(rr[0]), __uint_as_float(rr[1])); }
  if (__builtin_expect(__all(pmax - m_reg <= THR / SCALE), 1)) { mn = m_reg; alpha = 1.f; }
  else { mn = fmaxf(m_reg, pmax); alpha = __builtin_amdgcn_exp2f((m_reg - mn) * C); m_reg = mn; }
  float mnC = -mn * C;
#pragma unroll
  for (int r = 0; r < 16; ++r) p0[r] = fmaf(p0[r], C, mnC);
#pragma unroll
  for (int r = 0; r < 16; ++r) p1[r] = fmaf(p1[r], C, mnC);
#pragma unroll
  for (int r = 0; r < 16; ++r) p0[r] = __builtin_amdgcn_exp2f(p0[r]);
}
__device__ __forceinline__ void finishSM(f32x16& p0, f32x16& p1, float alpha, float& l_reg, bf16x8& pa0, bf16x8& pa1, bf16x8& pa2, bf16x8& pa3) {
#pragma unroll
  for (int r = 0; r < 16; ++r) p1[r] = __builtin_amdgcn_exp2f(p1[r]);
  float ps = 0;
#pragma unroll
  for (int r = 0; r < 16; ++r) ps += p0[r];
#pragma unroll
  for (int r = 0; r < 16; ++r) ps += p1[r];
  { auto rr = __builtin_amdgcn_permlane32_swap(__float_as_uint(ps), __float_as_uint(ps), false, false);
    ps = __uint_as_float(rr[0]) + __uint_as_float(rr[1]); }
  l_reg = l_reg * alpha + ps;
#define PK4(P, BASE, OUT) do { unsigned a0 = cvtpk(P[BASE + 0], P[BASE + 1]), a1 = cvtpk(P[BASE + 2], P[BASE + 3]);   \
    unsigned b0 = cvtpk(P[BASE + 4], P[BASE + 5]), b1 = cvtpk(P[BASE + 6], P[BASE + 7]);                              \
    auto r0 = __builtin_amdgcn_permlane32_swap(a0, b0, false, false); auto r1 = __builtin_amdgcn_permlane32_swap(a1, b1, false, false); \
    u32x4 w = {r0[0], r1[0], r0[1], r1[1]}; OUT = *reinterpret_cast<bf16x8*>(&w); } while (0)
  PK4(p0, 0, pa0); PK4(p0, 8, pa1); PK4(p1, 0, pa2); PK4(p1, 8, pa3);
#undef PK4
}
__device__ __forceinline__ void qkt(f32x16& p0, f32x16& p1, const bf16* Ks, const bf16x8* qr, int r32, int hi) {
  p0 = f32x16{}; p1 = f32x16{};
#pragma unroll
  for (int d0 = 0; d0 < 8; ++d0) { int cb = (d0 * 16 + hi * 8) * 2;
    bf16x8 b0 = *reinterpret_cast<const bf16x8*>((const char*)Ks + KSWZ(r32, cb));
    bf16x8 b1 = *reinterpret_cast<const bf16x8*>((const char*)Ks + KSWZ(32 + r32, cb));
    p0 = __builtin_amdgcn_mfma_f32_32x32x16_bf16(b0, qr[d0], p0, 0, 0, 0);
    p1 = __builtin_amdgcn_mfma_f32_32x32x16_bf16(b1, qr[d0], p1, 0, 0, 0); }
}
__device__ __forceinline__ void maskt(f32x16& p0, f32x16& p1, int kbase, int qpos, int hi) {
#pragma unroll
  for (int r = 0; r < 16; ++r) { const int d0 = qpos - (kbase + crow(r, hi)); const int d1 = d0 - 32;
    if (d0 > 128 || d0 < -128) p0[r] = -1e30f;
    if (d1 > 128 || d1 < -128) p1[r] = -1e30f; }
}
__device__ __forceinline__ int v_st(int k, int c) { const int kk = (k & ~0xC) | ((k & 4) << 1) | ((k & 8) >> 1); return ((kk >> 3) * 4 + (c >> 5)) * 512 + ((kk & 7) * 32 + (c & 31)) * 2; }
__device__ __forceinline__ int v_rd_base(int lane) { return ((lane & 3) << 3) | (((lane >> 2) & 3) << 6) | (((lane >> 4) & 1) << 5) | (((lane >> 5) & 1) << 8); }
constexpr int v_rd_off(int d0, int ks, int half) { return d0 * 512 + ks * 4096 + half * 2048; }
template <int OFF> __device__ __forceinline__ s16x4 tr_read(int vb) {
  s16x4 r; asm volatile("ds_read_b64_tr_b16 %0, %1 offset:%2" : "=&v"(r) : "v"(vb), "i"(OFF) : "memory"); return r;
}
template <int D0> __device__ __forceinline__ void pv_one(f32x16& od, int vb, bf16x8 pa0, bf16x8 pa1, bf16x8 pa2, bf16x8 pa3) {
  const s16x4 l0 = tr_read<v_rd_off(D0, 0, 0)>(vb), h0 = tr_read<v_rd_off(D0, 0, 1)>(vb), l1 = tr_read<v_rd_off(D0, 1, 0)>(vb), h1 = tr_read<v_rd_off(D0, 1, 1)>(vb);
  const s16x4 l2 = tr_read<v_rd_off(D0, 2, 0)>(vb), h2 = tr_read<v_rd_off(D0, 2, 1)>(vb), l3 = tr_read<v_rd_off(D0, 3, 0)>(vb), h3 = tr_read<v_rd_off(D0, 3, 1)>(vb);
  asm volatile("s_waitcnt lgkmcnt(0)" ::: "memory"); SBAR();
#define PK(L, H) (bf16x8){L[0], L[1], L[2], L[3], H[0], H[1], H[2], H[3]}
  od = __builtin_amdgcn_mfma_f32_32x32x16_bf16(pa0, PK(l0, h0), od, 0, 0, 0);
  od = __builtin_amdgcn_mfma_f32_32x32x16_bf16(pa1, PK(l1, h1), od, 0, 0, 0);
  od = __builtin_amdgcn_mfma_f32_32x32x16_bf16(pa2, PK(l2, h2), od, 0, 0, 0);
  od = __builtin_amdgcn_mfma_f32_32x32x16_bf16(pa3, PK(l3, h3), od, 0, 0, 0);
#undef PK
}
__device__ __forceinline__ void pv_d0(f32x16* o, int vb, bf16x8 pa0, bf16x8 pa1, bf16x8 pa2, bf16x8 pa3) {
  pv_one<0>(o[0], vb, pa0, pa1, pa2, pa3); pv_one<1>(o[1], vb, pa0, pa1, pa2, pa3); pv_one<2>(o[2], vb, pa0, pa1, pa2, pa3); pv_one<3>(o[3], vb, pa0, pa1, pa2, pa3);
}

template <bool MASK, bool OUT_BF16>
__device__ __forceinline__ void attn_unit(const bf16* __restrict__ Qb, const bf16* __restrict__ Kh, const bf16* __restrict__ Vh, void* __restrict__ Ob, int ldo,
                                          int klo, int nt1, int NT, int qpos0, float m_init, float l_init, char* lds) {
  const int tid = threadIdx.x, wid = tid >> 6, lane = tid & 63, r32 = lane & 31, hi = lane >> 5;
  bf16* V_lds = (bf16*)lds; bf16* K_lds = (bf16*)(lds + 2 * SHM_V);
  float* ws = (float*)(lds + 2 * SHM_V + 2 * SHM_K) + wid * 64; float* li_l = ws; float* al_l = ws + 32;
  float m_reg = m_init, l_reg = l_init; f32x16 o[4] = {}; bf16x8 qr[8];
  const bf16* Qw = Qb + (long)(wid * QBLK + r32) * LDQ + hi * 8;
#pragma unroll
  for (int d0 = 0; d0 < 8; ++d0) qr[d0] = *reinterpret_cast<const bf16x8*>(Qw + d0 * 16);
  const int sr = tid >> 4, sc = (tid & 15) * 8, vst0 = v_st(sr, sc), vst1 = v_st(32 + sr, sc);
  const int vb0 = (int)(uintptr_t)V_lds + v_rd_base(lane);
  const int qpos = qpos0 + wid * QBLK + r32;
  struct { bf16x8 vs0, vs1, ks0, ks1; } sr_[2];
#define KROW(t) ((t) < nt1 ? klo + (t) * KVBLK : 4096 + ((t) - nt1) * KVBLK)
#define SLOAD(i, t) do { const int k0_ = KROW(t); sr_[i].vs0 = *reinterpret_cast<const bf16x8*>(&Vh[(long)(k0_ + sr) * LDK + sc]); sr_[i].vs1 = *reinterpret_cast<const bf16x8*>(&Vh[(long)(k0_ + 32 + sr) * LDK + sc]); \
    sr_[i].ks0 = *reinterpret_cast<const bf16x8*>(&Kh[(long)(k0_ + sr) * LDK + sc]); sr_[i].ks1 = *reinterpret_cast<const bf16x8*>(&Kh[(long)(k0_ + 32 + sr) * LDK + sc]); } while (0)
#define SWRITE(b, i) do { *(bf16x8*)((char*)V_lds + (b) * SHM_V + vst0) = sr_[i].vs0;          \
    *(bf16x8*)((char*)V_lds + (b) * SHM_V + vst1) = sr_[i].vs1; int kc = sc * 2;               \
    *(bf16x8*)((char*)K_lds + (b) * SHM_K + KSWZ(sr, kc)) = sr_[i].ks0;                       \
    *(bf16x8*)((char*)K_lds + (b) * SHM_K + KSWZ(32 + sr, kc)) = sr_[i].ks1; } while (0)
#define SWAIT() asm volatile("s_waitcnt vmcnt(4)" ::: "memory")
#define RESC(a) do { if (__any((a) < 1.f)) { if (hi == 0) al_l[r32] = (a); asm volatile("s_waitcnt lgkmcnt(0)" ::: "memory"); \
    _Pragma("unroll") for (int d = 0; d < 4; ++d) _Pragma("unroll") for (int r = 0; r < 16; ++r) o[d][r] *= al_l[crow(r, hi)]; } } while (0)
#define MASKT(P0, P1, t) do { if (MASK) { if ((t) < nt1) maskt(P0, P1, klo + (t) * KVBLK, qpos, hi); } } while (0)
  f32x16 pA0, pA1, pB0, pB1; float mnA, mnB, alA, alB; bf16x8 pa0, pa1, pa2, pa3;
  constexpr int SE = 0, SO = 1;
  SLOAD(SE, 0); asm volatile("s_waitcnt vmcnt(0)" ::: "memory"); SWRITE(0, SE); __syncthreads();
  qkt(pA0, pA1, K_lds, qr, r32, hi); MASKT(pA0, pA1, 0); partialSM(pA0, pA1, m_reg, mnA, alA);
  SLOAD(SO, 1); if (2 < NT) SLOAD(SE, 2);
  SWAIT(); SWRITE(1, SO); __syncthreads();
  for (int j = 1; j + 1 < NT; j += 2) {
    SBAR(); qkt(pB0, pB1, (bf16*)((char*)K_lds + SHM_K), qr, r32, hi);
    finishSM(pA0, pA1, alA, l_reg, pa0, pa1, pa2, pa3); SBAR();
    SLOAD(SO, j + 2); SBAR();
    pv_d0(o, vb0, pa0, pa1, pa2, pa3); MASKT(pB0, pB1, j); partialSM(pB0, pB1, m_reg, mnB, alB);
    __syncthreads(); SWAIT(); SWRITE(0, SE);
    RESC(alB); __syncthreads();
    SBAR(); qkt(pA0, pA1, K_lds, qr, r32, hi);
    finishSM(pB0, pB1, alB, l_reg, pa0, pa1, pa2, pa3); SBAR();
    if (j + 3 < NT) SLOAD(SE, j + 3); SBAR();
    pv_d0(o, vb0 + (int)SHM_V, pa0, pa1, pa2, pa3); MASKT(pA0, pA1, j + 1); partialSM(pA0, pA1, m_reg, mnA, alA);
    __syncthreads(); SWAIT(); SWRITE(1, SO);
    RESC(alA); __syncthreads();
  }
  SBAR(); qkt(pB0, pB1, (bf16*)((char*)K_lds + SHM_K), qr, r32, hi);
  finishSM(pA0, pA1, alA, l_reg, pa0, pa1, pa2, pa3); SBAR();
  pv_d0(o, vb0, pa0, pa1, pa2, pa3); MASKT(pB0, pB1, NT - 1); partialSM(pB0, pB1, m_reg, mnB, alB);
  __syncthreads(); RESC(alB);
  finishSM(pB0, pB1, alB, l_reg, pa0, pa1, pa2, pa3); SBAR();
  pv_d0(o, vb0 + (int)SHM_V, pa0, pa1, pa2, pa3);
  if (hi == 0) li_l[r32] = l_reg; asm volatile("s_waitcnt lgkmcnt(0)" ::: "memory");
  float rli[16];
#pragma unroll
  for (int r = 0; r < 16; ++r) rli[r] = __builtin_amdgcn_rcpf(li_l[crow(r, hi)]);
  if constexpr (OUT_BF16) {
    bf16* Ow = (bf16*)Ob + (long)(wid * QBLK) * ldo;
#pragma unroll
    for (int r = 0; r < 16; ++r) { int orow = crow(r, hi);
#pragma unroll
      for (int d0 = 0; d0 < 4; ++d0) { const float ov = o[d0][r] * rli[r]; ((unsigned short*)Ow)[(long)orow * ldo + d0 * 32 + r32] = (unsigned short)cvtpk(ov, ov); } }
  } else {
    float* Ow = (float*)Ob + (long)(wid * QBLK) * ldo;
#pragma unroll
    for (int r = 0; r < 16; ++r) { int orow = crow(r, hi);
#pragma unroll
      for (int d0 = 0; d0 < 4; ++d0) Ow[(long)orow * ldo + d0 * 32 + r32] = o[d0][r] * rli[r]; }
  }
  __syncthreads();
#undef KROW
#undef SLOAD
#undef SWRITE
#undef SWAIT
#undef RESC
#undef MASKT
}
#undef KSWZ
#undef SBAR
}

constexpr int NWAVES = 8;
constexpr int D = 2048, NB = 2, SEQ = 4096, CTXL = 256;
constexpr int TL = NB * SEQ, TC = NB * CTXL, MR = TL + TC;
constexpr int KVR = SEQ + CTXL;
constexpr int EVEN_IN = 4608, ODD_IN = 3072, DFF = 5632, DFE = 7168, NE = 8, MODW = 6 * D;
constexpr int NSLOT0 = 36, NSLOT1 = 24;
constexpr int MAXT = 72, XROWS = MAXT * 256;
constexpr float EPS = 1e-6f;
constexpr float LAM_INIT = 0.2f;

constexpr size_t MiB = 1u << 20;
constexpr size_t WS_CTL = 0, CTL_ZERO_BYTES = 1 * MiB;
constexpr size_t WS_MODS = 1 * MiB;
constexpr size_t WS_LAM = WS_MODS + 512 * 1024;
constexpr size_t WS_ROUTE = 2 * MiB;
constexpr size_t RT_EID = WS_ROUTE, RT_GATE = WS_ROUTE + 64 * 1024, RT_POS = WS_ROUTE + 128 * 1024, RT_ROWTOK = WS_ROUTE + 192 * 1024, RT_ROWGATE = WS_ROUTE + 272 * 1024,
                 RT_TILE_E = WS_ROUTE + 352 * 1024, RT_NTILES = WS_ROUTE + 353 * 1024;
constexpr size_t WS_WT_EIN = 4 * MiB, WS_WT_EOUT = 22 * MiB, WS_WT_EF1 = 30 * MiB, WS_WT_EF2 = 74 * MiB, WS_WT_OIN = 96 * MiB, WS_WT_OOUT = 108 * MiB,
                 WS_WT_X1 = 116 * MiB, WS_WT_X2 = 564 * MiB;
constexpr size_t WS_H = 788 * MiB, WS_Z = 822 * MiB, WS_QKV = 900 * MiB, WS_PB = 978 * MiB, WS_OALL = 1046 * MiB, WS_X1 = 1080 * MiB, WS_X3 = 1148 * MiB,
                 WS_ACT = 1212 * MiB, WS_XS = 1306 * MiB, WS_ACT2 = 1378 * MiB, WS_YS = 1630 * MiB, WS_PART = 1774 * MiB, WS_END = 1838 * MiB;
static_assert(WS_WT_EIN + (size_t)EVEN_IN * D * 2 <= WS_WT_EOUT && WS_WT_EF1 + (size_t)2 * DFF * D * 2 <= WS_WT_EF2 && WS_WT_EF2 + (size_t)D * DFF * 2 <= WS_WT_OIN &&
              WS_WT_OIN + (size_t)ODD_IN * D * 2 <= WS_WT_OOUT && WS_WT_X1 + (size_t)NE * 2 * DFE * D * 2 <= WS_WT_X2 && WS_WT_X2 + (size_t)NE * D * DFE * 2 <= WS_H &&
              WS_H + (size_t)MR * D * 2 <= WS_Z && WS_Z + (size_t)MR * EVEN_IN * 2 <= WS_QKV && WS_QKV + (size_t)NB * NSLOT0 * KVR * 128 * 2 <= WS_PB &&
              WS_PB + (size_t)NB * 16 * KVR * 128 * 4 <= WS_OALL && WS_OALL + (size_t)MR * D * 2 <= WS_X1 && WS_X1 + (size_t)MR * D * 4 <= WS_X3 && WS_X3 + (size_t)TL * D * 4 <= WS_ACT &&
              WS_ACT + (size_t)MR * DFF * 2 <= WS_XS && WS_XS + (size_t)XROWS * D * 2 <= WS_ACT2 && WS_ACT2 + (size_t)XROWS * DFE * 2 <= WS_YS && WS_YS + (size_t)XROWS * D * 4 <= WS_PART && WS_PART + 64 * MiB <= WS_END, "d_ws map");
constexpr int CW_BAR = 4096;

constexpr int RING_BYTES = 131072;
constexpr int LDSCTL_OFF = 143360, MISC_OFF = LDSCTL_OFF + 320;
constexpr int LDS_BYTES = 147456;

#define GAS __attribute__((address_space(1)))
#define LAS __attribute__((address_space(3)))
typedef unsigned short bf16;
typedef unsigned v4u __attribute__((ext_vector_type(4)));
typedef unsigned v2u __attribute__((ext_vector_type(2)));
typedef float f32x4 __attribute__((ext_vector_type(4)));
typedef GAS unsigned gu32;
#define RLX_AGENT __ATOMIC_RELAXED, __HIP_MEMORY_SCOPE_AGENT
#define LDS_WAIT() asm volatile("s_waitcnt lgkmcnt(0)" ::: "memory")
#define VM_WAIT() asm volatile("s_waitcnt vmcnt(0)" ::: "memory")
__device__ __forceinline__ unsigned f2bf(float f) { unsigned u = __builtin_bit_cast(unsigned, f); return (u + 0x7fffu + ((u >> 16) & 1u)) >> 16; }
__device__ __forceinline__ unsigned pk2(float lo, float hi) { return f2bf(lo) | (f2bf(hi) << 16); }
__device__ __forceinline__ float bflo(unsigned w) { return __builtin_bit_cast(float, w << 16); }
__device__ __forceinline__ float bfhi(unsigned w) { return __builtin_bit_cast(float, w & 0xffff0000u); }
__device__ __forceinline__ float wave_sum(float v) {
#pragma unroll
    for (int o = 1; o < 64; o <<= 1) v += __shfl_xor(v, o);
    return v;
}

#define XB_TMO      128
#define XB_XCNT(j)  (256  + 64 * (j))
#define XB_XSUB(j)  (1280 + 64 * (j))
#define XB_XGEN(j)  (2304 + 64 * (j))
#define XB_TOP      3328
#define XB_TOPGEN   3392
#define XCD_BAR_WORDS 3456
#define XB_SPIN_CAP (1u << 18)

__device__ __forceinline__ unsigned xb_ld(unsigned* p)              { return __hip_atomic_load(p, __ATOMIC_RELAXED, __HIP_MEMORY_SCOPE_AGENT); }
__device__ __forceinline__ unsigned xb_add(unsigned* p, unsigned v) { return __hip_atomic_fetch_add(p, v, __ATOMIC_RELAXED, __HIP_MEMORY_SCOPE_AGENT); }
__device__ __forceinline__ unsigned xb_xcc_id() { return (unsigned)__builtin_amdgcn_s_getreg((3 << 11) | 20) & 0xFu; }
#define XB_SPIN(cond, bar) do { unsigned _sp = 0; while (cond) { __builtin_amdgcn_s_sleep(1); \
    if ((++_sp & 255u) == 0u) { if (xb_ld(&(bar)[XB_TMO])) break; if (_sp > XB_SPIN_CAP) { atomicAdd(&(bar)[XB_TMO], 1u); break; } } } } while (0)

struct XcdBarrier {
    unsigned* bar; unsigned x;
    volatile LAS unsigned* st;
};

__device__ __forceinline__ XcdBarrier xcd_barrier_post(unsigned* bar, volatile LAS unsigned* st) {
    XcdBarrier b; b.bar = bar; b.x = xb_xcc_id(); b.st = st;
    if (threadIdx.x == 0) (void)xb_add(&bar[XB_XCNT(b.x)], 1u);
    return b;
}
__device__ __forceinline__ void xcd_barrier_complete(unsigned* bar, unsigned x, unsigned& nloc, unsigned& nx) {
    const unsigned G = gridDim.x * gridDim.y * gridDim.z;
    unsigned sum, cnt, mine, sp = 0u;
    for (;;) {
        sum = 0u; cnt = 0u; mine = 0u;
#pragma unroll
        for (unsigned j = 0; j < 16; ++j) { const unsigned c = xb_ld(&bar[XB_XCNT(j)]); sum += c; cnt += (c > 0u) ? 1u : 0u; mine = (j == x) ? c : mine; }
        if (sum == G) break;
        __builtin_amdgcn_s_sleep(1);
        if ((++sp & 255u) == 0u) { if (xb_ld(&bar[XB_TMO])) break; if (sp > XB_SPIN_CAP) { atomicAdd(&bar[XB_TMO], 1u); break; } }
    }
    nloc = mine > 0u ? mine : 1u; nx = cnt > 0u ? cnt : 1u;
}

__device__ __forceinline__ void xcd_barrier(const XcdBarrier& b) {
    asm volatile("s_waitcnt vmcnt(0)" ::: "memory");
    __syncthreads();
    if (threadIdx.x == 0) {
        unsigned* bar = b.bar;
        __builtin_amdgcn_s_waitcnt(0);
        unsigned nloc = b.st[0], nx = b.st[1];
        if (nloc == 0u) { xcd_barrier_complete(bar, b.x, nloc, nx); b.st[0] = nloc; b.st[1] = nx; }
        const unsigned old = xb_add(&bar[XB_XSUB(b.x)], 1u);
        const unsigned gen = old / nloc;
        if (old + 1u == (gen + 1u) * nloc) {
            __builtin_amdgcn_fence(__ATOMIC_RELEASE, "agent");
            asm volatile("s_waitcnt vmcnt(0)" ::: "memory");
            const unsigned og = xb_add(&bar[XB_TOP], 1u);
            const unsigned tg = og / nx;
            if (og + 1u == (tg + 1u) * nx) xb_add(&bar[XB_TOPGEN], 1u);
            else XB_SPIN(xb_ld(&bar[XB_TOPGEN]) == tg, bar);
            __builtin_amdgcn_fence(__ATOMIC_ACQUIRE, "agent");
            xb_add(&bar[XB_XGEN(b.x)], 1u);
            asm volatile("s_waitcnt vmcnt(0)" ::: "memory");
        } else {
            XB_SPIN(xb_ld(&bar[XB_XGEN(b.x)]) == gen, bar);
            __builtin_amdgcn_fence(__ATOMIC_ACQUIRE, "agent");
            asm volatile("s_waitcnt vmcnt(0)" ::: "memory");
        }
    }
    __syncthreads();
}


struct Ctx {
    LAS unsigned char* lds; int tid, lane, wave, G, c, gw, NGW;
};

__device__ __forceinline__ void transpose_item(const float* __restrict__ W, int K, int N, bf16* __restrict__ WT, int q, int kind, LAS float* scr, int lane) {
    const int nblk = N >> 6, kb = q / nblk, nb = q - kb * nblk, k0 = kb * 64, n0 = nb * 64;
    int dest0 = n0;
    if (kind) { const int hf = N >> 1; const int j = n0 < hf ? n0 : n0 - hf; dest0 = (j >> 7) * 256 + (j & 127) + (n0 < hf ? 0 : 128); }
    const int l16 = lane & 15, kq = lane >> 4;
    f32x4 v[16];
#pragma unroll
    for (int i = 0; i < 16; ++i) v[i] = *(const f32x4*)(W + (size_t)(k0 + 4 * i + kq) * N + n0 + 4 * l16);
#pragma unroll
    for (int i = 0; i < 16; ++i) { LAS float* p = scr + (4 * i + kq) * 65 + 4 * l16; p[0] = v[i].x; p[1] = v[i].y; p[2] = v[i].z; p[3] = v[i].w; }
    LDS_WAIT(); asm volatile("" ::: "memory");
    const int c = lane & 7, nn = lane >> 3;
#pragma unroll
    for (int jj = 0; jj < 8; ++jj) { const int n = nn + 8 * jj; const LAS float* s = scr + (8 * c) * 65 + n;
        v4u o; o.x = pk2(s[0 * 65], s[1 * 65]); o.y = pk2(s[2 * 65], s[3 * 65]); o.z = pk2(s[4 * 65], s[5 * 65]); o.w = pk2(s[6 * 65], s[7 * 65]);
        *(v4u*)(WT + (size_t)(dest0 + n) * K + k0 + 8 * c) = o; }
    LDS_WAIT(); asm volatile("" ::: "memory");
}

__device__ __forceinline__ void mod_task(const Ctx& X, int task, const float* cvec, const float* cctx, const float* Wm, const float* bm, float* mods_l) {
    const int ch = task % 48;
    LAS float* S = (LAS float*)X.lds;
    LAS float* R = S + 3 * 2048;
    for (int idx = X.tid; idx < 3 * 2048; idx += NWAVES * 64) { const int i = idx >> 11, k = idx & 2047; const float cv = i < 2 ? cvec[i * 2048 + k] : cctx[k]; S[idx] = cv / (1.f + expf(-cv)); }
    __syncthreads();
    f32x4 a0 = {0.f, 0.f, 0.f, 0.f}, a1 = a0, a2 = a0;
    const float* wp = Wm + (size_t)(X.wave * 256) * MODW + ch * 256 + 4 * X.lane;
    for (int k = 0; k < 256; k += 8) {
        f32x4 w[8];
#pragma unroll
        for (int u = 0; u < 8; ++u) w[u] = *(const f32x4*)(wp + (size_t)(k + u) * MODW);
#pragma unroll
        for (int u = 0; u < 8; ++u) { const int kk = X.wave * 256 + k + u; a0 += w[u] * S[kk]; a1 += w[u] * S[2048 + kk]; a2 += w[u] * S[4096 + kk]; }
    }
#pragma unroll
    for (int j = 0; j < 4; ++j) { R[(X.wave * 3 + 0) * 256 + 4 * X.lane + j] = a0[j]; R[(X.wave * 3 + 1) * 256 + 4 * X.lane + j] = a1[j]; R[(X.wave * 3 + 2) * 256 + 4 * X.lane + j] = a2[j]; }
    __syncthreads();
    for (int idx = X.tid; idx < 768; idx += NWAVES * 64) { const int i = idx >> 8, col = idx & 255; float s = 0.f;
#pragma unroll
        for (int w = 0; w < 8; ++w) s += R[(w * 3 + i) * 256 + col];
        mods_l[(size_t)i * MODW + ch * 256 + col] = s + bm[ch * 256 + col]; }
    __syncthreads();
}

template <bool ROUTER, bool PSUM = false>
__device__ __forceinline__ void norm_mod_rows(const Ctx& X, const float* src_lat, const float* src_ctx, int nrows, const float* gain, const float* mods_l, int sh_i, int sc_i, bf16* H,
                                              const float* wrouter, int* eid, float* egate, const float* part = nullptr, int Sp = 0, const float* pgate = nullptr, float* wb = nullptr) {
    LAS float* WR = (LAS float*)X.lds;
    if (ROUTER) { for (int idx = X.tid; idx < 8 * 2048; idx += NWAVES * 64) { const int k = idx >> 3, e = idx & 7; WR[e * 2048 + k] = wrouter[idx]; } __syncthreads(); }
    for (int row = X.gw; row < nrows; row += X.NGW) {
        const float* xr = row < TL ? src_lat + (size_t)row * D : src_ctx + (size_t)(row - TL) * D;
        const int cond = row < SEQ ? 0 : (row < TL ? 1 : 2);
        const float* shp = mods_l + (size_t)cond * MODW + sh_i * D; const float* scp = mods_l + (size_t)cond * MODW + sc_i * D;
        f32x4 v[8]; float ss = 0.f;
#pragma unroll
        for (int j = 0; j < 8; ++j) v[j] = *(const f32x4*)(xr + 4 * X.lane + 256 * j);
        if (PSUM) { if (row >= TL) {
            f32x4 a[8];
#pragma unroll
            for (int j = 0; j < 8; ++j) a[j] = (f32x4){0.f, 0.f, 0.f, 0.f};
            for (int p = 0; p < Sp; ++p) { const float* pr = part + ((size_t)p * TC + (row - TL)) * D + 4 * X.lane;
#pragma unroll
                for (int j = 0; j < 8; ++j) a[j] += *(const f32x4*)(pr + 256 * j); }
#pragma unroll
            for (int j = 0; j < 8; ++j) { v[j] += a[j] * *(const f32x4*)(pgate + 4 * X.lane + 256 * j); if (wb) *(f32x4*)(wb + (size_t)(row - TL) * D + 4 * X.lane + 256 * j) = v[j]; }
        } }
#pragma unroll
        for (int j = 0; j < 8; ++j) ss += (v[j].x * v[j].x + v[j].y * v[j].y) + (v[j].z * v[j].z + v[j].w * v[j].w);
        const float rstd = 1.0f / sqrtf(wave_sum(ss) * (1.f / D) + EPS);
#pragma unroll
        for (int j = 0; j < 8; ++j) { const int col = 4 * X.lane + 256 * j; const f32x4 g = *(const f32x4*)(gain + col), sc = *(const f32x4*)(scp + col), sh = *(const f32x4*)(shp + col);
            v[j] = (v[j] * rstd * g) * (sc + 1.0f) + sh;
            v2u o; o.x = pk2(v[j].x, v[j].y); o.y = pk2(v[j].z, v[j].w); *(v2u*)(H + (size_t)row * D + col) = o; }
        if (ROUTER) {
            float v1 = -3.0e38f, v2 = -3.0e38f; int i1 = 0, i2 = 0;
#pragma unroll 1
            for (int e = 0; e < 8; ++e) { float a = 0.f;
#pragma unroll
                for (int j = 0; j < 8; ++j) { const f32x4 w = *(const LAS f32x4*)(WR + e * 2048 + 4 * X.lane + 256 * j); a += (v[j].x * w.x + v[j].y * w.y) + (v[j].z * w.z + v[j].w * w.w); }
                const float s = wave_sum(a);
                if (s > v1) { v2 = v1; i2 = i1; v1 = s; i1 = e; } else if (s > v2) { v2 = s; i2 = e; } }
            const float ex = expf(v2 - v1), g1 = 1.f / (1.f + ex), g2 = ex / (1.f + ex);
            if (X.lane == 0) { eid[row * 2] = i1; eid[row * 2 + 1] = i2; egate[row * 2] = g1; egate[row * 2 + 1] = g2; }
        }
    }
}

template <int NG>
__device__ __forceinline__ void qkv_post(const Ctx& X, const bf16* z, bf16* QKV, const float* qn_a, const float* kn_a, const float* qn_b, const float* kn_b) {
    typedef float f32x2 __attribute__((ext_vector_type(2)));
    LAS f32x2* CS = (LAS f32x2*)X.lds;
    for (int idx = X.tid; idx < 2048; idx += NWAVES * 64) { const int p = idx >> 5, i = idx & 31; const float inv = exp2f(-(float)i * (13.287712379549449f / 32.0f)); const float a = (float)p * inv;
        float sn, cs; sincosf(a, &sn, &cs); CS[idx] = (f32x2){cs, sn}; }
    __syncthreads();
    const int l16 = X.lane & 15, gq = X.lane >> 4, chunk = l16 >> 2;
    for (int row = X.gw; row < MR; row += X.NGW) {
        const bool lat = row < TL; const int b = lat ? (row >> 12) : ((row - TL) >> 8); const int pos = lat ? (row & 4095) : (SEQ + ((row - TL) & 255));
        const int p = (chunk < 2) ? (pos >> 6) : (pos & 63);
#pragma unroll 1
        for (int it = 0; it < NG / 4; ++it) {
            const int g = it * 4 + gq;
            const float* gp; bool hn;
            if (NG == NSLOT0) { hn = !(g == 10 || g == 11 || g >= 28); gp = g < 8 ? qn_a : (g < 12 ? kn_a : (g < 20 ? qn_b : kn_b)); }
            else { hn = g < 20; gp = g < 16 ? qn_a : kn_a; }
            const v4u raw = *(const v4u*)(z + (size_t)row * (NG * 128) + g * 128 + 8 * l16);
            float v[8] = {bflo(raw.x), bfhi(raw.x), bflo(raw.y), bfhi(raw.y), bflo(raw.z), bfhi(raw.z), bflo(raw.w), bfhi(raw.w)};
            float ss = 0.f;
#pragma unroll
            for (int j = 0; j < 8; ++j) ss += v[j] * v[j];
            ss += __shfl_xor(ss, 1); ss += __shfl_xor(ss, 2); ss += __shfl_xor(ss, 4); ss += __shfl_xor(ss, 8);
            const float rs = 1.0f / sqrtf(ss * (1.f / 128.f) + EPS);
            const f32x4 ga = *(const f32x4*)(gp + 8 * l16), gb = *(const f32x4*)(gp + 8 * l16 + 4);
            const float gg[8] = {ga.x, ga.y, ga.z, ga.w, gb.x, gb.y, gb.z, gb.w};
#pragma unroll
            for (int j = 0; j < 8; ++j) v[j] = hn ? v[j] * rs * gg[j] : v[j];
            float o[8];
#pragma unroll
            for (int j = 0; j < 8; ++j) { const float pv = __shfl_xor(v[j], 4); const f32x2 cs = CS[p * 32 + 8 * (l16 & 3) + j];
                const float rot = (chunk & 1) ? (v[j] * cs.x + pv * cs.y) : (v[j] * cs.x - pv * cs.y); o[j] = (hn && lat) ? rot : v[j]; }
            v4u w; w.x = pk2(o[0], o[1]); w.y = pk2(o[2], o[3]); w.z = pk2(o[4], o[5]); w.w = pk2(o[6], o[7]);
            *(v4u*)(QKV + ((size_t)(b * NG + g) * KVR + pos) * 128 + 8 * l16) = w;
        }
    }
}

__device__ __forceinline__ void b_combine(const Ctx& X, const float* PB, const float* lamv, const float* subln, bf16* OALL) {
    const int half = X.lane >> 5, d4 = (X.lane & 31) * 4;
    for (int item = X.gw; item < MR * 4; item += X.NGW) {
        const int row = item >> 2, hb = item & 3; const bool lat = row < TL; const int b = lat ? (row >> 12) : ((row - TL) >> 8); const int pos = lat ? (row & 4095) : (SEQ + ((row - TL) & 255));
        const f32x4 o1 = *(const f32x4*)(PB + ((size_t)(b * 16 + (hb * 2 + 0) * 2 + half) * KVR + pos) * 128 + d4);
        const f32x4 o2 = *(const f32x4*)(PB + ((size_t)(b * 16 + (hb * 2 + 1) * 2 + half) * KVR + pos) * 128 + d4);
        const float lam = lamv[hb];
        const f32x4 v = o1 - o2 * lam;
        const float ss = wave_sum((v.x * v.x + v.y * v.y) + (v.z * v.z + v.w * v.w));
        const float rs = (1.0f - LAM_INIT) / sqrtf(ss * (1.f / 256.f) + EPS);
        const f32x4 g = *(const f32x4*)(subln + half * 128 + d4);
        const f32x4 y = v * rs * g;
        v2u o; o.x = pk2(y.x, y.y); o.y = pk2(y.z, y.w);
        *(v2u*)(OALL + (size_t)row * D + 1024 + hb * 256 + half * 128 + d4) = o;
    }
}

__device__ __forceinline__ void moe_route(const Ctx& X, const int* eid, const float* egate, const bf16* H, bf16* XS, int* pos, int* rowtok, float* rowgate, int* tile_e, int* ntiles) {
    LAS int* tot = (LAS int*)X.lds;
    LAS int* pre = tot + 8;
    LAS int* base = tot + 16;
    LAS int* dst = tot + 64;
    const int tpw = (TL + X.G - 1) / X.G, t0 = X.c * tpw, t1 = (t0 + tpw) < TL ? (t0 + tpw) : TL;
    if (X.tid < 16) tot[X.tid] = 0;
    __syncthreads();
    for (int idx = X.tid; idx < 2 * TL; idx += NWAVES * 64) { const int e = eid[idx]; __hip_atomic_fetch_add(&tot[e], 1, __ATOMIC_RELAXED, __HIP_MEMORY_SCOPE_WORKGROUP); if ((idx >> 1) < t0) __hip_atomic_fetch_add(&pre[e], 1, __ATOMIC_RELAXED, __HIP_MEMORY_SCOPE_WORKGROUP); }
    __syncthreads();
    if (X.tid == 0) { int acc = 0; for (int e = 0; e < 8; ++e) { base[e] = acc; acc += (tot[e] + 255) & ~255; }
        if (X.c == 0) { *ntiles = acc >> 8; for (int e = 0; e < 8; ++e) { const int nt = (tot[e] + 255) >> 8; for (int i = 0; i < nt; ++i) tile_e[(base[e] >> 8) + i] = e; } } }
    __syncthreads();
    if (X.wave == 0) {
        int run[8];
#pragma unroll
        for (int e = 0; e < 8; ++e) run[e] = 0;
        const int n_ent = 2 * (t1 - t0);
        for (int b0 = 0; b0 < n_ent; b0 += 64) {
            const int li = b0 + X.lane; const bool valid = li < n_ent; const int idx = 2 * t0 + li; const int e = valid ? eid[idx] : -1;
            int rank = 0;
#pragma unroll
            for (int ee = 0; ee < 8; ++ee) { const unsigned long long m = __ballot(e == ee); if (e == ee) rank = run[ee] + __popcll(m & ((1ull << X.lane) - 1ull)); run[ee] += __popcll(m); }
            if (valid) { const int d = base[e] + pre[e] + rank; dst[li] = d; pos[idx] = d; rowtok[d] = idx >> 1; rowgate[d] = egate[idx]; }
        }
    }
    __syncthreads();
    { const int n_ent = 2 * (t1 - t0);
      for (int li = X.wave; li < n_ent; li += NWAVES) { const int tok = t0 + (li >> 1); const int d = dst[li];
          const v4u* s = (const v4u*)(H + (size_t)tok * D) + X.lane; v4u* o = (v4u*)(XS + (size_t)d * D) + X.lane;
#pragma unroll
          for (int j = 0; j < 4; ++j) o[64 * j] = s[64 * j]; } }
    if (X.c < 8) { const int e = X.c; const int r0 = base[e] + tot[e], r1 = base[e] + ((tot[e] + 255) & ~255);
        for (int r = r0 + X.wave; r < r1; r += NWAVES) { if (X.lane == 0) { rowtok[r] = -1; rowgate[r] = 0.f; }
            v4u* o = (v4u*)(XS + (size_t)r * D) + X.lane; const v4u zz = {0u, 0u, 0u, 0u};
#pragma unroll
            for (int j = 0; j < 4; ++j) o[64 * j] = zz; } }
    __syncthreads();
}

constexpr int MOE_MAIN_TILES = 64, MOE_MAIN_ROWS = MOE_MAIN_TILES * 256;
__device__ __forceinline__ void moe_final(const Ctx& X, const float* X3, const float* YS, const int* pos, const float* mods_l, float* out, const float* part, int ntiles) {
    int Sp, ppair; const int tail_rows = (ntiles - MOE_MAIN_TILES) * 256; pg8::tail_split(X.G, (ntiles - MOE_MAIN_TILES) * (D / 256), DFE / 64, Sp, ppair);
    for (int row = X.gw; row < TL; row += X.NGW) {
        const int p0 = pos[2 * row], p1 = pos[2 * row + 1]; const float* gp = mods_l + (size_t)(row >> 12) * MODW + 5 * D;
        f32x4 a[8], b[8];
        if (p0 < MOE_MAIN_ROWS) {
#pragma unroll
            for (int j = 0; j < 8; ++j) a[j] = *(const f32x4*)(YS + (size_t)p0 * D + 4 * X.lane + 256 * j);
        } else {
#pragma unroll
            for (int j = 0; j < 8; ++j) a[j] = (f32x4){0.f, 0.f, 0.f, 0.f};
            for (int p = 0; p < Sp; ++p) { const float* pr = part + ((size_t)p * tail_rows + (p0 - MOE_MAIN_ROWS)) * D + 4 * X.lane;
#pragma unroll
                for (int j = 0; j < 8; ++j) a[j] += *(const f32x4*)(pr + 256 * j); }
        }
        if (p1 < MOE_MAIN_ROWS) {
#pragma unroll
            for (int j = 0; j < 8; ++j) b[j] = *(const f32x4*)(YS + (size_t)p1 * D + 4 * X.lane + 256 * j);
        } else {
#pragma unroll
            for (int j = 0; j < 8; ++j) b[j] = (f32x4){0.f, 0.f, 0.f, 0.f};
            for (int p = 0; p < Sp; ++p) { const float* pr = part + ((size_t)p * tail_rows + (p1 - MOE_MAIN_ROWS)) * D + 4 * X.lane;
#pragma unroll
                for (int j = 0; j < 8; ++j) b[j] += *(const f32x4*)(pr + 256 * j); }
        }
#pragma unroll
        for (int j = 0; j < 8; ++j) { const int col = 4 * X.lane + 256 * j; const f32x4 x = *(const f32x4*)(X3 + (size_t)row * D + col), g = *(const f32x4*)(gp + col);
            *(f32x4*)(out + (size_t)row * D + col) = x + g * (a[j] + b[j]); }
    }
}

__device__ __forceinline__ const float* arg_in(int i) {
    auto kp = __builtin_amdgcn_kernarg_segment_ptr();
    asm volatile("" : "+s"(kp));
    return ((const float* const __attribute__((address_space(4)))*)kp)[i];
}
#define AIN(i) arg_in(i)
constexpr int NPHASE = 20;
#ifndef PHMASK
#define PHMASK 0xFFFFFu
#endif
#ifndef PHDUP
#define PHDUP 0u
#endif
#define REP(k) _Pragma("unroll") for (int rep_ = 0; rep_ < ((((PHDUP) >> (k)) & 1u) ? 2 : 1); ++rep_)
#ifndef MK_LAUNCHES
#define MK_LAUNCHES {{0, NPHASE}}
#endif
struct PhRange { int lo, hi; };
constexpr PhRange kLaunches[] = MK_LAUNCHES;
struct Args { const float* in[33]; float* out; unsigned char* ws; int ph_lo, ph_hi, li, pad; };
__global__ void __launch_bounds__(NWAVES * 64, 2) fwd_kernel(Args args) {
    extern __shared__ __attribute__((aligned(16))) unsigned char lds[];
    Ctx X;
    X.lds = (LAS unsigned char*)lds; X.tid = threadIdx.x; X.lane = X.tid & 63; X.wave = __builtin_amdgcn_readfirstlane(X.tid >> 6);
    X.G = gridDim.x; X.c = blockIdx.x; X.gw = X.c * NWAVES + X.wave; X.NGW = X.G * NWAVES;
    unsigned char* ws = args.ws;
    gu32* ctl = (gu32*)(ws + WS_CTL);
    volatile LAS unsigned* MISC = (volatile LAS unsigned*)(X.lds + MISC_OFF);
    for (int u = X.tid; u < (LDS_BYTES - LDSCTL_OFF) / 4; u += NWAVES * 64) ((LAS unsigned*)(X.lds + LDSCTL_OFF))[u] = 0u;
    __syncthreads();
    const int lo = args.ph_lo, hi = args.ph_hi;
    XcdBarrier bar; bar.bar = (unsigned*)(ctl + CW_BAR) + args.li * XCD_BAR_WORDS; bar.x = 0; bar.st = nullptr;
    if (hi - lo > 1) bar = xcd_barrier_post((unsigned*)(ctl + CW_BAR) + args.li * XCD_BAR_WORDS, MISC + 8);
#define GRID_BAR() xcd_barrier(bar)
#define IN(k) ((((PHMASK) >> (k)) & 1u) && lo <= (k) && (k) < hi)
#define BOTH(k) (IN(k) && ((k) + 1) < hi)

#define x_in (AIN(0))
#define c_in (AIN(1))
#define ctx_in (AIN(2))
#define cctx_in (AIN(3))
#define mods0 ((float*)(ws + WS_MODS))
#define mods1 ((float*)(ws + WS_MODS) + 3 * MODW)
#define lamv ((float*)(ws + WS_LAM))
#define WT_EIN ((bf16*)(ws + WS_WT_EIN))
#define WT_EOUT ((bf16*)(ws + WS_WT_EOUT))
#define WT_EF1 ((bf16*)(ws + WS_WT_EF1))
#define WT_EF2 ((bf16*)(ws + WS_WT_EF2))
#define WT_OIN ((bf16*)(ws + WS_WT_OIN))
#define WT_OOUT ((bf16*)(ws + WS_WT_OOUT))
#define WT_X1 ((bf16*)(ws + WS_WT_X1))
#define WT_X2 ((bf16*)(ws + WS_WT_X2))
#define H ((bf16*)(ws + WS_H))
#define Z ((bf16*)(ws + WS_Z))
#define QKV ((bf16*)(ws + WS_QKV))
#define PB ((float*)(ws + WS_PB))
#define OALL ((bf16*)(ws + WS_OALL))
#define X1 ((float*)(ws + WS_X1))
#define X3 ((float*)(ws + WS_X3))
#define ACT ((bf16*)(ws + WS_ACT))
#define XS ((bf16*)(ws + WS_XS))
#define ACT2 ((bf16*)(ws + WS_ACT2))
#define YS ((float*)(ws + WS_YS))
#define PART ((float*)(ws + WS_PART))
#define EID ((int*)(ws + RT_EID))
#define EGATE ((float*)(ws + RT_GATE))
#define POS ((int*)(ws + RT_POS))
#define ROWTOK ((int*)(ws + RT_ROWTOK))
#define ROWGATE ((float*)(ws + RT_ROWGATE))
#define TILE_E ((int*)(ws + RT_TILE_E))
#define NTILES ((int*)(ws + RT_NTILES))

    if (IN(0)) {
    REP(0) { if (rep_) __syncthreads();
    {
        for (int task = X.c; task < 96; task += X.G) { const int l = task / 48; mod_task(X, task, c_in, cctx_in, l ? AIN(24) : AIN(6), l ? AIN(25) : AIN(7), l ? mods1 : mods0); }
        if (X.c == X.G - 1 && X.wave == 0) {
            for (int h = 0; h < 4; ++h) { const float* q1 = AIN(15) + h * 128; const float* k1 = AIN(16) + h * 128; const float* q2 = AIN(17) + h * 128; const float* k2 = AIN(18) + h * 128;
                const float s1 = wave_sum(q1[X.lane] * k1[X.lane] + q1[X.lane + 64] * k1[X.lane + 64]); const float s2 = wave_sum(q2[X.lane] * k2[X.lane] + q2[X.lane + 64] * k2[X.lane + 64]);
                if (X.lane == 0) lamv[h] = expf(s1) - expf(s2) + LAM_INIT; }
        }
        LAS float* scr = (LAS float*)(X.lds + X.wave * 16896);
        int tbase = 0;
#define TPASS(Wp, K_, N_, WTp, kind_, nexp) { constexpr int per_ = ((K_) / 64) * ((N_) / 64), tot_ = per_ * (nexp); int j_ = (X.gw - tbase) % X.NGW; if (j_ < 0) j_ += X.NGW; \
            for (; j_ < tot_; j_ += X.NGW) { const int e_ = j_ / per_, q_ = j_ - e_ * per_; transpose_item((Wp) + (size_t)e_ * (K_) * (N_), (K_), (N_), (WTp) + (size_t)e_ * (N_) * (K_), q_, (kind_), scr, X.lane); } tbase += tot_; }
        TPASS(AIN(8), D, EVEN_IN, WT_EIN, 0, 1)
        TPASS(AIN(9), D, D, WT_EOUT, 0, 1)
        TPASS(AIN(20), D, 2 * DFF, WT_EF1, 1, 1)
        TPASS(AIN(21), DFF, D, WT_EF2, 0, 1)
        TPASS(AIN(26), D, ODD_IN, WT_OIN, 0, 1)
        TPASS(AIN(27), D, D, WT_OOUT, 0, 1)
        TPASS(AIN(31), D, 2 * DFE, WT_X1, 1, NE)
        TPASS(AIN(32), DFE, D, WT_X2, 0, NE)
#undef TPASS
    }
    }
    if (BOTH(0)) GRID_BAR();
    }
    if (IN(1)) {
    REP(1) { if (rep_) __syncthreads();
    norm_mod_rows<false>(X, x_in, ctx_in, MR, AIN(4), mods0, 0, 1, H, nullptr, nullptr, nullptr);
    }
    if (BOTH(1)) GRID_BAR();
    }
    if (IN(2)) {
    REP(2) { if (rep_) __syncthreads();
    { pg8::Gemm g{H, WT_EIN, MR, EVEN_IN, D}; pg8::StaticOrder S; S.init(MR, EVEN_IN, D, X.G, X.c); pg8::EpiBf16 E{Z, EVEN_IN};
      pg8::gemm_phase<pg8::EpiBf16, pg8::StaticOrder, true, true>(X.lds, g, S, E); }
    }
    if (BOTH(2)) GRID_BAR();
    }
    if (IN(3)) {
    REP(3) { if (rep_) __syncthreads();
    qkv_post<NSLOT0>(X, Z, QKV, AIN(10), AIN(11), AIN(13), AIN(14));
    }
    if (BOTH(3)) GRID_BAR();
    }
    if (IN(4)) {
    REP(4) { if (rep_) __syncthreads();
    {
        const att::bf16* Q0 = (const att::bf16*)QKV;
        for (int u = X.c; u < 544; u += X.G) {
            const bool isl = u < 512; const int b = isl ? (u >> 8) : ((u - 512) >> 4), vh = isl ? ((u >> 4) & 15) : ((u - 512) & 15), qb = isl ? (u & 15) : 16;
            const int hb = vh >> 2, map = (vh >> 1) & 1, half = vh & 1;
            const att::bf16* Qp = Q0 + ((size_t)(b * NSLOT0 + 12 + 2 * hb + map) * KVR + qb * 256) * 128;
            const att::bf16* Kp = Q0 + ((size_t)(b * NSLOT0 + 20 + 2 * hb + map) * KVR) * 128;
            const att::bf16* Vp = Q0 + ((size_t)(b * NSLOT0 + 28 + 2 * hb + half) * KVR) * 128;
            float* Op = PB + ((size_t)(b * 16 + vh) * KVR + qb * 256) * 128;
            att::attn_unit<false, false>(Qp, Kp, Vp, (void*)Op, 128, 0, isl ? 68 : 0, isl ? 68 : 4, 0, -1e30f, 0.f, (char*)lds);
        }
        const int ca = (X.c + X.G - 32) % X.G;
        for (int u = ca; u < 272; u += X.G) {
            const bool isl = u < 256; const int b = isl ? (u >> 7) : ((u - 256) >> 3), h = isl ? ((u >> 4) & 7) : ((u - 256) & 7), qb = isl ? (u & 15) : 16;
            const int q0 = qb * 256; const int klo = isl ? (q0 >= 128 ? q0 - 128 : 0) : 0; const int khi = (q0 + 384) < SEQ ? (q0 + 384) : SEQ; const int nt1 = isl ? ((khi - klo) >> 6) : 0;
            const att::bf16* Qp = Q0 + ((size_t)(b * NSLOT0 + h) * KVR + q0) * 128;
            const att::bf16* Kp = Q0 + ((size_t)(b * NSLOT0 + 8 + (h >> 2)) * KVR) * 128;
            const att::bf16* Vp = Q0 + ((size_t)(b * NSLOT0 + 10 + (h >> 2)) * KVR) * 128;
            bf16* Op = OALL + (size_t)(isl ? (b * SEQ + q0) : (TL + b * CTXL)) * D + h * 128;
            const float sink = AIN(12)[h];
            att::attn_unit<true, true>(Qp, Kp, Vp, (void*)Op, D, klo, nt1, nt1 + 4, q0, sink * (1.0f / att::SCALE), 1.f, (char*)lds);
        }
    }
    }
    if (BOTH(4)) GRID_BAR();
    }
    if (IN(5)) {
    REP(5) { if (rep_) __syncthreads();
    b_combine(X, PB, lamv, AIN(19), OALL);
    }
    if (BOTH(5)) GRID_BAR();
    }
    if (IN(6)) {
    REP(6) { if (rep_) __syncthreads();
    { pg8::Gemm g{OALL, WT_EOUT, MR, D, D}; pg8::TailOrder S; S.init(TL / 256, TC / 256, D / 256, D / 64, X.G, X.c, nullptr); pg8::EpiRes E{x_in, ctx_in, X1, D, mods0 + 2 * D, MODW, PART, TL, TC};
      pg8::gemm_phase<pg8::EpiRes, pg8::TailOrder, true, true>(X.lds, g, S, E); }
    }
    if (BOTH(6)) GRID_BAR();
    }
    if (IN(7)) {
    REP(7) { if (rep_) __syncthreads();
    { int Sp, pp; pg8::tail_split(X.G, (TC / 256) * (D / 256), D / 64, Sp, pp);
      norm_mod_rows<false, true>(X, X1, ctx_in, MR, AIN(5), mods0, 3, 4, H, nullptr, nullptr, nullptr, PART, Sp, mods0 + 2 * MODW + 2 * D, X1 + (size_t)TL * D); }
    }
    if (BOTH(7)) GRID_BAR();
    }
    if (IN(8)) {
    REP(8) { if (rep_) __syncthreads();
    { pg8::Gemm g{H, WT_EF1, MR, 2 * DFF, D}; pg8::StaticOrder S; S.init(MR, 2 * DFF, D, X.G, X.c); pg8::EpiSwiglu E{ACT, DFF};
      pg8::gemm_phase<pg8::EpiSwiglu, pg8::StaticOrder, true, true>(X.lds, g, S, E); }
    }
    if (BOTH(8)) GRID_BAR();
    }
    if (IN(9)) {
    REP(9) { if (rep_) __syncthreads();
    { pg8::Gemm g{ACT, WT_EF2, MR, D, DFF}; pg8::TailOrder S; S.init(TL / 256, TC / 256, D / 256, DFF / 64, X.G, X.c, nullptr); pg8::EpiRes E{X1, X1 + (size_t)TL * D, X1, D, mods0 + 5 * D, MODW, PART, TL, TC};
      pg8::gemm_phase<pg8::EpiRes, pg8::TailOrder, true, true>(X.lds, g, S, E); }
    }
    if (BOTH(9)) GRID_BAR();
    }
    if (IN(10)) {
    REP(10) { if (rep_) __syncthreads();
    { int Sp, pp; pg8::tail_split(X.G, (TC / 256) * (D / 256), DFF / 64, Sp, pp);
      norm_mod_rows<false, true>(X, X1, X1 + (size_t)TL * D, MR, AIN(22), mods1, 0, 1, H, nullptr, nullptr, nullptr, PART, Sp, mods0 + 2 * MODW + 5 * D, X1 + (size_t)TL * D); }
    }
    if (BOTH(10)) GRID_BAR();
    }
    if (IN(11)) {
    REP(11) { if (rep_) __syncthreads();
    { pg8::Gemm g{H, WT_OIN, MR, ODD_IN, D}; pg8::StaticOrder S; S.init(MR, ODD_IN, D, X.G, X.c); pg8::EpiBf16 E{Z, ODD_IN};
      pg8::gemm_phase<pg8::EpiBf16, pg8::StaticOrder, true, true>(X.lds, g, S, E); }
    }
    if (BOTH(11)) GRID_BAR();
    }
    if (IN(12)) {
    REP(12) { if (rep_) __syncthreads();
    qkv_post<NSLOT1>(X, Z, QKV, AIN(28), AIN(29), nullptr, nullptr);
    }
    if (BOTH(12)) GRID_BAR();
    }
    if (IN(13)) {
    REP(13) { if (rep_) __syncthreads();
    {
        const att::bf16* Q0 = (const att::bf16*)QKV;
        for (int u = X.c; u < 512; u += X.G) {
            const int b = u >> 8, h = (u >> 4) & 15, qb = u & 15;
            const att::bf16* Qp = Q0 + ((size_t)(b * NSLOT1 + h) * KVR + qb * 256) * 128;
            const att::bf16* Kp = Q0 + ((size_t)(b * NSLOT1 + 16 + (h >> 2)) * KVR) * 128;
            const att::bf16* Vp = Q0 + ((size_t)(b * NSLOT1 + 20 + (h >> 2)) * KVR) * 128;
            bf16* Op = OALL + (size_t)(b * SEQ + qb * 256) * D + h * 128;
            const int ntc = 68 + (X.G >> 20);
            att::attn_unit<false, true>(Qp, Kp, Vp, (void*)Op, D, 0, ntc, ntc, 0, -1e30f, 0.f, (char*)lds);
        }
    }
    }
    if (BOTH(13)) GRID_BAR();
    }
    if (IN(14)) {
    REP(14) { if (rep_) __syncthreads();
    { pg8::Gemm g{OALL, WT_OOUT, TL, D, D}; pg8::StaticOrder S; S.init(TL, D, D, X.G, X.c); pg8::EpiRes E{X1, X1, X3, D, mods1 + 2 * D, MODW, nullptr, 0, 0};
      pg8::gemm_phase<pg8::EpiRes, pg8::StaticOrder, true, true>(X.lds, g, S, E); }
    }
    if (BOTH(14)) GRID_BAR();
    }
    if (IN(15)) {
    REP(15) { if (rep_) __syncthreads();
    norm_mod_rows<true>(X, X3, X3, TL, AIN(23), mods1, 3, 4, H, AIN(30), EID, EGATE);
    }
    if (BOTH(15)) GRID_BAR();
    }
    if (IN(16)) {
    REP(16) { if (rep_) __syncthreads();
    moe_route(X, EID, EGATE, H, XS, POS, ROWTOK, ROWGATE, TILE_E, NTILES);
    }
    if (BOTH(16)) GRID_BAR();
    }
    if (IN(17)) {
    REP(17) { if (rep_) __syncthreads();
    { const int nt = *(volatile int*)NTILES; pg8::Gemm g{XS, WT_X1, XROWS, 2 * DFE, D}; pg8::TailOrder S; S.init(nt, 0, 2 * DFE / 256, D / 64, X.G, X.c, TILE_E); pg8::EpiSwiglu E{ACT2, DFE};
      pg8::gemm_phase<pg8::EpiSwiglu, pg8::TailOrder, true, true>(X.lds, g, S, E); }
    }
    if (BOTH(17)) GRID_BAR();
    }
    if (IN(18)) {
    REP(18) { if (rep_) __syncthreads();
    { const int nt = *(volatile int*)NTILES; pg8::Gemm g{ACT2, WT_X2, XROWS, D, DFE}; pg8::TailOrder S; S.init(MOE_MAIN_TILES, nt - MOE_MAIN_TILES, D / 256, DFE / 64, X.G, X.c, TILE_E); pg8::EpiRowScale E{YS, D, ROWGATE, PART, MOE_MAIN_ROWS, (nt - MOE_MAIN_TILES) * 256};
      pg8::gemm_phase<pg8::EpiRowScale, pg8::TailOrder, true, true>(X.lds, g, S, E); }
    }
    if (BOTH(18)) GRID_BAR();
    }
    if (IN(19)) {
    REP(19) { if (rep_) __syncthreads();
    moe_final(X, X3, YS, POS, mods1, args.out, PART, *(volatile int*)NTILES);
    }
    }
}

extern "C" void kernel_launch(void* const* d_in, const int* in_sizes, int n_in, void* d_out, int out_size, void* d_ws, size_t ws_size, hipStream_t stream) {
    static int grid = 0;
    if (grid == 0) {
        if (n_in != 33 || in_sizes[0] != TL * D || out_size != TL * D || ws_size < WS_END) { fprintf(stderr, "kernel_launch: unexpected shapes (n_in %d, in0 %d, out %d, ws %zu)\n", n_in, n_in > 0 ? in_sizes[0] : -1, out_size, ws_size); grid = -1; return; }
        int dev = 0, cus = 0, per_cu = 0;
        if (hipGetDevice(&dev) != hipSuccess || hipDeviceGetAttribute(&cus, hipDeviceAttributeMultiprocessorCount, dev) != hipSuccess) { grid = -1; return; }
        if (hipFuncSetAttribute((const void*)fwd_kernel, hipFuncAttributeMaxDynamicSharedMemorySize, LDS_BYTES) != hipSuccess) { fprintf(stderr, "kernel_launch: hipFuncSetAttribute failed\n"); grid = -1; return; }
        if (hipOccupancyMaxActiveBlocksPerMultiprocessor(&per_cu, (const void*)fwd_kernel, NWAVES * 64, LDS_BYTES) != hipSuccess || per_cu < 1) { fprintf(stderr, "kernel_launch: occupancy query says %d blocks per CU\n", per_cu); }
        (void)hipGetLastError();
        grid = cus;
    }
    if (grid < 0) return;
    if (hipMemsetAsync((char*)d_ws + WS_CTL, 0, CTL_ZERO_BYTES, stream) != hipSuccess) return;
    Args a{};
    for (int i = 0; i < 33; ++i) a.in[i] = (const float*)d_in[i];
    a.out = (float*)d_out; a.ws = (unsigned char*)d_ws;
    constexpr int NL = sizeof(kLaunches) / sizeof(kLaunches[0]);
    for (int li = 0; li < NL; ++li) {
        a.ph_lo = kLaunches[li].lo; a.ph_hi = kLaunches[li].hi; a.li = li; a.pad = 0;
        hipLaunchKernelGGL(fwd_kernel, dim3(grid), dim3(NWAVES * 64), LDS_BYTES, stream, a);
        const hipError_t le = hipPeekAtLastError();
        if (le != hipSuccess) { fprintf(stderr, "kernel_launch: launch %d failed: %s\n", li, hipGetErrorName(le)); break; }
    }
}
```

```cpp
#include <hip/hip_runtime.h>
#include <hip/hip_bf16.h>
#include <cstdio>
#include <cstdint>

namespace pg8 {
#define PG8_LAS __attribute__((address_space(3)))
typedef unsigned short bf16_t;
typedef short bf16x8 __attribute__((ext_vector_type(8)));
typedef float f32x4 __attribute__((ext_vector_type(4)));
typedef unsigned u32x4 __attribute__((ext_vector_type(4)));
constexpr int BM = 256, BK = 64, HALF = 128, HTB = HALF * BK * 2  , STAGE_BYTES = 8 * HTB, NXCD = 8, WGM = 8;

__host__ __device__ __forceinline__ int lds_byte(int r, int c) { const int st = (r >> 4) * 2 + (c >> 5), rr = r & 15, cc = c & 31, ob = rr * 64 + cc * 2; return st * 1024 + (ob ^ (((ob >> 9) & 1) << 5)); }
__host__ __device__ __forceinline__ void stage_rc(int b, int& R, int& C) { const int st = b / 1024, sb = b % 1024, swz = sb ^ (((sb >> 9) & 1) << 5); R = (st >> 1) * 16 + swz / 64; C = (st & 1) * 32 + (swz % 64) / 2; }
__host__ __device__ __forceinline__ int perm32(int rho) { const int n = rho >> 4, i = rho & 15; return 8 * (i >> 2) + 4 * n + (i & 3); }

struct Unit { int pm, pn, pnb, kt0, nkt, part; };
struct Gemm { const void* A; const void* Bt; int M, N, K; };

struct StaticOrder {
    int nM, nN, nwg, G, c, KT;
    __host__ __device__ __forceinline__ void init(int M, int N, int KT_, int G_, int c_) { nM = M / BM; nN = N / BM; nwg = nM * nN; G = G_; c = c_; KT = KT_; }
    __host__ __device__ __forceinline__ bool next(int i, Unit& u) const {
        const long L = (long)i * G + c; if (L >= nwg) return false;
        int wgid = (int)L; { const int q = nwg / NXCD, r = nwg % NXCD, xcd = wgid % NXCD, off = wgid / NXCD; wgid = (xcd < r ? xcd * (q + 1) : r * (q + 1) + (xcd - r) * q) + off; }
        const int nig = WGM * nN, gid = wgid / nig, fm = gid * WGM, gsz = (nM - fm) < WGM ? (nM - fm) : WGM;
        u.pm = fm + ((wgid % nig) % gsz); u.pn = (wgid % nig) / gsz; u.pnb = u.pn; u.kt0 = 0; u.nkt = KT; u.part = -1; return true;
    }
    __device__ __forceinline__ void a_ready(const Unit&) const {}
    __device__ __forceinline__ void done(const Unit&) const {}
};
__host__ __device__ __forceinline__ void tail_split(int G, int T, int KT, int& Sp, int& ppair) {
    if (T <= 0) { Sp = 0; ppair = 0; return; }
    int S = G / T; if (S < 1) S = 1; const int pairs = KT >> 1; ppair = (pairs + S - 1) / S; if (ppair < 2) ppair = 2; Sp = (pairs + ppair - 1) / ppair;
}
struct TailOrder {
    StaticOrder so; int T, Sp, ppair; const int* tile_e;
    __device__ __forceinline__ void init(int nMm, int nTm, int nN, int KT, int G_, int c_, const int* te) { so.nM = nMm; so.nN = nN; so.nwg = nMm * nN; so.G = G_; so.c = c_; so.KT = KT; T = nTm * nN; tile_e = te; tail_split(G_, T, KT, Sp, ppair); }
    __device__ __forceinline__ bool next(int i, Unit& u) const {
        const int nm = so.c < so.nwg ? (so.nwg - so.c + so.G - 1) / so.G : 0;
        const int cc = so.G - 1 - so.c;
        int pm, pn, kt0 = 0, nkt = so.KT, part = -1;
        if (i < nm) { Unit t; so.next(i, t); pm = t.pm; pn = t.pn; }
        else if (i == nm && cc < T * Sp) { const int tu = cc / Sp, j = cc - tu * Sp; pm = so.nM + tu / so.nN; pn = tu % so.nN; kt0 = 2 * ppair * j; nkt = (so.KT - kt0) < 2 * ppair ? (so.KT - kt0) : 2 * ppair; part = j; }
        else return false;
        int e = 0; if (tile_e) e = __builtin_amdgcn_readfirstlane(tile_e[pm]);
        u.pm = pm; u.pn = pn; u.pnb = e * so.nN + pn; u.kt0 = kt0; u.nkt = nkt; u.part = part; return true;
    }
    __device__ __forceinline__ void a_ready(const Unit&) const {}
    __device__ __forceinline__ void done(const Unit&) const {}
};

__device__ __forceinline__ unsigned cvt_pk_bf16(float lo, float hi) { unsigned r; asm volatile("v_cvt_pk_bf16_f32 %0, %1, %2" : "=v"(r) : "v"(lo), "v"(hi)); return r; }

struct EpiBf16 {
    static constexpr bool PERM = true, AFTER_DRAIN = false;
    bf16_t* O; int ldc;
    __device__ __forceinline__ void operator()(const f32x4 (&acc)[2][2][4][2], const Unit& u, int wr, int wc, int fr, int fq) const {
        const int row0 = u.pm * BM + wr * 64 + fr; const int col0 = u.pn * BM + wc * 32 + 8 * fq;
#pragma unroll
        for (int ai = 0; ai < 2; ++ai)
#pragma unroll
            for (int m = 0; m < 4; ++m) { bf16_t* rowp = O + (size_t)(row0 + ai * HALF + m * 16) * ldc + col0;
#pragma unroll
                for (int bj = 0; bj < 2; ++bj) { const f32x4 v0 = acc[ai][bj][m][0], v1 = acc[ai][bj][m][1];
                    u32x4 w; w.x = cvt_pk_bf16(v0[0], v0[1]); w.y = cvt_pk_bf16(v0[2], v0[3]); w.z = cvt_pk_bf16(v1[0], v1[1]); w.w = cvt_pk_bf16(v1[2], v1[3]);
                    *(u32x4*)(rowp + bj * HALF) = w; } }
    }
};
__device__ __forceinline__ float clamp448(float x) { return __builtin_fminf(__builtin_fmaxf(x, -448.f), 448.f); }
__device__ __forceinline__ unsigned pk4_fp8(float a, float b, float c, float d) {
    int w = __builtin_amdgcn_cvt_pk_fp8_f32(clamp448(a), clamp448(b), 0, false); w = __builtin_amdgcn_cvt_pk_fp8_f32(clamp448(c), clamp448(d), w, true); return (unsigned)w; }
__device__ __forceinline__ float silu_mul(float g, float u) { return g * u * __builtin_amdgcn_rcpf(1.0f + __builtin_amdgcn_exp2f(-1.4426950408889634f * g)); }
template <bool OUT8> struct EpiSwigluT {
    static constexpr bool PERM = true, AFTER_DRAIN = false;
    void* O; int ldc; float scale;
    __device__ __forceinline__ void operator()(const f32x4 (&acc)[2][2][4][2], const Unit& u, int wr, int wc, int fr, int fq) const {
        const int row0 = u.pm * BM + wr * 64 + fr; const int col0 = u.pn * HALF + wc * 32 + 8 * fq;
#pragma unroll
        for (int ai = 0; ai < 2; ++ai)
#pragma unroll
            for (int m = 0; m < 4; ++m) { const size_t eo = (size_t)(row0 + ai * HALF + m * 16) * ldc + col0;
                const f32x4 g0 = acc[ai][0][m][0] * scale, g1 = acc[ai][0][m][1] * scale, u0 = acc[ai][1][m][0] * scale, u1 = acc[ai][1][m][1] * scale;
                const float r0 = silu_mul(g0[0], u0[0]), r1 = silu_mul(g0[1], u0[1]), r2 = silu_mul(g0[2], u0[2]), r3 = silu_mul(g0[3], u0[3]);
                const float r4 = silu_mul(g1[0], u1[0]), r5 = silu_mul(g1[1], u1[1]), r6 = silu_mul(g1[2], u1[2]), r7 = silu_mul(g1[3], u1[3]);
                if constexpr (OUT8) { typedef unsigned u32x2 __attribute__((ext_vector_type(2))); u32x2 w; w.x = pk4_fp8(r0, r1, r2, r3); w.y = pk4_fp8(r4, r5, r6, r7); *(u32x2*)((unsigned char*)O + eo) = w; }
                else { u32x4 w; w.x = cvt_pk_bf16(r0, r1); w.y = cvt_pk_bf16(r2, r3); w.z = cvt_pk_bf16(r4, r5); w.w = cvt_pk_bf16(r6, r7); *(u32x4*)((bf16_t*)O + eo) = w; } }
    }
};
typedef EpiSwigluT<false> EpiSwiglu; typedef EpiSwigluT<true> EpiSwiglu8;
struct EpiRes {
    static constexpr bool PERM = false, AFTER_DRAIN = false;
    const float* base_lat; const float* base_ctx; float* out; int ldc; const float* gate; int gate_stride;
    float* part; int part_row0, part_rows;
    __device__ __forceinline__ void operator()(const f32x4 (&acc)[2][2][4][2], const Unit& u, int wr, int wc, int fr, int fq) const {
        if (u.part >= 0) {
            float* pp = part + ((long)u.part * part_rows + (u.pm * BM - part_row0)) * (long)ldc; const int rl0 = wr * 64 + fr, col0 = u.pn * BM + wc * 32 + 4 * fq;
#pragma unroll
            for (int ai = 0; ai < 2; ++ai)
#pragma unroll
                for (int m = 0; m < 4; ++m) { const size_t ro = (size_t)(rl0 + ai * HALF + m * 16) * ldc;
#pragma unroll
                    for (int bj = 0; bj < 2; ++bj)
#pragma unroll
                        for (int n = 0; n < 2; ++n) *(f32x4*)(pp + ro + col0 + bj * HALF + 16 * n) = acc[ai][bj][m][n]; }
            return;
        }
        const int prow = u.pm * BM; const int cond = prow < 4096 ? 0 : (prow < 8192 ? 1 : 2);
        const float* bp = prow < 8192 ? base_lat + (size_t)prow * ldc : base_ctx + (size_t)(prow - 8192) * ldc;
        float* op = out + (size_t)prow * ldc; const float* gp = gate + (size_t)cond * gate_stride;
        const int rl0 = wr * 64 + fr, col0 = u.pn * BM + wc * 32 + 4 * fq;
        f32x4 gv[2][2];
#pragma unroll
        for (int bj = 0; bj < 2; ++bj)
#pragma unroll
            for (int n = 0; n < 2; ++n) gv[bj][n] = *(const f32x4*)(gp + col0 + bj * HALF + 16 * n);
#pragma unroll
        for (int ai = 0; ai < 2; ++ai)
#pragma unroll
            for (int m = 0; m < 4; ++m) { const size_t ro = (size_t)(rl0 + ai * HALF + m * 16) * ldc;
#pragma unroll
                for (int bj = 0; bj < 2; ++bj)
#pragma unroll
                    for (int n = 0; n < 2; ++n) { const int col = col0 + bj * HALF + 16 * n; const f32x4 b = *(const f32x4*)(bp + ro + col);
                        *(f32x4*)(op + ro + col) = b + gv[bj][n] * acc[ai][bj][m][n]; } }
    }
};
struct EpiRowScale {
    static constexpr bool PERM = false, AFTER_DRAIN = false;
    float* out; int ldc; const float* rs; float* part; int part_row0, part_rows; float scale;
    __device__ __forceinline__ void operator()(const f32x4 (&acc)[2][2][4][2], const Unit& u, int wr, int wc, int fr, int fq) const {
        const int row0 = u.pm * BM + wr * 64 + fr, col0 = u.pn * BM + wc * 32 + 4 * fq;
        float* ob = u.part >= 0 ? part + ((long)u.part * part_rows - part_row0) * (long)ldc : out;
#pragma unroll
        for (int ai = 0; ai < 2; ++ai)
#pragma unroll
            for (int m = 0; m < 4; ++m) { const int row = row0 + ai * HALF + m * 16; const float s = rs[row] * scale; float* rp = ob + (size_t)row * ldc + col0;
#pragma unroll
                for (int bj = 0; bj < 2; ++bj)
#pragma unroll
                    for (int n = 0; n < 2; ++n) *(f32x4*)(rp + bj * HALF + 16 * n) = acc[ai][bj][m][n] * s; }
    }
};

typedef int v8i __attribute__((ext_vector_type(8)));
__device__ __forceinline__ v8i cat8(bf16x8 a, bf16x8 b) { struct P { bf16x8 a, b; } p{a, b}; return __builtin_bit_cast(v8i, p); }
template <class Epi, class Sched, bool ALIGN_EPI = false, bool SP2 = false, bool FP8 = false>
__device__ __forceinline__ void gemm_phase(PG8_LAS unsigned char* lds, const Gemm g, const Sched& S, const Epi& E) {
    const int tid = threadIdx.x, wid = __builtin_amdgcn_readfirstlane(tid >> 6), lane = tid & 63, wr = wid >> 2, wc = wid & 3, fr = lane & 15, fq = lane >> 4;
    const int K = g.K; const int pitch = FP8 ? K : K * 2;
    unsigned voffA[2], voffB[2];
#pragma unroll
    for (int i = 0; i < 2; ++i) { int R, C; stage_rc(tid * 16 + i * 8192, R, C); const int Rb = Epi::PERM ? ((R & ~31) + perm32(R & 31)) : R;
        voffA[i] = (unsigned)(R * pitch + C * 2); voffB[i] = (unsigned)(Rb * pitch + C * 2); }
    const size_t kstep = (size_t)(BK * 2);
    const size_t hstep = (size_t)HALF * pitch;
    const size_t tstep = 2 * hstep;
    const unsigned ldsw = (unsigned)wid * 1024u;
    const int aoff = lds_byte(wr * 64 + fr, fq * 8), boff = lds_byte(wc * 32 + fr, fq * 8);
#define PG8_SA(b, h) (((b) * 2 + (h)) * HTB)
#define PG8_SB(b, h) ((4 + (b) * 2 + (h)) * HTB)
#define PG8_STAGE(bufoff, gbase, voff) do { _Pragma("unroll") for (int _i = 0; _i < 2; ++_i) \
        __builtin_amdgcn_global_load_lds((const unsigned*)((const char*)(gbase) + (voff)[_i]), (PG8_LAS unsigned*)(lds + (bufoff) + ldsw + _i * 8192), 16, 0, 0); } while (0)
#define PG8_LDA(dst, b, h) do { _Pragma("unroll") for (int m = 0; m < 4; ++m) _Pragma("unroll") for (int k = 0; k < 2; ++k) dst[m][k] = *(const PG8_LAS bf16x8*)(lds + PG8_SA(b, h) + aoff + m * 2048 + k * 1024); } while (0)
#define PG8_LDB(dst, b, h) do { _Pragma("unroll") for (int n = 0; n < 2; ++n) _Pragma("unroll") for (int k = 0; k < 2; ++k) dst[n][k] = *(const PG8_LAS bf16x8*)(lds + PG8_SB(b, h) + boff + n * 2048 + k * 1024); } while (0)
#define PG8_MMA(ai, bj, At, Bt) do { __builtin_amdgcn_s_setprio(1); if constexpr (FP8) { _Pragma("unroll") for (int m = 0; m < 4; ++m) _Pragma("unroll") for (int n = 0; n < 2; ++n) \
        asm volatile("v_mfma_f32_16x16x128_f8f6f4 %0, %1, %2, %0" : "+v"(acc[ai][bj][m][n]) : "v"(cat8(Bt[n][0], Bt[n][1])), "v"(cat8(At[m][0], At[m][1]))); } \
      else { _Pragma("unroll") for (int m = 0; m < 4; ++m) _Pragma("unroll") for (int n = 0; n < 2; ++n) _Pragma("unroll") for (int k = 0; k < 2; ++k) \
        acc[ai][bj][m][n] = __builtin_amdgcn_mfma_f32_16x16x32_bf16(Bt[n][k], At[m][k], acc[ai][bj][m][n], 0, 0, 0); } __builtin_amdgcn_s_setprio(0); } while (0)
#define PG8_WAIT_V(n) asm volatile("s_waitcnt vmcnt(" #n ")" ::: "memory")
#define PG8_WAIT_L(n) asm volatile("s_waitcnt lgkmcnt(" #n ")" ::: "memory")
#define PG8_BAR __builtin_amdgcn_s_barrier()
#define PG8_SCHED __builtin_amdgcn_sched_barrier(0)
    Unit cur, nxt; int ui = 0;
    if (!S.next(0, cur)) return;
    f32x4 acc[2][2][4][2];
#pragma unroll
    for (int a = 0; a < 2; ++a)
#pragma unroll
        for (int b = 0; b < 2; ++b)
#pragma unroll
            for (int m = 0; m < 4; ++m)
#pragma unroll
                for (int n = 0; n < 2; ++n) acc[a][b][m][n] = (f32x4){0.f, 0.f, 0.f, 0.f};
    bf16x8 At[4][2], B0[2][2], B1[2][2];
    const char* cA = (const char*)g.A + (size_t)cur.pm * tstep + (size_t)cur.kt0 * kstep; const char* cB = (const char*)g.Bt + (size_t)cur.pnb * tstep + (size_t)cur.kt0 * kstep;
    S.a_ready(cur);
    if constexpr (SP2) {
        PG8_STAGE(PG8_SB(0, 0), cB, voffB); PG8_STAGE(PG8_SB(0, 1), cB + hstep, voffB); PG8_STAGE(PG8_SA(0, 0), cA, voffA); PG8_STAGE(PG8_SA(0, 1), cA + hstep, voffA);
        if (wr == 1) PG8_BAR;
        PG8_WAIT_V(2); PG8_BAR;
        PG8_STAGE(PG8_SB(1, 0), cB + kstep, voffB); PG8_STAGE(PG8_SA(1, 0), cA + kstep, voffA); PG8_STAGE(PG8_SB(1, 1), cB + hstep + kstep, voffB);
        PG8_WAIT_V(6); PG8_BAR;
    } else {
        PG8_STAGE(PG8_SB(0, 0), cB, voffB); PG8_STAGE(PG8_SA(0, 0), cA, voffA); PG8_STAGE(PG8_SB(0, 1), cB + hstep, voffB); PG8_STAGE(PG8_SA(0, 1), cA + hstep, voffA);
        if (wr == 1) PG8_BAR;
        PG8_WAIT_V(4); PG8_BAR;
        PG8_STAGE(PG8_SB(1, 0), cB + kstep, voffB); PG8_STAGE(PG8_SA(1, 0), cA + kstep, voffA); PG8_STAGE(PG8_SB(1, 1), cB + hstep + kstep, voffB);
        PG8_WAIT_V(6); PG8_BAR;
    }
    for (;;) {
        const bool has_next = S.next(ui + 1, nxt);
        const char* nA = has_next ? (const char*)g.A + (size_t)nxt.pm * tstep + (size_t)nxt.kt0 * kstep : cA; const char* nB = has_next ? (const char*)g.Bt + (size_t)nxt.pnb * tstep + (size_t)nxt.kt0 * kstep : cB;
        const int nt = cur.nkt;
        for (int t = 0; t < nt; t += 2) {
            const bool last = (t == nt - 2);
            const char* a1 = cA + (size_t)(t + 1) * kstep;
            const char* a2 = last ? nA : cA + (size_t)(t + 2) * kstep; const char* b2 = last ? nB : cB + (size_t)(t + 2) * kstep;
            const char* a3 = a2 + kstep; const char* b3 = b2 + kstep;
            if (last && has_next) S.a_ready(nxt);
            if constexpr (SP2) {
            PG8_LDB(B0, 0, 0); PG8_LDB(B1, 0, 1); PG8_SCHED; PG8_LDA(At, 0, 0); PG8_STAGE(PG8_SA(1, 1), a1 + hstep, voffA);
            PG8_WAIT_V(8); PG8_WAIT_L(0); PG8_BAR; PG8_MMA(0, 0, At, B0); PG8_MMA(0, 1, At, B1); PG8_BAR; PG8_SCHED;
            PG8_LDA(At, 0, 1); PG8_STAGE(PG8_SB(0, 0), b2, voffB); PG8_STAGE(PG8_SB(0, 1), b2 + hstep, voffB); PG8_STAGE(PG8_SA(0, 0), a2, voffA);
            PG8_WAIT_V(8); PG8_WAIT_L(0); PG8_BAR; PG8_MMA(1, 0, At, B0); PG8_MMA(1, 1, At, B1); PG8_BAR; PG8_SCHED;
            PG8_LDB(B0, 1, 0); PG8_LDB(B1, 1, 1); PG8_SCHED; PG8_LDA(At, 1, 0); PG8_STAGE(PG8_SA(0, 1), a2 + hstep, voffA);
            PG8_WAIT_V(8); PG8_WAIT_L(0); PG8_BAR; PG8_MMA(0, 0, At, B0); PG8_MMA(0, 1, At, B1); PG8_BAR; PG8_SCHED;
            PG8_LDA(At, 1, 1); PG8_STAGE(PG8_SB(1, 0), b3, voffB); PG8_STAGE(PG8_SB(1, 1), b3 + hstep, voffB); PG8_STAGE(PG8_SA(1, 0), a3, voffA);
            PG8_WAIT_V(8); PG8_WAIT_L(0); PG8_BAR; PG8_MMA(1, 0, At, B0); PG8_MMA(1, 1, At, B1); PG8_BAR; PG8_SCHED;
            } else {
            PG8_LDB(B0, 0, 0); PG8_SCHED; PG8_LDA(At, 0, 0); PG8_STAGE(PG8_SA(1, 1), a1 + hstep, voffA);
            PG8_WAIT_L(8); PG8_BAR; PG8_WAIT_L(0); PG8_MMA(0, 0, At, B0); PG8_BAR; PG8_SCHED;
            PG8_LDB(B1, 0, 1); PG8_STAGE(PG8_SB(0, 0), b2, voffB);
            PG8_BAR; PG8_WAIT_L(0); PG8_MMA(0, 1, At, B1); PG8_BAR;
            PG8_LDA(At, 0, 1); PG8_STAGE(PG8_SA(0, 0), a2, voffA);
            PG8_BAR; PG8_WAIT_L(0); PG8_MMA(1, 0, At, B0); PG8_BAR; PG8_SCHED;
            PG8_STAGE(PG8_SB(0, 1), b2 + hstep, voffB);
            PG8_WAIT_V(6); PG8_BAR; PG8_MMA(1, 1, At, B1); PG8_BAR;
            PG8_LDB(B0, 1, 0); PG8_SCHED; PG8_LDA(At, 1, 0); PG8_STAGE(PG8_SA(0, 1), a2 + hstep, voffA);
            PG8_WAIT_L(8); PG8_BAR; PG8_WAIT_L(0); PG8_MMA(0, 0, At, B0); PG8_BAR; PG8_SCHED;
            PG8_LDB(B1, 1, 1); PG8_STAGE(PG8_SB(1, 0), b3, voffB);
            PG8_BAR; PG8_WAIT_L(0); PG8_MMA(0, 1, At, B1); PG8_BAR;
            PG8_LDA(At, 1, 1); PG8_STAGE(PG8_SA(1, 0), a3, voffA);
            PG8_BAR; PG8_WAIT_L(0); PG8_MMA(1, 0, At, B0); PG8_BAR; PG8_SCHED;
            PG8_STAGE(PG8_SB(1, 1), b3 + hstep, voffB);
            PG8_WAIT_V(6); PG8_BAR; PG8_MMA(1, 1, At, B1); PG8_BAR;
            }
        }
        if constexpr (FP8) asm volatile("s_nop 15\n\ts_nop 15" ::: "memory");
        if constexpr (ALIGN_EPI) { if (wr == 0) PG8_BAR; }
        if constexpr (!Epi::AFTER_DRAIN) { E(acc, cur, wr, wc, fr, fq); S.done(cur); }
        if (!has_next) break;
#pragma unroll
        for (int a = 0; a < 2; ++a)
#pragma unroll
            for (int b = 0; b < 2; ++b)
#pragma unroll
                for (int m = 0; m < 4; ++m)
#pragma unroll
                    for (int n = 0; n < 2; ++n) acc[a][b][m][n] = (f32x4){0.f, 0.f, 0.f, 0.f};
        cur = nxt; cA = nA; cB = nB; ++ui;
        if constexpr (ALIGN_EPI) { if (wr == 1) PG8_BAR; }
    }
    PG8_WAIT_V(0);
    if constexpr (!ALIGN_EPI) { if (wr == 0) PG8_BAR; }
    PG8_BAR;
    if constexpr (Epi::AFTER_DRAIN) { E.fused(acc, cur, wr, wc, fr, fq, lds, wid, lane); S.done(cur); }
#undef PG8_SA
#undef PG8_SB
#undef PG8_STAGE
#undef PG8_LDA
#undef PG8_LDB
#undef PG8_MMA
#undef PG8_WAIT_V
#undef PG8_WAIT_L
#undef PG8_BAR
#undef PG8_SCHED
}
}


namespace att {
using bf16 = __hip_bfloat16;
constexpr int   D = 128, NW = 8, QBLK = 32, KVBLK = 64;
constexpr float SCALE = 0.088388347648318440f;
constexpr float THR = 8.f;
constexpr int LDQ = 128, LDK = 128;
constexpr size_t SHM_V = KVBLK * D * 2, SHM_K = KVBLK * D * 2, SHM_ATTN = 2 * SHM_V + 2 * SHM_K + NW * 64 * 4;
using bf16x8 = __attribute__((ext_vector_type(8))) short;
using s16x4  = __attribute__((ext_vector_type(4))) short;
using f32x16 = __attribute__((ext_vector_type(16))) float;
using u32x4  = __attribute__((ext_vector_type(4))) unsigned;
#define KSWZ(row, colB) ((row) * 256 + ((colB) ^ (((row) & 7) << 4)))
#define SBAR() __builtin_amdgcn_sched_barrier(0)
__device__ __forceinline__ int crow(int r, int hi) { return (r & 3) + 8 * (r >> 2) + 4 * hi; }
__device__ __forceinline__ unsigned cvtpk(float lo, float hi) {
  unsigned r; asm volatile("v_cvt_pk_bf16_f32 %0, %1, %2" : "=v"(r) : "v"(lo), "v"(hi)); return r;
}
__device__ __forceinline__ void partialSM(f32x16& p0, f32x16& p1, float& m_reg, float& mn, float& alpha) {
  constexpr float C = SCALE * 1.4426950408889634f;
  float pmax = p0[0];
#pragma unroll
  for (int r = 1; r < 16; ++r) pmax = fmaxf(pmax, p0[r]);
#pragma unroll
  for (int r = 0; r < 16; ++r) pmax = fmaxf(pmax, p1[r]);
  { auto rr = __builtin_amdgcn_permlane32_swap(__float_as_uint(pmax), __float_as_uint(pmax), false, false);
    pmax = fmaxf(__uint_as_float(rr[0]), __uint_as_float(rr[1])); }
  if (__builtin_expect(__all(pmax - m_reg <= THR / SCALE), 1)) { mn = m_reg; alpha = 1.f; }
  else { mn = fmaxf(m_reg, pmax); alpha = __builtin_amdgcn_exp2f((m_reg - mn) * C); m_reg = mn; }
  float mnC = -mn * C;
#pragma unroll
  for (int r = 0; r < 16; ++r) p0[r] = fmaf(p0[r], C, mnC);
#pragma unroll
  for (int r = 0; r < 16; ++r) p1[r] = fmaf(p1[r], C, mnC);
#pragma unroll
  for (int r = 0; r < 16; ++r) p0[r] = __builtin_amdgcn_exp2f(p0[r]);
}
__device__ __forceinline__ void finishSM(f32x16& p0, f32x16& p1, float alpha, float& l_reg, bf16x8& pa0, bf16x8& pa1, bf16x8& pa2, bf16x8& pa3) {
#pragma unroll
  for (int r = 0; r < 16; ++r) p1[r] = __builtin_amdgcn_exp2f(p1[r]);
  float ps = 0;
#pragma unroll
  for (int r = 0; r < 16; ++r) ps += p0[r];
#pragma unroll
  for (int r = 0; r < 16; ++r) ps += p1[r];
  { auto rr = __builtin_amdgcn_permlane32_swap(__float_as_uint(ps), __float_as_uint(ps), false, false);
    ps = __uint_as_float(rr[0]) + __uint_as_float(rr[1]); }
  l_reg = l_reg * alpha + ps;
#define PK4(P, BASE, OUT) do { unsigned a0 = cvtpk(P[BASE + 0], P[BASE + 1]), a1 = cvtpk(P[BASE + 2], P[BASE + 3]);   \
    unsigned b0 = cvtpk(P[BASE + 4], P[BASE + 5]), b1 = cvtpk(P[BASE + 6], P[BASE + 7]);                              \
    auto r0 = __builtin_amdgcn_permlane32_swap(a0, b0, false, false); auto r1 = __builtin_amdgcn_permlane32_swap(a1, b1, false, false); \
    u32x4 w = {r0[0], r1[0], r0[1], r1[1]}; OUT = *reinterpret_cast<bf16x8*>(&w); } while (0)
  PK4(p0, 0, pa0); PK4(p0, 8, pa1); PK4(p1, 0, pa2); PK4(p1, 8, pa3);
#undef PK4
}
__device__ __forceinline__ void qkt(f32x16& p0, f32x16& p1, const bf16* Ks, const bf16x8* qr, int r32, int hi) {
  p0 = f32x16{}; p1 = f32x16{};
#pragma unroll
  for (int d0 = 0; d0 < 8; ++d0) { int cb = (d0 * 16 + hi * 8) * 2;
    bf16x8 b0 = *reinterpret_cast<const bf16x8*>((const char*)Ks + KSWZ(r32, cb));
    bf16x8 b1 = *reinterpret_cast<const bf16x8*>((const char*)Ks + KSWZ(32 + r32, cb));
    p0 = __builtin_amdgcn_mfma_f32_32x32x16_bf16(b0, qr[d0], p0, 0, 0, 0);
    p1 = __builtin_amdgcn_mfma_f32_32x32x16_bf16(b1, qr[d0], p1, 0, 0, 0); }
}
__device__ __forceinline__ void maskt(f32x16& p0, f32x16& p1, int kbase, int qpos, int hi) {
#pragma unroll
  for (int r = 0; r < 16; ++r) { const int d0 = qpos - (kbase + crow(r, hi)); const int d1 = d0 - 32;
    if (d0 > 128 || d0 < -128) p0[r] = -1e30f;
    if (d1 > 128 || d1 < -128) p1[r] = -1e30f; }
}
__device__ __forceinline__ int v_st(int k, int c) { const int kk = (k & ~0xC) | ((k & 4) << 1) | ((k & 8) >> 1); return ((kk >> 3) * 4 + (c >> 5)) * 512 + ((kk & 7) * 32 + (c & 31)) * 2; }
__device__ __forceinline__ int v_rd_base(int lane) { return ((lane & 3) << 3) | (((lane >> 2) & 3) << 6) | (((lane >> 4) & 1) << 5) | (((lane >> 5) & 1) << 8); }
constexpr int v_rd_off(int d0, int ks, int half) { return d0 * 512 + ks * 4096 + half * 2048; }
template <int OFF> __device__ __forceinline__ s16x4 tr_read(int vb) {
  s16x4 r; asm volatile("ds_read_b64_tr_b16 %0, %1 offset:%2" : "=&v"(r) : "v"(vb), "i"(OFF) : "memory"); return r;
}
template <int D0> __device__ __forceinline__ void pv_one(f32x16& od, int vb, bf16x8 pa0, bf16x8 pa1, bf16x8 pa2, bf16x8 pa3) {
  const s16x4 l0 = tr_read<v_rd_off(D0, 0, 0)>(vb), h0 = tr_read<v_rd_off(D0, 0, 1)>(vb), l1 = tr_read<v_rd_off(D0, 1, 0)>(vb), h1 = tr_read<v_rd_off(D0, 1, 1)>(vb);
  const s16x4 l2 = tr_read<v_rd_off(D0, 2, 0)>(vb), h2 = tr_read<v_rd_off(D0, 2, 1)>(vb), l3 = tr_read<v_rd_off(D0, 3, 0)>(vb), h3 = tr_read<v_rd_off(D0, 3, 1)>(vb);
  asm volatile("s_waitcnt lgkmcnt(0)" ::: "memory"); SBAR();
#define PK(L, H) (bf16x8){L[0], L[1], L[2], L[3], H[0], H[1], H[2], H[3]}
  od = __builtin_amdgcn_mfma_f32_32x32x16_bf16(pa0, PK(l0, h0), od, 0, 0, 0);
  od = __builtin_amdgcn_mfma_f32_32x32x16_bf16(pa1, PK(l1, h1), od, 0, 0, 0);
  od = __builtin_amdgcn_mfma_f32_32x32x16_bf16(pa2, PK(l2, h2), od, 0, 0, 0);
  od = __builtin_amdgcn_mfma_f32_32x32x16_bf16(pa3, PK(l3, h3), od, 0, 0, 0);
#undef PK
}
__device__ __forceinline__ void pv_d0(f32x16* o, int vb, bf16x8 pa0, bf16x8 pa1, bf16x8 pa2, bf16x8 pa3) {
  pv_one<0>(o[0], vb, pa0, pa1, pa2, pa3); pv_one<1>(o[1], vb, pa0, pa1, pa2, pa3); pv_one<2>(o[2], vb, pa0, pa1, pa2, pa3); pv_one<3>(o[3], vb, pa0, pa1, pa2, pa3);
}

template <bool MASK, bool OUT_BF16>
__device__ __forceinline__ void attn_unit(const bf16* __restrict__ Qb, const bf16* __restrict__ Kh, const bf16* __restrict__ Vh, void* __restrict__ Ob, int ldo,
                                          int klo, int nt1, int NT, int qpos0, float m_init, float l_init, char* lds) {
  const int tid = threadIdx.x, wid = tid >> 6, lane = tid & 63, r32 = lane & 31, hi = lane >> 5;
  bf16* V_lds = (bf16*)lds; bf16* K_lds = (bf16*)(lds + 2 * SHM_V);
  float* ws = (float*)(lds + 2 * SHM_V + 2 * SHM_K) + wid * 64; float* li_l = ws; float* al_l = ws + 32;
  float m_reg = m_init, l_reg = l_init; f32x16 o[4] = {}; bf16x8 qr[8];
  const bf16* Qw = Qb + (long)(wid * QBLK + r32) * LDQ + hi * 8;
#pragma unroll
  for (int d0 = 0; d0 < 8; ++d0) qr[d0] = *reinterpret_cast<const bf16x8*>(Qw + d0 * 16);
  const int sr = tid >> 4, sc = (tid & 15) * 8, vst0 = v_st(sr, sc), vst1 = v_st(32 + sr, sc);
  const int vb0 = (int)(uintptr_t)V_lds + v_rd_base(lane);
  const int qpos = qpos0 + wid * QBLK + r32;
  struct { bf16x8 vs0, vs1, ks0, ks1; } sr_[2];
#define KROW(t) ((t) < nt1 ? klo + (t) * KVBLK : 4096 + ((t) - nt1) * KVBLK)
#define SLOAD(i, t) do { const int k0_ = KROW(t); sr_[i].vs0 = *reinterpret_cast<const bf16x8*>(&Vh[(long)(k0_ + sr) * LDK + sc]); sr_[i].vs1 = *reinterpret_cast<const bf16x8*>(&Vh[(long)(k0_ + 32 + sr) * LDK + sc]); \
    sr_[i].ks0 = *reinterpret_cast<const bf16x8*>(&Kh[(long)(k0_ + sr) * LDK + sc]); sr_[i].ks1 = *reinterpret_cast<const bf16x8*>(&Kh[(long)(k0_ + 32 + sr) * LDK + sc]); } while (0)
#define SWRITE(b, i) do { *(bf16x8*)((char*)V_lds + (b) * SHM_V + vst0) = sr_[i].vs0;          \
    *(bf16x8*)((char*)V_lds + (b) * SHM_V + vst1) = sr_[i].vs1; int kc = sc * 2;               \
    *(bf16x8*)((char*)K_lds + (b) * SHM_K + KSWZ(sr, kc)) = sr_[i].ks0;                       \
    *(bf16x8*)((char*)K_lds + (b) * SHM_K + KSWZ(32 + sr, kc)) = sr_[i].ks1; } while (0)
#define SWAIT() asm volatile("s_waitcnt vmcnt(4)" ::: "memory")
#define RESC(a) do { if (__any((a) < 1.f)) { if (hi == 0) al_l[r32] = (a); asm volatile("s_waitcnt lgkmcnt(0)" ::: "memory"); \
    _Pragma("unroll") for (int d = 0; d < 4; ++d) _Pragma("unroll") for (int r = 0; r < 16; ++r) o[d][r] *= al_l[crow(r, hi)]; } } while (0)
#define MASKT(P0, P1, t) do { if (MASK) { if ((t) < nt1) maskt(P0, P1, klo + (t) * KVBLK, qpos, hi); } } while (0)
  f32x16 pA0, pA1, pB0, pB1; float mnA, mnB, alA, alB; bf16x8 pa0, pa1, pa2, pa3;
  constexpr int SE = 0, SO = 1;
  SLOAD(SE, 0); asm volatile("s_waitcnt vmcnt(0)" ::: "memory"); SWRITE(0, SE); __syncthreads();
  qkt(pA0, pA1, K_lds, qr, r32, hi); MASKT(pA0, pA1, 0); partialSM(pA0, pA1, m_reg, mnA, alA);
  SLOAD(SO, 1); if (2 < NT) SLOAD(SE, 2);
  SWAIT(); SWRITE(1, SO); __syncthreads();
  for (int j = 1; j + 1 < NT; j += 2) {
    SBAR(); qkt(pB0, pB1, (bf16*)((char*)K_lds + SHM_K), qr, r32, hi);
    finishSM(pA0, pA1, alA, l_reg, pa0, pa1, pa2, pa3); SBAR();
    SLOAD(SO, j + 2); SBAR();
    pv_d0(o, vb0, pa0, pa1, pa2, pa3); MASKT(pB0, pB1, j); partialSM(pB0, pB1, m_reg, mnB, alB);
    __syncthreads(); SWAIT(); SWRITE(0, SE);
    RESC(alB); __syncthreads();
    SBAR(); qkt(pA0, pA1, K_lds, qr, r32, hi);
    finishSM(pB0, pB1, alB, l_reg, pa0, pa1, pa2, pa3); SBAR();
    if (j + 3 < NT) SLOAD(SE, j + 3); SBAR();
    pv_d0(o, vb0 + (int)SHM_V, pa0, pa1, pa2, pa3); MASKT(pA0, pA1, j + 1); partialSM(pA0, pA1, m_reg, mnA, alA);
    __syncthreads(); SWAIT(); SWRITE(1, SO);
    RESC(alA); __syncthreads();
  }
  SBAR(); qkt(pB0, pB1, (bf16*)((char*)K_lds + SHM_K), qr, r32, hi);
  finishSM(pA0, pA1, alA, l_reg, pa0, pa1, pa2, pa3); SBAR();
  pv_d0(o, vb0, pa0, pa1, pa2, pa3); MASKT(pB0, pB1, NT - 1); partialSM(pB0, pB1, m_reg, mnB, alB);
  __syncthreads(); RESC(alB);
  finishSM(pB0, pB1, alB, l_reg, pa0, pa1, pa2, pa3); SBAR();
  pv_d0(o, vb0 + (int)SHM_V, pa0, pa1, pa2, pa3);
  if (hi == 0) li_l[r32] = l_reg; asm volatile("s_waitcnt lgkmcnt(0)" ::: "memory");
  float rli[16];
#pragma unroll
  for (int r = 0; r < 16; ++r) rli[r] = __builtin_amdgcn_rcpf(li_l[crow(r, hi)]);
  if constexpr (OUT_BF16) {
    bf16* Ow = (bf16*)Ob + (long)(wid * QBLK) * ldo;
#pragma unroll
    for (int r = 0; r < 16; ++r) { int orow = crow(r, hi);
#pragma unroll
      for (int d0 = 0; d0 < 4; ++d0) { const float ov = o[d0][r] * rli[r]; ((unsigned short*)Ow)[(long)orow * ldo + d0 * 32 + r32] = (unsigned short)cvtpk(ov, ov); } }
  } else {
    float* Ow = (float*)Ob + (long)(wid * QBLK) * ldo;
#pragma unroll
    for (int r = 0; r < 16; ++r) { int orow = crow(r, hi);
#pragma unroll
      for (int d0 = 0; d0 < 4; ++d0) Ow[(long)orow * ldo + d0 * 32 + r32] = o[d0][r] * rli[r]; }
  }
  __syncthreads();
#undef KROW
#undef SLOAD
#undef SWRITE
#undef SWAIT
#undef RESC
#undef MASKT
}
#undef KSWZ
#undef SBAR
}

constexpr int NWAVES = 8;
constexpr int D = 2048, NB = 2, SEQ = 4096, CTXL = 256;
constexpr int TL = NB * SEQ, TC = NB * CTXL, MR = TL + TC;
constexpr int KVR = SEQ + CTXL;
constexpr int EVEN_IN = 4608, ODD_IN = 3072, DFF = 5632, DFE = 7168, NE = 8, MODW = 6 * D;
constexpr int NSLOT0 = 36, NSLOT1 = 24;
constexpr int MAXT = 72, XROWS = MAXT * 256;
constexpr float EPS = 1e-6f;
constexpr float LAM_INIT = 0.2f;

constexpr size_t MiB = 1u << 20;
constexpr size_t WS_CTL = 0, CTL_ZERO_BYTES = 1 * MiB;
constexpr size_t WS_MODS = 1 * MiB;
constexpr size_t WS_LAM = WS_MODS + 512 * 1024;
constexpr size_t WS_ROUTE = 2 * MiB;
constexpr size_t RT_EID = WS_ROUTE, RT_GATE = WS_ROUTE + 64 * 1024, RT_POS = WS_ROUTE + 128 * 1024, RT_ROWTOK = WS_ROUTE + 192 * 1024, RT_ROWGATE = WS_ROUTE + 272 * 1024,
                 RT_TILE_E = WS_ROUTE + 352 * 1024, RT_NTILES = WS_ROUTE + 353 * 1024;
constexpr size_t WS_WT_EIN = 4 * MiB, WS_WT_EOUT = 22 * MiB, WS_WT_EF1 = 30 * MiB, WS_WT_EF2 = 74 * MiB, WS_WT_OIN = 96 * MiB, WS_WT_OOUT = 108 * MiB,
                 WS_WT_X1 = 116 * MiB, WS_WT_X2 = 564 * MiB;
constexpr size_t WS_H = 788 * MiB, WS_Z = 822 * MiB, WS_QKV = 900 * MiB, WS_PB = 978 * MiB, WS_OALL = 1046 * MiB, WS_X1 = 1080 * MiB, WS_X3 = 1148 * MiB,
                 WS_ACT = 1212 * MiB, WS_XS = 1306 * MiB, WS_ACT2 = 1378 * MiB, WS_YS = 1630 * MiB, WS_PART = 1774 * MiB, WS_END = 1838 * MiB;
static_assert(WS_WT_EIN + (size_t)EVEN_IN * D * 2 <= WS_WT_EOUT && WS_WT_EF1 + (size_t)2 * DFF * D * 2 <= WS_WT_EF2 && WS_WT_EF2 + (size_t)D * DFF * 2 <= WS_WT_OIN &&
              WS_WT_OIN + (size_t)ODD_IN * D * 2 <= WS_WT_OOUT && WS_WT_X1 + (size_t)NE * 2 * DFE * D * 2 <= WS_WT_X2 && WS_WT_X2 + (size_t)NE * D * DFE * 2 <= WS_H &&
              WS_H + (size_t)MR * D * 2 <= WS_Z && WS_Z + (size_t)MR * EVEN_IN * 2 <= WS_QKV && WS_QKV + (size_t)NB * NSLOT0 * KVR * 128 * 2 <= WS_PB &&
              WS_PB + (size_t)NB * 16 * KVR * 128 * 4 <= WS_OALL && WS_OALL + (size_t)MR * D * 2 <= WS_X1 && WS_X1 + (size_t)MR * D * 4 <= WS_X3 && WS_X3 + (size_t)TL * D * 4 <= WS_ACT &&
              WS_ACT + (size_t)MR * DFF * 2 <= WS_XS && WS_XS + (size_t)XROWS * D * 2 <= WS_ACT2 && WS_ACT2 + (size_t)XROWS * DFE * 2 <= WS_YS && WS_YS + (size_t)XROWS * D * 4 <= WS_PART && WS_PART + 64 * MiB <= WS_END, "d_ws map");
constexpr int CW_BAR = 4096;

constexpr int RING_BYTES = 131072;
constexpr int LDSCTL_OFF = 143360, MISC_OFF = LDSCTL_OFF + 320;
constexpr int LDS_BYTES = 147456;

#define GAS __attribute__((address_space(1)))
#define LAS __attribute__((address_space(3)))
typedef unsigned short bf16;
typedef unsigned v4u __attribute__((ext_vector_type(4)));
typedef unsigned v2u __attribute__((ext_vector_type(2)));
typedef float f32x4 __attribute__((ext_vector_type(4)));
typedef GAS unsigned gu32;
#define RLX_AGENT __ATOMIC_RELAXED, __HIP_MEMORY_SCOPE_AGENT
#define LDS_WAIT() asm volatile("s_waitcnt lgkmcnt(0)" ::: "memory")
#define VM_WAIT() asm volatile("s_waitcnt vmcnt(0)" ::: "memory")
__device__ __forceinline__ unsigned f2bf(float f) { unsigned u = __builtin_bit_cast(unsigned, f); return (u + 0x7fffu + ((u >> 16) & 1u)) >> 16; }
__device__ __forceinline__ unsigned pk2(float lo, float hi) { return f2bf(lo) | (f2bf(hi) << 16); }
using pg8::pk4_fp8;
constexpr float W8_SCALE = 64.f;
__device__ __forceinline__ float bflo(unsigned w) { return __builtin_bit_cast(float, w << 16); }
__device__ __forceinline__ float bfhi(unsigned w) { return __builtin_bit_cast(float, w & 0xffff0000u); }
__device__ __forceinline__ float wave_sum(float v) {
#pragma unroll
    for (int o = 1; o < 64; o <<= 1) v += __shfl_xor(v, o);
    return v;
}

#define XB_TMO      128
#define XB_XCNT(j)  (256  + 64 * (j))
#define XB_XSUB(j)  (1280 + 64 * (j))
#define XB_XGEN(j)  (2304 + 64 * (j))
#define XB_TOP      3328
#define XB_TOPGEN   3392
#define XCD_BAR_WORDS 3456
#define XB_SPIN_CAP (1u << 18)

__device__ __forceinline__ unsigned xb_ld(unsigned* p)              { return __hip_atomic_load(p, __ATOMIC_RELAXED, __HIP_MEMORY_SCOPE_AGENT); }
__device__ __forceinline__ unsigned xb_add(unsigned* p, unsigned v) { return __hip_atomic_fetch_add(p, v, __ATOMIC_RELAXED, __HIP_MEMORY_SCOPE_AGENT); }
__device__ __forceinline__ unsigned xb_xcc_id() { return (unsigned)__builtin_amdgcn_s_getreg((3 << 11) | 20) & 0xFu; }
#define XB_SPIN(cond, bar) do { unsigned _sp = 0; while (cond) { __builtin_amdgcn_s_sleep(1); \
    if ((++_sp & 255u) == 0u) { if (xb_ld(&(bar)[XB_TMO])) break; if (_sp > XB_SPIN_CAP) { atomicAdd(&(bar)[XB_TMO], 1u); break; } } } } while (0)

struct XcdBarrier {
    unsigned* bar; unsigned x;
    volatile LAS unsigned* st;
};

__device__ __forceinline__ XcdBarrier xcd_barrier_post(unsigned* bar, volatile LAS unsigned* st) {
    XcdBarrier b; b.bar = bar; b.x = xb_xcc_id(); b.st = st;
    if (threadIdx.x == 0) (void)xb_add(&bar[XB_XCNT(b.x)], 1u);
    return b;
}
__device__ __forceinline__ void xcd_barrier_complete(unsigned* bar, unsigned x, unsigned& nloc, unsigned& nx) {
    const unsigned G = gridDim.x * gridDim.y * gridDim.z;
    unsigned sum, cnt, mine, sp = 0u;
    for (;;) {
        sum = 0u; cnt = 0u; mine = 0u;
#pragma unroll
        for (unsigned j = 0; j < 16; ++j) { const unsigned c = xb_ld(&bar[XB_XCNT(j)]); sum += c; cnt += (c > 0u) ? 1u : 0u; mine = (j == x) ? c : mine; }
        if (sum == G) break;
        __builtin_amdgcn_s_sleep(1);
        if ((++sp & 255u) == 0u) { if (xb_ld(&bar[XB_TMO])) break; if (sp > XB_SPIN_CAP) { atomicAdd(&bar[XB_TMO], 1u); break; } }
    }
    nloc = mine > 0u ? mine : 1u; nx = cnt > 0u ? cnt : 1u;
}

__device__ __forceinline__ void xcd_barrier(const XcdBarrier& b) {
    asm volatile("s_waitcnt vmcnt(0)" ::: "memory");
    __syncthreads();
    if (threadIdx.x == 0) {
        unsigned* bar = b.bar;
        __builtin_amdgcn_s_waitcnt(0);
        unsigned nloc = b.st[0], nx = b.st[1];
        if (nloc == 0u) { xcd_barrier_complete(bar, b.x, nloc, nx); b.st[0] = nloc; b.st[1] = nx; }
        const unsigned old = xb_add(&bar[XB_XSUB(b.x)], 1u);
        const unsigned gen = old / nloc;
        if (old + 1u == (gen + 1u) * nloc) {
            __builtin_amdgcn_fence(__ATOMIC_RELEASE, "agent");
            asm volatile("s_waitcnt vmcnt(0)" ::: "memory");
            const unsigned og = xb_add(&bar[XB_TOP], 1u);
            const unsigned tg = og / nx;
            if (og + 1u == (tg + 1u) * nx) xb_add(&bar[XB_TOPGEN], 1u);
            else XB_SPIN(xb_ld(&bar[XB_TOPGEN]) == tg, bar);
            __builtin_amdgcn_fence(__ATOMIC_ACQUIRE, "agent");
            xb_add(&bar[XB_XGEN(b.x)], 1u);
            asm volatile("s_waitcnt vmcnt(0)" ::: "memory");
        } else {
            XB_SPIN(xb_ld(&bar[XB_XGEN(b.x)]) == gen, bar);
            __builtin_amdgcn_fence(__ATOMIC_ACQUIRE, "agent");
            asm volatile("s_waitcnt vmcnt(0)" ::: "memory");
        }
    }
    __syncthreads();
}


struct Ctx {
    LAS unsigned char* lds; int tid, lane, wave, G, c, gw, NGW;
};

__device__ __forceinline__ void transpose_item(const float* __restrict__ W, int K, int N, bf16* __restrict__ WT, int q, int kind, LAS float* scr, int lane) {
    const int nblk = N >> 6, kb = q / nblk, nb = q - kb * nblk, k0 = kb * 64, n0 = nb * 64;
    int dest0 = n0;
    if (kind) { const int hf = N >> 1; const int j = n0 < hf ? n0 : n0 - hf; dest0 = (j >> 7) * 256 + (j & 127) + (n0 < hf ? 0 : 128); }
    const int l16 = lane & 15, kq = lane >> 4;
    f32x4 v[16];
#pragma unroll
    for (int i = 0; i < 16; ++i) v[i] = *(const f32x4*)(W + (size_t)(k0 + 4 * i + kq) * N + n0 + 4 * l16);
#pragma unroll
    for (int i = 0; i < 16; ++i) { LAS float* p = scr + (4 * i + kq) * 65 + 4 * l16; p[0] = v[i].x; p[1] = v[i].y; p[2] = v[i].z; p[3] = v[i].w; }
    LDS_WAIT(); asm volatile("" ::: "memory");
    const int c = lane & 7, nn = lane >> 3;
#pragma unroll
    for (int jj = 0; jj < 8; ++jj) { const int n = nn + 8 * jj; const LAS float* s = scr + (8 * c) * 65 + n;
        v4u o; o.x = pk2(s[0 * 65], s[1 * 65]); o.y = pk2(s[2 * 65], s[3 * 65]); o.z = pk2(s[4 * 65], s[5 * 65]); o.w = pk2(s[6 * 65], s[7 * 65]);
        *(v4u*)(WT + (size_t)(dest0 + n) * K + k0 + 8 * c) = o; }
    LDS_WAIT(); asm volatile("" ::: "memory");
}

__device__ __forceinline__ void transpose_item8(const float* __restrict__ W, int K, int N, unsigned char* __restrict__ WT, int q, int kind, LAS float* scr, int lane) {
    const int nblk = N >> 5, kb = q / nblk, nb = q - kb * nblk, k0 = kb * 128, n0 = nb * 32;
    int dest0 = n0;
    if (kind) { const int hf = N >> 1; const int j = n0 < hf ? n0 : n0 - hf; dest0 = (j >> 7) * 256 + (j & 127) + (n0 < hf ? 0 : 128); }
    const int l8 = lane & 7, kq = lane >> 3;
    f32x4 v[16];
#pragma unroll
    for (int i = 0; i < 16; ++i) v[i] = *(const f32x4*)(W + (size_t)(k0 + 8 * i + kq) * N + n0 + 4 * l8);
#pragma unroll
    for (int i = 0; i < 16; ++i) { LAS float* p = scr + (8 * i + kq) * 33 + 4 * l8; p[0] = v[i].x; p[1] = v[i].y; p[2] = v[i].z; p[3] = v[i].w; }
    LDS_WAIT(); asm volatile("" ::: "memory");
    const int c = lane & 7, nn = lane >> 3;
#pragma unroll
    for (int jj = 0; jj < 4; ++jj) { const int n = nn + 8 * jj; const LAS float* s = scr + (16 * c) * 33 + n;
        v4u o; o.x = pk4_fp8(s[0 * 33] * W8_SCALE, s[1 * 33] * W8_SCALE, s[2 * 33] * W8_SCALE, s[3 * 33] * W8_SCALE); o.y = pk4_fp8(s[4 * 33] * W8_SCALE, s[5 * 33] * W8_SCALE, s[6 * 33] * W8_SCALE, s[7 * 33] * W8_SCALE);
        o.z = pk4_fp8(s[8 * 33] * W8_SCALE, s[9 * 33] * W8_SCALE, s[10 * 33] * W8_SCALE, s[11 * 33] * W8_SCALE); o.w = pk4_fp8(s[12 * 33] * W8_SCALE, s[13 * 33] * W8_SCALE, s[14 * 33] * W8_SCALE, s[15 * 33] * W8_SCALE);
        *(v4u*)(WT + (size_t)(dest0 + n) * K + k0 + 16 * c) = o; }
    LDS_WAIT(); asm volatile("" ::: "memory");
}

__device__ __forceinline__ void mod_task(const Ctx& X, int task, const float* cvec, const float* cctx, const float* Wm, const float* bm, float* mods_l) {
    const int ch = task % 48;
    LAS float* S = (LAS float*)X.lds;
    LAS float* R = S + 3 * 2048;
    for (int idx = X.tid; idx < 3 * 2048; idx += NWAVES * 64) { const int i = idx >> 11, k = idx & 2047; const float cv = i < 2 ? cvec[i * 2048 + k] : cctx[k]; S[idx] = cv / (1.f + expf(-cv)); }
    __syncthreads();
    f32x4 a0 = {0.f, 0.f, 0.f, 0.f}, a1 = a0, a2 = a0;
    const float* wp = Wm + (size_t)(X.wave * 256) * MODW + ch * 256 + 4 * X.lane;
    for (int k = 0; k < 256; k += 8) {
        f32x4 w[8];
#pragma unroll
        for (int u = 0; u < 8; ++u) w[u] = *(const f32x4*)(wp + (size_t)(k + u) * MODW);
#pragma unroll
        for (int u = 0; u < 8; ++u) { const int kk = X.wave * 256 + k + u; a0 += w[u] * S[kk]; a1 += w[u] * S[2048 + kk]; a2 += w[u] * S[4096 + kk]; }
    }
#pragma unroll
    for (int j = 0; j < 4; ++j) { R[(X.wave * 3 + 0) * 256 + 4 * X.lane + j] = a0[j]; R[(X.wave * 3 + 1) * 256 + 4 * X.lane + j] = a1[j]; R[(X.wave * 3 + 2) * 256 + 4 * X.lane + j] = a2[j]; }
    __syncthreads();
    for (int idx = X.tid; idx < 768; idx += NWAVES * 64) { const int i = idx >> 8, col = idx & 255; float s = 0.f;
#pragma unroll
        for (int w = 0; w < 8; ++w) s += R[(w * 3 + i) * 256 + col];
        mods_l[(size_t)i * MODW + ch * 256 + col] = s + bm[ch * 256 + col]; }
    __syncthreads();
}

template <bool ROUTER, bool PSUM = false, bool OUT8 = false>
__device__ __forceinline__ void norm_mod_rows(const Ctx& X, const float* src_lat, const float* src_ctx, int nrows, const float* gain, const float* mods_l, int sh_i, int sc_i, bf16* H,
                                              const float* wrouter, int* eid, float* egate, const float* part = nullptr, int Sp = 0, const float* pgate = nullptr, float* wb = nullptr) {
    LAS float* WR = (LAS float*)X.lds;
    if (ROUTER) { for (int idx = X.tid; idx < 8 * 2048; idx += NWAVES * 64) { const int k = idx >> 3, e = idx & 7; WR[e * 2048 + k] = wrouter[idx]; } __syncthreads(); }
    for (int row = X.gw; row < nrows; row += X.NGW) {
        const float* xr = row < TL ? src_lat + (size_t)row * D : src_ctx + (size_t)(row - TL) * D;
        const int cond = row < SEQ ? 0 : (row < TL ? 1 : 2);
        const float* shp = mods_l + (size_t)cond * MODW + sh_i * D; const float* scp = mods_l + (size_t)cond * MODW + sc_i * D;
        f32x4 v[8]; float ss = 0.f;
#pragma unroll
        for (int j = 0; j < 8; ++j) v[j] = *(const f32x4*)(xr + 4 * X.lane + 256 * j);
        if (PSUM) { if (row >= TL) {
            f32x4 a[8];
#pragma unroll
            for (int j = 0; j < 8; ++j) a[j] = (f32x4){0.f, 0.f, 0.f, 0.f};
            for (int p = 0; p < Sp; ++p) { const float* pr = part + ((size_t)p * TC + (row - TL)) * D + 4 * X.lane;
#pragma unroll
                for (int j = 0; j < 8; ++j) a[j] += *(const f32x4*)(pr + 256 * j); }
#pragma unroll
            for (int j = 0; j < 8; ++j) { v[j] += a[j] * *(const f32x4*)(pgate + 4 * X.lane + 256 * j); if (wb) *(f32x4*)(wb + (size_t)(row - TL) * D + 4 * X.lane + 256 * j) = v[j]; }
        } }
#pragma unroll
        for (int j = 0; j < 8; ++j) ss += (v[j].x * v[j].x + v[j].y * v[j].y) + (v[j].z * v[j].z + v[j].w * v[j].w);
        const float rstd = 1.0f / sqrtf(wave_sum(ss) * (1.f / D) + EPS);
#pragma unroll
        for (int j = 0; j < 8; ++j) { const int col = 4 * X.lane + 256 * j; const f32x4 g = *(const f32x4*)(gain + col), sc = *(const f32x4*)(scp + col), sh = *(const f32x4*)(shp + col);
            v[j] = (v[j] * rstd * g) * (sc + 1.0f) + sh;
            if (OUT8) { *(unsigned*)((unsigned char*)H + (size_t)row * D + col) = pk4_fp8(v[j].x, v[j].y, v[j].z, v[j].w); }
            else { v2u o; o.x = pk2(v[j].x, v[j].y); o.y = pk2(v[j].z, v[j].w); *(v2u*)(H + (size_t)row * D + col) = o; } }
        if (ROUTER) {
            float v1 = -3.0e38f, v2 = -3.0e38f; int i1 = 0, i2 = 0;
#pragma unroll 1
            for (int e = 0; e < 8; ++e) { float a = 0.f;
#pragma unroll
                for (int j = 0; j < 8; ++j) { const f32x4 w = *(const LAS f32x4*)(WR + e * 2048 + 4 * X.lane + 256 * j); a += (v[j].x * w.x + v[j].y * w.y) + (v[j].z * w.z + v[j].w * w.w); }
                const float s = wave_sum(a);
                if (s > v1) { v2 = v1; i2 = i1; v1 = s; i1 = e; } else if (s > v2) { v2 = s; i2 = e; } }
            const float ex = expf(v2 - v1), g1 = 1.f / (1.f + ex), g2 = ex / (1.f + ex);
            if (X.lane == 0) { eid[row * 2] = i1; eid[row * 2 + 1] = i2; egate[row * 2] = g1; egate[row * 2 + 1] = g2; }
        }
    }
}

template <int NG>
__device__ __forceinline__ void qkv_post(const Ctx& X, const bf16* z, bf16* QKV, const float* qn_a, const float* kn_a, const float* qn_b, const float* kn_b) {
    typedef float f32x2 __attribute__((ext_vector_type(2)));
    LAS f32x2* CS = (LAS f32x2*)X.lds;
    for (int idx = X.tid; idx < 2048; idx += NWAVES * 64) { const int p = idx >> 5, i = idx & 31; const float inv = exp2f(-(float)i * (13.287712379549449f / 32.0f)); const float a = (float)p * inv;
        float sn, cs; sincosf(a, &sn, &cs); CS[idx] = (f32x2){cs, sn}; }
    __syncthreads();
    const int l16 = X.lane & 15, gq = X.lane >> 4, chunk = l16 >> 2;
    for (int row = X.gw; row < MR; row += X.NGW) {
        const bool lat = row < TL; const int b = lat ? (row >> 12) : ((row - TL) >> 8); const int pos = lat ? (row & 4095) : (SEQ + ((row - TL) & 255));
        const int p = (chunk < 2) ? (pos >> 6) : (pos & 63);
#pragma unroll 1
        for (int it = 0; it < NG / 4; ++it) {
            const int g = it * 4 + gq;
            const float* gp; bool hn;
            if (NG == NSLOT0) { hn = !(g == 10 || g == 11 || g >= 28); gp = g < 8 ? qn_a : (g < 12 ? kn_a : (g < 20 ? qn_b : kn_b)); }
            else { hn = g < 20; gp = g < 16 ? qn_a : kn_a; }
            const v4u raw = *(const v4u*)(z + (size_t)row * (NG * 128) + g * 128 + 8 * l16);
            float v[8] = {bflo(raw.x), bfhi(raw.x), bflo(raw.y), bfhi(raw.y), bflo(raw.z), bfhi(raw.z), bflo(raw.w), bfhi(raw.w)};
            float ss = 0.f;
#pragma unroll
            for (int j = 0; j < 8; ++j) ss += v[j] * v[j];
            ss += __shfl_xor(ss, 1); ss += __shfl_xor(ss, 2); ss += __shfl_xor(ss, 4); ss += __shfl_xor(ss, 8);
            const float rs = 1.0f / sqrtf(ss * (1.f / 128.f) + EPS);
            const f32x4 ga = *(const f32x4*)(gp + 8 * l16), gb = *(const f32x4*)(gp + 8 * l16 + 4);
            const float gg[8] = {ga.x, ga.y, ga.z, ga.w, gb.x, gb.y, gb.z, gb.w};
#pragma unroll
            for (int j = 0; j < 8; ++j) v[j] = hn ? v[j] * rs * gg[j] : v[j];
            float o[8];
#pragma unroll
            for (int j = 0; j < 8; ++j) { const float pv = __shfl_xor(v[j], 4); const f32x2 cs = CS[p * 32 + 8 * (l16 & 3) + j];
                const float rot = (chunk & 1) ? (v[j] * cs.x + pv * cs.y) : (v[j] * cs.x - pv * cs.y); o[j] = (hn && lat) ? rot : v[j]; }
            v4u w; w.x = pk2(o[0], o[1]); w.y = pk2(o[2], o[3]); w.z = pk2(o[4], o[5]); w.w = pk2(o[6], o[7]);
            *(v4u*)(QKV + ((size_t)(b * NG + g) * KVR + pos) * 128 + 8 * l16) = w;
        }
    }
}

__device__ __forceinline__ void b_combine(const Ctx& X, const float* PB, const float* lamv, const float* subln, bf16* OALL) {
    const int half = X.lane >> 5, d4 = (X.lane & 31) * 4;
    for (int item = X.gw; item < MR * 4; item += X.NGW) {
        const int row = item >> 2, hb = item & 3; const bool lat = row < TL; const int b = lat ? (row >> 12) : ((row - TL) >> 8); const int pos = lat ? (row & 4095) : (SEQ + ((row - TL) & 255));
        const f32x4 o1 = *(const f32x4*)(PB + ((size_t)(b * 16 + (hb * 2 + 0) * 2 + half) * KVR + pos) * 128 + d4);
        const f32x4 o2 = *(const f32x4*)(PB + ((size_t)(b * 16 + (hb * 2 + 1) * 2 + half) * KVR + pos) * 128 + d4);
        const float lam = lamv[hb];
        const f32x4 v = o1 - o2 * lam;
        const float ss = wave_sum((v.x * v.x + v.y * v.y) + (v.z * v.z + v.w * v.w));
        const float rs = (1.0f - LAM_INIT) / sqrtf(ss * (1.f / 256.f) + EPS);
        const f32x4 g = *(const f32x4*)(subln + half * 128 + d4);
        const f32x4 y = v * rs * g;
        v2u o; o.x = pk2(y.x, y.y); o.y = pk2(y.z, y.w);
        *(v2u*)(OALL + (size_t)row * D + 1024 + hb * 256 + half * 128 + d4) = o;
    }
}

__device__ __forceinline__ void moe_route(const Ctx& X, const int* eid, const float* egate, const bf16* H, bf16* XS, int* pos, int* rowtok, float* rowgate, int* tile_e, int* ntiles) {
    LAS int* tot = (LAS int*)X.lds;
    LAS int* pre = tot + 8;
    LAS int* base = tot + 16;
    LAS int* dst = tot + 64;
    const int tpw = (TL + X.G - 1) / X.G, t0 = X.c * tpw, t1 = (t0 + tpw) < TL ? (t0 + tpw) : TL;
    if (X.tid < 16) tot[X.tid] = 0;
    __syncthreads();
    for (int idx = X.tid; idx < 2 * TL; idx += NWAVES * 64) { const int e = eid[idx]; __hip_atomic_fetch_add(&tot[e], 1, __ATOMIC_RELAXED, __HIP_MEMORY_SCOPE_WORKGROUP); if ((idx >> 1) < t0) __hip_atomic_fetch_add(&pre[e], 1, __ATOMIC_RELAXED, __HIP_MEMORY_SCOPE_WORKGROUP); }
    __syncthreads();
    if (X.tid == 0) { int acc = 0; for (int e = 0; e < 8; ++e) { base[e] = acc; acc += (tot[e] + 255) & ~255; }
        if (X.c == 0) { *ntiles = acc >> 8; for (int e = 0; e < 8; ++e) { const int nt = (tot[e] + 255) >> 8; for (int i = 0; i < nt; ++i) tile_e[(base[e] >> 8) + i] = e; } } }
    __syncthreads();
    if (X.wave == 0) {
        int run[8];
#pragma unroll
        for (int e = 0; e < 8; ++e) run[e] = 0;
        const int n_ent = 2 * (t1 - t0);
        for (int b0 = 0; b0 < n_ent; b0 += 64) {
            const int li = b0 + X.lane; const bool valid = li < n_ent; const int idx = 2 * t0 + li; const int e = valid ? eid[idx] : -1;
            int rank = 0;
#pragma unroll
            for (int ee = 0; ee < 8; ++ee) { const unsigned long long m = __ballot(e == ee); if (e == ee) rank = run[ee] + __popcll(m & ((1ull << X.lane) - 1ull)); run[ee] += __popcll(m); }
            if (valid) { const int d = base[e] + pre[e] + rank; dst[li] = d; pos[idx] = d; rowtok[d] = idx >> 1; rowgate[d] = egate[idx]; }
        }
    }
    __syncthreads();
    { const int n_ent = 2 * (t1 - t0);
      for (int li = X.wave; li < n_ent; li += NWAVES) { const int tok = t0 + (li >> 1); const int d = dst[li];
          const v4u* s = (const v4u*)((const unsigned char*)H + (size_t)tok * D) + X.lane; v4u* o = (v4u*)((unsigned char*)XS + (size_t)d * D) + X.lane;
#pragma unroll
          for (int j = 0; j < 2; ++j) o[64 * j] = s[64 * j]; } }
    if (X.c < 8) { const int e = X.c; const int r0 = base[e] + tot[e], r1 = base[e] + ((tot[e] + 255) & ~255);
        for (int r = r0 + X.wave; r < r1; r += NWAVES) { if (X.lane == 0) { rowtok[r] = -1; rowgate[r] = 0.f; }
            v4u* o = (v4u*)((unsigned char*)XS + (size_t)r * D) + X.lane; const v4u zz = {0u, 0u, 0u, 0u};
#pragma unroll
            for (int j = 0; j < 2; ++j) o[64 * j] = zz; } }
    __syncthreads();
}

constexpr int MOE_MAIN_TILES = 64, MOE_MAIN_ROWS = MOE_MAIN_TILES * 256;
__device__ __forceinline__ void moe_final(const Ctx& X, const float* X3, const float* YS, const int* pos, const float* mods_l, float* out, const float* part, int ntiles) {
    int Sp, ppair; const int tail_rows = (ntiles - MOE_MAIN_TILES) * 256; pg8::tail_split(X.G, (ntiles - MOE_MAIN_TILES) * (D / 256), DFE / 128, Sp, ppair);
    for (int row = X.gw; row < TL; row += X.NGW) {
        const int p0 = pos[2 * row], p1 = pos[2 * row + 1]; const float* gp = mods_l + (size_t)(row >> 12) * MODW + 5 * D;
        f32x4 a[8], b[8];
        if (p0 < MOE_MAIN_ROWS) {
#pragma unroll
            for (int j = 0; j < 8; ++j) a[j] = *(const f32x4*)(YS + (size_t)p0 * D + 4 * X.lane + 256 * j);
        } else {
#pragma unroll
            for (int j = 0; j < 8; ++j) a[j] = (f32x4){0.f, 0.f, 0.f, 0.f};
            for (int p = 0; p < Sp; ++p) { const float* pr = part + ((size_t)p * tail_rows + (p0 - MOE_MAIN_ROWS)) * D + 4 * X.lane;
#pragma unroll
                for (int j = 0; j < 8; ++j) a[j] += *(const f32x4*)(pr + 256 * j); }
        }
        if (p1 < MOE_MAIN_ROWS) {
#pragma unroll
            for (int j = 0; j < 8; ++j) b[j] = *(const f32x4*)(YS + (size_t)p1 * D + 4 * X.lane + 256 * j);
        } else {
#pragma unroll
            for (int j = 0; j < 8; ++j) b[j] = (f32x4){0.f, 0.f, 0.f, 0.f};
            for (int p = 0; p < Sp; ++p) { const float* pr = part + ((size_t)p * tail_rows + (p1 - MOE_MAIN_ROWS)) * D + 4 * X.lane;
#pragma unroll
                for (int j = 0; j < 8; ++j) b[j] += *(const f32x4*)(pr + 256 * j); }
        }
#pragma unroll
        for (int j = 0; j < 8; ++j) { const int col = 4 * X.lane + 256 * j; const f32x4 x = *(const f32x4*)(X3 + (size_t)row * D + col), g = *(const f32x4*)(gp + col);
            *(f32x4*)(out + (size_t)row * D + col) = x + g * (a[j] + b[j]); }
    }
}

__device__ __forceinline__ const float* arg_in(int i) {
    auto kp = __builtin_amdgcn_kernarg_segment_ptr();
    asm volatile("" : "+s"(kp));
    return ((const float* const __attribute__((address_space(4)))*)kp)[i];
}
#define AIN(i) arg_in(i)
constexpr int NPHASE = 20;
#ifndef PHMASK
#define PHMASK 0xFFFFFu
#endif
#ifndef PHDUP
#define PHDUP 0u
#endif
#define REP(k) _Pragma("unroll") for (int rep_ = 0; rep_ < ((((PHDUP) >> (k)) & 1u) ? 2 : 1); ++rep_)
#ifndef MK_LAUNCHES
#define MK_LAUNCHES {{0, NPHASE}}
#endif
struct PhRange { int lo, hi; };
constexpr PhRange kLaunches[] = MK_LAUNCHES;
struct Args { const float* in[33]; float* out; unsigned char* ws; int ph_lo, ph_hi, li, pad; };
__global__ void __launch_bounds__(NWAVES * 64, 2) fwd_kernel(Args args) {
    extern __shared__ __attribute__((aligned(16))) unsigned char lds[];
    Ctx X;
    X.lds = (LAS unsigned char*)lds; X.tid = threadIdx.x; X.lane = X.tid & 63; X.wave = __builtin_amdgcn_readfirstlane(X.tid >> 6);
    X.G = gridDim.x; X.c = blockIdx.x; X.gw = X.c * NWAVES + X.wave; X.NGW = X.G * NWAVES;
    unsigned char* ws = args.ws;
    gu32* ctl = (gu32*)(ws + WS_CTL);
    volatile LAS unsigned* MISC = (volatile LAS unsigned*)(X.lds + MISC_OFF);
    for (int u = X.tid; u < (LDS_BYTES - LDSCTL_OFF) / 4; u += NWAVES * 64) ((LAS unsigned*)(X.lds + LDSCTL_OFF))[u] = 0u;
    __syncthreads();
    const int lo = args.ph_lo, hi = args.ph_hi;
    XcdBarrier bar; bar.bar = (unsigned*)(ctl + CW_BAR) + args.li * XCD_BAR_WORDS; bar.x = 0; bar.st = nullptr;
    if (hi - lo > 1) bar = xcd_barrier_post((unsigned*)(ctl + CW_BAR) + args.li * XCD_BAR_WORDS, MISC + 8);
#define GRID_BAR() xcd_barrier(bar)
#define IN(k) ((((PHMASK) >> (k)) & 1u) && lo <= (k) && (k) < hi)
#define BOTH(k) (IN(k) && ((k) + 1) < hi)

#define x_in (AIN(0))
#define c_in (AIN(1))
#define ctx_in (AIN(2))
#define cctx_in (AIN(3))
#define mods0 ((float*)(ws + WS_MODS))
#define mods1 ((float*)(ws + WS_MODS) + 3 * MODW)
#define lamv ((float*)(ws + WS_LAM))
#define WT_EIN ((bf16*)(ws + WS_WT_EIN))
#define WT_EOUT ((bf16*)(ws + WS_WT_EOUT))
#define WT_EF1 ((bf16*)(ws + WS_WT_EF1))
#define WT_EF2 ((bf16*)(ws + WS_WT_EF2))
#define WT_OIN ((bf16*)(ws + WS_WT_OIN))
#define WT_OOUT ((bf16*)(ws + WS_WT_OOUT))
#define WT_X1 ((bf16*)(ws + WS_WT_X1))
#define WT_X2 ((bf16*)(ws + WS_WT_X2))
#define H ((bf16*)(ws + WS_H))
#define Z ((bf16*)(ws + WS_Z))
#define QKV ((bf16*)(ws + WS_QKV))
#define PB ((float*)(ws + WS_PB))
#define OALL ((bf16*)(ws + WS_OALL))
#define X1 ((float*)(ws + WS_X1))
#define X3 ((float*)(ws + WS_X3))
#define ACT ((bf16*)(ws + WS_ACT))
#define XS ((bf16*)(ws + WS_XS))
#define ACT2 ((bf16*)(ws + WS_ACT2))
#define YS ((float*)(ws + WS_YS))
#define PART ((float*)(ws + WS_PART))
#define EID ((int*)(ws + RT_EID))
#define EGATE ((float*)(ws + RT_GATE))
#define POS ((int*)(ws + RT_POS))
#define ROWTOK ((int*)(ws + RT_ROWTOK))
#define ROWGATE ((float*)(ws + RT_ROWGATE))
#define TILE_E ((int*)(ws + RT_TILE_E))
#define NTILES ((int*)(ws + RT_NTILES))

    if (IN(0)) {
    REP(0) { if (rep_) __syncthreads();
    {
        for (int task = X.c; task < 96; task += X.G) { const int l = task / 48; mod_task(X, task, c_in, cctx_in, l ? AIN(24) : AIN(6), l ? AIN(25) : AIN(7), l ? mods1 : mods0); }
        if (X.c == X.G - 1 && X.wave == 0) {
            for (int h = 0; h < 4; ++h) { const float* q1 = AIN(15) + h * 128; const float* k1 = AIN(16) + h * 128; const float* q2 = AIN(17) + h * 128; const float* k2 = AIN(18) + h * 128;
                const float s1 = wave_sum(q1[X.lane] * k1[X.lane] + q1[X.lane + 64] * k1[X.lane + 64]); const float s2 = wave_sum(q2[X.lane] * k2[X.lane] + q2[X.lane + 64] * k2[X.lane + 64]);
                if (X.lane == 0) lamv[h] = expf(s1) - expf(s2) + LAM_INIT; }
        }
        LAS float* scr = (LAS float*)(X.lds + X.wave * 16896);
        int tbase = 0;
#define TPASS(Wp, K_, N_, WTp, kind_, nexp) { constexpr int per_ = ((K_) / 64) * ((N_) / 64), tot_ = per_ * (nexp); int j_ = (X.gw - tbase) % X.NGW; if (j_ < 0) j_ += X.NGW; \
            for (; j_ < tot_; j_ += X.NGW) { const int e_ = j_ / per_, q_ = j_ - e_ * per_; transpose_item((Wp) + (size_t)e_ * (K_) * (N_), (K_), (N_), (WTp) + (size_t)e_ * (N_) * (K_), q_, (kind_), scr, X.lane); } tbase += tot_; }
#define TPASS8(Wp, K_, N_, WTp, kind_, nexp) { constexpr int per_ = ((K_) / 128) * ((N_) / 32), tot_ = per_ * (nexp); int j_ = (X.gw - tbase) % X.NGW; if (j_ < 0) j_ += X.NGW; \
            for (; j_ < tot_; j_ += X.NGW) { const int e_ = j_ / per_, q_ = j_ - e_ * per_; transpose_item8((Wp) + (size_t)e_ * (K_) * (N_), (K_), (N_), (WTp) + (size_t)e_ * (N_) * (K_), q_, (kind_), scr, X.lane); } tbase += tot_; }
        TPASS(AIN(8), D, EVEN_IN, WT_EIN, 0, 1)
        TPASS(AIN(9), D, D, WT_EOUT, 0, 1)
        TPASS(AIN(20), D, 2 * DFF, WT_EF1, 1, 1)
        TPASS(AIN(21), DFF, D, WT_EF2, 0, 1)
        TPASS(AIN(26), D, ODD_IN, WT_OIN, 0, 1)
        TPASS(AIN(27), D, D, WT_OOUT, 0, 1)
        TPASS8(AIN(31), D, 2 * DFE, (unsigned char*)WT_X1, 1, NE)
        TPASS8(AIN(32), DFE, D, (unsigned char*)WT_X2, 0, NE)
#undef TPASS
#undef TPASS8
    }
    }
    if (BOTH(0)) GRID_BAR();
    }
    if (IN(1)) {
    REP(1) { if (rep_) __syncthreads();
    norm_mod_rows<false>(X, x_in, ctx_in, MR, AIN(4), mods0, 0, 1, H, nullptr, nullptr, nullptr);
    }
    if (BOTH(1)) GRID_BAR();
    }
    if (IN(2)) {
    REP(2) { if (rep_) __syncthreads();
    { pg8::Gemm g{H, WT_EIN, MR, EVEN_IN, D}; pg8::StaticOrder S; S.init(MR, EVEN_IN, D / 64, X.G, X.c); pg8::EpiBf16 E{Z, EVEN_IN};
      pg8::gemm_phase<pg8::EpiBf16, pg8::StaticOrder, true, true>(X.lds, g, S, E); }
    }
    if (BOTH(2)) GRID_BAR();
    }
    if (IN(3)) {
    REP(3) { if (rep_) __syncthreads();
    qkv_post<NSLOT0>(X, Z, QKV, AIN(10), AIN(11), AIN(13), AIN(14));
    }
    if (BOTH(3)) GRID_BAR();
    }
    if (IN(4)) {
    REP(4) { if (rep_) __syncthreads();
    {
        const att::bf16* Q0 = (const att::bf16*)QKV;
        for (int u = X.c; u < 544; u += X.G) {
            const bool isl = u < 512; const int b = isl ? (u >> 8) : ((u - 512) >> 4), vh = isl ? ((u >> 4) & 15) : ((u - 512) & 15), qb = isl ? (u & 15) : 16;
            const int hb = vh >> 2, map = (vh >> 1) & 1, half = vh & 1;
            const att::bf16* Qp = Q0 + ((size_t)(b * NSLOT0 + 12 + 2 * hb + map) * KVR + qb * 256) * 128;
            const att::bf16* Kp = Q0 + ((size_t)(b * NSLOT0 + 20 + 2 * hb + map) * KVR) * 128;
            const att::bf16* Vp = Q0 + ((size_t)(b * NSLOT0 + 28 + 2 * hb + half) * KVR) * 128;
            float* Op = PB + ((size_t)(b * 16 + vh) * KVR + qb * 256) * 128;
            att::attn_unit<false, false>(Qp, Kp, Vp, (void*)Op, 128, 0, isl ? 68 : 0, isl ? 68 : 4, 0, -1e30f, 0.f, (char*)lds);
        }
        const int ca = (X.c + X.G - 32) % X.G;
        for (int u = ca; u < 272; u += X.G) {
            const bool isl = u < 256; const int b = isl ? (u >> 7) : ((u - 256) >> 3), h = isl ? ((u >> 4) & 7) : ((u - 256) & 7), qb = isl ? (u & 15) : 16;
            const int q0 = qb * 256; const int klo = isl ? (q0 >= 128 ? q0 - 128 : 0) : 0; const int khi = (q0 + 384) < SEQ ? (q0 + 384) : SEQ; const int nt1 = isl ? ((khi - klo) >> 6) : 0;
            const att::bf16* Qp = Q0 + ((size_t)(b * NSLOT0 + h) * KVR + q0) * 128;
            const att::bf16* Kp = Q0 + ((size_t)(b * NSLOT0 + 8 + (h >> 2)) * KVR) * 128;
            const att::bf16* Vp = Q0 + ((size_t)(b * NSLOT0 + 10 + (h >> 2)) * KVR) * 128;
            bf16* Op = OALL + (size_t)(isl ? (b * SEQ + q0) : (TL + b * CTXL)) * D + h * 128;
            const float sink = AIN(12)[h];
            att::attn_unit<true, true>(Qp, Kp, Vp, (void*)Op, D, klo, nt1, nt1 + 4, q0, sink * (1.0f / att::SCALE), 1.f, (char*)lds);
        }
    }
    }
    if (BOTH(4)) GRID_BAR();
    }
    if (IN(5)) {
    REP(5) { if (rep_) __syncthreads();
    b_combine(X, PB, lamv, AIN(19), OALL);
    }
    if (BOTH(5)) GRID_BAR();
    }
    if (IN(6)) {
    REP(6) { if (rep_) __syncthreads();
    { pg8::Gemm g{OALL, WT_EOUT, MR, D, D}; pg8::TailOrder S; S.init(TL / 256, TC / 256, D / 256, D / 64, X.G, X.c, nullptr); pg8::EpiRes E{x_in, ctx_in, X1, D, mods0 + 2 * D, MODW, PART, TL, TC};
      pg8::gemm_phase<pg8::EpiRes, pg8::TailOrder, true, true>(X.lds, g, S, E); }
    }
    if (BOTH(6)) GRID_BAR();
    }
    if (IN(7)) {
    REP(7) { if (rep_) __syncthreads();
    { int Sp, pp; pg8::tail_split(X.G, (TC / 256) * (D / 256), D / 64, Sp, pp);
      norm_mod_rows<false, true>(X, X1, ctx_in, MR, AIN(5), mods0, 3, 4, H, nullptr, nullptr, nullptr, PART, Sp, mods0 + 2 * MODW + 2 * D, X1 + (size_t)TL * D); }
    }
    if (BOTH(7)) GRID_BAR();
    }
    if (IN(8)) {
    REP(8) { if (rep_) __syncthreads();
    { pg8::Gemm g{H, WT_EF1, MR, 2 * DFF, D}; pg8::StaticOrder S; S.init(MR, 2 * DFF, D / 64, X.G, X.c); pg8::EpiSwiglu E{ACT, DFF, 1.0f};
      pg8::gemm_phase<pg8::EpiSwiglu, pg8::StaticOrder, true, true>(X.lds, g, S, E); }
    }
    if (BOTH(8)) GRID_BAR();
    }
    if (IN(9)) {
    REP(9) { if (rep_) __syncthreads();
    { pg8::Gemm g{ACT, WT_EF2, MR, D, DFF}; pg8::TailOrder S; S.init(TL / 256, TC / 256, D / 256, DFF / 64, X.G, X.c, nullptr); pg8::EpiRes E{X1, X1 + (size_t)TL * D, X1, D, mods0 + 5 * D, MODW, PART, TL, TC};
      pg8::gemm_phase<pg8::EpiRes, pg8::TailOrder, true, true>(X.lds, g, S, E); }
    }
    if (BOTH(9)) GRID_BAR();
    }
    if (IN(10)) {
    REP(10) { if (rep_) __syncthreads();
    { int Sp, pp; pg8::tail_split(X.G, (TC / 256) * (D / 256), DFF / 64, Sp, pp);
      norm_mod_rows<false, true>(X, X1, X1 + (size_t)TL * D, MR, AIN(22), mods1, 0, 1, H, nullptr, nullptr, nullptr, PART, Sp, mods0 + 2 * MODW + 5 * D, nullptr); }
    }
    if (BOTH(10)) GRID_BAR();
    }
    if (IN(11)) {
    REP(11) { if (rep_) __syncthreads();
    { pg8::Gemm g{H, WT_OIN, MR, ODD_IN, D}; pg8::StaticOrder S; S.init(MR, ODD_IN, D / 64, X.G, X.c); pg8::EpiBf16 E{Z, ODD_IN};
      pg8::gemm_phase<pg8::EpiBf16, pg8::StaticOrder, true, true>(X.lds, g, S, E); }
    }
    if (BOTH(11)) GRID_BAR();
    }
    if (IN(12)) {
    REP(12) { if (rep_) __syncthreads();
    qkv_post<NSLOT1>(X, Z, QKV, AIN(28), AIN(29), nullptr, nullptr);
    }
    if (BOTH(12)) GRID_BAR();
    }
    if (IN(13)) {
    REP(13) { if (rep_) __syncthreads();
    {
        const att::bf16* Q0 = (const att::bf16*)QKV;
        for (int u = X.c; u < 512; u += X.G) {
            const int b = u >> 8, h = (u >> 4) & 15, qb = u & 15;
            const att::bf16* Qp = Q0 + ((size_t)(b * NSLOT1 + h) * KVR + qb * 256) * 128;
            const att::bf16* Kp = Q0 + ((size_t)(b * NSLOT1 + 16 + (h >> 2)) * KVR) * 128;
            const att::bf16* Vp = Q0 + ((size_t)(b * NSLOT1 + 20 + (h >> 2)) * KVR) * 128;
            bf16* Op = OALL + (size_t)(b * SEQ + qb * 256) * D + h * 128;
            const int ntc = 68 + (X.G >> 20);
            att::attn_unit<false, true>(Qp, Kp, Vp, (void*)Op, D, 0, ntc, ntc, 0, -1e30f, 0.f, (char*)lds);
        }
    }
    }
    if (BOTH(13)) GRID_BAR();
    }
    if (IN(14)) {
    REP(14) { if (rep_) __syncthreads();
    { pg8::Gemm g{OALL, WT_OOUT, TL, D, D}; pg8::StaticOrder S; S.init(TL, D, D / 64, X.G, X.c); pg8::EpiRes E{X1, X1, X3, D, mods1 + 2 * D, MODW, nullptr, 0, 0};
      pg8::gemm_phase<pg8::EpiRes, pg8::StaticOrder, true, true>(X.lds, g, S, E); }
    }
    if (BOTH(14)) GRID_BAR();
    }
    if (IN(15)) {
    REP(15) { if (rep_) __syncthreads();
    norm_mod_rows<true, false, true>(X, X3, X3, TL, AIN(23), mods1, 3, 4, H, AIN(30), EID, EGATE);
    }
    if (BOTH(15)) GRID_BAR();
    }
    if (IN(16)) {
    REP(16) { if (rep_) __syncthreads();
    moe_route(X, EID, EGATE, H, XS, POS, ROWTOK, ROWGATE, TILE_E, NTILES);
    }
    if (BOTH(16)) GRID_BAR();
    }
    if (IN(17)) {
    REP(17) { if (rep_) __syncthreads();
    { const int nt = *(volatile int*)NTILES; pg8::Gemm g{XS, WT_X1, XROWS, 2 * DFE, D}; pg8::TailOrder S; S.init(nt, 0, 2 * DFE / 256, D / 128, X.G, X.c, TILE_E); pg8::EpiSwiglu8 E{ACT2, DFE, 1.0f / W8_SCALE};
      pg8::gemm_phase<pg8::EpiSwiglu8, pg8::TailOrder, true, true, true>(X.lds, g, S, E); }
    }
    if (BOTH(17)) GRID_BAR();
    }
    if (IN(18)) {
    REP(18) { if (rep_) __syncthreads();
    { const int nt = *(volatile int*)NTILES; pg8::Gemm g{ACT2, WT_X2, XROWS, D, DFE}; pg8::TailOrder S; S.init(MOE_MAIN_TILES, nt - MOE_MAIN_TILES, D / 256, DFE / 128, X.G, X.c, TILE_E); pg8::EpiRowScale E{YS, D, ROWGATE, PART, MOE_MAIN_ROWS, (nt - MOE_MAIN_TILES) * 256, 1.0f / W8_SCALE};
      pg8::gemm_phase<pg8::EpiRowScale, pg8::TailOrder, true, true, true>(X.lds, g, S, E); }
    }
    if (BOTH(18)) GRID_BAR();
    }
    if (IN(19)) {
    REP(19) { if (rep_) __syncthreads();
    moe_final(X, X3, YS, POS, mods1, args.out, PART, *(volatile int*)NTILES);
    }
    }
}

extern "C" void kernel_launch(void* const* d_in, const int* in_sizes, int n_in, void* d_out, int out_size, void* d_ws, size_t ws_size, hipStream_t stream) {
    static int grid = 0;
    if (grid == 0) {
        if (n_in != 33 || in_sizes[0] != TL * D || out_size != TL * D || ws_size < WS_END) { fprintf(stderr, "kernel_launch: unexpected shapes (n_in %d, in0 %d, out %d, ws %zu)\n", n_in, n_in > 0 ? in_sizes[0] : -1, out_size, ws_size); grid = -1; return; }
        int dev = 0, cus = 0, per_cu = 0;
        if (hipGetDevice(&dev) != hipSuccess || hipDeviceGetAttribute(&cus, hipDeviceAttributeMultiprocessorCount, dev) != hipSuccess) { grid = -1; return; }
        if (hipFuncSetAttribute((const void*)fwd_kernel, hipFuncAttributeMaxDynamicSharedMemorySize, LDS_BYTES) != hipSuccess) { fprintf(stderr, "kernel_launch: hipFuncSetAttribute failed\n"); grid = -1; return; }
        if (hipOccupancyMaxActiveBlocksPerMultiprocessor(&per_cu, (const void*)fwd_kernel, NWAVES * 64, LDS_BYTES) != hipSuccess || per_cu < 1) { fprintf(stderr, "kernel_launch: occupancy query says %d blocks per CU\n", per_cu); }
        (void)hipGetLastError();
        grid = cus;
    }
    if (grid < 0) return;
    if (hipMemsetAsync((char*)d_ws + WS_CTL, 0, CTL_ZERO_BYTES, stream) != hipSuccess) return;
    Args a{};
    for (int i = 0; i < 33; ++i) a.in[i] = (const float*)d_in[i];
    a.out = (float*)d_out; a.ws = (unsigned char*)d_ws;
    constexpr int NL = sizeof(kLaunches) / sizeof(kLaunches[0]);
    for (int li = 0; li < NL; ++li) {
        a.ph_lo = kLaunches[li].lo; a.ph_hi = kLaunches[li].hi; a.li = li; a.pad = 0;
        hipLaunchKernelGGL(fwd_kernel, dim3(grid), dim3(NWAVES * 64), LDS_BYTES, stream, a);
        const hipError_t le = hipPeekAtLastError();
        if (le != hipSuccess) { fprintf(stderr, "kernel_launch: launch %d failed: %s\n", li, hipGetErrorName(le)); break; }
    }
}
```

```cpp
#include <hip/hip_runtime.h>
#include <hip/hip_bf16.h>
#include <cstdio>
#include <cstdint>

namespace pg8 {
#define PG8_LAS __attribute__((address_space(3)))
typedef unsigned short bf16_t;
typedef short bf16x8 __attribute__((ext_vector_type(8)));
typedef float f32x4 __attribute__((ext_vector_type(4)));
typedef unsigned u32x4 __attribute__((ext_vector_type(4)));
constexpr int BM = 256, BK = 64, HALF = 128, HTB = HALF * BK * 2  , STAGE_BYTES = 8 * HTB, NXCD = 8, WGM = 8;

__host__ __device__ __forceinline__ int lds_byte(int r, int c) { const int st = (r >> 4) * 2 + (c >> 5), rr = r & 15, cc = c & 31, ob = rr * 64 + cc * 2; return st * 1024 + (ob ^ (((ob >> 9) & 1) << 5)); }
__host__ __device__ __forceinline__ void stage_rc(int b, int& R, int& C) { const int st = b / 1024, sb = b % 1024, swz = sb ^ (((sb >> 9) & 1) << 5); R = (st >> 1) * 16 + swz / 64; C = (st & 1) * 32 + (swz % 64) / 2; }
__host__ __device__ __forceinline__ int perm32(int rho) { const int n = rho >> 4, i = rho & 15; return 8 * (i >> 2) + 4 * n + (i & 3); }

struct Unit { int pm, pn, pnb, kt0, nkt, part; };
struct Gemm { const void* A; const void* Bt; int M, N, K; };

struct StaticOrder {
    int nM, nN, nwg, G, c, KT;
    __host__ __device__ __forceinline__ void init(int M, int N, int KT_, int G_, int c_) { nM = M / BM; nN = N / BM; nwg = nM * nN; G = G_; c = c_; KT = KT_; }
    __host__ __device__ __forceinline__ bool next(int i, Unit& u) const {
        const long L = (long)i * G + c; if (L >= nwg) return false;
        int wgid = (int)L; { const int q = nwg / NXCD, r = nwg % NXCD, xcd = wgid % NXCD, off = wgid / NXCD; wgid = (xcd < r ? xcd * (q + 1) : r * (q + 1) + (xcd - r) * q) + off; }
        const int nig = WGM * nN, gid = wgid / nig, fm = gid * WGM, gsz = (nM - fm) < WGM ? (nM - fm) : WGM;
        u.pm = fm + ((wgid % nig) % gsz); u.pn = (wgid % nig) / gsz; u.pnb = u.pn; u.kt0 = 0; u.nkt = KT; u.part = -1; return true;
    }
    __device__ __forceinline__ void a_ready(const Unit&) const {}
    __device__ __forceinline__ void done(const Unit&) const {}
};
__host__ __device__ __forceinline__ void tail_split(int G, int T, int KT, int& Sp, int& ppair) {
    if (T <= 0) { Sp = 0; ppair = 0; return; }
    int S = G / T; if (S < 1) S = 1; const int pairs = KT >> 1; ppair = (pairs + S - 1) / S; if (ppair < 2) ppair = 2; Sp = (pairs + ppair - 1) / ppair;
}
struct TailOrder {
    StaticOrder so; int T, Sp, ppair; const int* tile_e;
    __device__ __forceinline__ void init(int nMm, int nTm, int nN, int KT, int G_, int c_, const int* te) { so.nM = nMm; so.nN = nN; so.nwg = nMm * nN; so.G = G_; so.c = c_; so.KT = KT; T = nTm * nN; tile_e = te; tail_split(G_, T, KT, Sp, ppair); }
    __device__ __forceinline__ bool next(int i, Unit& u) const {
        const int nm = so.c < so.nwg ? (so.nwg - so.c + so.G - 1) / so.G : 0;
        const int cc = so.G - 1 - so.c;
        int pm, pn, kt0 = 0, nkt = so.KT, part = -1;
        if (i < nm) { Unit t; so.next(i, t); pm = t.pm; pn = t.pn; }
        else if (i == nm && cc < T * Sp) { const int tu = cc / Sp, j = cc - tu * Sp; pm = so.nM + tu / so.nN; pn = tu % so.nN; kt0 = 2 * ppair * j; nkt = (so.KT - kt0) < 2 * ppair ? (so.KT - kt0) : 2 * ppair; part = j; }
        else return false;
        int e = 0; if (tile_e) e = __builtin_amdgcn_readfirstlane(tile_e[pm]);
        u.pm = pm; u.pn = pn; u.pnb = e * so.nN + pn; u.kt0 = kt0; u.nkt = nkt; u.part = part; return true;
    }
    __device__ __forceinline__ void a_ready(const Unit&) const {}
    __device__ __forceinline__ void done(const Unit&) const {}
};

__device__ __forceinline__ unsigned cvt_pk_bf16(float lo, float hi) { unsigned r; asm volatile("v_cvt_pk_bf16_f32 %0, %1, %2" : "=v"(r) : "v"(lo), "v"(hi)); return r; }

struct EpiBf16 {
    static constexpr bool PERM = true, AFTER_DRAIN = false;
    bf16_t* O; int ldc; float scale;
    __device__ __forceinline__ void operator()(const f32x4 (&acc)[2][2][4][2], const Unit& u, int wr, int wc, int fr, int fq) const {
        const int row0 = u.pm * BM + wr * 64 + fr; const int col0 = u.pn * BM + wc * 32 + 8 * fq;
#pragma unroll
        for (int ai = 0; ai < 2; ++ai)
#pragma unroll
            for (int m = 0; m < 4; ++m) { bf16_t* rowp = O + (size_t)(row0 + ai * HALF + m * 16) * ldc + col0;
#pragma unroll
                for (int bj = 0; bj < 2; ++bj) { const f32x4 v0 = acc[ai][bj][m][0] * scale, v1 = acc[ai][bj][m][1] * scale;
                    u32x4 w; w.x = cvt_pk_bf16(v0[0], v0[1]); w.y = cvt_pk_bf16(v0[2], v0[3]); w.z = cvt_pk_bf16(v1[0], v1[1]); w.w = cvt_pk_bf16(v1[2], v1[3]);
                    *(u32x4*)(rowp + bj * HALF) = w; } }
    }
};
struct EpiSlots {
    static constexpr bool PERM = true, AFTER_DRAIN = false;
    bf16_t* QKV; int NG; int kvr;
    __device__ __forceinline__ void operator()(const f32x4 (&acc)[2][2][4][2], const Unit& u, int wr, int wc, int fr, int fq) const {
        const int prow = u.pm * BM; const bool lat = prow < 8192; const int b = lat ? (prow >> 12) : ((prow - 8192) >> 8); const int pos0 = lat ? (prow & 4095) : 4096;
        const int rl0 = wr * 64 + fr;
#pragma unroll
        for (int bj = 0; bj < 2; ++bj) { bf16_t* gbase = QKV + ((size_t)(b * NG + 2 * u.pn + bj) * kvr + pos0 + rl0) * 128 + wc * 32 + 8 * fq;
#pragma unroll
            for (int ai = 0; ai < 2; ++ai)
#pragma unroll
                for (int m = 0; m < 4; ++m) { const f32x4 v0 = acc[ai][bj][m][0], v1 = acc[ai][bj][m][1];
                    u32x4 w; w.x = cvt_pk_bf16(v0[0], v0[1]); w.y = cvt_pk_bf16(v0[2], v0[3]); w.z = cvt_pk_bf16(v1[0], v1[1]); w.w = cvt_pk_bf16(v1[2], v1[3]);
                    *(u32x4*)(gbase + (size_t)(ai * HALF + m * 16) * 128) = w; } }
    }
};
__device__ __forceinline__ float clamp448(float x) { return __builtin_fminf(__builtin_fmaxf(x, -448.f), 448.f); }
__device__ __forceinline__ unsigned pk4_fp8(float a, float b, float c, float d) {
    int w = __builtin_amdgcn_cvt_pk_fp8_f32(clamp448(a), clamp448(b), 0, false); w = __builtin_amdgcn_cvt_pk_fp8_f32(clamp448(c), clamp448(d), w, true); return (unsigned)w; }
__device__ __forceinline__ float silu_mul(float g, float u) { return g * u * __builtin_amdgcn_rcpf(1.0f + __builtin_amdgcn_exp2f(-1.4426950408889634f * g)); }
template <bool OUT8> struct EpiSwigluT {
    static constexpr bool PERM = true, AFTER_DRAIN = false;
    void* O; int ldc; float scale;
    __device__ __forceinline__ void operator()(const f32x4 (&acc)[2][2][4][2], const Unit& u, int wr, int wc, int fr, int fq) const {
        const int row0 = u.pm * BM + wr * 64 + fr; const int col0 = u.pn * HALF + wc * 32 + 8 * fq;
#pragma unroll
        for (int ai = 0; ai < 2; ++ai)
#pragma unroll
            for (int m = 0; m < 4; ++m) { const size_t eo = (size_t)(row0 + ai * HALF + m * 16) * ldc + col0;
                const f32x4 g0 = acc[ai][0][m][0] * scale, g1 = acc[ai][0][m][1] * scale, u0 = acc[ai][1][m][0] * scale, u1 = acc[ai][1][m][1] * scale;
                const float r0 = silu_mul(g0[0], u0[0]), r1 = silu_mul(g0[1], u0[1]), r2 = silu_mul(g0[2], u0[2]), r3 = silu_mul(g0[3], u0[3]);
                const float r4 = silu_mul(g1[0], u1[0]), r5 = silu_mul(g1[1], u1[1]), r6 = silu_mul(g1[2], u1[2]), r7 = silu_mul(g1[3], u1[3]);
                if constexpr (OUT8) { typedef unsigned u32x2 __attribute__((ext_vector_type(2))); u32x2 w; w.x = pk4_fp8(r0, r1, r2, r3); w.y = pk4_fp8(r4, r5, r6, r7); *(u32x2*)((unsigned char*)O + eo) = w; }
                else { u32x4 w; w.x = cvt_pk_bf16(r0, r1); w.y = cvt_pk_bf16(r2, r3); w.z = cvt_pk_bf16(r4, r5); w.w = cvt_pk_bf16(r6, r7); *(u32x4*)((bf16_t*)O + eo) = w; } }
    }
};
typedef EpiSwigluT<false> EpiSwiglu; typedef EpiSwigluT<true> EpiSwiglu8;
struct EpiRes {
    static constexpr bool PERM = false, AFTER_DRAIN = false;
    const float* base_lat; const float* base_ctx; float* out; int ldc; const float* gate; int gate_stride;
    float* part; int part_row0, part_rows; float scale;
    __device__ __forceinline__ void operator()(const f32x4 (&acc)[2][2][4][2], const Unit& u, int wr, int wc, int fr, int fq) const {
        if (u.part >= 0) {
            float* pp = part + ((long)u.part * part_rows + (u.pm * BM - part_row0)) * (long)ldc; const int rl0 = wr * 64 + fr, col0 = u.pn * BM + wc * 32 + 4 * fq;
#pragma unroll
            for (int ai = 0; ai < 2; ++ai)
#pragma unroll
                for (int m = 0; m < 4; ++m) { const size_t ro = (size_t)(rl0 + ai * HALF + m * 16) * ldc;
#pragma unroll
                    for (int bj = 0; bj < 2; ++bj)
#pragma unroll
                        for (int n = 0; n < 2; ++n) *(f32x4*)(pp + ro + col0 + bj * HALF + 16 * n) = acc[ai][bj][m][n] * scale; }
            return;
        }
        const int prow = u.pm * BM; const int cond = prow < 4096 ? 0 : (prow < 8192 ? 1 : 2);
        const float* bp = prow < 8192 ? base_lat + (size_t)prow * ldc : base_ctx + (size_t)(prow - 8192) * ldc;
        float* op = out + (size_t)prow * ldc; const float* gp = gate + (size_t)cond * gate_stride;
        const int rl0 = wr * 64 + fr, col0 = u.pn * BM + wc * 32 + 4 * fq;
        f32x4 gv[2][2];
#pragma unroll
        for (int bj = 0; bj < 2; ++bj)
#pragma unroll
            for (int n = 0; n < 2; ++n) gv[bj][n] = *(const f32x4*)(gp + col0 + bj * HALF + 16 * n) * scale;
#pragma unroll
        for (int ai = 0; ai < 2; ++ai)
#pragma unroll
            for (int m = 0; m < 4; ++m) { const size_t ro = (size_t)(rl0 + ai * HALF + m * 16) * ldc;
#pragma unroll
                for (int bj = 0; bj < 2; ++bj)
#pragma unroll
                    for (int n = 0; n < 2; ++n) { const int col = col0 + bj * HALF + 16 * n; const f32x4 b = *(const f32x4*)(bp + ro + col);
                        *(f32x4*)(op + ro + col) = b + gv[bj][n] * acc[ai][bj][m][n]; } }
    }
};
struct EpiRowScale {
    static constexpr bool PERM = false, AFTER_DRAIN = false;
    float* out; int ldc; const float* rs; float* part; int part_row0, part_rows; float scale;
    __device__ __forceinline__ void operator()(const f32x4 (&acc)[2][2][4][2], const Unit& u, int wr, int wc, int fr, int fq) const {
        const int row0 = u.pm * BM + wr * 64 + fr, col0 = u.pn * BM + wc * 32 + 4 * fq;
        float* ob = u.part >= 0 ? part + ((long)u.part * part_rows - part_row0) * (long)ldc : out;
#pragma unroll
        for (int ai = 0; ai < 2; ++ai)
#pragma unroll
            for (int m = 0; m < 4; ++m) { const int row = row0 + ai * HALF + m * 16; const float s = rs[row] * scale; float* rp = ob + (size_t)row * ldc + col0;
#pragma unroll
                for (int bj = 0; bj < 2; ++bj)
#pragma unroll
                    for (int n = 0; n < 2; ++n) *(f32x4*)(rp + bj * HALF + 16 * n) = acc[ai][bj][m][n] * s; }
    }
};

typedef int v8i __attribute__((ext_vector_type(8)));
__device__ __forceinline__ v8i cat8(bf16x8 a, bf16x8 b) { struct P { bf16x8 a, b; } p{a, b}; return __builtin_bit_cast(v8i, p); }
template <class Epi, class Sched, bool ALIGN_EPI = false, bool SP2 = false, bool FP8 = false>
__device__ __forceinline__ void gemm_phase(PG8_LAS unsigned char* lds, const Gemm g, const Sched& S, const Epi& E) {
    int tid = threadIdx.x; asm volatile("" : "+v"(tid));
    const int wid = __builtin_amdgcn_readfirstlane(tid >> 6), lane = tid & 63, wr = wid >> 2, wc = wid & 3, fr = lane & 15, fq = lane >> 4;
    const int K = g.K; const int pitch = FP8 ? K : K * 2;
    unsigned voffA[2], voffB[2];
#pragma unroll
    for (int i = 0; i < 2; ++i) { int R, C; stage_rc(tid * 16 + i * 8192, R, C); const int Rb = Epi::PERM ? ((R & ~31) + perm32(R & 31)) : R;
        voffA[i] = (unsigned)(R * pitch + C * 2); voffB[i] = (unsigned)(Rb * pitch + C * 2); }
    const size_t kstep = (size_t)(BK * 2);
    const size_t hstep = (size_t)HALF * pitch;
    const size_t tstep = 2 * hstep;
    const unsigned ldsw = (unsigned)wid * 1024u;
    const int aoff = lds_byte(wr * 64 + fr, fq * 8), boff = lds_byte(wc * 32 + fr, fq * 8);
#define PG8_SA(b, h) (((b) * 2 + (h)) * HTB)
#define PG8_SB(b, h) ((4 + (b) * 2 + (h)) * HTB)
#define PG8_STAGE(bufoff, gbase, voff) do { _Pragma("unroll") for (int _i = 0; _i < 2; ++_i) \
        __builtin_amdgcn_global_load_lds((const unsigned*)((const char*)(gbase) + (voff)[_i]), (PG8_LAS unsigned*)(lds + (bufoff) + ldsw + _i * 8192), 16, 0, 0); } while (0)
#define PG8_LDA(dst, b, h) do { _Pragma("unroll") for (int m = 0; m < 4; ++m) _Pragma("unroll") for (int k = 0; k < 2; ++k) dst[m][k] = *(const PG8_LAS bf16x8*)(lds + PG8_SA(b, h) + aoff + m * 2048 + k * 1024); } while (0)
#define PG8_LDB(dst, b, h) do { _Pragma("unroll") for (int n = 0; n < 2; ++n) _Pragma("unroll") for (int k = 0; k < 2; ++k) dst[n][k] = *(const PG8_LAS bf16x8*)(lds + PG8_SB(b, h) + boff + n * 2048 + k * 1024); } while (0)
#define PG8_MMA(ai, bj, At, Bt) do { __builtin_amdgcn_s_setprio(1); if constexpr (FP8) { _Pragma("unroll") for (int m = 0; m < 4; ++m) _Pragma("unroll") for (int n = 0; n < 2; ++n) \
        asm volatile("v_mfma_f32_16x16x128_f8f6f4 %0, %1, %2, %0" : "+v"(acc[ai][bj][m][n]) : "v"(cat8(Bt[n][0], Bt[n][1])), "v"(cat8(At[m][0], At[m][1]))); } \
      else { _Pragma("unroll") for (int m = 0; m < 4; ++m) _Pragma("unroll") for (int n = 0; n < 2; ++n) _Pragma("unroll") for (int k = 0; k < 2; ++k) \
        acc[ai][bj][m][n] = __builtin_amdgcn_mfma_f32_16x16x32_bf16(Bt[n][k], At[m][k], acc[ai][bj][m][n], 0, 0, 0); } __builtin_amdgcn_s_setprio(0); } while (0)
#define PG8_WAIT_V(n) asm volatile("s_waitcnt vmcnt(" #n ")" ::: "memory")
#define PG8_WAIT_L(n) asm volatile("s_waitcnt lgkmcnt(" #n ")" ::: "memory")
#define PG8_BAR __builtin_amdgcn_s_barrier()
#define PG8_SCHED __builtin_amdgcn_sched_barrier(0)
    Unit cur, nxt; int ui = 0;
    if (!S.next(0, cur)) return;
    f32x4 acc[2][2][4][2];
#pragma unroll
    for (int a = 0; a < 2; ++a)
#pragma unroll
        for (int b = 0; b < 2; ++b)
#pragma unroll
            for (int m = 0; m < 4; ++m)
#pragma unroll
                for (int n = 0; n < 2; ++n) acc[a][b][m][n] = (f32x4){0.f, 0.f, 0.f, 0.f};
    bf16x8 At[4][2], B0[2][2], B1[2][2];
    const char* cA = (const char*)g.A + (size_t)cur.pm * tstep + (size_t)cur.kt0 * kstep; const char* cB = (const char*)g.Bt + (size_t)cur.pnb * tstep + (size_t)cur.kt0 * kstep;
    S.a_ready(cur);
    if constexpr (SP2) {
        PG8_STAGE(PG8_SB(0, 0), cB, voffB); PG8_STAGE(PG8_SB(0, 1), cB + hstep, voffB); PG8_STAGE(PG8_SA(0, 0), cA, voffA); PG8_STAGE(PG8_SA(0, 1), cA + hstep, voffA);
        if (wr == 1) PG8_BAR;
        PG8_WAIT_V(2); PG8_BAR;
        PG8_STAGE(PG8_SB(1, 0), cB + kstep, voffB); PG8_STAGE(PG8_SA(1, 0), cA + kstep, voffA); PG8_STAGE(PG8_SB(1, 1), cB + hstep + kstep, voffB);
        PG8_WAIT_V(6); PG8_BAR;
    } else {
        PG8_STAGE(PG8_SB(0, 0), cB, voffB); PG8_STAGE(PG8_SA(0, 0), cA, voffA); PG8_STAGE(PG8_SB(0, 1), cB + hstep, voffB); PG8_STAGE(PG8_SA(0, 1), cA + hstep, voffA);
        if (wr == 1) PG8_BAR;
        PG8_WAIT_V(4); PG8_BAR;
        PG8_STAGE(PG8_SB(1, 0), cB + kstep, voffB); PG8_STAGE(PG8_SA(1, 0), cA + kstep, voffA); PG8_STAGE(PG8_SB(1, 1), cB + hstep + kstep, voffB);
        PG8_WAIT_V(6); PG8_BAR;
    }
    for (;;) {
        const bool has_next = S.next(ui + 1, nxt);
        const char* nA = has_next ? (const char*)g.A + (size_t)nxt.pm * tstep + (size_t)nxt.kt0 * kstep : cA; const char* nB = has_next ? (const char*)g.Bt + (size_t)nxt.pnb * tstep + (size_t)nxt.kt0 * kstep : cB;
        const int nt = cur.nkt;
        for (int t = 0; t < nt; t += 2) {
            const bool last = (t == nt - 2);
            const char* a1 = cA + (size_t)(t + 1) * kstep;
            const char* a2 = last ? nA : cA + (size_t)(t + 2) * kstep; const char* b2 = last ? nB : cB + (size_t)(t + 2) * kstep;
            const char* a3 = a2 + kstep; const char* b3 = b2 + kstep;
            if (last && has_next) S.a_ready(nxt);
            if constexpr (SP2) {
            PG8_LDB(B0, 0, 0); PG8_LDB(B1, 0, 1); PG8_SCHED; PG8_LDA(At, 0, 0); PG8_STAGE(PG8_SA(1, 1), a1 + hstep, voffA);
            PG8_WAIT_V(8); PG8_WAIT_L(0); PG8_BAR; PG8_MMA(0, 0, At, B0); PG8_MMA(0, 1, At, B1); PG8_BAR; PG8_SCHED;
            PG8_LDA(At, 0, 1); PG8_STAGE(PG8_SB(0, 0), b2, voffB); PG8_STAGE(PG8_SB(0, 1), b2 + hstep, voffB); PG8_STAGE(PG8_SA(0, 0), a2, voffA);
            PG8_WAIT_V(8); PG8_WAIT_L(0); PG8_BAR; PG8_MMA(1, 0, At, B0); PG8_MMA(1, 1, At, B1); PG8_BAR; PG8_SCHED;
            PG8_LDB(B0, 1, 0); PG8_LDB(B1, 1, 1); PG8_SCHED; PG8_LDA(At, 1, 0); PG8_STAGE(PG8_SA(0, 1), a2 + hstep, voffA);
            PG8_WAIT_V(8); PG8_WAIT_L(0); PG8_BAR; PG8_MMA(0, 0, At, B0); PG8_MMA(0, 1, At, B1); PG8_BAR; PG8_SCHED;
            PG8_LDA(At, 1, 1); PG8_STAGE(PG8_SB(1, 0), b3, voffB); PG8_STAGE(PG8_SB(1, 1), b3 + hstep, voffB); PG8_STAGE(PG8_SA(1, 0), a3, voffA);
            PG8_WAIT_V(8); PG8_WAIT_L(0); PG8_BAR; PG8_MMA(1, 0, At, B0); PG8_MMA(1, 1, At, B1); PG8_BAR; PG8_SCHED;
            } else {
            PG8_LDB(B0, 0, 0); PG8_SCHED; PG8_LDA(At, 0, 0); PG8_STAGE(PG8_SA(1, 1), a1 + hstep, voffA);
            PG8_WAIT_L(8); PG8_BAR; PG8_WAIT_L(0); PG8_MMA(0, 0, At, B0); PG8_BAR; PG8_SCHED;
            PG8_LDB(B1, 0, 1); PG8_STAGE(PG8_SB(0, 0), b2, voffB);
            PG8_BAR; PG8_WAIT_L(0); PG8_MMA(0, 1, At, B1); PG8_BAR;
            PG8_LDA(At, 0, 1); PG8_STAGE(PG8_SA(0, 0), a2, voffA);
            PG8_BAR; PG8_WAIT_L(0); PG8_MMA(1, 0, At, B0); PG8_BAR; PG8_SCHED;
            PG8_STAGE(PG8_SB(0, 1), b2 + hstep, voffB);
            PG8_WAIT_V(6); PG8_BAR; PG8_MMA(1, 1, At, B1); PG8_BAR;
            PG8_LDB(B0, 1, 0); PG8_SCHED; PG8_LDA(At, 1, 0); PG8_STAGE(PG8_SA(0, 1), a2 + hstep, voffA);
            PG8_WAIT_L(8); PG8_BAR; PG8_WAIT_L(0); PG8_MMA(0, 0, At, B0); PG8_BAR; PG8_SCHED;
            PG8_LDB(B1, 1, 1); PG8_STAGE(PG8_SB(1, 0), b3, voffB);
            PG8_BAR; PG8_WAIT_L(0); PG8_MMA(0, 1, At, B1); PG8_BAR;
            PG8_LDA(At, 1, 1); PG8_STAGE(PG8_SA(1, 0), a3, voffA);
            PG8_BAR; PG8_WAIT_L(0); PG8_MMA(1, 0, At, B0); PG8_BAR; PG8_SCHED;
            PG8_STAGE(PG8_SB(1, 1), b3 + hstep, voffB);
            PG8_WAIT_V(6); PG8_BAR; PG8_MMA(1, 1, At, B1); PG8_BAR;
            }
        }
        if constexpr (FP8) asm volatile("s_nop 15\n\ts_nop 15" ::: "memory");
        if constexpr (ALIGN_EPI) { if (wr == 0) PG8_BAR; }
        if constexpr (!Epi::AFTER_DRAIN) { E(acc, cur, wr, wc, fr, fq); S.done(cur); }
        if (!has_next) break;
#pragma unroll
        for (int a = 0; a < 2; ++a)
#pragma unroll
            for (int b = 0; b < 2; ++b)
#pragma unroll
                for (int m = 0; m < 4; ++m)
#pragma unroll
                    for (int n = 0; n < 2; ++n) acc[a][b][m][n] = (f32x4){0.f, 0.f, 0.f, 0.f};
        cur = nxt; cA = nA; cB = nB; ++ui;
        if constexpr (ALIGN_EPI) { if (wr == 1) PG8_BAR; }
    }
    PG8_WAIT_V(0);
    if constexpr (!ALIGN_EPI) { if (wr == 0) PG8_BAR; }
    PG8_BAR;
    if constexpr (Epi::AFTER_DRAIN) { E.fused(acc, cur, wr, wc, fr, fq, lds, wid, lane); S.done(cur); }
#undef PG8_SA
#undef PG8_SB
#undef PG8_STAGE
#undef PG8_LDA
#undef PG8_LDB
#undef PG8_MMA
#undef PG8_WAIT_V
#undef PG8_WAIT_L
#undef PG8_BAR
#undef PG8_SCHED
}
}


namespace att {
using bf16 = __hip_bfloat16;
constexpr int   D = 128, NW = 8, QBLK = 32, KVBLK = 64;
constexpr float SCALE = 0.088388347648318440f;
constexpr float THR = 8.f;
constexpr int LDQ = 128, LDK = 128;
constexpr size_t SHM_V = KVBLK * D * 2, SHM_K = KVBLK * D * 2, SHM_ATTN = 2 * SHM_V + 2 * SHM_K + NW * 64 * 4;
using bf16x8 = __attribute__((ext_vector_type(8))) short;
using s16x4  = __attribute__((ext_vector_type(4))) short;
using f32x16 = __attribute__((ext_vector_type(16))) float;
using u32x4  = __attribute__((ext_vector_type(4))) unsigned;
#define KSWZ(row, colB) ((row) * 256 + ((colB) ^ (((row) & 7) << 4)))
#define SBAR() __builtin_amdgcn_sched_barrier(0)
__device__ __forceinline__ int crow(int r, int hi) { return (r & 3) + 8 * (r >> 2) + 4 * hi; }
__device__ __forceinline__ unsigned cvtpk(float lo, float hi) {
  unsigned r; asm volatile("v_cvt_pk_bf16_f32 %0, %1, %2" : "=v"(r) : "v"(lo), "v"(hi)); return r;
}
__device__ __forceinline__ void partialSM(f32x16& p0, f32x16& p1, float& m_reg, float& mn, float& alpha) {
  constexpr float C = SCALE * 1.4426950408889634f;
  float pmax = p0[0];
#pragma unroll
  for (int r = 1; r < 16; ++r) pmax = fmaxf(pmax, p0[r]);
#pragma unroll
  for (int r = 0; r < 16; ++r) pmax = fmaxf(pmax, p1[r]);
  { auto rr = __builtin_amdgcn_permlane32_swap(__float_as_uint(pmax), __float_as_uint(pmax), false, false);
    pmax = fmaxf(__uint_as_float(rr[0]), __uint_as_float(rr[1])); }
  if (__builtin_expect(__all(pmax - m_reg <= THR / SCALE), 1)) { mn = m_reg; alpha = 1.f; }
  else { mn = fmaxf(m_reg, pmax); alpha = __builtin_amdgcn_exp2f((m_reg - mn) * C); m_reg = mn; }
  float mnC = -mn * C;
#pragma unroll
  for (int r = 0; r < 16; ++r) p0[r] = fmaf(p0[r], C, mnC);
#pragma unroll
  for (int r = 0; r < 16; ++r) p1[r] = fmaf(p1[r], C, mnC);
#pragma unroll
  for (int r = 0; r < 16; ++r) p0[r] = __builtin_amdgcn_exp2f(p0[r]);
}
__device__ __forceinline__ void finishSM(f32x16& p0, f32x16& p1, float alpha, float& l_reg, bf16x8& pa0, bf16x8& pa1, bf16x8& pa2, bf16x8& pa3) {
#pragma unroll
  for (int r = 0; r < 16; ++r) p1[r] = __builtin_amdgcn_exp2f(p1[r]);
  float ps = 0;
#pragma unroll
  for (int r = 0; r < 16; ++r) ps += p0[r];
#pragma unroll
  for (int r = 0; r < 16; ++r) ps += p1[r];
  { auto rr = __builtin_amdgcn_permlane32_swap(__float_as_uint(ps), __float_as_uint(ps), false, false);
    ps = __uint_as_float(rr[0]) + __uint_as_float(rr[1]); }
  l_reg = l_reg * alpha + ps;
#define PK4(P, BASE, OUT) do { unsigned a0 = cvtpk(P[BASE + 0], P[BASE + 1]), a1 = cvtpk(P[BASE + 2], P[BASE + 3]);   \
    unsigned b0 = cvtpk(P[BASE + 4], P[BASE + 5]), b1 = cvtpk(P[BASE + 6], P[BASE + 7]);                              \
    auto r0 = __builtin_amdgcn_permlane32_swap(a0, b0, false, false); auto r1 = __builtin_amdgcn_permlane32_swap(a1, b1, false, false); \
    u32x4 w = {r0[0], r1[0], r0[1], r1[1]}; OUT = *reinterpret_cast<bf16x8*>(&w); } while (0)
  PK4(p0, 0, pa0); PK4(p0, 8, pa1); PK4(p1, 0, pa2); PK4(p1, 8, pa3);
#undef PK4
}
__device__ __forceinline__ void qkt(f32x16& p0, f32x16& p1, const bf16* Ks, const bf16x8* qr, int r32, int hi) {
  p0 = f32x16{}; p1 = f32x16{};
#pragma unroll
  for (int d0 = 0; d0 < 8; ++d0) { int cb = (d0 * 16 + hi * 8) * 2;
    bf16x8 b0 = *reinterpret_cast<const bf16x8*>((const char*)Ks + KSWZ(r32, cb));
    bf16x8 b1 = *reinterpret_cast<const bf16x8*>((const char*)Ks + KSWZ(32 + r32, cb));
    p0 = __builtin_amdgcn_mfma_f32_32x32x16_bf16(b0, qr[d0], p0, 0, 0, 0);
    p1 = __builtin_amdgcn_mfma_f32_32x32x16_bf16(b1, qr[d0], p1, 0, 0, 0); }
}
__device__ __forceinline__ void maskt(f32x16& p0, f32x16& p1, int kbase, int qpos, int hi) {
#pragma unroll
  for (int r = 0; r < 16; ++r) { const int d0 = qpos - (kbase + crow(r, hi)); const int d1 = d0 - 32;
    if (d0 > 128 || d0 < -128) p0[r] = -1e30f;
    if (d1 > 128 || d1 < -128) p1[r] = -1e30f; }
}
__device__ __forceinline__ int v_st(int k, int c) { const int kk = (k & ~0xC) | ((k & 4) << 1) | ((k & 8) >> 1); return ((kk >> 3) * 4 + (c >> 5)) * 512 + ((kk & 7) * 32 + (c & 31)) * 2; }
__device__ __forceinline__ int v_rd_base(int lane) { return ((lane & 3) << 3) | (((lane >> 2) & 3) << 6) | (((lane >> 4) & 1) << 5) | (((lane >> 5) & 1) << 8); }
constexpr int v_rd_off(int d0, int ks, int half) { return d0 * 512 + ks * 4096 + half * 2048; }
template <int OFF> __device__ __forceinline__ s16x4 tr_read(int vb) {
  s16x4 r; asm volatile("ds_read_b64_tr_b16 %0, %1 offset:%2" : "=&v"(r) : "v"(vb), "i"(OFF) : "memory"); return r;
}
template <int D0> __device__ __forceinline__ void pv_one(f32x16& od, int vb, bf16x8 pa0, bf16x8 pa1, bf16x8 pa2, bf16x8 pa3) {
  const s16x4 l0 = tr_read<v_rd_off(D0, 0, 0)>(vb), h0 = tr_read<v_rd_off(D0, 0, 1)>(vb), l1 = tr_read<v_rd_off(D0, 1, 0)>(vb), h1 = tr_read<v_rd_off(D0, 1, 1)>(vb);
  const s16x4 l2 = tr_read<v_rd_off(D0, 2, 0)>(vb), h2 = tr_read<v_rd_off(D0, 2, 1)>(vb), l3 = tr_read<v_rd_off(D0, 3, 0)>(vb), h3 = tr_read<v_rd_off(D0, 3, 1)>(vb);
  asm volatile("s_waitcnt lgkmcnt(0)" ::: "memory"); SBAR();
#define PK(L, H) (bf16x8){L[0], L[1], L[2], L[3], H[0], H[1], H[2], H[3]}
  od = __builtin_amdgcn_mfma_f32_32x32x16_bf16(pa0, PK(l0, h0), od, 0, 0, 0);
  od = __builtin_amdgcn_mfma_f32_32x32x16_bf16(pa1, PK(l1, h1), od, 0, 0, 0);
  od = __builtin_amdgcn_mfma_f32_32x32x16_bf16(pa2, PK(l2, h2), od, 0, 0, 0);
  od = __builtin_amdgcn_mfma_f32_32x32x16_bf16(pa3, PK(l3, h3), od, 0, 0, 0);
#undef PK
}
__device__ __forceinline__ void pv_d0(f32x16* o, int vb, bf16x8 pa0, bf16x8 pa1, bf16x8 pa2, bf16x8 pa3) {
  pv_one<0>(o[0], vb, pa0, pa1, pa2, pa3); pv_one<1>(o[1], vb, pa0, pa1, pa2, pa3); pv_one<2>(o[2], vb, pa0, pa1, pa2, pa3); pv_one<3>(o[3], vb, pa0, pa1, pa2, pa3);
}

template <bool MASK, bool OUT_BF16>
__device__ __forceinline__ void attn_unit(const bf16* __restrict__ Qb, const bf16* __restrict__ Kh, const bf16* __restrict__ Vh, void* __restrict__ Ob, int ldo,
                                          int klo, int nt1, int NT, int qpos0, float m_init, float l_init, char* lds, const float* __restrict__ qgain, bool qrope, const float* cs) {
  int tid = threadIdx.x; asm volatile("" : "+v"(tid));
  const int wid = tid >> 6, lane = tid & 63, r32 = lane & 31, hi = lane >> 5;
  bf16* V_lds = (bf16*)lds; bf16* K_lds = (bf16*)(lds + 2 * SHM_V);
  float* ws = (float*)(lds + 2 * SHM_V + 2 * SHM_K) + wid * 64; float* li_l = ws; float* al_l = ws + 32;
  float m_reg = m_init, l_reg = l_init; f32x16 o[4] = {}; bf16x8 qr[8];
  const bf16* Qw = Qb + (long)(wid * QBLK + r32) * LDQ + hi * 8;
#pragma unroll
  for (int d0 = 0; d0 < 8; ++d0) qr[d0] = *reinterpret_cast<const bf16x8*>(Qw + d0 * 16);
  const int qpos = qpos0 + wid * QBLK + r32;
  {
    float f[8][8]; float ss = 0.f;
#pragma unroll
    for (int d0 = 0; d0 < 8; ++d0)
#pragma unroll
      for (int j = 0; j < 8; ++j) { const unsigned short h = (unsigned short)qr[d0][j]; f[d0][j] = __uint_as_float((unsigned)h << 16); ss += f[d0][j] * f[d0][j]; }
    ss += __shfl_xor(ss, 32);
    const float rs = 1.0f / sqrtf(ss * (1.f / 128.f) + 1e-6f);
#pragma unroll
    for (int d0 = 0; d0 < 8; ++d0)
#pragma unroll
      for (int j = 0; j < 8; ++j) f[d0][j] *= rs * qgain[d0 * 16 + hi * 8 + j];
    if (qrope) {
      const int prow = qpos >> 6, pcol = qpos & 63;
#pragma unroll
      for (int dd = 0; dd < 4; ++dd) { const int d0 = (dd & 1) + 4 * (dd >> 1); const int p = (dd >> 1) ? pcol : prow;
#pragma unroll
        for (int j = 0; j < 8; ++j) { const int i = (d0 & 1) * 16 + hi * 8 + j; const float c = cs[(p * 32 + i) * 2], s = cs[(p * 32 + i) * 2 + 1];
          const float x1 = f[d0][j], x2 = f[d0 + 2][j]; f[d0][j] = x1 * c - x2 * s; f[d0 + 2][j] = x2 * c + x1 * s; } }
    }
#pragma unroll
    for (int d0 = 0; d0 < 8; ++d0) { u32x4 w = {cvtpk(f[d0][0], f[d0][1]), cvtpk(f[d0][2], f[d0][3]), cvtpk(f[d0][4], f[d0][5]), cvtpk(f[d0][6], f[d0][7])}; qr[d0] = *reinterpret_cast<bf16x8*>(&w); }
  }
  const int sr = tid >> 4, sc = (tid & 15) * 8, vst0 = v_st(sr, sc), vst1 = v_st(32 + sr, sc);
  const int vb0 = (int)(uintptr_t)V_lds + v_rd_base(lane);
  struct { bf16x8 vs0, vs1, ks0, ks1; } sr_[2];
#define KROW(t) ((t) < nt1 ? klo + (t) * KVBLK : 4096 + ((t) - nt1) * KVBLK)
#define SLOAD(i, t) do { const int k0_ = KROW(t); sr_[i].vs0 = *reinterpret_cast<const bf16x8*>(&Vh[(long)(k0_ + sr) * LDK + sc]); sr_[i].vs1 = *reinterpret_cast<const bf16x8*>(&Vh[(long)(k0_ + 32 + sr) * LDK + sc]); \
    sr_[i].ks0 = *reinterpret_cast<const bf16x8*>(&Kh[(long)(k0_ + sr) * LDK + sc]); sr_[i].ks1 = *reinterpret_cast<const bf16x8*>(&Kh[(long)(k0_ + 32 + sr) * LDK + sc]); } while (0)
#define SWRITE(b, i) do { *(bf16x8*)((char*)V_lds + (b) * SHM_V + vst0) = sr_[i].vs0;          \
    *(bf16x8*)((char*)V_lds + (b) * SHM_V + vst1) = sr_[i].vs1; int kc = sc * 2;               \
    *(bf16x8*)((char*)K_lds + (b) * SHM_K + KSWZ(sr, kc)) = sr_[i].ks0;                       \
    *(bf16x8*)((char*)K_lds + (b) * SHM_K + KSWZ(32 + sr, kc)) = sr_[i].ks1; } while (0)
#define SWAIT() asm volatile("s_waitcnt vmcnt(4)" ::: "memory")
#define RESC(a) do { if (__any((a) < 1.f)) { if (hi == 0) al_l[r32] = (a); asm volatile("s_waitcnt lgkmcnt(0)" ::: "memory"); \
    _Pragma("unroll") for (int d = 0; d < 4; ++d) _Pragma("unroll") for (int r = 0; r < 16; ++r) o[d][r] *= al_l[crow(r, hi)]; } } while (0)
#define MASKT(P0, P1, t) do { if (MASK) { if ((t) < nt1) maskt(P0, P1, klo + (t) * KVBLK, qpos, hi); } } while (0)
  f32x16 pA0, pA1, pB0, pB1; float mnA, mnB, alA, alB; bf16x8 pa0, pa1, pa2, pa3;
  constexpr int SE = 0, SO = 1;
  SLOAD(SE, 0); asm volatile("s_waitcnt vmcnt(0)" ::: "memory"); SWRITE(0, SE); __syncthreads();
  qkt(pA0, pA1, K_lds, qr, r32, hi); MASKT(pA0, pA1, 0); partialSM(pA0, pA1, m_reg, mnA, alA);
  SLOAD(SO, 1); if (2 < NT) SLOAD(SE, 2);
  SWAIT(); SWRITE(1, SO); __syncthreads();
  for (int j = 1; j + 1 < NT; j += 2) {
    SBAR(); qkt(pB0, pB1, (bf16*)((char*)K_lds + SHM_K), qr, r32, hi);
    finishSM(pA0, pA1, alA, l_reg, pa0, pa1, pa2, pa3); SBAR();
    SLOAD(SO, j + 2); SBAR();
    pv_d0(o, vb0, pa0, pa1, pa2, pa3); MASKT(pB0, pB1, j); partialSM(pB0, pB1, m_reg, mnB, alB);
    __syncthreads(); SWAIT(); SWRITE(0, SE);
    RESC(alB); __syncthreads();
    SBAR(); qkt(pA0, pA1, K_lds, qr, r32, hi);
    finishSM(pB0, pB1, alB, l_reg, pa0, pa1, pa2, pa3); SBAR();
    if (j + 3 < NT) SLOAD(SE, j + 3); SBAR();
    pv_d0(o, vb0 + (int)SHM_V, pa0, pa1, pa2, pa3); MASKT(pA0, pA1, j + 1); partialSM(pA0, pA1, m_reg, mnA, alA);
    __syncthreads(); SWAIT(); SWRITE(1, SO);
    RESC(alA); __syncthreads();
  }
  SBAR(); qkt(pB0, pB1, (bf16*)((char*)K_lds + SHM_K), qr, r32, hi);
  finishSM(pA0, pA1, alA, l_reg, pa0, pa1, pa2, pa3); SBAR();
  pv_d0(o, vb0, pa0, pa1, pa2, pa3); MASKT(pB0, pB1, NT - 1); partialSM(pB0, pB1, m_reg, mnB, alB);
  __syncthreads(); RESC(alB);
  finishSM(pB0, pB1, alB, l_reg, pa0, pa1, pa2, pa3); SBAR();
  pv_d0(o, vb0 + (int)SHM_V, pa0, pa1, pa2, pa3);
  if (hi == 0) li_l[r32] = l_reg; asm volatile("s_waitcnt lgkmcnt(0)" ::: "memory");
  float rli[16];
#pragma unroll
  for (int r = 0; r < 16; ++r) rli[r] = __builtin_amdgcn_rcpf(li_l[crow(r, hi)]);
  if constexpr (OUT_BF16) {
    bf16* Ow = (bf16*)Ob + (long)(wid * QBLK) * ldo;
#pragma unroll
    for (int r = 0; r < 16; ++r) { int orow = crow(r, hi);
#pragma unroll
      for (int d0 = 0; d0 < 4; ++d0) { const float ov = o[d0][r] * rli[r]; ((unsigned short*)Ow)[(long)orow * ldo + d0 * 32 + r32] = (unsigned short)cvtpk(ov, ov); } }
  } else {
    float* Ow = (float*)Ob + (long)(wid * QBLK) * ldo;
#pragma unroll
    for (int r = 0; r < 16; ++r) { int orow = crow(r, hi);
#pragma unroll
      for (int d0 = 0; d0 < 4; ++d0) Ow[(long)orow * ldo + d0 * 32 + r32] = o[d0][r] * rli[r]; }
  }
  __syncthreads();
#undef KROW
#undef SLOAD
#undef SWRITE
#undef SWAIT
#undef RESC
#undef MASKT
}
#undef KSWZ
#undef SBAR
}

constexpr int NWAVES = 8;
constexpr int D = 2048, NB = 2, SEQ = 4096, CTXL = 256;
constexpr int TL = NB * SEQ, TC = NB * CTXL, MR = TL + TC;
constexpr int KVR = SEQ + CTXL;
constexpr int EVEN_IN = 4608, ODD_IN = 3072, DFF = 5632, DFE = 7168, NE = 8, MODW = 6 * D;
constexpr int NSLOT0 = 36, NSLOT1 = 24;
constexpr int MAXT = 72, XROWS = MAXT * 256;
constexpr float EPS = 1e-6f;
constexpr float LAM_INIT = 0.2f;

constexpr size_t MiB = 1u << 20;
constexpr size_t WS_CTL = 0, CTL_ZERO_BYTES = 1 * MiB;
constexpr size_t WS_MODS = 1 * MiB;
constexpr size_t WS_LAM = WS_MODS + 512 * 1024;
constexpr size_t WS_ROUTE = 2 * MiB;
constexpr size_t RT_EID = WS_ROUTE, RT_GATE = WS_ROUTE + 64 * 1024, RT_POS = WS_ROUTE + 128 * 1024, RT_ROWTOK = WS_ROUTE + 192 * 1024, RT_ROWGATE = WS_ROUTE + 272 * 1024,
                 RT_TILE_E = WS_ROUTE + 352 * 1024, RT_NTILES = WS_ROUTE + 353 * 1024;
constexpr size_t WS_WT_EIN = 4 * MiB, WS_WT_EOUT = 22 * MiB, WS_WT_EF1 = 30 * MiB, WS_WT_EF2 = 74 * MiB, WS_WT_OIN = 96 * MiB, WS_WT_OOUT = 108 * MiB,
                 WS_WT_X1 = 116 * MiB, WS_WT_X2 = 564 * MiB;
constexpr size_t WS_H = 788 * MiB, WS_Z = 822 * MiB, WS_QKV = 900 * MiB, WS_PB = 978 * MiB, WS_OALL = 1046 * MiB, WS_X1 = 1080 * MiB, WS_X3 = 1148 * MiB,
                 WS_ACT = 1212 * MiB, WS_XS = 1306 * MiB, WS_ACT2 = 1378 * MiB, WS_YS = 1630 * MiB, WS_PART = 1774 * MiB, WS_END = 1838 * MiB;
static_assert(WS_WT_EIN + (size_t)EVEN_IN * D * 2 <= WS_WT_EOUT && WS_WT_EF1 + (size_t)2 * DFF * D * 2 <= WS_WT_EF2 && WS_WT_EF2 + (size_t)D * DFF * 2 <= WS_WT_OIN &&
              WS_WT_OIN + (size_t)ODD_IN * D * 2 <= WS_WT_OOUT && WS_WT_X1 + (size_t)NE * 2 * DFE * D * 2 <= WS_WT_X2 && WS_WT_X2 + (size_t)NE * D * DFE * 2 <= WS_H &&
              WS_H + (size_t)MR * D * 2 <= WS_Z && WS_Z + (size_t)MR * EVEN_IN * 2 <= WS_QKV && WS_QKV + (size_t)NB * NSLOT0 * KVR * 128 * 2 <= WS_PB &&
              WS_PB + (size_t)NB * 16 * KVR * 128 * 4 <= WS_OALL && WS_OALL + (size_t)MR * D * 2 <= WS_X1 && WS_X1 + (size_t)MR * D * 4 <= WS_X3 && WS_X3 + (size_t)TL * D * 4 <= WS_ACT &&
              WS_ACT + (size_t)MR * DFF * 2 <= WS_XS && WS_XS + (size_t)XROWS * D * 2 <= WS_ACT2 && WS_ACT2 + (size_t)XROWS * DFE * 2 <= WS_YS && WS_YS + (size_t)XROWS * D * 4 <= WS_PART && WS_PART + 64 * MiB <= WS_END, "d_ws map");
constexpr int CW_BAR = 4096;

constexpr int RING_BYTES = 131072;
constexpr int LDSCTL_OFF = 143360, MISC_OFF = LDSCTL_OFF + 320;
constexpr int LDS_BYTES = 147456;

#define GAS __attribute__((address_space(1)))
#define LAS __attribute__((address_space(3)))
typedef unsigned short bf16;
typedef unsigned v4u __attribute__((ext_vector_type(4)));
typedef unsigned v2u __attribute__((ext_vector_type(2)));
typedef float f32x4 __attribute__((ext_vector_type(4)));
typedef GAS unsigned gu32;
#define RLX_AGENT __ATOMIC_RELAXED, __HIP_MEMORY_SCOPE_AGENT
#define LDS_WAIT() asm volatile("s_waitcnt lgkmcnt(0)" ::: "memory")
#define VM_WAIT() asm volatile("s_waitcnt vmcnt(0)" ::: "memory")
__device__ __forceinline__ unsigned f2bf(float f) { unsigned u = __builtin_bit_cast(unsigned, f); return (u + 0x7fffu + ((u >> 16) & 1u)) >> 16; }
__device__ __forceinline__ unsigned pk2(float lo, float hi) { return f2bf(lo) | (f2bf(hi) << 16); }
using pg8::pk4_fp8;
constexpr float W8_SCALE = 64.f;
__device__ __forceinline__ float bflo(unsigned w) { return __builtin_bit_cast(float, w << 16); }
__device__ __forceinline__ float bfhi(unsigned w) { return __builtin_bit_cast(float, w & 0xffff0000u); }
__device__ __forceinline__ float wave_sum(float v) {
#pragma unroll
    for (int o = 1; o < 64; o <<= 1) v += __shfl_xor(v, o);
    return v;
}

#define XB_TMO      128
#define XB_XCNT(j)  (256  + 64 * (j))
#define XB_XSUB(j)  (1280 + 64 * (j))
#define XB_XGEN(j)  (2304 + 64 * (j))
#define XB_TOP      3328
#define XB_TOPGEN   3392
#define XCD_BAR_WORDS 3456
#define XB_SPIN_CAP (1u << 18)

__device__ __forceinline__ unsigned xb_ld(unsigned* p)              { return __hip_atomic_load(p, __ATOMIC_RELAXED, __HIP_MEMORY_SCOPE_AGENT); }
__device__ __forceinline__ unsigned xb_add(unsigned* p, unsigned v) { return __hip_atomic_fetch_add(p, v, __ATOMIC_RELAXED, __HIP_MEMORY_SCOPE_AGENT); }
__device__ __forceinline__ unsigned xb_xcc_id() { return (unsigned)__builtin_amdgcn_s_getreg((3 << 11) | 20) & 0xFu; }
#define XB_SPIN(cond, bar) do { unsigned _sp = 0; while (cond) { __builtin_amdgcn_s_sleep(1); \
    if ((++_sp & 255u) == 0u) { if (xb_ld(&(bar)[XB_TMO])) break; if (_sp > XB_SPIN_CAP) { atomicAdd(&(bar)[XB_TMO], 1u); break; } } } } while (0)

struct XcdBarrier {
    unsigned* bar; unsigned x;
    volatile LAS unsigned* st;
};

__device__ __forceinline__ XcdBarrier xcd_barrier_post(unsigned* bar, volatile LAS unsigned* st) {
    XcdBarrier b; b.bar = bar; b.x = xb_xcc_id(); b.st = st;
    if (threadIdx.x == 0) (void)xb_add(&bar[XB_XCNT(b.x)], 1u);
    return b;
}
__device__ __forceinline__ void xcd_barrier_complete(unsigned* bar, unsigned x, unsigned& nloc, unsigned& nx) {
    const unsigned G = gridDim.x * gridDim.y * gridDim.z;
    unsigned sum, cnt, mine, sp = 0u;
    for (;;) {
        sum = 0u; cnt = 0u; mine = 0u;
#pragma unroll
        for (unsigned j = 0; j < 16; ++j) { const unsigned c = xb_ld(&bar[XB_XCNT(j)]); sum += c; cnt += (c > 0u) ? 1u : 0u; mine = (j == x) ? c : mine; }
        if (sum == G) break;
        __builtin_amdgcn_s_sleep(1);
        if ((++sp & 255u) == 0u) { if (xb_ld(&bar[XB_TMO])) break; if (sp > XB_SPIN_CAP) { atomicAdd(&bar[XB_TMO], 1u); break; } }
    }
    nloc = mine > 0u ? mine : 1u; nx = cnt > 0u ? cnt : 1u;
}

__device__ __forceinline__ void xcd_barrier(const XcdBarrier& b) {
    asm volatile("s_waitcnt vmcnt(0)" ::: "memory");
    __syncthreads();
    if (threadIdx.x == 0) {
        unsigned* bar = b.bar;
        __builtin_amdgcn_s_waitcnt(0);
        unsigned nloc = b.st[0], nx = b.st[1];
        if (nloc == 0u) { xcd_barrier_complete(bar, b.x, nloc, nx); b.st[0] = nloc; b.st[1] = nx; }
        const unsigned old = xb_add(&bar[XB_XSUB(b.x)], 1u);
        const unsigned gen = old / nloc;
        if (old + 1u == (gen + 1u) * nloc) {
            __builtin_amdgcn_fence(__ATOMIC_RELEASE, "agent");
            asm volatile("s_waitcnt vmcnt(0)" ::: "memory");
            const unsigned og = xb_add(&bar[XB_TOP], 1u);
            const unsigned tg = og / nx;
            if (og + 1u == (tg + 1u) * nx) xb_add(&bar[XB_TOPGEN], 1u);
            else XB_SPIN(xb_ld(&bar[XB_TOPGEN]) == tg, bar);
            __builtin_amdgcn_fence(__ATOMIC_ACQUIRE, "agent");
            xb_add(&bar[XB_XGEN(b.x)], 1u);
            asm volatile("s_waitcnt vmcnt(0)" ::: "memory");
        } else {
            XB_SPIN(xb_ld(&bar[XB_XGEN(b.x)]) == gen, bar);
            __builtin_amdgcn_fence(__ATOMIC_ACQUIRE, "agent");
            asm volatile("s_waitcnt vmcnt(0)" ::: "memory");
        }
    }
    __syncthreads();
}


struct Ctx {
    LAS unsigned char* lds; int tid, lane, wave, G, c, gw, NGW;
};

__device__ __forceinline__ void transpose_item(const float* __restrict__ W, int K, int N, bf16* __restrict__ WT, int q, int kind, LAS float* scr, int lane) {
    const int nblk = N >> 6, kb = q / nblk, nb = q - kb * nblk, k0 = kb * 64, n0 = nb * 64;
    int dest0 = n0;
    if (kind) { const int hf = N >> 1; const int j = n0 < hf ? n0 : n0 - hf; dest0 = (j >> 7) * 256 + (j & 127) + (n0 < hf ? 0 : 128); }
    const int l16 = lane & 15, kq = lane >> 4;
    f32x4 v[16];
#pragma unroll
    for (int i = 0; i < 16; ++i) v[i] = *(const f32x4*)(W + (size_t)(k0 + 4 * i + kq) * N + n0 + 4 * l16);
#pragma unroll
    for (int i = 0; i < 16; ++i) { LAS float* p = scr + (4 * i + kq) * 65 + 4 * l16; p[0] = v[i].x; p[1] = v[i].y; p[2] = v[i].z; p[3] = v[i].w; }
    LDS_WAIT(); asm volatile("" ::: "memory");
    const int c = lane & 7, nn = lane >> 3;
#pragma unroll
    for (int jj = 0; jj < 8; ++jj) { const int n = nn + 8 * jj; const LAS float* s = scr + (8 * c) * 65 + n;
        v4u o; o.x = pk2(s[0 * 65], s[1 * 65]); o.y = pk2(s[2 * 65], s[3 * 65]); o.z = pk2(s[4 * 65], s[5 * 65]); o.w = pk2(s[6 * 65], s[7 * 65]);
        *(v4u*)(WT + (size_t)(dest0 + n) * K + k0 + 8 * c) = o; }
    LDS_WAIT(); asm volatile("" ::: "memory");
}

__device__ __forceinline__ void transpose_item8(const float* __restrict__ W, int K, int N, unsigned char* __restrict__ WT, int q, int kind, LAS float* scr, int lane) {
    const int nblk = N >> 5, kb = q / nblk, nb = q - kb * nblk, k0 = kb * 128, n0 = nb * 32;
    int dest0 = n0;
    if (kind) { const int hf = N >> 1; const int j = n0 < hf ? n0 : n0 - hf; dest0 = (j >> 7) * 256 + (j & 127) + (n0 < hf ? 0 : 128); }
    const int l8 = lane & 7, kq = lane >> 3;
    f32x4 v[16];
#pragma unroll
    for (int i = 0; i < 16; ++i) v[i] = *(const f32x4*)(W + (size_t)(k0 + 8 * i + kq) * N + n0 + 4 * l8);
#pragma unroll
    for (int i = 0; i < 16; ++i) { LAS float* p = scr + (8 * i + kq) * 33 + 4 * l8; p[0] = v[i].x; p[1] = v[i].y; p[2] = v[i].z; p[3] = v[i].w; }
    LDS_WAIT(); asm volatile("" ::: "memory");
    const int c = lane & 7, nn = lane >> 3;
#pragma unroll
    for (int jj = 0; jj < 4; ++jj) { const int n = nn + 8 * jj; const LAS float* s = scr + (16 * c) * 33 + n;
        v4u o; o.x = pk4_fp8(s[0 * 33] * W8_SCALE, s[1 * 33] * W8_SCALE, s[2 * 33] * W8_SCALE, s[3 * 33] * W8_SCALE); o.y = pk4_fp8(s[4 * 33] * W8_SCALE, s[5 * 33] * W8_SCALE, s[6 * 33] * W8_SCALE, s[7 * 33] * W8_SCALE);
        o.z = pk4_fp8(s[8 * 33] * W8_SCALE, s[9 * 33] * W8_SCALE, s[10 * 33] * W8_SCALE, s[11 * 33] * W8_SCALE); o.w = pk4_fp8(s[12 * 33] * W8_SCALE, s[13 * 33] * W8_SCALE, s[14 * 33] * W8_SCALE, s[15 * 33] * W8_SCALE);
        *(v4u*)(WT + (size_t)(dest0 + n) * K + k0 + 16 * c) = o; }
    LDS_WAIT(); asm volatile("" ::: "memory");
}

__device__ __forceinline__ void mod_task(const Ctx& X, int task, const float* cvec, const float* cctx, const float* Wm, const float* bm, float* mods_l) {
    const int ch = task % 48;
    LAS float* S = (LAS float*)X.lds;
    LAS float* R = S + 3 * 2048;
    for (int idx = X.tid; idx < 3 * 2048; idx += NWAVES * 64) { const int i = idx >> 11, k = idx & 2047; const float cv = i < 2 ? cvec[i * 2048 + k] : cctx[k]; S[idx] = cv / (1.f + expf(-cv)); }
    __syncthreads();
    f32x4 a0 = {0.f, 0.f, 0.f, 0.f}, a1 = a0, a2 = a0;
    const float* wp = Wm + (size_t)(X.wave * 256) * MODW + ch * 256 + 4 * X.lane;
    for (int k = 0; k < 256; k += 8) {
        f32x4 w[8];
#pragma unroll
        for (int u = 0; u < 8; ++u) w[u] = *(const f32x4*)(wp + (size_t)(k + u) * MODW);
#pragma unroll
        for (int u = 0; u < 8; ++u) { const int kk = X.wave * 256 + k + u; a0 += w[u] * S[kk]; a1 += w[u] * S[2048 + kk]; a2 += w[u] * S[4096 + kk]; }
    }
#pragma unroll
    for (int j = 0; j < 4; ++j) { R[(X.wave * 3 + 0) * 256 + 4 * X.lane + j] = a0[j]; R[(X.wave * 3 + 1) * 256 + 4 * X.lane + j] = a1[j]; R[(X.wave * 3 + 2) * 256 + 4 * X.lane + j] = a2[j]; }
    __syncthreads();
    for (int idx = X.tid; idx < 768; idx += NWAVES * 64) { const int i = idx >> 8, col = idx & 255; float s = 0.f;
#pragma unroll
        for (int w = 0; w < 8; ++w) s += R[(w * 3 + i) * 256 + col];
        mods_l[(size_t)i * MODW + ch * 256 + col] = s + bm[ch * 256 + col]; }
    __syncthreads();
}

template <bool ROUTER, bool PSUM = false, bool OUT8 = false>
__device__ __forceinline__ void norm_mod_rows(const Ctx& X, const float* src_lat, const float* src_ctx, int nrows, const float* gain, const float* mods_l, int sh_i, int sc_i, bf16* H,
                                              const float* wrouter, int* eid, float* egate, const float* part = nullptr, int Sp = 0, const float* pgate = nullptr, float* wb = nullptr) {
    LAS float* WR = (LAS float*)X.lds;
    if (ROUTER) { for (int idx = X.tid; idx < 8 * 2048; idx += NWAVES * 64) { const int k = idx >> 3, e = idx & 7; WR[e * 2048 + k] = wrouter[idx]; } __syncthreads(); }
    f32x4 vn[8];
    if (X.gw < nrows) { const float* xr = X.gw < TL ? src_lat + (size_t)X.gw * D : src_ctx + (size_t)(X.gw - TL) * D;
#pragma unroll
        for (int j = 0; j < 8; ++j) vn[j] = *(const f32x4*)(xr + 4 * X.lane + 256 * j); }
    for (int row = X.gw; row < nrows; row += X.NGW) {
        const int cond = row < SEQ ? 0 : (row < TL ? 1 : 2);
        const float* shp = mods_l + (size_t)cond * MODW + sh_i * D; const float* scp = mods_l + (size_t)cond * MODW + sc_i * D;
        f32x4 v[8]; float ss = 0.f;
#pragma unroll
        for (int j = 0; j < 8; ++j) v[j] = vn[j];
        { const int nr = row + X.NGW; if (nr < nrows) { const float* xr = nr < TL ? src_lat + (size_t)nr * D : src_ctx + (size_t)(nr - TL) * D;
#pragma unroll
            for (int j = 0; j < 8; ++j) vn[j] = *(const f32x4*)(xr + 4 * X.lane + 256 * j); } }
        if (PSUM) { if (row >= TL) {
            f32x4 a[8];
#pragma unroll
            for (int j = 0; j < 8; ++j) a[j] = (f32x4){0.f, 0.f, 0.f, 0.f};
            for (int p = 0; p < Sp; ++p) { const float* pr = part + ((size_t)p * TC + (row - TL)) * D + 4 * X.lane;
#pragma unroll
                for (int j = 0; j < 8; ++j) a[j] += *(const f32x4*)(pr + 256 * j); }
#pragma unroll
            for (int j = 0; j < 8; ++j) { v[j] += a[j] * *(const f32x4*)(pgate + 4 * X.lane + 256 * j); if (wb) *(f32x4*)(wb + (size_t)(row - TL) * D + 4 * X.lane + 256 * j) = v[j]; }
        } }
#pragma unroll
        for (int j = 0; j < 8; ++j) ss += (v[j].x * v[j].x + v[j].y * v[j].y) + (v[j].z * v[j].z + v[j].w * v[j].w);
        const float rstd = 1.0f / sqrtf(wave_sum(ss) * (1.f / D) + EPS);
#pragma unroll
        for (int j = 0; j < 8; ++j) { const int col = 4 * X.lane + 256 * j; const f32x4 g = *(const f32x4*)(gain + col), sc = *(const f32x4*)(scp + col), sh = *(const f32x4*)(shp + col);
            v[j] = (v[j] * rstd * g) * (sc + 1.0f) + sh;
            if (OUT8) { *(unsigned*)((unsigned char*)H + (size_t)row * D + col) = pk4_fp8(v[j].x, v[j].y, v[j].z, v[j].w); }
            else { v2u o; o.x = pk2(v[j].x, v[j].y); o.y = pk2(v[j].z, v[j].w); *(v2u*)(H + (size_t)row * D + col) = o; } }
        if (ROUTER) {
            float v1 = -3.0e38f, v2 = -3.0e38f; int i1 = 0, i2 = 0;
#pragma unroll 1
            for (int e = 0; e < 8; ++e) { float a = 0.f;
#pragma unroll
                for (int j = 0; j < 8; ++j) { const f32x4 w = *(const LAS f32x4*)(WR + e * 2048 + 4 * X.lane + 256 * j); a += (v[j].x * w.x + v[j].y * w.y) + (v[j].z * w.z + v[j].w * w.w); }
                const float s = wave_sum(a);
                if (s > v1) { v2 = v1; i2 = i1; v1 = s; i1 = e; } else if (s > v2) { v2 = s; i2 = e; } }
            const float ex = expf(v2 - v1), g1 = 1.f / (1.f + ex), g2 = ex / (1.f + ex);
            if (X.lane == 0) { eid[row * 2] = i1; eid[row * 2 + 1] = i2; egate[row * 2] = g1; egate[row * 2 + 1] = g2; }
        }
    }
}

template <int NG>
__device__ __forceinline__ void qkv_post(const Ctx& X, const bf16* z, bf16* QKV, const float* qn_a, const float* kn_a, const float* qn_b, const float* kn_b) {
    typedef float f32x2 __attribute__((ext_vector_type(2)));
    LAS f32x2* CS = (LAS f32x2*)X.lds;
    for (int idx = X.tid; idx < 2048; idx += NWAVES * 64) { const int p = idx >> 5, i = idx & 31; const float inv = exp2f(-(float)i * (13.287712379549449f / 32.0f)); const float a = (float)p * inv;
        float sn, cs; sincosf(a, &sn, &cs); CS[idx] = (f32x2){cs, sn}; }
    __syncthreads();
    const int l16 = X.lane & 15, gq = X.lane >> 4, chunk = l16 >> 2;
    v4u rawn = {0u, 0u, 0u, 0u};
    if (X.gw < MR) rawn = *(const v4u*)(z + (size_t)X.gw * (NG * 128) + gq * 128 + 8 * l16);
    for (int row = X.gw; row < MR; row += X.NGW) {
        const bool lat = row < TL; const int b = lat ? (row >> 12) : ((row - TL) >> 8); const int pos = lat ? (row & 4095) : (SEQ + ((row - TL) & 255));
        const int p = (chunk < 2) ? (pos >> 6) : (pos & 63);
#pragma unroll 1
        for (int it = 0; it < NG / 4; ++it) {
            const int g = it * 4 + gq;
            const float* gp; bool hn;
            if (NG == NSLOT0) { hn = !(g == 10 || g == 11 || g >= 28); gp = g < 8 ? qn_a : (g < 12 ? kn_a : (g < 20 ? qn_b : kn_b)); }
            else { hn = g < 20; gp = g < 16 ? qn_a : kn_a; }
            const v4u raw = rawn;
            { const bool same = it + 1 < NG / 4; const int nrow = same ? row : row + X.NGW, ng = same ? g + 4 : gq; if (nrow < MR) rawn = *(const v4u*)(z + (size_t)nrow * (NG * 128) + ng * 128 + 8 * l16); }
            float v[8] = {bflo(raw.x), bfhi(raw.x), bflo(raw.y), bfhi(raw.y), bflo(raw.z), bfhi(raw.z), bflo(raw.w), bfhi(raw.w)};
            float ss = 0.f;
#pragma unroll
            for (int j = 0; j < 8; ++j) ss += v[j] * v[j];
            ss += __shfl_xor(ss, 1); ss += __shfl_xor(ss, 2); ss += __shfl_xor(ss, 4); ss += __shfl_xor(ss, 8);
            const float rs = 1.0f / sqrtf(ss * (1.f / 128.f) + EPS);
            const f32x4 ga = *(const f32x4*)(gp + 8 * l16), gb = *(const f32x4*)(gp + 8 * l16 + 4);
            const float gg[8] = {ga.x, ga.y, ga.z, ga.w, gb.x, gb.y, gb.z, gb.w};
#pragma unroll
            for (int j = 0; j < 8; ++j) v[j] = hn ? v[j] * rs * gg[j] : v[j];
            float o[8];
#pragma unroll
            for (int j = 0; j < 8; ++j) { const float pv = __shfl_xor(v[j], 4); const f32x2 cs = CS[p * 32 + 8 * (l16 & 3) + j];
                const float rot = (chunk & 1) ? (v[j] * cs.x + pv * cs.y) : (v[j] * cs.x - pv * cs.y); o[j] = (hn && lat) ? rot : v[j]; }
            v4u w; w.x = pk2(o[0], o[1]); w.y = pk2(o[2], o[3]); w.z = pk2(o[4], o[5]); w.w = pk2(o[6], o[7]);
            *(v4u*)(QKV + ((size_t)(b * NG + g) * KVR + pos) * 128 + 8 * l16) = w;
        }
    }
}

template <int NG>
__device__ __forceinline__ void k_post(const Ctx& X, bf16* QKV, const float* kn_a, const float* kn_b, const float* cs_lds) {
    constexpr int NK = (NG == NSLOT0) ? 10 : 4;
    const int l16 = X.lane & 15, rq = X.lane >> 4, chunk = l16 >> 2;
    for (int item = X.gw; item < NB * NK * (KVR / 4); item += X.NGW) {
        const int p4 = item % (KVR / 4), t = item / (KVR / 4), kgi = t % NK, b = t / NK;
        const int g = (NG == NSLOT0) ? (kgi < 2 ? 8 + kgi : 18 + kgi) : 16 + kgi;
        const float* gp = (NG == NSLOT0) ? (kgi < 2 ? kn_a : kn_b) : kn_a;
        const int pos = p4 * 4 + rq; const bool lat = pos < SEQ; const int p = (chunk < 2) ? (pos >> 6) : (pos & 63);
        bf16* ptr = QKV + ((size_t)(b * NG + g) * KVR + pos) * 128 + 8 * l16;
        const v4u raw = *(const v4u*)ptr;
        float v[8] = {bflo(raw.x), bfhi(raw.x), bflo(raw.y), bfhi(raw.y), bflo(raw.z), bfhi(raw.z), bflo(raw.w), bfhi(raw.w)};
        float ss = 0.f;
#pragma unroll
        for (int j = 0; j < 8; ++j) ss += v[j] * v[j];
        ss += __shfl_xor(ss, 1); ss += __shfl_xor(ss, 2); ss += __shfl_xor(ss, 4); ss += __shfl_xor(ss, 8);
        const float rs = 1.0f / sqrtf(ss * (1.f / 128.f) + EPS);
        const f32x4 ga = *(const f32x4*)(gp + 8 * l16), gb = *(const f32x4*)(gp + 8 * l16 + 4);
        const float gg[8] = {ga.x, ga.y, ga.z, ga.w, gb.x, gb.y, gb.z, gb.w};
        float o[8];
#pragma unroll
        for (int j = 0; j < 8; ++j) { v[j] = v[j] * rs * gg[j]; const float pv = __shfl_xor(v[j], 4); const int ci = (lat ? p : 0) * 32 + 8 * (l16 & 3) + j; const float c = cs_lds[ci * 2], sn = cs_lds[ci * 2 + 1];
            const float rot = (chunk & 1) ? (v[j] * c + pv * sn) : (v[j] * c - pv * sn); o[j] = lat ? rot : v[j]; }
        v4u w; w.x = pk2(o[0], o[1]); w.y = pk2(o[2], o[3]); w.z = pk2(o[4], o[5]); w.w = pk2(o[6], o[7]);
        *(v4u*)ptr = w;
    }
}
constexpr int CS_OFF = 98304;
__device__ __forceinline__ void build_cs(const Ctx& X) {
    LAS float* CS = (LAS float*)(X.lds + CS_OFF);
    for (int idx = X.tid; idx < 2048; idx += NWAVES * 64) { const int p = idx >> 5, i = idx & 31; const float inv = exp2f(-(float)i * (13.287712379549449f / 32.0f)); const float a = (float)p * inv;
        float sn, cs; sincosf(a, &sn, &cs); CS[idx * 2] = cs; CS[idx * 2 + 1] = sn; }
    __syncthreads();
}

__device__ __forceinline__ void b_combine(const Ctx& X, const float* PB, const float* lamv, const float* subln, bf16* OALL) {
    const int half = X.lane >> 5, d4 = (X.lane & 31) * 4;
    f32x4 n1, n2;
#define BC_LOAD(item_, d1, d2) do { const int row_ = (item_) >> 2, hb_ = (item_) & 3; const bool lat_ = row_ < TL; const int b_ = lat_ ? (row_ >> 12) : ((row_ - TL) >> 8); const int pos_ = lat_ ? (row_ & 4095) : (SEQ + ((row_ - TL) & 255)); \
        d1 = *(const f32x4*)(PB + ((size_t)(b_ * 16 + (hb_ * 2 + 0) * 2 + half) * KVR + pos_) * 128 + d4); d2 = *(const f32x4*)(PB + ((size_t)(b_ * 16 + (hb_ * 2 + 1) * 2 + half) * KVR + pos_) * 128 + d4); } while (0)
    if (X.gw < MR * 4) BC_LOAD(X.gw, n1, n2);
    for (int item = X.gw; item < MR * 4; item += X.NGW) {
        const int row = item >> 2, hb = item & 3;
        const f32x4 o1 = n1, o2 = n2;
        if (item + X.NGW < MR * 4) BC_LOAD(item + X.NGW, n1, n2);
        const float lam = lamv[hb];
        const f32x4 v = o1 - o2 * lam;
        const float ss = wave_sum((v.x * v.x + v.y * v.y) + (v.z * v.z + v.w * v.w));
        const float rs = (1.0f - LAM_INIT) / sqrtf(ss * (1.f / 256.f) + EPS);
        const f32x4 g = *(const f32x4*)(subln + half * 128 + d4);
        const f32x4 y = v * rs * g;
        v2u o; o.x = pk2(y.x, y.y); o.y = pk2(y.z, y.w);
        *(v2u*)(OALL + (size_t)row * D + 1024 + hb * 256 + half * 128 + d4) = o;
    }
#undef BC_LOAD
}

__device__ __forceinline__ void moe_route(const Ctx& X, const int* eid, const float* egate, const bf16* H, bf16* XS, int* pos, int* rowtok, float* rowgate, int* tile_e, int* ntiles) {
    LAS int* tot = (LAS int*)X.lds;
    LAS int* pre = tot + 8;
    LAS int* base = tot + 16;
    LAS int* dst = tot + 64;
    const int tpw = (TL + X.G - 1) / X.G, t0 = X.c * tpw, t1 = (t0 + tpw) < TL ? (t0 + tpw) : TL;
    if (X.tid < 16) tot[X.tid] = 0;
    __syncthreads();
    for (int idx = X.tid; idx < 2 * TL; idx += NWAVES * 64) { const int e = eid[idx]; __hip_atomic_fetch_add(&tot[e], 1, __ATOMIC_RELAXED, __HIP_MEMORY_SCOPE_WORKGROUP); if ((idx >> 1) < t0) __hip_atomic_fetch_add(&pre[e], 1, __ATOMIC_RELAXED, __HIP_MEMORY_SCOPE_WORKGROUP); }
    __syncthreads();
    if (X.tid == 0) { int acc = 0; for (int e = 0; e < 8; ++e) { base[e] = acc; acc += (tot[e] + 255) & ~255; }
        if (X.c == 0) { *ntiles = acc >> 8; for (int e = 0; e < 8; ++e) { const int nt = (tot[e] + 255) >> 8; for (int i = 0; i < nt; ++i) tile_e[(base[e] >> 8) + i] = e; } } }
    __syncthreads();
    if (X.wave == 0) {
        int run[8];
#pragma unroll
        for (int e = 0; e < 8; ++e) run[e] = 0;
        const int n_ent = 2 * (t1 - t0);
        for (int b0 = 0; b0 < n_ent; b0 += 64) {
            const int li = b0 + X.lane; const bool valid = li < n_ent; const int idx = 2 * t0 + li; const int e = valid ? eid[idx] : -1;
            int rank = 0;
#pragma unroll
            for (int ee = 0; ee < 8; ++ee) { const unsigned long long m = __ballot(e == ee); if (e == ee) rank = run[ee] + __popcll(m & ((1ull << X.lane) - 1ull)); run[ee] += __popcll(m); }
            if (valid) { const int d = base[e] + pre[e] + rank; dst[li] = d; pos[idx] = d; rowtok[d] = idx >> 1; rowgate[d] = egate[idx]; }
        }
    }
    __syncthreads();
    { const int n_ent = 2 * (t1 - t0);
      for (int li = X.wave; li < n_ent; li += NWAVES) { const int tok = t0 + (li >> 1); const int d = dst[li];
          const v4u* s = (const v4u*)((const unsigned char*)H + (size_t)tok * D) + X.lane; v4u* o = (v4u*)((unsigned char*)XS + (size_t)d * D) + X.lane;
#pragma unroll
          for (int j = 0; j < 2; ++j) o[64 * j] = s[64 * j]; } }
    if (X.c < 8) { const int e = X.c; const int r0 = base[e] + tot[e], r1 = base[e] + ((tot[e] + 255) & ~255);
        for (int r = r0 + X.wave; r < r1; r += NWAVES) { if (X.lane == 0) { rowtok[r] = -1; rowgate[r] = 0.f; }
            v4u* o = (v4u*)((unsigned char*)XS + (size_t)r * D) + X.lane; const v4u zz = {0u, 0u, 0u, 0u};
#pragma unroll
            for (int j = 0; j < 2; ++j) o[64 * j] = zz; } }
    __syncthreads();
}

constexpr int MOE_MAIN_TILES = 64, MOE_MAIN_ROWS = MOE_MAIN_TILES * 256;
__device__ __forceinline__ void moe_final(const Ctx& X, const float* X3, const float* YS, const int* pos, const float* mods_l, float* out, const float* part, int ntiles) {
    int Sp, ppair; const int tail_rows = (ntiles - MOE_MAIN_TILES) * 256; pg8::tail_split(X.G, (ntiles - MOE_MAIN_TILES) * (D / 256), DFE / 128, Sp, ppair);
    int np0 = 0, np1 = 0; if (X.gw < TL) { np0 = pos[2 * X.gw]; np1 = pos[2 * X.gw + 1]; }
    for (int row = X.gw; row < TL; row += X.NGW) {
        const int p0 = np0, p1 = np1; const float* gp = mods_l + (size_t)(row >> 12) * MODW + 5 * D;
        if (row + X.NGW < TL) { np0 = pos[2 * (row + X.NGW)]; np1 = pos[2 * (row + X.NGW) + 1]; }
        f32x4 a[8], b[8];
        if (p0 < MOE_MAIN_ROWS) {
#pragma unroll
            for (int j = 0; j < 8; ++j) a[j] = *(const f32x4*)(YS + (size_t)p0 * D + 4 * X.lane + 256 * j);
        } else {
#pragma unroll
            for (int j = 0; j < 8; ++j) a[j] = (f32x4){0.f, 0.f, 0.f, 0.f};
            for (int p = 0; p < Sp; ++p) { const float* pr = part + ((size_t)p * tail_rows + (p0 - MOE_MAIN_ROWS)) * D + 4 * X.lane;
#pragma unroll
                for (int j = 0; j < 8; ++j) a[j] += *(const f32x4*)(pr + 256 * j); }
        }
        if (p1 < MOE_MAIN_ROWS) {
#pragma unroll
            for (int j = 0; j < 8; ++j) b[j] = *(const f32x4*)(YS + (size_t)p1 * D + 4 * X.lane + 256 * j);
        } else {
#pragma unroll
            for (int j = 0; j < 8; ++j) b[j] = (f32x4){0.f, 0.f, 0.f, 0.f};
            for (int p = 0; p < Sp; ++p) { const float* pr = part + ((size_t)p * tail_rows + (p1 - MOE_MAIN_ROWS)) * D + 4 * X.lane;
#pragma unroll
                for (int j = 0; j < 8; ++j) b[j] += *(const f32x4*)(pr + 256 * j); }
        }
#pragma unroll
        for (int j = 0; j < 8; ++j) { const int col = 4 * X.lane + 256 * j; const f32x4 x = *(const f32x4*)(X3 + (size_t)row * D + col), g = *(const f32x4*)(gp + col);
            *(f32x4*)(out + (size_t)row * D + col) = x + g * (a[j] + b[j]); }
    }
}

__device__ __forceinline__ const float* arg_in(int i) {
    auto kp = __builtin_amdgcn_kernarg_segment_ptr();
    asm volatile("" : "+s"(kp));
    return ((const float* const __attribute__((address_space(4)))*)kp)[i];
}
#define AIN(i) arg_in(i)
constexpr int NPHASE = 20;
#ifndef PHMASK
#define PHMASK 0xFFFFFu
#endif
#ifndef PHDUP
#define PHDUP 0u
#endif
#define REP(k) _Pragma("unroll") for (int rep_ = 0; rep_ < ((((PHDUP) >> (k)) & 1u) ? 2 : 1); ++rep_)
#ifndef MK_LAUNCHES
#define MK_LAUNCHES {{0, NPHASE}}
#endif
struct PhRange { int lo, hi; };
constexpr PhRange kLaunches[] = MK_LAUNCHES;
struct Args { const float* in[33]; float* out; unsigned char* ws; int ph_lo, ph_hi, li, pad; };
__global__ void __launch_bounds__(NWAVES * 64, 2) fwd_kernel(Args args) {
    extern __shared__ __attribute__((aligned(16))) unsigned char lds[];
    Ctx X;
    X.lds = (LAS unsigned char*)lds; X.tid = threadIdx.x; X.lane = X.tid & 63; X.wave = __builtin_amdgcn_readfirstlane(X.tid >> 6);
    X.G = gridDim.x; X.c = blockIdx.x; X.gw = X.c * NWAVES + X.wave; X.NGW = X.G * NWAVES;
    unsigned char* ws = args.ws;
    gu32* ctl = (gu32*)(ws + WS_CTL);
    volatile LAS unsigned* MISC = (volatile LAS unsigned*)(X.lds + MISC_OFF);
    for (int u = X.tid; u < (LDS_BYTES - LDSCTL_OFF) / 4; u += NWAVES * 64) ((LAS unsigned*)(X.lds + LDSCTL_OFF))[u] = 0u;
    __syncthreads();
    const int lo = args.ph_lo, hi = args.ph_hi;
    XcdBarrier bar; bar.bar = (unsigned*)(ctl + CW_BAR) + args.li * XCD_BAR_WORDS; bar.x = 0; bar.st = nullptr;
    if (hi - lo > 1) bar = xcd_barrier_post((unsigned*)(ctl + CW_BAR) + args.li * XCD_BAR_WORDS, MISC + 8);
#define GRID_BAR() xcd_barrier(bar)
#define IN(k) ((((PHMASK) >> (k)) & 1u) && lo <= (k) && (k) < hi)
#define BOTH(k) (IN(k) && ((k) + 1) < hi)

#define x_in (AIN(0))
#define c_in (AIN(1))
#define ctx_in (AIN(2))
#define cctx_in (AIN(3))
#define mods0 ((float*)(ws + WS_MODS))
#define mods1 ((float*)(ws + WS_MODS) + 3 * MODW)
#define lamv ((float*)(ws + WS_LAM))
#define WT_EIN ((bf16*)(ws + WS_WT_EIN))
#define WT_EOUT ((bf16*)(ws + WS_WT_EOUT))
#define WT_EF1 ((bf16*)(ws + WS_WT_EF1))
#define WT_EF2 ((bf16*)(ws + WS_WT_EF2))
#define WT_OIN ((bf16*)(ws + WS_WT_OIN))
#define WT_OOUT ((bf16*)(ws + WS_WT_OOUT))
#define WT_X1 ((bf16*)(ws + WS_WT_X1))
#define WT_X2 ((bf16*)(ws + WS_WT_X2))
#define H ((bf16*)(ws + WS_H))
#define Z ((bf16*)(ws + WS_Z))
#define QKV ((bf16*)(ws + WS_QKV))
#define PB ((float*)(ws + WS_PB))
#define OALL ((bf16*)(ws + WS_OALL))
#define X1 ((float*)(ws + WS_X1))
#define X3 ((float*)(ws + WS_X3))
#define ACT ((bf16*)(ws + WS_ACT))
#define XS ((bf16*)(ws + WS_XS))
#define ACT2 ((bf16*)(ws + WS_ACT2))
#define YS ((float*)(ws + WS_YS))
#define PART ((float*)(ws + WS_PART))
#define EID ((int*)(ws + RT_EID))
#define EGATE ((float*)(ws + RT_GATE))
#define POS ((int*)(ws + RT_POS))
#define ROWTOK ((int*)(ws + RT_ROWTOK))
#define ROWGATE ((float*)(ws + RT_ROWGATE))
#define TILE_E ((int*)(ws + RT_TILE_E))
#define NTILES ((int*)(ws + RT_NTILES))

    if (IN(0)) {
    REP(0) { if (rep_) __syncthreads();
    {
        for (int task = X.c; task < 96; task += X.G) { const int l = task / 48; mod_task(X, task, c_in, cctx_in, l ? AIN(24) : AIN(6), l ? AIN(25) : AIN(7), l ? mods1 : mods0); }
        if (X.c == X.G - 1 && X.wave == 0) {
            for (int h = 0; h < 4; ++h) { const float* q1 = AIN(15) + h * 128; const float* k1 = AIN(16) + h * 128; const float* q2 = AIN(17) + h * 128; const float* k2 = AIN(18) + h * 128;
                const float s1 = wave_sum(q1[X.lane] * k1[X.lane] + q1[X.lane + 64] * k1[X.lane + 64]); const float s2 = wave_sum(q2[X.lane] * k2[X.lane] + q2[X.lane + 64] * k2[X.lane + 64]);
                if (X.lane == 0) lamv[h] = expf(s1) - expf(s2) + LAM_INIT; }
        }
        LAS float* scr = (LAS float*)(X.lds + X.wave * 16896);
        int tbase = 0;
#define TPASS(Wp, K_, N_, WTp, kind_, nexp) { constexpr int per_ = ((K_) / 64) * ((N_) / 64), tot_ = per_ * (nexp); int j_ = (X.gw - tbase) % X.NGW; if (j_ < 0) j_ += X.NGW; \
            for (; j_ < tot_; j_ += X.NGW) { const int e_ = j_ / per_, q_ = j_ - e_ * per_; transpose_item((Wp) + (size_t)e_ * (K_) * (N_), (K_), (N_), (WTp) + (size_t)e_ * (N_) * (K_), q_, (kind_), scr, X.lane); } tbase += tot_; }
#define TPASS8(Wp, K_, N_, WTp, kind_, nexp) { constexpr int per_ = ((K_) / 128) * ((N_) / 32), tot_ = per_ * (nexp); int j_ = (X.gw - tbase) % X.NGW; if (j_ < 0) j_ += X.NGW; \
            for (; j_ < tot_; j_ += X.NGW) { const int e_ = j_ / per_, q_ = j_ - e_ * per_; transpose_item8((Wp) + (size_t)e_ * (K_) * (N_), (K_), (N_), (WTp) + (size_t)e_ * (N_) * (K_), q_, (kind_), scr, X.lane); } tbase += tot_; }
        TPASS(AIN(8), D, EVEN_IN, WT_EIN, 0, 1)
        TPASS(AIN(9), D, D, WT_EOUT, 0, 1)
        TPASS(AIN(20), D, 2 * DFF, WT_EF1, 1, 1)
        TPASS(AIN(21), DFF, D, WT_EF2, 0, 1)
        TPASS(AIN(26), D, ODD_IN, WT_OIN, 0, 1)
        TPASS(AIN(27), D, D, WT_OOUT, 0, 1)
        TPASS8(AIN(31), D, 2 * DFE, (unsigned char*)WT_X1, 1, NE)
        TPASS8(AIN(32), DFE, D, (unsigned char*)WT_X2, 0, NE)
#undef TPASS
#undef TPASS8
    }
    }
    if (BOTH(0)) GRID_BAR();
    }
    if (IN(1)) {
    REP(1) { if (rep_) __syncthreads();
    norm_mod_rows<false>(X, x_in, ctx_in, MR, AIN(4), mods0, 0, 1, H, nullptr, nullptr, nullptr);
    }
    if (BOTH(1)) GRID_BAR();
    }
    if (IN(2)) {
    REP(2) { if (rep_) __syncthreads();
    { pg8::Gemm g{H, WT_EIN, MR, EVEN_IN, D}; pg8::StaticOrder S; S.init(MR, EVEN_IN, D / 64, X.G, X.c); pg8::EpiSlots E{QKV, NSLOT0, KVR};
      pg8::gemm_phase<pg8::EpiSlots, pg8::StaticOrder, true, true>(X.lds, g, S, E); }
    }
    if (BOTH(2)) GRID_BAR();
    }
    if (IN(3)) {
    REP(3) { if (rep_) __syncthreads();
    build_cs(X); k_post<NSLOT0>(X, QKV, AIN(11), AIN(14), (const float*)(lds + CS_OFF));
    }
    if (BOTH(3)) GRID_BAR();
    }
    if (IN(4)) {
    REP(4) { if (rep_) __syncthreads();
    {
        build_cs(X); const float* csp = (const float*)(lds + CS_OFF);
        const att::bf16* Q0 = (const att::bf16*)QKV;
        for (int u = X.c; u < 544; u += X.G) {
            const bool isl = u < 512; const int b = isl ? (u >> 8) : ((u - 512) >> 4), vh = isl ? ((u >> 4) & 15) : ((u - 512) & 15), qb = isl ? (u & 15) : 16;
            const int hb = vh >> 2, map = (vh >> 1) & 1, half = vh & 1;
            const att::bf16* Qp = Q0 + ((size_t)(b * NSLOT0 + 12 + 2 * hb + map) * KVR + qb * 256) * 128;
            const att::bf16* Kp = Q0 + ((size_t)(b * NSLOT0 + 20 + 2 * hb + map) * KVR) * 128;
            const att::bf16* Vp = Q0 + ((size_t)(b * NSLOT0 + 28 + 2 * hb + half) * KVR) * 128;
            float* Op = PB + ((size_t)(b * 16 + vh) * KVR + qb * 256) * 128;
            att::attn_unit<false, false>(Qp, Kp, Vp, (void*)Op, 128, 0, isl ? 68 : 0, isl ? 68 : 4, qb * 256, -1e30f, 0.f, (char*)lds, AIN(13), isl, csp);
        }
        const int ca = (X.c + X.G - 32) % X.G;
        for (int u = ca; u < 272; u += X.G) {
            const bool isl = u < 256; const int b = isl ? (u >> 7) : ((u - 256) >> 3), h = isl ? ((u >> 4) & 7) : ((u - 256) & 7), qb = isl ? (u & 15) : 16;
            const int q0 = qb * 256; const int klo = isl ? (q0 >= 128 ? q0 - 128 : 0) : 0; const int khi = (q0 + 384) < SEQ ? (q0 + 384) : SEQ; const int nt1 = isl ? ((khi - klo) >> 6) : 0;
            const att::bf16* Qp = Q0 + ((size_t)(b * NSLOT0 + h) * KVR + q0) * 128;
            const att::bf16* Kp = Q0 + ((size_t)(b * NSLOT0 + 8 + (h >> 2)) * KVR) * 128;
            const att::bf16* Vp = Q0 + ((size_t)(b * NSLOT0 + 10 + (h >> 2)) * KVR) * 128;
            bf16* Op = OALL + (size_t)(isl ? (b * SEQ + q0) : (TL + b * CTXL)) * D + h * 128;
            const float sink = AIN(12)[h];
            att::attn_unit<true, true>(Qp, Kp, Vp, (void*)Op, D, klo, nt1, nt1 + 4, q0, sink * (1.0f / att::SCALE), 1.f, (char*)lds, AIN(10), isl, csp);
        }
    }
    }
    if (BOTH(4)) GRID_BAR();
    }
    if (IN(5)) {
    REP(5) { if (rep_) __syncthreads();
    b_combine(X, PB, lamv, AIN(19), OALL);
    }
    if (BOTH(5)) GRID_BAR();
    }
    if (IN(6)) {
    REP(6) { if (rep_) __syncthreads();
    { pg8::Gemm g{OALL, WT_EOUT, MR, D, D}; pg8::TailOrder S; S.init(TL / 256, TC / 256, D / 256, D / 64, X.G, X.c, nullptr); pg8::EpiRes E{x_in, ctx_in, X1, D, mods0 + 2 * D, MODW, PART, TL, TC, 1.0f};
      pg8::gemm_phase<pg8::EpiRes, pg8::TailOrder, true, true>(X.lds, g, S, E); }
    }
    if (BOTH(6)) GRID_BAR();
    }
    if (IN(7)) {
    REP(7) { if (rep_) __syncthreads();
    { int Sp, pp; pg8::tail_split(X.G, (TC / 256) * (D / 256), D / 64, Sp, pp);
      norm_mod_rows<false, true>(X, X1, ctx_in, MR, AIN(5), mods0, 3, 4, H, nullptr, nullptr, nullptr, PART, Sp, mods0 + 2 * MODW + 2 * D, X1 + (size_t)TL * D); }
    }
    if (BOTH(7)) GRID_BAR();
    }
    if (IN(8)) {
    REP(8) { if (rep_) __syncthreads();
    { pg8::Gemm g{H, WT_EF1, MR, 2 * DFF, D}; pg8::StaticOrder S; S.init(MR, 2 * DFF, D / 64, X.G, X.c); pg8::EpiSwiglu E{ACT, DFF, 1.0f};
      pg8::gemm_phase<pg8::EpiSwiglu, pg8::StaticOrder, true, true>(X.lds, g, S, E); }
    }
    if (BOTH(8)) GRID_BAR();
    }
    if (IN(9)) {
    REP(9) { if (rep_) __syncthreads();
    { pg8::Gemm g{ACT, WT_EF2, MR, D, DFF}; pg8::TailOrder S; S.init(TL / 256, TC / 256, D / 256, DFF / 64, X.G, X.c, nullptr); pg8::EpiRes E{X1, X1 + (size_t)TL * D, X1, D, mods0 + 5 * D, MODW, PART, TL, TC, 1.0f};
      pg8::gemm_phase<pg8::EpiRes, pg8::TailOrder, true, true>(X.lds, g, S, E); }
    }
    if (BOTH(9)) GRID_BAR();
    }
    if (IN(10)) {
    REP(10) { if (rep_) __syncthreads();
    { int Sp, pp; pg8::tail_split(X.G, (TC / 256) * (D / 256), DFF / 64, Sp, pp);
      norm_mod_rows<false, true>(X, X1, X1 + (size_t)TL * D, MR, AIN(22), mods1, 0, 1, H, nullptr, nullptr, nullptr, PART, Sp, mods0 + 2 * MODW + 5 * D, nullptr); }
    }
    if (BOTH(10)) GRID_BAR();
    }
    if (IN(11)) {
    REP(11) { if (rep_) __syncthreads();
    { pg8::Gemm g{H, WT_OIN, MR, ODD_IN, D}; pg8::StaticOrder S; S.init(MR, ODD_IN, D / 64, X.G, X.c); pg8::EpiSlots E{QKV, NSLOT1, KVR};
      pg8::gemm_phase<pg8::EpiSlots, pg8::StaticOrder, true, true>(X.lds, g, S, E); }
    }
    if (BOTH(11)) GRID_BAR();
    }
    if (IN(12)) {
    REP(12) { if (rep_) __syncthreads();
    build_cs(X); k_post<NSLOT1>(X, QKV, AIN(29), nullptr, (const float*)(lds + CS_OFF));
    }
    if (BOTH(12)) GRID_BAR();
    }
    if (IN(13)) {
    REP(13) { if (rep_) __syncthreads();
    {
        build_cs(X); const float* csp = (const float*)(lds + CS_OFF);
        const att::bf16* Q0 = (const att::bf16*)QKV;
        for (int u = X.c; u < 512; u += X.G) {
            const int b = u >> 8, h = (u >> 4) & 15, qb = u & 15;
            const att::bf16* Qp = Q0 + ((size_t)(b * NSLOT1 + h) * KVR + qb * 256) * 128;
            const att::bf16* Kp = Q0 + ((size_t)(b * NSLOT1 + 16 + (h >> 2)) * KVR) * 128;
            const att::bf16* Vp = Q0 + ((size_t)(b * NSLOT1 + 20 + (h >> 2)) * KVR) * 128;
            bf16* Op = OALL + (size_t)(b * SEQ + qb * 256) * D + h * 128;
            const int ntc = 68 + (X.G >> 20);
            att::attn_unit<false, true>(Qp, Kp, Vp, (void*)Op, D, 0, ntc, ntc, qb * 256, -1e30f, 0.f, (char*)lds, AIN(28), true, csp);
        }
    }
    }
    if (BOTH(13)) GRID_BAR();
    }
    if (IN(14)) {
    REP(14) { if (rep_) __syncthreads();
    { pg8::Gemm g{OALL, WT_OOUT, TL, D, D}; pg8::StaticOrder S; S.init(TL, D, D / 64, X.G, X.c); pg8::EpiRes E{X1, X1, X3, D, mods1 + 2 * D, MODW, nullptr, 0, 0, 1.0f};
      pg8::gemm_phase<pg8::EpiRes, pg8::StaticOrder, true, true>(X.lds, g, S, E); }
    }
    if (BOTH(14)) GRID_BAR();
    }
    if (IN(15)) {
    REP(15) { if (rep_) __syncthreads();
    norm_mod_rows<true, false, true>(X, X3, X3, TL, AIN(23), mods1, 3, 4, H, AIN(30), EID, EGATE);
    }
    if (BOTH(15)) GRID_BAR();
    }
    if (IN(16)) {
    REP(16) { if (rep_) __syncthreads();
    moe_route(X, EID, EGATE, H, XS, POS, ROWTOK, ROWGATE, TILE_E, NTILES);
    }
    if (BOTH(16)) GRID_BAR();
    }
    if (IN(17)) {
    REP(17) { if (rep_) __syncthreads();
    { const int nt = *(volatile int*)NTILES; pg8::Gemm g{XS, WT_X1, XROWS, 2 * DFE, D}; pg8::TailOrder S; S.init(nt, 0, 2 * DFE / 256, D / 128, X.G, X.c, TILE_E); pg8::EpiSwiglu8 E{ACT2, DFE, 1.0f / W8_SCALE};
      pg8::gemm_phase<pg8::EpiSwiglu8, pg8::TailOrder, true, true, true>(X.lds, g, S, E); }
    }
    if (BOTH(17)) GRID_BAR();
    }
    if (IN(18)) {
    REP(18) { if (rep_) __syncthreads();
    { const int nt = *(volatile int*)NTILES; pg8::Gemm g{ACT2, WT_X2, XROWS, D, DFE}; pg8::TailOrder S; S.init(MOE_MAIN_TILES, nt - MOE_MAIN_TILES, D / 256, DFE / 128, X.G, X.c, TILE_E); pg8::EpiRowScale E{YS, D, ROWGATE, PART, MOE_MAIN_ROWS, (nt - MOE_MAIN_TILES) * 256, 1.0f / W8_SCALE};
      pg8::gemm_phase<pg8::EpiRowScale, pg8::TailOrder, true, true, true>(X.lds, g, S, E); }
    }
    if (BOTH(18)) GRID_BAR();
    }
    if (IN(19)) {
    REP(19) { if (rep_) __syncthreads();
    moe_final(X, X3, YS, POS, mods1, args.out, PART, *(volatile int*)NTILES);
    }
    }
}

extern "C" void kernel_launch(void* const* d_in, const int* in_sizes, int n_in, void* d_out, int out_size, void* d_ws, size_t ws_size, hipStream_t stream) {
    static int grid = 0;
    if (grid == 0) {
        if (n_in != 33 || in_sizes[0] != TL * D || out_size != TL * D || ws_size < WS_END) { fprintf(stderr, "kernel_launch: unexpected shapes (n_in %d, in0 %d, out %d, ws %zu)\n", n_in, n_in > 0 ? in_sizes[0] : -1, out_size, ws_size); grid = -1; return; }
        int dev = 0, cus = 0, per_cu = 0;
        if (hipGetDevice(&dev) != hipSuccess || hipDeviceGetAttribute(&cus, hipDeviceAttributeMultiprocessorCount, dev) != hipSuccess) { grid = -1; return; }
        if (hipFuncSetAttribute((const void*)fwd_kernel, hipFuncAttributeMaxDynamicSharedMemorySize, LDS_BYTES) != hipSuccess) { fprintf(stderr, "kernel_launch: hipFuncSetAttribute failed\n"); grid = -1; return; }
        if (hipOccupancyMaxActiveBlocksPerMultiprocessor(&per_cu, (const void*)fwd_kernel, NWAVES * 64, LDS_BYTES) != hipSuccess || per_cu < 1) { fprintf(stderr, "kernel_launch: occupancy query says %d blocks per CU\n", per_cu); }
        (void)hipGetLastError();
        grid = cus;
    }
    if (grid < 0) return;
    if (hipMemsetAsync((char*)d_ws + WS_CTL, 0, CTL_ZERO_BYTES, stream) != hipSuccess) return;
    Args a{};
    for (int i = 0; i < 33; ++i) a.in[i] = (const float*)d_in[i];
    a.out = (float*)d_out; a.ws = (unsigned char*)d_ws;
    constexpr int NL = sizeof(kLaunches) / sizeof(kLaunches[0]);
    for (int li = 0; li < NL; ++li) {
        a.ph_lo = kLaunches[li].lo; a.ph_hi = kLaunches[li].hi; a.li = li; a.pad = 0;
        hipLaunchKernelGGL(fwd_kernel, dim3(grid), dim3(NWAVES * 64), LDS_BYTES, stream, a);
        const hipError_t le = hipPeekAtLastError();
        if (le != hipSuccess) { fprintf(stderr, "kernel_launch: launch %d failed: %s\n", li, hipGetErrorName(le)); break; }
    }
}
```

```cpp
#include <hip/hip_runtime.h>
#include <hip/hip_bf16.h>
#include <cstdio>
#include <cstdint>

namespace pg8 {
#define PG8_LAS __attribute__((address_space(3)))
typedef unsigned short bf16_t;
typedef short bf16x8 __attribute__((ext_vector_type(8)));
typedef float f32x4 __attribute__((ext_vector_type(4)));
typedef unsigned u32x4 __attribute__((ext_vector_type(4)));
constexpr int BM = 256, BK = 64, HALF = 128, HTB = HALF * BK * 2  , STAGE_BYTES = 8 * HTB, NXCD = 8, WGM = 8;

__host__ __device__ __forceinline__ int lds_byte(int r, int c) { const int st = (r >> 4) * 2 + (c >> 5), rr = r & 15, cc = c & 31, ob = rr * 64 + cc * 2; return st * 1024 + (ob ^ (((ob >> 9) & 1) << 5)); }
__host__ __device__ __forceinline__ void stage_rc(int b, int& R, int& C) { const int st = b / 1024, sb = b % 1024, swz = sb ^ (((sb >> 9) & 1) << 5); R = (st >> 1) * 16 + swz / 64; C = (st & 1) * 32 + (swz % 64) / 2; }
__host__ __device__ __forceinline__ int perm32(int rho) { const int n = rho >> 4, i = rho & 15; return 8 * (i >> 2) + 4 * n + (i & 3); }

struct Unit { int pm, pn, pnb, kt0, nkt, part; };
struct Gemm { const void* A; const void* Bt; int M, N, K; };

struct StaticOrder {
    int nM, nN, nwg, G, c, KT;
    __host__ __device__ __forceinline__ void init(int M, int N, int KT_, int G_, int c_) { nM = M / BM; nN = N / BM; nwg = nM * nN; G = G_; c = c_; KT = KT_; }
    __host__ __device__ __forceinline__ bool next(int i, Unit& u) const {
        const long L = (long)i * G + c; if (L >= nwg) return false;
        int wgid = (int)L; { const int q = nwg / NXCD, r = nwg % NXCD, xcd = wgid % NXCD, off = wgid / NXCD; wgid = (xcd < r ? xcd * (q + 1) : r * (q + 1) + (xcd - r) * q) + off; }
        const int nig = WGM * nN, gid = wgid / nig, fm = gid * WGM, gsz = (nM - fm) < WGM ? (nM - fm) : WGM;
        u.pm = fm + ((wgid % nig) % gsz); u.pn = (wgid % nig) / gsz; u.pnb = u.pn; u.kt0 = 0; u.nkt = KT; u.part = -1; return true;
    }
    __device__ __forceinline__ void a_ready(const Unit&) const {}
    __device__ __forceinline__ void done(const Unit&) const {}
};
__host__ __device__ __forceinline__ void tail_split(int G, int T, int KT, int& Sp, int& ppair) {
    if (T <= 0) { Sp = 0; ppair = 0; return; }
    int S = G / T; if (S < 1) S = 1; const int pairs = KT >> 1; ppair = (pairs + S - 1) / S; if (ppair < 2) ppair = 2; Sp = (pairs + ppair - 1) / ppair;
}
struct TailOrder {
    StaticOrder so; int T, Sp, ppair; const int* tile_e;
    __device__ __forceinline__ void init(int nMm, int nTm, int nN, int KT, int G_, int c_, const int* te) { so.nM = nMm; so.nN = nN; so.nwg = nMm * nN; so.G = G_; so.c = c_; so.KT = KT; T = nTm * nN; tile_e = te; tail_split(G_, T, KT, Sp, ppair); }
    __device__ __forceinline__ bool next(int i, Unit& u) const {
        const int nm = so.c < so.nwg ? (so.nwg - so.c + so.G - 1) / so.G : 0;
        const int cc = so.G - 1 - so.c;
        int pm, pn, kt0 = 0, nkt = so.KT, part = -1;
        if (i < nm) { Unit t; so.next(i, t); pm = t.pm; pn = t.pn; }
        else if (i == nm && cc < T * Sp) { const int tu = cc / Sp, j = cc - tu * Sp; pm = so.nM + tu / so.nN; pn = tu % so.nN; kt0 = 2 * ppair * j; nkt = (so.KT - kt0) < 2 * ppair ? (so.KT - kt0) : 2 * ppair; part = j; }
        else return false;
        int e = 0; if (tile_e) e = __builtin_amdgcn_readfirstlane(tile_e[pm]);
        u.pm = pm; u.pn = pn; u.pnb = e * so.nN + pn; u.kt0 = kt0; u.nkt = nkt; u.part = part; return true;
    }
    __device__ __forceinline__ void a_ready(const Unit&) const {}
    __device__ __forceinline__ void done(const Unit&) const {}
};

__device__ __forceinline__ unsigned cvt_pk_bf16(float lo, float hi) { unsigned r; asm volatile("v_cvt_pk_bf16_f32 %0, %1, %2" : "=v"(r) : "v"(lo), "v"(hi)); return r; }

struct EpiBf16 {
    static constexpr bool PERM = true, AFTER_DRAIN = false;
    bf16_t* O; int ldc; float scale;
    __device__ __forceinline__ void operator()(const f32x4 (&acc)[2][2][4][2], const Unit& u, int wr, int wc, int fr, int fq) const {
        const int row0 = u.pm * BM + wr * 64 + fr; const int col0 = u.pn * BM + wc * 32 + 8 * fq;
#pragma unroll
        for (int ai = 0; ai < 2; ++ai)
#pragma unroll
            for (int m = 0; m < 4; ++m) { bf16_t* rowp = O + (size_t)(row0 + ai * HALF + m * 16) * ldc + col0;
#pragma unroll
                for (int bj = 0; bj < 2; ++bj) { const f32x4 v0 = acc[ai][bj][m][0] * scale, v1 = acc[ai][bj][m][1] * scale;
                    u32x4 w; w.x = cvt_pk_bf16(v0[0], v0[1]); w.y = cvt_pk_bf16(v0[2], v0[3]); w.z = cvt_pk_bf16(v1[0], v1[1]); w.w = cvt_pk_bf16(v1[2], v1[3]);
                    *(u32x4*)(rowp + bj * HALF) = w; } }
    }
};
struct EpiSlots {
    static constexpr bool PERM = true, AFTER_DRAIN = false;
    bf16_t* QKV; int NG; int kvr;
    __device__ __forceinline__ void operator()(const f32x4 (&acc)[2][2][4][2], const Unit& u, int wr, int wc, int fr, int fq) const {
        const int prow = u.pm * BM; const bool lat = prow < 8192; const int b = lat ? (prow >> 12) : ((prow - 8192) >> 8); const int pos0 = lat ? (prow & 4095) : 4096;
        const int rl0 = wr * 64 + fr;
#pragma unroll
        for (int bj = 0; bj < 2; ++bj) { bf16_t* gbase = QKV + ((size_t)(b * NG + 2 * u.pn + bj) * kvr + pos0 + rl0) * 128 + wc * 32 + 8 * fq;
#pragma unroll
            for (int ai = 0; ai < 2; ++ai)
#pragma unroll
                for (int m = 0; m < 4; ++m) { const f32x4 v0 = acc[ai][bj][m][0], v1 = acc[ai][bj][m][1];
                    u32x4 w; w.x = cvt_pk_bf16(v0[0], v0[1]); w.y = cvt_pk_bf16(v0[2], v0[3]); w.z = cvt_pk_bf16(v1[0], v1[1]); w.w = cvt_pk_bf16(v1[2], v1[3]);
                    *(u32x4*)(gbase + (size_t)(ai * HALF + m * 16) * 128) = w; } }
    }
};
__device__ __forceinline__ float clamp448(float x) { return __builtin_fminf(__builtin_fmaxf(x, -448.f), 448.f); }
__device__ __forceinline__ unsigned pk4_fp8(float a, float b, float c, float d) {
    int w = __builtin_amdgcn_cvt_pk_fp8_f32(clamp448(a), clamp448(b), 0, false); w = __builtin_amdgcn_cvt_pk_fp8_f32(clamp448(c), clamp448(d), w, true); return (unsigned)w; }
__device__ __forceinline__ float silu_mul(float g, float u) { return g * u * __builtin_amdgcn_rcpf(1.0f + __builtin_amdgcn_exp2f(-1.4426950408889634f * g)); }
template <bool OUT8> struct EpiSwigluT {
    static constexpr bool PERM = true, AFTER_DRAIN = false;
    void* O; int ldc; float scale;
    __device__ __forceinline__ void operator()(const f32x4 (&acc)[2][2][4][2], const Unit& u, int wr, int wc, int fr, int fq) const {
        const int row0 = u.pm * BM + wr * 64 + fr; const int col0 = u.pn * HALF + wc * 32 + 8 * fq;
#pragma unroll
        for (int ai = 0; ai < 2; ++ai)
#pragma unroll
            for (int m = 0; m < 4; ++m) { const size_t eo = (size_t)(row0 + ai * HALF + m * 16) * ldc + col0;
                const f32x4 g0 = acc[ai][0][m][0] * scale, g1 = acc[ai][0][m][1] * scale, u0 = acc[ai][1][m][0] * scale, u1 = acc[ai][1][m][1] * scale;
                const float r0 = silu_mul(g0[0], u0[0]), r1 = silu_mul(g0[1], u0[1]), r2 = silu_mul(g0[2], u0[2]), r3 = silu_mul(g0[3], u0[3]);
                const float r4 = silu_mul(g1[0], u1[0]), r5 = silu_mul(g1[1], u1[1]), r6 = silu_mul(g1[2], u1[2]), r7 = silu_mul(g1[3], u1[3]);
                if constexpr (OUT8) { typedef unsigned u32x2 __attribute__((ext_vector_type(2))); u32x2 w; w.x = pk4_fp8(r0, r1, r2, r3); w.y = pk4_fp8(r4, r5, r6, r7); *(u32x2*)((unsigned char*)O + eo) = w; }
                else { u32x4 w; w.x = cvt_pk_bf16(r0, r1); w.y = cvt_pk_bf16(r2, r3); w.z = cvt_pk_bf16(r4, r5); w.w = cvt_pk_bf16(r6, r7); *(u32x4*)((bf16_t*)O + eo) = w; } }
    }
};
typedef EpiSwigluT<false> EpiSwiglu; typedef EpiSwigluT<true> EpiSwiglu8;
struct EpiRes {
    static constexpr bool PERM = false, AFTER_DRAIN = false;
    const float* base_lat; const float* base_ctx; float* out; int ldc; const float* gate; int gate_stride;
    float* part; int part_row0, part_rows; float scale;
    __device__ __forceinline__ void operator()(const f32x4 (&acc)[2][2][4][2], const Unit& u, int wr, int wc, int fr, int fq) const {
        if (u.part >= 0) {
            float* pp = part + ((long)u.part * part_rows + (u.pm * BM - part_row0)) * (long)ldc; const int rl0 = wr * 64 + fr, col0 = u.pn * BM + wc * 32 + 4 * fq;
#pragma unroll
            for (int ai = 0; ai < 2; ++ai)
#pragma unroll
                for (int m = 0; m < 4; ++m) { const size_t ro = (size_t)(rl0 + ai * HALF + m * 16) * ldc;
#pragma unroll
                    for (int bj = 0; bj < 2; ++bj)
#pragma unroll
                        for (int n = 0; n < 2; ++n) *(f32x4*)(pp + ro + col0 + bj * HALF + 16 * n) = acc[ai][bj][m][n] * scale; }
            return;
        }
        const int prow = u.pm * BM; const int cond = prow < 4096 ? 0 : (prow < 8192 ? 1 : 2);
        const float* bp = prow < 8192 ? base_lat + (size_t)prow * ldc : base_ctx + (size_t)(prow - 8192) * ldc;
        float* op = out + (size_t)prow * ldc; const float* gp = gate + (size_t)cond * gate_stride;
        const int rl0 = wr * 64 + fr, col0 = u.pn * BM + wc * 32 + 4 * fq;
        f32x4 gv[2][2];
#pragma unroll
        for (int bj = 0; bj < 2; ++bj)
#pragma unroll
            for (int n = 0; n < 2; ++n) gv[bj][n] = *(const f32x4*)(gp + col0 + bj * HALF + 16 * n) * scale;
#pragma unroll
        for (int ai = 0; ai < 2; ++ai)
#pragma unroll
            for (int m = 0; m < 4; ++m) { const size_t ro = (size_t)(rl0 + ai * HALF + m * 16) * ldc;
#pragma unroll
                for (int bj = 0; bj < 2; ++bj)
#pragma unroll
                    for (int n = 0; n < 2; ++n) { const int col = col0 + bj * HALF + 16 * n; const f32x4 b = *(const f32x4*)(bp + ro + col);
                        *(f32x4*)(op + ro + col) = b + gv[bj][n] * acc[ai][bj][m][n]; } }
    }
};
struct EpiRowScale {
    static constexpr bool PERM = true, AFTER_DRAIN = false;
    bf16_t* out; int ldc; const float* rs; float* part; int part_row0, part_rows; float scale;
    __device__ __forceinline__ void operator()(const f32x4 (&acc)[2][2][4][2], const Unit& u, int wr, int wc, int fr, int fq) const {
        const int row0 = u.pm * BM + wr * 64 + fr, col0 = u.pn * BM + wc * 32 + 8 * fq;
#pragma unroll
        for (int ai = 0; ai < 2; ++ai)
#pragma unroll
            for (int m = 0; m < 4; ++m) { const int row = row0 + ai * HALF + m * 16; const float s = rs[row] * scale;
                if (u.part >= 0) { float* rp = part + ((long)u.part * part_rows - part_row0 + row) * (long)ldc + col0;
#pragma unroll
                    for (int bj = 0; bj < 2; ++bj) { *(f32x4*)(rp + bj * HALF) = acc[ai][bj][m][0] * s; *(f32x4*)(rp + bj * HALF + 4) = acc[ai][bj][m][1] * s; } }
                else { bf16_t* rp = out + (size_t)row * ldc + col0;
#pragma unroll
                    for (int bj = 0; bj < 2; ++bj) { const f32x4 v0 = acc[ai][bj][m][0] * s, v1 = acc[ai][bj][m][1] * s;
                        u32x4 w; w.x = cvt_pk_bf16(v0[0], v0[1]); w.y = cvt_pk_bf16(v0[2], v0[3]); w.z = cvt_pk_bf16(v1[0], v1[1]); w.w = cvt_pk_bf16(v1[2], v1[3]);
                        *(u32x4*)(rp + bj * HALF) = w; } } }
    }
};

typedef int v8i __attribute__((ext_vector_type(8)));
__device__ __forceinline__ v8i cat8(bf16x8 a, bf16x8 b) { struct P { bf16x8 a, b; } p{a, b}; return __builtin_bit_cast(v8i, p); }
template <class Epi, class Sched, bool ALIGN_EPI = false, bool SP2 = false, bool FP8 = false>
__device__ __forceinline__ void gemm_phase(PG8_LAS unsigned char* lds, const Gemm g, const Sched& S, const Epi& E) {
    int tid = threadIdx.x; asm volatile("" : "+v"(tid));
    const int wid = __builtin_amdgcn_readfirstlane(tid >> 6), lane = tid & 63, wr = wid >> 2, wc = wid & 3, fr = lane & 15, fq = lane >> 4;
    const int K = g.K; const int pitch = FP8 ? K : K * 2;
    unsigned voffA[2], voffB[2];
#pragma unroll
    for (int i = 0; i < 2; ++i) { int R, C; stage_rc(tid * 16 + i * 8192, R, C); const int Rb = Epi::PERM ? ((R & ~31) + perm32(R & 31)) : R;
        voffA[i] = (unsigned)(R * pitch + C * 2); voffB[i] = (unsigned)(Rb * pitch + C * 2); }
    const size_t kstep = (size_t)(BK * 2);
    const size_t hstep = (size_t)HALF * pitch;
    const size_t tstep = 2 * hstep;
    const unsigned ldsw = (unsigned)wid * 1024u;
    const int aoff = lds_byte(wr * 64 + fr, fq * 8), boff = lds_byte(wc * 32 + fr, fq * 8);
#define PG8_SA(b, h) (((b) * 2 + (h)) * HTB)
#define PG8_SB(b, h) ((4 + (b) * 2 + (h)) * HTB)
#define PG8_STAGE(bufoff, gbase, voff) do { _Pragma("unroll") for (int _i = 0; _i < 2; ++_i) \
        __builtin_amdgcn_global_load_lds((const unsigned*)((const char*)(gbase) + (voff)[_i]), (PG8_LAS unsigned*)(lds + (bufoff) + ldsw + _i * 8192), 16, 0, 0); } while (0)
#define PG8_LDA(dst, b, h) do { _Pragma("unroll") for (int m = 0; m < 4; ++m) _Pragma("unroll") for (int k = 0; k < 2; ++k) dst[m][k] = *(const PG8_LAS bf16x8*)(lds + PG8_SA(b, h) + aoff + m * 2048 + k * 1024); } while (0)
#define PG8_LDB(dst, b, h) do { _Pragma("unroll") for (int n = 0; n < 2; ++n) _Pragma("unroll") for (int k = 0; k < 2; ++k) dst[n][k] = *(const PG8_LAS bf16x8*)(lds + PG8_SB(b, h) + boff + n * 2048 + k * 1024); } while (0)
#define PG8_MMA(ai, bj, At, Bt) do { __builtin_amdgcn_s_setprio(1); if constexpr (FP8) { _Pragma("unroll") for (int m = 0; m < 4; ++m) _Pragma("unroll") for (int n = 0; n < 2; ++n) \
        asm volatile("v_mfma_f32_16x16x128_f8f6f4 %0, %1, %2, %0" : "+v"(acc[ai][bj][m][n]) : "v"(cat8(Bt[n][0], Bt[n][1])), "v"(cat8(At[m][0], At[m][1]))); } \
      else { _Pragma("unroll") for (int m = 0; m < 4; ++m) _Pragma("unroll") for (int n = 0; n < 2; ++n) _Pragma("unroll") for (int k = 0; k < 2; ++k) \
        acc[ai][bj][m][n] = __builtin_amdgcn_mfma_f32_16x16x32_bf16(Bt[n][k], At[m][k], acc[ai][bj][m][n], 0, 0, 0); } __builtin_amdgcn_s_setprio(0); } while (0)
#define PG8_WAIT_V(n) asm volatile("s_waitcnt vmcnt(" #n ")" ::: "memory")
#define PG8_WAIT_L(n) asm volatile("s_waitcnt lgkmcnt(" #n ")" ::: "memory")
#define PG8_BAR __builtin_amdgcn_s_barrier()
#define PG8_SCHED __builtin_amdgcn_sched_barrier(0)
    Unit cur, nxt; int ui = 0;
    if (!S.next(0, cur)) return;
    f32x4 acc[2][2][4][2];
#pragma unroll
    for (int a = 0; a < 2; ++a)
#pragma unroll
        for (int b = 0; b < 2; ++b)
#pragma unroll
            for (int m = 0; m < 4; ++m)
#pragma unroll
                for (int n = 0; n < 2; ++n) acc[a][b][m][n] = (f32x4){0.f, 0.f, 0.f, 0.f};
    bf16x8 At[4][2], B0[2][2], B1[2][2];
    const char* cA = (const char*)g.A + (size_t)cur.pm * tstep + (size_t)cur.kt0 * kstep; const char* cB = (const char*)g.Bt + (size_t)cur.pnb * tstep + (size_t)cur.kt0 * kstep;
    S.a_ready(cur);
    if constexpr (SP2) {
        PG8_STAGE(PG8_SB(0, 0), cB, voffB); PG8_STAGE(PG8_SB(0, 1), cB + hstep, voffB); PG8_STAGE(PG8_SA(0, 0), cA, voffA); PG8_STAGE(PG8_SA(0, 1), cA + hstep, voffA);
        if (wr == 1) PG8_BAR;
        PG8_WAIT_V(2); PG8_BAR;
        PG8_STAGE(PG8_SB(1, 0), cB + kstep, voffB); PG8_STAGE(PG8_SA(1, 0), cA + kstep, voffA); PG8_STAGE(PG8_SB(1, 1), cB + hstep + kstep, voffB);
        PG8_WAIT_V(6); PG8_BAR;
    } else {
        PG8_STAGE(PG8_SB(0, 0), cB, voffB); PG8_STAGE(PG8_SA(0, 0), cA, voffA); PG8_STAGE(PG8_SB(0, 1), cB + hstep, voffB); PG8_STAGE(PG8_SA(0, 1), cA + hstep, voffA);
        if (wr == 1) PG8_BAR;
        PG8_WAIT_V(4); PG8_BAR;
        PG8_STAGE(PG8_SB(1, 0), cB + kstep, voffB); PG8_STAGE(PG8_SA(1, 0), cA + kstep, voffA); PG8_STAGE(PG8_SB(1, 1), cB + hstep + kstep, voffB);
        PG8_WAIT_V(6); PG8_BAR;
    }
    for (;;) {
        const bool has_next = S.next(ui + 1, nxt);
        const char* nA = has_next ? (const char*)g.A + (size_t)nxt.pm * tstep + (size_t)nxt.kt0 * kstep : cA; const char* nB = has_next ? (const char*)g.Bt + (size_t)nxt.pnb * tstep + (size_t)nxt.kt0 * kstep : cB;
        const int nt = cur.nkt;
        for (int t = 0; t < nt; t += 2) {
            const bool last = (t == nt - 2);
            const char* a1 = cA + (size_t)(t + 1) * kstep;
            const char* a2 = last ? nA : cA + (size_t)(t + 2) * kstep; const char* b2 = last ? nB : cB + (size_t)(t + 2) * kstep;
            const char* a3 = a2 + kstep; const char* b3 = b2 + kstep;
            if (last && has_next) S.a_ready(nxt);
            if constexpr (SP2) {
            PG8_LDB(B0, 0, 0); PG8_LDB(B1, 0, 1); PG8_SCHED; PG8_LDA(At, 0, 0); PG8_STAGE(PG8_SA(1, 1), a1 + hstep, voffA);
            PG8_WAIT_V(8); PG8_WAIT_L(0); PG8_BAR; PG8_MMA(0, 0, At, B0); PG8_MMA(0, 1, At, B1); PG8_BAR; PG8_SCHED;
            PG8_LDA(At, 0, 1); PG8_STAGE(PG8_SB(0, 0), b2, voffB); PG8_STAGE(PG8_SB(0, 1), b2 + hstep, voffB); PG8_STAGE(PG8_SA(0, 0), a2, voffA);
            PG8_WAIT_V(8); PG8_WAIT_L(0); PG8_BAR; PG8_MMA(1, 0, At, B0); PG8_MMA(1, 1, At, B1); PG8_BAR; PG8_SCHED;
            PG8_LDB(B0, 1, 0); PG8_LDB(B1, 1, 1); PG8_SCHED; PG8_LDA(At, 1, 0); PG8_STAGE(PG8_SA(0, 1), a2 + hstep, voffA);
            PG8_WAIT_V(8); PG8_WAIT_L(0); PG8_BAR; PG8_MMA(0, 0, At, B0); PG8_MMA(0, 1, At, B1); PG8_BAR; PG8_SCHED;
            PG8_LDA(At, 1, 1); PG8_STAGE(PG8_SB(1, 0), b3, voffB); PG8_STAGE(PG8_SB(1, 1), b3 + hstep, voffB); PG8_STAGE(PG8_SA(1, 0), a3, voffA);
            PG8_WAIT_V(8); PG8_WAIT_L(0); PG8_BAR; PG8_MMA(1, 0, At, B0); PG8_MMA(1, 1, At, B1); PG8_BAR; PG8_SCHED;
            } else {
            PG8_LDB(B0, 0, 0); PG8_SCHED; PG8_LDA(At, 0, 0); PG8_STAGE(PG8_SA(1, 1), a1 + hstep, voffA);
            PG8_WAIT_L(8); PG8_BAR; PG8_WAIT_L(0); PG8_MMA(0, 0, At, B0); PG8_BAR; PG8_SCHED;
            PG8_LDB(B1, 0, 1); PG8_STAGE(PG8_SB(0, 0), b2, voffB);
            PG8_BAR; PG8_WAIT_L(0); PG8_MMA(0, 1, At, B1); PG8_BAR;
            PG8_LDA(At, 0, 1); PG8_STAGE(PG8_SA(0, 0), a2, voffA);
            PG8_BAR; PG8_WAIT_L(0); PG8_MMA(1, 0, At, B0); PG8_BAR; PG8_SCHED;
            PG8_STAGE(PG8_SB(0, 1), b2 + hstep, voffB);
            PG8_WAIT_V(6); PG8_BAR; PG8_MMA(1, 1, At, B1); PG8_BAR;
            PG8_LDB(B0, 1, 0); PG8_SCHED; PG8_LDA(At, 1, 0); PG8_STAGE(PG8_SA(0, 1), a2 + hstep, voffA);
            PG8_WAIT_L(8); PG8_BAR; PG8_WAIT_L(0); PG8_MMA(0, 0, At, B0); PG8_BAR; PG8_SCHED;
            PG8_LDB(B1, 1, 1); PG8_STAGE(PG8_SB(1, 0), b3, voffB);
            PG8_BAR; PG8_WAIT_L(0); PG8_MMA(0, 1, At, B1); PG8_BAR;
            PG8_LDA(At, 1, 1); PG8_STAGE(PG8_SA(1, 0), a3, voffA);
            PG8_BAR; PG8_WAIT_L(0); PG8_MMA(1, 0, At, B0); PG8_BAR; PG8_SCHED;
            PG8_STAGE(PG8_SB(1, 1), b3 + hstep, voffB);
            PG8_WAIT_V(6); PG8_BAR; PG8_MMA(1, 1, At, B1); PG8_BAR;
            }
        }
        if constexpr (FP8) asm volatile("s_nop 15\n\ts_nop 15" ::: "memory");
        if constexpr (ALIGN_EPI) { if (wr == 0) PG8_BAR; }
        if constexpr (!Epi::AFTER_DRAIN) { E(acc, cur, wr, wc, fr, fq); S.done(cur); }
        if (!has_next) break;
#pragma unroll
        for (int a = 0; a < 2; ++a)
#pragma unroll
            for (int b = 0; b < 2; ++b)
#pragma unroll
                for (int m = 0; m < 4; ++m)
#pragma unroll
                    for (int n = 0; n < 2; ++n) acc[a][b][m][n] = (f32x4){0.f, 0.f, 0.f, 0.f};
        cur = nxt; cA = nA; cB = nB; ++ui;
        if constexpr (ALIGN_EPI) { if (wr == 1) PG8_BAR; }
    }
    PG8_WAIT_V(0);
    if constexpr (!ALIGN_EPI) { if (wr == 0) PG8_BAR; }
    PG8_BAR;
    if constexpr (Epi::AFTER_DRAIN) { E.fused(acc, cur, wr, wc, fr, fq, lds, wid, lane); S.done(cur); }
#undef PG8_SA
#undef PG8_SB
#undef PG8_STAGE
#undef PG8_LDA
#undef PG8_LDB
#undef PG8_MMA
#undef PG8_WAIT_V
#undef PG8_WAIT_L
#undef PG8_BAR
#undef PG8_SCHED
}
}


namespace att {
using bf16 = __hip_bfloat16;
constexpr int   D = 128, NW = 8, QBLK = 32, KVBLK = 64;
constexpr float SCALE = 0.088388347648318440f;
constexpr float THR = 8.f;
constexpr int LDQ = 128, LDK = 128;
constexpr size_t SHM_V = KVBLK * D * 2, SHM_K = KVBLK * D * 2, SHM_ATTN = 2 * SHM_V + 2 * SHM_K + NW * 64 * 4;
using bf16x8 = __attribute__((ext_vector_type(8))) short;
using s16x4  = __attribute__((ext_vector_type(4))) short;
using f32x16 = __attribute__((ext_vector_type(16))) float;
using u32x4  = __attribute__((ext_vector_type(4))) unsigned;
#define KSWZ(row, colB) ((row) * 256 + ((colB) ^ (((row) & 7) << 4)))
#define SBAR() __builtin_amdgcn_sched_barrier(0)
__device__ __forceinline__ int crow(int r, int hi) { return (r & 3) + 8 * (r >> 2) + 4 * hi; }
__device__ __forceinline__ unsigned cvtpk(float lo, float hi) {
  unsigned r; asm volatile("v_cvt_pk_bf16_f32 %0, %1, %2" : "=v"(r) : "v"(lo), "v"(hi)); return r;
}
__device__ __forceinline__ void partialSM(f32x16& p0, f32x16& p1, float& m_reg, float& mn, float& alpha) {
  constexpr float C = SCALE * 1.4426950408889634f;
  float pmax = p0[0];
#pragma unroll
  for (int r = 1; r < 16; ++r) pmax = fmaxf(pmax, p0[r]);
#pragma unroll
  for (int r = 0; r < 16; ++r) pmax = fmaxf(pmax, p1[r]);
  { auto rr = __builtin_amdgcn_permlane32_swap(__float_as_uint(pmax), __float_as_uint(pmax), false, false);
    pmax = fmaxf(__uint_as_float(rr[0]), __uint_as_float(rr[1])); }
  if (__builtin_expect(__all(pmax - m_reg <= THR / SCALE), 1)) { mn = m_reg; alpha = 1.f; }
  else { mn = fmaxf(m_reg, pmax); alpha = __builtin_amdgcn_exp2f((m_reg - mn) * C); m_reg = mn; }
  float mnC = -mn * C;
#pragma unroll
  for (int r = 0; r < 16; ++r) p0[r] = fmaf(p0[r], C, mnC);
#pragma unroll
  for (int r = 0; r < 16; ++r) p1[r] = fmaf(p1[r], C, mnC);
#pragma unroll
  for (int r = 0; r < 16; ++r) p0[r] = __builtin_amdgcn_exp2f(p0[r]);
}
__device__ __forceinline__ void finishSM(f32x16& p0, f32x16& p1, float alpha, float& l_reg, bf16x8& pa0, bf16x8& pa1, bf16x8& pa2, bf16x8& pa3) {
#pragma unroll
  for (int r = 0; r < 16; ++r) p1[r] = __builtin_amdgcn_exp2f(p1[r]);
  float ps = 0;
#pragma unroll
  for (int r = 0; r < 16; ++r) ps += p0[r];
#pragma unroll
  for (int r = 0; r < 16; ++r) ps += p1[r];
  { auto rr = __builtin_amdgcn_permlane32_swap(__float_as_uint(ps), __float_as_uint(ps), false, false);
    ps = __uint_as_float(rr[0]) + __uint_as_float(rr[1]); }
  l_reg = l_reg * alpha + ps;
#define PK4(P, BASE, OUT) do { unsigned a0 = cvtpk(P[BASE + 0], P[BASE + 1]), a1 = cvtpk(P[BASE + 2], P[BASE + 3]);   \
    unsigned b0 = cvtpk(P[BASE + 4], P[BASE + 5]), b1 = cvtpk(P[BASE + 6], P[BASE + 7]);                              \
    auto r0 = __builtin_amdgcn_permlane32_swap(a0, b0, false, false); auto r1 = __builtin_amdgcn_permlane32_swap(a1, b1, false, false); \
    u32x4 w = {r0[0], r1[0], r0[1], r1[1]}; OUT = *reinterpret_cast<bf16x8*>(&w); } while (0)
  PK4(p0, 0, pa0); PK4(p0, 8, pa1); PK4(p1, 0, pa2); PK4(p1, 8, pa3);
#undef PK4
}
__device__ __forceinline__ void qkt(f32x16& p0, f32x16& p1, const bf16* Ks, const bf16x8* qr, int r32, int hi) {
  p0 = f32x16{}; p1 = f32x16{};
#pragma unroll
  for (int d0 = 0; d0 < 8; ++d0) { int cb = (d0 * 16 + hi * 8) * 2;
    bf16x8 b0 = *reinterpret_cast<const bf16x8*>((const char*)Ks + KSWZ(r32, cb));
    bf16x8 b1 = *reinterpret_cast<const bf16x8*>((const char*)Ks + KSWZ(32 + r32, cb));
    p0 = __builtin_amdgcn_mfma_f32_32x32x16_bf16(b0, qr[d0], p0, 0, 0, 0);
    p1 = __builtin_amdgcn_mfma_f32_32x32x16_bf16(b1, qr[d0], p1, 0, 0, 0); }
}
__device__ __forceinline__ void maskt(f32x16& p0, f32x16& p1, int kbase, int qpos, int hi) {
#pragma unroll
  for (int r = 0; r < 16; ++r) { const int d0 = qpos - (kbase + crow(r, hi)); const int d1 = d0 - 32;
    if (d0 > 128 || d0 < -128) p0[r] = -1e30f;
    if (d1 > 128 || d1 < -128) p1[r] = -1e30f; }
}
__device__ __forceinline__ int v_st(int k, int c) { const int kk = (k & ~0xC) | ((k & 4) << 1) | ((k & 8) >> 1); return ((kk >> 3) * 4 + (c >> 5)) * 512 + ((kk & 7) * 32 + (c & 31)) * 2; }
__device__ __forceinline__ int v_rd_base(int lane) { return ((lane & 3) << 3) | (((lane >> 2) & 3) << 6) | (((lane >> 4) & 1) << 5) | (((lane >> 5) & 1) << 8); }
constexpr int v_rd_off(int d0, int ks, int half) { return d0 * 512 + ks * 4096 + half * 2048; }
template <int OFF> __device__ __forceinline__ s16x4 tr_read(int vb) {
  s16x4 r; asm volatile("ds_read_b64_tr_b16 %0, %1 offset:%2" : "=&v"(r) : "v"(vb), "i"(OFF) : "memory"); return r;
}
template <int D0> __device__ __forceinline__ void pv_one(f32x16& od, int vb, bf16x8 pa0, bf16x8 pa1, bf16x8 pa2, bf16x8 pa3) {
  const s16x4 l0 = tr_read<v_rd_off(D0, 0, 0)>(vb), h0 = tr_read<v_rd_off(D0, 0, 1)>(vb), l1 = tr_read<v_rd_off(D0, 1, 0)>(vb), h1 = tr_read<v_rd_off(D0, 1, 1)>(vb);
  const s16x4 l2 = tr_read<v_rd_off(D0, 2, 0)>(vb), h2 = tr_read<v_rd_off(D0, 2, 1)>(vb), l3 = tr_read<v_rd_off(D0, 3, 0)>(vb), h3 = tr_read<v_rd_off(D0, 3, 1)>(vb);
  asm volatile("s_waitcnt lgkmcnt(0)" ::: "memory"); SBAR();
#define PK(L, H) (bf16x8){L[0], L[1], L[2], L[3], H[0], H[1], H[2], H[3]}
  od = __builtin_amdgcn_mfma_f32_32x32x16_bf16(pa0, PK(l0, h0), od, 0, 0, 0);
  od = __builtin_amdgcn_mfma_f32_32x32x16_bf16(pa1, PK(l1, h1), od, 0, 0, 0);
  od = __builtin_amdgcn_mfma_f32_32x32x16_bf16(pa2, PK(l2, h2), od, 0, 0, 0);
  od = __builtin_amdgcn_mfma_f32_32x32x16_bf16(pa3, PK(l3, h3), od, 0, 0, 0);
#undef PK
}
__device__ __forceinline__ void pv_d0(f32x16* o, int vb, bf16x8 pa0, bf16x8 pa1, bf16x8 pa2, bf16x8 pa3) {
  pv_one<0>(o[0], vb, pa0, pa1, pa2, pa3); pv_one<1>(o[1], vb, pa0, pa1, pa2, pa3); pv_one<2>(o[2], vb, pa0, pa1, pa2, pa3); pv_one<3>(o[3], vb, pa0, pa1, pa2, pa3);
}

template <bool MASK, bool OUT_BF16>
__device__ __forceinline__ void attn_unit(const bf16* __restrict__ Qb, const bf16* __restrict__ Kh, const bf16* __restrict__ Vh, void* __restrict__ Ob, int ldo,
                                          int klo, int nt1, int NT, int qpos0, float m_init, float l_init, char* lds, const float* __restrict__ qgain, bool qrope, const float* cs) {
  int tid = threadIdx.x; asm volatile("" : "+v"(tid));
  const int wid = tid >> 6, lane = tid & 63, r32 = lane & 31, hi = lane >> 5;
  bf16* V_lds = (bf16*)lds; bf16* K_lds = (bf16*)(lds + 2 * SHM_V);
  float* ws = (float*)(lds + 2 * SHM_V + 2 * SHM_K) + wid * 64; float* li_l = ws; float* al_l = ws + 32;
  float m_reg = m_init, l_reg = l_init; f32x16 o[4] = {}; bf16x8 qr[8];
  const bf16* Qw = Qb + (long)(wid * QBLK + r32) * LDQ + hi * 8;
#pragma unroll
  for (int d0 = 0; d0 < 8; ++d0) qr[d0] = *reinterpret_cast<const bf16x8*>(Qw + d0 * 16);
  const int qpos = qpos0 + wid * QBLK + r32;
  {
    float f[8][8]; float ss = 0.f;
#pragma unroll
    for (int d0 = 0; d0 < 8; ++d0)
#pragma unroll
      for (int j = 0; j < 8; ++j) { const unsigned short h = (unsigned short)qr[d0][j]; f[d0][j] = __uint_as_float((unsigned)h << 16); ss += f[d0][j] * f[d0][j]; }
    ss += __shfl_xor(ss, 32);
    const float rs = 1.0f / sqrtf(ss * (1.f / 128.f) + 1e-6f);
#pragma unroll
    for (int d0 = 0; d0 < 8; ++d0)
#pragma unroll
      for (int j = 0; j < 8; ++j) f[d0][j] *= rs * qgain[d0 * 16 + hi * 8 + j];
    if (qrope) {
      const int prow = qpos >> 6, pcol = qpos & 63;
#pragma unroll
      for (int dd = 0; dd < 4; ++dd) { const int d0 = (dd & 1) + 4 * (dd >> 1); const int p = (dd >> 1) ? pcol : prow;
#pragma unroll
        for (int j = 0; j < 8; ++j) { const int i = (d0 & 1) * 16 + hi * 8 + j; const float c = cs[(p * 32 + i) * 2], s = cs[(p * 32 + i) * 2 + 1];
          const float x1 = f[d0][j], x2 = f[d0 + 2][j]; f[d0][j] = x1 * c - x2 * s; f[d0 + 2][j] = x2 * c + x1 * s; } }
    }
#pragma unroll
    for (int d0 = 0; d0 < 8; ++d0) { u32x4 w = {cvtpk(f[d0][0], f[d0][1]), cvtpk(f[d0][2], f[d0][3]), cvtpk(f[d0][4], f[d0][5]), cvtpk(f[d0][6], f[d0][7])}; qr[d0] = *reinterpret_cast<bf16x8*>(&w); }
  }
  const int sr = tid >> 4, sc = (tid & 15) * 8, vst0 = v_st(sr, sc), vst1 = v_st(32 + sr, sc);
  const int vb0 = (int)(uintptr_t)V_lds + v_rd_base(lane);
  struct { bf16x8 vs0, vs1, ks0, ks1; } sr_[2];
#define KROW(t) ((t) < nt1 ? klo + (t) * KVBLK : 4096 + ((t) - nt1) * KVBLK)
#define SLOAD(i, t) do { const int k0_ = KROW(t); sr_[i].vs0 = *reinterpret_cast<const bf16x8*>(&Vh[(long)(k0_ + sr) * LDK + sc]); sr_[i].vs1 = *reinterpret_cast<const bf16x8*>(&Vh[(long)(k0_ + 32 + sr) * LDK + sc]); \
    sr_[i].ks0 = *reinterpret_cast<const bf16x8*>(&Kh[(long)(k0_ + sr) * LDK + sc]); sr_[i].ks1 = *reinterpret_cast<const bf16x8*>(&Kh[(long)(k0_ + 32 + sr) * LDK + sc]); } while (0)
#define SWRITE(b, i) do { *(bf16x8*)((char*)V_lds + (b) * SHM_V + vst0) = sr_[i].vs0;          \
    *(bf16x8*)((char*)V_lds + (b) * SHM_V + vst1) = sr_[i].vs1; int kc = sc * 2;               \
    *(bf16x8*)((char*)K_lds + (b) * SHM_K + KSWZ(sr, kc)) = sr_[i].ks0;                       \
    *(bf16x8*)((char*)K_lds + (b) * SHM_K + KSWZ(32 + sr, kc)) = sr_[i].ks1; } while (0)
#define SWAIT() asm volatile("s_waitcnt vmcnt(4)" ::: "memory")
#define RESC(a) do { if (__any((a) < 1.f)) { if (hi == 0) al_l[r32] = (a); asm volatile("s_waitcnt lgkmcnt(0)" ::: "memory"); \
    _Pragma("unroll") for (int d = 0; d < 4; ++d) _Pragma("unroll") for (int r = 0; r < 16; ++r) o[d][r] *= al_l[crow(r, hi)]; } } while (0)
#define MASKT(P0, P1, t) do { if (MASK) { if ((t) < nt1) maskt(P0, P1, klo + (t) * KVBLK, qpos, hi); } } while (0)
  f32x16 pA0, pA1, pB0, pB1; float mnA, mnB, alA, alB; bf16x8 pa0, pa1, pa2, pa3;
  constexpr int SE = 0, SO = 1;
  SLOAD(SE, 0); asm volatile("s_waitcnt vmcnt(0)" ::: "memory"); SWRITE(0, SE); __syncthreads();
  qkt(pA0, pA1, K_lds, qr, r32, hi); MASKT(pA0, pA1, 0); partialSM(pA0, pA1, m_reg, mnA, alA);
  SLOAD(SO, 1); if (2 < NT) SLOAD(SE, 2);
  SWAIT(); SWRITE(1, SO); __syncthreads();
  for (int j = 1; j + 1 < NT; j += 2) {
    SBAR(); qkt(pB0, pB1, (bf16*)((char*)K_lds + SHM_K), qr, r32, hi);
    finishSM(pA0, pA1, alA, l_reg, pa0, pa1, pa2, pa3); SBAR();
    SLOAD(SO, j + 2); SBAR();
    pv_d0(o, vb0, pa0, pa1, pa2, pa3); MASKT(pB0, pB1, j); partialSM(pB0, pB1, m_reg, mnB, alB);
    __syncthreads(); SWAIT(); SWRITE(0, SE);
    RESC(alB); __syncthreads();
    SBAR(); qkt(pA0, pA1, K_lds, qr, r32, hi);
    finishSM(pB0, pB1, alB, l_reg, pa0, pa1, pa2, pa3); SBAR();
    if (j + 3 < NT) SLOAD(SE, j + 3); SBAR();
    pv_d0(o, vb0 + (int)SHM_V, pa0, pa1, pa2, pa3); MASKT(pA0, pA1, j + 1); partialSM(pA0, pA1, m_reg, mnA, alA);
    __syncthreads(); SWAIT(); SWRITE(1, SO);
    RESC(alA); __syncthreads();
  }
  SBAR(); qkt(pB0, pB1, (bf16*)((char*)K_lds + SHM_K), qr, r32, hi);
  finishSM(pA0, pA1, alA, l_reg, pa0, pa1, pa2, pa3); SBAR();
  pv_d0(o, vb0, pa0, pa1, pa2, pa3); MASKT(pB0, pB1, NT - 1); partialSM(pB0, pB1, m_reg, mnB, alB);
  __syncthreads(); RESC(alB);
  finishSM(pB0, pB1, alB, l_reg, pa0, pa1, pa2, pa3); SBAR();
  pv_d0(o, vb0 + (int)SHM_V, pa0, pa1, pa2, pa3);
  if (hi == 0) li_l[r32] = l_reg; asm volatile("s_waitcnt lgkmcnt(0)" ::: "memory");
  float rli[16];
#pragma unroll
  for (int r = 0; r < 16; ++r) rli[r] = __builtin_amdgcn_rcpf(li_l[crow(r, hi)]);
  if constexpr (OUT_BF16) {
    bf16* Ow = (bf16*)Ob + (long)(wid * QBLK) * ldo;
#pragma unroll
    for (int r = 0; r < 16; ++r) { int orow = crow(r, hi);
#pragma unroll
      for (int d0 = 0; d0 < 4; ++d0) { const float ov = o[d0][r] * rli[r]; ((unsigned short*)Ow)[(long)orow * ldo + d0 * 32 + r32] = (unsigned short)cvtpk(ov, ov); } }
  } else {
    float* Ow = (float*)Ob + (long)(wid * QBLK) * ldo;
#pragma unroll
    for (int r = 0; r < 16; ++r) { int orow = crow(r, hi);
#pragma unroll
      for (int d0 = 0; d0 < 4; ++d0) Ow[(long)orow * ldo + d0 * 32 + r32] = o[d0][r] * rli[r]; }
  }
  __syncthreads();
#undef KROW
#undef SLOAD
#undef SWRITE
#undef SWAIT
#undef RESC
#undef MASKT
}
#undef KSWZ
#undef SBAR
}

constexpr int NWAVES = 8;
constexpr int D = 2048, NB = 2, SEQ = 4096, CTXL = 256;
constexpr int TL = NB * SEQ, TC = NB * CTXL, MR = TL + TC;
constexpr int KVR = SEQ + CTXL;
constexpr int EVEN_IN = 4608, ODD_IN = 3072, DFF = 5632, DFE = 7168, NE = 8, MODW = 6 * D;
constexpr int NSLOT0 = 36, NSLOT1 = 24;
constexpr int MAXT = 72, XROWS = MAXT * 256;
constexpr float EPS = 1e-6f;
constexpr float LAM_INIT = 0.2f;

constexpr size_t MiB = 1u << 20;
constexpr size_t WS_CTL = 0, CTL_ZERO_BYTES = 1 * MiB;
constexpr size_t WS_MODS = 1 * MiB;
constexpr size_t WS_LAM = WS_MODS + 512 * 1024;
constexpr size_t WS_ROUTE = 2 * MiB;
constexpr size_t RT_EID = WS_ROUTE, RT_GATE = WS_ROUTE + 64 * 1024, RT_POS = WS_ROUTE + 128 * 1024, RT_ROWTOK = WS_ROUTE + 192 * 1024, RT_ROWGATE = WS_ROUTE + 272 * 1024,
                 RT_TILE_E = WS_ROUTE + 352 * 1024, RT_NTILES = WS_ROUTE + 353 * 1024;
constexpr size_t WS_WT_EIN = 4 * MiB, WS_WT_EOUT = 22 * MiB, WS_WT_EF1 = 30 * MiB, WS_WT_EF2 = 74 * MiB, WS_WT_OIN = 96 * MiB, WS_WT_OOUT = 108 * MiB,
                 WS_WT_X1 = 116 * MiB, WS_WT_X2 = 564 * MiB;
constexpr size_t WS_H = 788 * MiB, WS_Z = 822 * MiB, WS_QKV = 900 * MiB, WS_PB = 978 * MiB, WS_OALL = 1046 * MiB, WS_X1 = 1080 * MiB, WS_X3 = 1148 * MiB,
                 WS_ACT = 1212 * MiB, WS_XS = 1306 * MiB, WS_ACT2 = 1378 * MiB, WS_YS = 1630 * MiB, WS_PART = 1774 * MiB, WS_END = 1838 * MiB;
static_assert(WS_WT_EIN + (size_t)EVEN_IN * D * 2 <= WS_WT_EOUT && WS_WT_EF1 + (size_t)2 * DFF * D * 2 <= WS_WT_EF2 && WS_WT_EF2 + (size_t)D * DFF * 2 <= WS_WT_OIN &&
              WS_WT_OIN + (size_t)ODD_IN * D * 2 <= WS_WT_OOUT && WS_WT_X1 + (size_t)NE * 2 * DFE * D * 2 <= WS_WT_X2 && WS_WT_X2 + (size_t)NE * D * DFE * 2 <= WS_H &&
              WS_H + (size_t)MR * D * 2 <= WS_Z && WS_Z + (size_t)MR * EVEN_IN * 2 <= WS_QKV && WS_QKV + (size_t)NB * NSLOT0 * KVR * 128 * 2 <= WS_PB &&
              WS_PB + (size_t)NB * 16 * KVR * 128 * 4 <= WS_OALL && WS_OALL + (size_t)MR * D * 2 <= WS_X1 && WS_X1 + (size_t)MR * D * 4 <= WS_X3 && WS_X3 + (size_t)TL * D * 4 <= WS_ACT &&
              WS_ACT + (size_t)MR * DFF * 2 <= WS_XS && WS_XS + (size_t)XROWS * D * 2 <= WS_ACT2 && WS_ACT2 + (size_t)XROWS * DFE * 2 <= WS_YS && WS_YS + (size_t)XROWS * D * 4 <= WS_PART && WS_PART + 64 * MiB <= WS_END, "d_ws map");
constexpr int CW_BAR = 4096;

constexpr int RING_BYTES = 131072;
constexpr int LDSCTL_OFF = 143360, MISC_OFF = LDSCTL_OFF + 320;
constexpr int LDS_BYTES = 147456;

#define GAS __attribute__((address_space(1)))
#define LAS __attribute__((address_space(3)))
typedef unsigned short bf16;
typedef unsigned v4u __attribute__((ext_vector_type(4)));
typedef unsigned v2u __attribute__((ext_vector_type(2)));
typedef float f32x4 __attribute__((ext_vector_type(4)));
typedef GAS unsigned gu32;
#define RLX_AGENT __ATOMIC_RELAXED, __HIP_MEMORY_SCOPE_AGENT
#define LDS_WAIT() asm volatile("s_waitcnt lgkmcnt(0)" ::: "memory")
#define VM_WAIT() asm volatile("s_waitcnt vmcnt(0)" ::: "memory")
__device__ __forceinline__ unsigned f2bf(float f) { unsigned u = __builtin_bit_cast(unsigned, f); return (u + 0x7fffu + ((u >> 16) & 1u)) >> 16; }
__device__ __forceinline__ unsigned pk2(float lo, float hi) { return f2bf(lo) | (f2bf(hi) << 16); }
using pg8::pk4_fp8;
constexpr float W8_SCALE = 64.f;
__device__ __forceinline__ float bflo(unsigned w) { return __builtin_bit_cast(float, w << 16); }
__device__ __forceinline__ float bfhi(unsigned w) { return __builtin_bit_cast(float, w & 0xffff0000u); }
__device__ __forceinline__ float wave_sum(float v) {
#pragma unroll
    for (int o = 1; o < 64; o <<= 1) v += __shfl_xor(v, o);
    return v;
}

#define XB_TMO      128
#define XB_XCNT(j)  (256  + 64 * (j))
#define XB_XSUB(j)  (1280 + 64 * (j))
#define XB_XGEN(j)  (2304 + 64 * (j))
#define XB_TOP      3328
#define XB_TOPGEN   3392
#define XCD_BAR_WORDS 3456
#define XB_SPIN_CAP (1u << 18)

__device__ __forceinline__ unsigned xb_ld(unsigned* p)              { return __hip_atomic_load(p, __ATOMIC_RELAXED, __HIP_MEMORY_SCOPE_AGENT); }
__device__ __forceinline__ unsigned xb_add(unsigned* p, unsigned v) { return __hip_atomic_fetch_add(p, v, __ATOMIC_RELAXED, __HIP_MEMORY_SCOPE_AGENT); }
__device__ __forceinline__ unsigned xb_xcc_id() { return (unsigned)__builtin_amdgcn_s_getreg((3 << 11) | 20) & 0xFu; }
#define XB_SPIN(cond, bar) do { unsigned _sp = 0; while (cond) { __builtin_amdgcn_s_sleep(1); \
    if ((++_sp & 255u) == 0u) { if (xb_ld(&(bar)[XB_TMO])) break; if (_sp > XB_SPIN_CAP) { atomicAdd(&(bar)[XB_TMO], 1u); break; } } } } while (0)

struct XcdBarrier {
    unsigned* bar; unsigned x;
    volatile LAS unsigned* st;
};

__device__ __forceinline__ XcdBarrier xcd_barrier_post(unsigned* bar, volatile LAS unsigned* st) {
    XcdBarrier b; b.bar = bar; b.x = xb_xcc_id(); b.st = st;
    if (threadIdx.x == 0) (void)xb_add(&bar[XB_XCNT(b.x)], 1u);
    return b;
}
__device__ __forceinline__ void xcd_barrier_complete(unsigned* bar, unsigned x, unsigned& nloc, unsigned& nx) {
    const unsigned G = gridDim.x * gridDim.y * gridDim.z;
    unsigned sum, cnt, mine, sp = 0u;
    for (;;) {
        sum = 0u; cnt = 0u; mine = 0u;
#pragma unroll
        for (unsigned j = 0; j < 16; ++j) { const unsigned c = xb_ld(&bar[XB_XCNT(j)]); sum += c; cnt += (c > 0u) ? 1u : 0u; mine = (j == x) ? c : mine; }
        if (sum == G) break;
        __builtin_amdgcn_s_sleep(1);
        if ((++sp & 255u) == 0u) { if (xb_ld(&bar[XB_TMO])) break; if (sp > XB_SPIN_CAP) { atomicAdd(&bar[XB_TMO], 1u); break; } }
    }
    nloc = mine > 0u ? mine : 1u; nx = cnt > 0u ? cnt : 1u;
}

__device__ __forceinline__ void xcd_barrier(const XcdBarrier& b) {
    asm volatile("s_waitcnt vmcnt(0)" ::: "memory");
    __syncthreads();
    if (threadIdx.x == 0) {
        unsigned* bar = b.bar;
        __builtin_amdgcn_s_waitcnt(0);
        unsigned nloc = b.st[0], nx = b.st[1];
        if (nloc == 0u) { xcd_barrier_complete(bar, b.x, nloc, nx); b.st[0] = nloc; b.st[1] = nx; }
        const unsigned old = xb_add(&bar[XB_XSUB(b.x)], 1u);
        const unsigned gen = old / nloc;
        if (old + 1u == (gen + 1u) * nloc) {
            __builtin_amdgcn_fence(__ATOMIC_RELEASE, "agent");
            asm volatile("s_waitcnt vmcnt(0)" ::: "memory");
            const unsigned og = xb_add(&bar[XB_TOP], 1u);
            const unsigned tg = og / nx;
            if (og + 1u == (tg + 1u) * nx) xb_add(&bar[XB_TOPGEN], 1u);
            else XB_SPIN(xb_ld(&bar[XB_TOPGEN]) == tg, bar);
            __builtin_amdgcn_fence(__ATOMIC_ACQUIRE, "agent");
            xb_add(&bar[XB_XGEN(b.x)], 1u);
            asm volatile("s_waitcnt vmcnt(0)" ::: "memory");
        } else {
            XB_SPIN(xb_ld(&bar[XB_XGEN(b.x)]) == gen, bar);
            __builtin_amdgcn_fence(__ATOMIC_ACQUIRE, "agent");
            asm volatile("s_waitcnt vmcnt(0)" ::: "memory");
        }
    }
    __syncthreads();
}


struct Ctx {
    LAS unsigned char* lds; int tid, lane, wave, G, c, gw, NGW;
};

__device__ __forceinline__ void transpose_item(const float* __restrict__ W, int K, int N, bf16* __restrict__ WT, int q, int kind, LAS float* scr, int lane) {
    const int nblk = N >> 6, kb = q / nblk, nb = q - kb * nblk, k0 = kb * 64, n0 = nb * 64;
    int dest0 = n0;
    if (kind) { const int hf = N >> 1; const int j = n0 < hf ? n0 : n0 - hf; dest0 = (j >> 7) * 256 + (j & 127) + (n0 < hf ? 0 : 128); }
    const int l16 = lane & 15, kq = lane >> 4;
    f32x4 v[16];
#pragma unroll
    for (int i = 0; i < 16; ++i) v[i] = __builtin_nontemporal_load((const f32x4*)(W + (size_t)(k0 + 4 * i + kq) * N + n0 + 4 * l16));
#pragma unroll
    for (int i = 0; i < 16; ++i) { LAS float* p = scr + (4 * i + kq) * 65 + 4 * l16; p[0] = v[i].x; p[1] = v[i].y; p[2] = v[i].z; p[3] = v[i].w; }
    LDS_WAIT(); asm volatile("" ::: "memory");
    const int c = lane & 7, nn = lane >> 3;
#pragma unroll
    for (int jj = 0; jj < 8; ++jj) { const int n = nn + 8 * jj; const LAS float* s = scr + (8 * c) * 65 + n;
        v4u o; o.x = pk2(s[0 * 65], s[1 * 65]); o.y = pk2(s[2 * 65], s[3 * 65]); o.z = pk2(s[4 * 65], s[5 * 65]); o.w = pk2(s[6 * 65], s[7 * 65]);
        *(v4u*)(WT + (size_t)(dest0 + n) * K + k0 + 8 * c) = o; }
    LDS_WAIT(); asm volatile("" ::: "memory");
}

__device__ __forceinline__ void transpose_item8(const float* __restrict__ W, int K, int N, unsigned char* __restrict__ WT, int q, int kind, LAS float* scr, int lane) {
    const int nblk = N >> 5, kb = q / nblk, nb = q - kb * nblk, k0 = kb * 128, n0 = nb * 32;
    int dest0 = n0;
    if (kind) { const int hf = N >> 1; const int j = n0 < hf ? n0 : n0 - hf; dest0 = (j >> 7) * 256 + (j & 127) + (n0 < hf ? 0 : 128); }
    const int l8 = lane & 7, kq = lane >> 3;
    f32x4 v[16];
#pragma unroll
    for (int i = 0; i < 16; ++i) v[i] = __builtin_nontemporal_load((const f32x4*)(W + (size_t)(k0 + 8 * i + kq) * N + n0 + 4 * l8));
#pragma unroll
    for (int i = 0; i < 16; ++i) { LAS float* p = scr + (8 * i + kq) * 33 + 4 * l8; p[0] = v[i].x; p[1] = v[i].y; p[2] = v[i].z; p[3] = v[i].w; }
    LDS_WAIT(); asm volatile("" ::: "memory");
    const int c = lane & 7, nn = lane >> 3;
#pragma unroll
    for (int jj = 0; jj < 4; ++jj) { const int n = nn + 8 * jj; const LAS float* s = scr + (16 * c) * 33 + n;
        v4u o; o.x = pk4_fp8(s[0 * 33] * W8_SCALE, s[1 * 33] * W8_SCALE, s[2 * 33] * W8_SCALE, s[3 * 33] * W8_SCALE); o.y = pk4_fp8(s[4 * 33] * W8_SCALE, s[5 * 33] * W8_SCALE, s[6 * 33] * W8_SCALE, s[7 * 33] * W8_SCALE);
        o.z = pk4_fp8(s[8 * 33] * W8_SCALE, s[9 * 33] * W8_SCALE, s[10 * 33] * W8_SCALE, s[11 * 33] * W8_SCALE); o.w = pk4_fp8(s[12 * 33] * W8_SCALE, s[13 * 33] * W8_SCALE, s[14 * 33] * W8_SCALE, s[15 * 33] * W8_SCALE);
        *(v4u*)(WT + (size_t)(dest0 + n) * K + k0 + 16 * c) = o; }
    LDS_WAIT(); asm volatile("" ::: "memory");
}

constexpr int MOD_TASKS = 2 * (MODW / 32);
__device__ __forceinline__ void mod_fill_silu(const Ctx& X, const float* cvec, const float* cctx) {
    LAS float* S = (LAS float*)X.lds;
    for (int idx = X.tid; idx < 3 * 2048; idx += NWAVES * 64) { const int i = idx >> 11, k = idx & 2047; const float cv = i < 2 ? cvec[i * 2048 + k] : cctx[k]; S[idx] = cv / (1.f + expf(-cv)); }
    __syncthreads();
}
__device__ __forceinline__ void mod_task(const Ctx& X, int task, const float* Wm, const float* bm, float* mods_l) {
    const int ch = task % (MODW / 32);
    LAS float* S = (LAS float*)X.lds;
    LAS float* R = S + 3 * 2048;
    const int kq = X.lane >> 3, c4 = X.lane & 7;
    f32x4 a0 = {0.f, 0.f, 0.f, 0.f}, a1 = a0, a2 = a0;
    const float* wp = Wm + (size_t)(X.wave * 256 + kq) * MODW + ch * 32 + 4 * c4;
    for (int k = 0; k < 256; k += 64) {
        f32x4 w[8];
#pragma unroll
        for (int u = 0; u < 8; ++u) w[u] = __builtin_nontemporal_load((const f32x4*)(wp + (size_t)(k + 8 * u) * MODW));
#pragma unroll
        for (int u = 0; u < 8; ++u) { const int kk = X.wave * 256 + k + 8 * u + kq; a0 += w[u] * S[kk]; a1 += w[u] * S[2048 + kk]; a2 += w[u] * S[4096 + kk]; }
    }
#pragma unroll
    for (int j = 0; j < 4; ++j) {
#pragma unroll
        for (int o = 8; o < 64; o <<= 1) { a0[j] += __shfl_xor(a0[j], o); a1[j] += __shfl_xor(a1[j], o); a2[j] += __shfl_xor(a2[j], o); } }
    if (kq == 0) {
#pragma unroll
        for (int j = 0; j < 4; ++j) { R[(X.wave * 3 + 0) * 32 + 4 * c4 + j] = a0[j]; R[(X.wave * 3 + 1) * 32 + 4 * c4 + j] = a1[j]; R[(X.wave * 3 + 2) * 32 + 4 * c4 + j] = a2[j]; } }
    __syncthreads();
    if (X.tid < 96) { const int i = X.tid >> 5, col = X.tid & 31; float s = 0.f;
#pragma unroll
        for (int w = 0; w < 8; ++w) s += R[(w * 3 + i) * 32 + col];
        mods_l[(size_t)i * MODW + ch * 32 + col] = s + bm[ch * 32 + col]; }
    __syncthreads();
}

template <bool ROUTER, bool PSUM = false, bool OUT8 = false>
__device__ __forceinline__ void norm_mod_rows(const Ctx& X, const float* src_lat, const float* src_ctx, int nrows, const float* gain, const float* mods_l, int sh_i, int sc_i, bf16* H,
                                              const float* wrouter, int* eid, float* egate, const float* part = nullptr, int Sp = 0, const float* pgate = nullptr, float* wb = nullptr) {
    LAS float* WR = (LAS float*)X.lds;
    if (ROUTER) { for (int idx = X.tid; idx < 8 * 2048; idx += NWAVES * 64) { const int k = idx >> 3, e = idx & 7; WR[e * 2048 + k] = wrouter[idx]; } __syncthreads(); }
    f32x4 vn[8];
    if (X.gw < nrows) { const float* xr = X.gw < TL ? src_lat + (size_t)X.gw * D : src_ctx + (size_t)(X.gw - TL) * D;
#pragma unroll
        for (int j = 0; j < 8; ++j) vn[j] = *(const f32x4*)(xr + 4 * X.lane + 256 * j); }
    for (int row = X.gw; row < nrows; row += X.NGW) {
        const int cond = row < SEQ ? 0 : (row < TL ? 1 : 2);
        const float* shp = mods_l + (size_t)cond * MODW + sh_i * D; const float* scp = mods_l + (size_t)cond * MODW + sc_i * D;
        f32x4 v[8]; float ss = 0.f;
#pragma unroll
        for (int j = 0; j < 8; ++j) v[j] = vn[j];
        { const int nr = row + X.NGW; if (nr < nrows) { const float* xr = nr < TL ? src_lat + (size_t)nr * D : src_ctx + (size_t)(nr - TL) * D;
#pragma unroll
            for (int j = 0; j < 8; ++j) vn[j] = *(const f32x4*)(xr + 4 * X.lane + 256 * j); } }
        if (PSUM) { if (row >= TL) {
            f32x4 a[8];
#pragma unroll
            for (int j = 0; j < 8; ++j) a[j] = (f32x4){0.f, 0.f, 0.f, 0.f};
            for (int p = 0; p < Sp; ++p) { const float* pr = part + ((size_t)p * TC + (row - TL)) * D + 4 * X.lane;
#pragma unroll
                for (int j = 0; j < 8; ++j) a[j] += *(const f32x4*)(pr + 256 * j); }
#pragma unroll
            for (int j = 0; j < 8; ++j) { v[j] += a[j] * *(const f32x4*)(pgate + 4 * X.lane + 256 * j); if (wb) *(f32x4*)(wb + (size_t)(row - TL) * D + 4 * X.lane + 256 * j) = v[j]; }
        } }
#pragma unroll
        for (int j = 0; j < 8; ++j) ss += (v[j].x * v[j].x + v[j].y * v[j].y) + (v[j].z * v[j].z + v[j].w * v[j].w);
        const float rstd = 1.0f / sqrtf(wave_sum(ss) * (1.f / D) + EPS);
#pragma unroll
        for (int j = 0; j < 8; ++j) { const int col = 4 * X.lane + 256 * j; const f32x4 g = *(const f32x4*)(gain + col), sc = *(const f32x4*)(scp + col), sh = *(const f32x4*)(shp + col);
            v[j] = (v[j] * rstd * g) * (sc + 1.0f) + sh;
            if (OUT8) { *(unsigned*)((unsigned char*)H + (size_t)row * D + col) = pk4_fp8(v[j].x, v[j].y, v[j].z, v[j].w); }
            else { v2u o; o.x = pk2(v[j].x, v[j].y); o.y = pk2(v[j].z, v[j].w); *(v2u*)(H + (size_t)row * D + col) = o; } }
        if (ROUTER) {
            float v1 = -3.0e38f, v2 = -3.0e38f; int i1 = 0, i2 = 0;
#pragma unroll 1
            for (int e = 0; e < 8; ++e) { float a = 0.f;
#pragma unroll
                for (int j = 0; j < 8; ++j) { const f32x4 w = *(const LAS f32x4*)(WR + e * 2048 + 4 * X.lane + 256 * j); a += (v[j].x * w.x + v[j].y * w.y) + (v[j].z * w.z + v[j].w * w.w); }
                const float s = wave_sum(a);
                if (s > v1) { v2 = v1; i2 = i1; v1 = s; i1 = e; } else if (s > v2) { v2 = s; i2 = e; } }
            const float ex = expf(v2 - v1), g1 = 1.f / (1.f + ex), g2 = ex / (1.f + ex);
            if (X.lane == 0) { eid[row * 2] = i1; eid[row * 2 + 1] = i2; egate[row * 2] = g1; egate[row * 2 + 1] = g2; }
        }
    }
}

template <int NG>
__device__ __forceinline__ void qkv_post(const Ctx& X, const bf16* z, bf16* QKV, const float* qn_a, const float* kn_a, const float* qn_b, const float* kn_b) {
    typedef float f32x2 __attribute__((ext_vector_type(2)));
    LAS f32x2* CS = (LAS f32x2*)X.lds;
    for (int idx = X.tid; idx < 2048; idx += NWAVES * 64) { const int p = idx >> 5, i = idx & 31; const float inv = exp2f(-(float)i * (13.287712379549449f / 32.0f)); const float a = (float)p * inv;
        float sn, cs; sincosf(a, &sn, &cs); CS[idx] = (f32x2){cs, sn}; }
    __syncthreads();
    const int l16 = X.lane & 15, gq = X.lane >> 4, chunk = l16 >> 2;
    v4u rawn = {0u, 0u, 0u, 0u};
    if (X.gw < MR) rawn = *(const v4u*)(z + (size_t)X.gw * (NG * 128) + gq * 128 + 8 * l16);
    for (int row = X.gw; row < MR; row += X.NGW) {
        const bool lat = row < TL; const int b = lat ? (row >> 12) : ((row - TL) >> 8); const int pos = lat ? (row & 4095) : (SEQ + ((row - TL) & 255));
        const int p = (chunk < 2) ? (pos >> 6) : (pos & 63);
#pragma unroll 1
        for (int it = 0; it < NG / 4; ++it) {
            const int g = it * 4 + gq;
            const float* gp; bool hn;
            if (NG == NSLOT0) { hn = !(g == 10 || g == 11 || g >= 28); gp = g < 8 ? qn_a : (g < 12 ? kn_a : (g < 20 ? qn_b : kn_b)); }
            else { hn = g < 20; gp = g < 16 ? qn_a : kn_a; }
            const v4u raw = rawn;
            { const bool same = it + 1 < NG / 4; const int nrow = same ? row : row + X.NGW, ng = same ? g + 4 : gq; if (nrow < MR) rawn = *(const v4u*)(z + (size_t)nrow * (NG * 128) + ng * 128 + 8 * l16); }
            float v[8] = {bflo(raw.x), bfhi(raw.x), bflo(raw.y), bfhi(raw.y), bflo(raw.z), bfhi(raw.z), bflo(raw.w), bfhi(raw.w)};
            float ss = 0.f;
#pragma unroll
            for (int j = 0; j < 8; ++j) ss += v[j] * v[j];
            ss += __shfl_xor(ss, 1); ss += __shfl_xor(ss, 2); ss += __shfl_xor(ss, 4); ss += __shfl_xor(ss, 8);
            const float rs = 1.0f / sqrtf(ss * (1.f / 128.f) + EPS);
            const f32x4 ga = *(const f32x4*)(gp + 8 * l16), gb = *(const f32x4*)(gp + 8 * l16 + 4);
            const float gg[8] = {ga.x, ga.y, ga.z, ga.w, gb.x, gb.y, gb.z, gb.w};
#pragma unroll
            for (int j = 0; j < 8; ++j) v[j] = hn ? v[j] * rs * gg[j] : v[j];
            float o[8];
#pragma unroll
            for (int j = 0; j < 8; ++j) { const float pv = __shfl_xor(v[j], 4); const f32x2 cs = CS[p * 32 + 8 * (l16 & 3) + j];
                const float rot = (chunk & 1) ? (v[j] * cs.x + pv * cs.y) : (v[j] * cs.x - pv * cs.y); o[j] = (hn && lat) ? rot : v[j]; }
            v4u w; w.x = pk2(o[0], o[1]); w.y = pk2(o[2], o[3]); w.z = pk2(o[4], o[5]); w.w = pk2(o[6], o[7]);
            *(v4u*)(QKV + ((size_t)(b * NG + g) * KVR + pos) * 128 + 8 * l16) = w;
        }
    }
}

template <int NG>
__device__ __forceinline__ void k_post(const Ctx& X, bf16* QKV, const float* kn_a, const float* kn_b, const float* cs_lds) {
    constexpr int NK = (NG == NSLOT0) ? 10 : 4;
    const int l16 = X.lane & 15, rq = X.lane >> 4, chunk = l16 >> 2;
    for (int item = X.gw; item < NB * NK * (KVR / 4); item += X.NGW) {
        const int p4 = item % (KVR / 4), t = item / (KVR / 4), kgi = t % NK, b = t / NK;
        const int g = (NG == NSLOT0) ? (kgi < 2 ? 8 + kgi : 18 + kgi) : 16 + kgi;
        const float* gp = (NG == NSLOT0) ? (kgi < 2 ? kn_a : kn_b) : kn_a;
        const int pos = p4 * 4 + rq; const bool lat = pos < SEQ; const int p = (chunk < 2) ? (pos >> 6) : (pos & 63);
        bf16* ptr = QKV + ((size_t)(b * NG + g) * KVR + pos) * 128 + 8 * l16;
        const v4u raw = *(const v4u*)ptr;
        float v[8] = {bflo(raw.x), bfhi(raw.x), bflo(raw.y), bfhi(raw.y), bflo(raw.z), bfhi(raw.z), bflo(raw.w), bfhi(raw.w)};
        float ss = 0.f;
#pragma unroll
        for (int j = 0; j < 8; ++j) ss += v[j] * v[j];
        ss += __shfl_xor(ss, 1); ss += __shfl_xor(ss, 2); ss += __shfl_xor(ss, 4); ss += __shfl_xor(ss, 8);
        const float rs = 1.0f / sqrtf(ss * (1.f / 128.f) + EPS);
        const f32x4 ga = *(const f32x4*)(gp + 8 * l16), gb = *(const f32x4*)(gp + 8 * l16 + 4);
        const float gg[8] = {ga.x, ga.y, ga.z, ga.w, gb.x, gb.y, gb.z, gb.w};
        float o[8];
#pragma unroll
        for (int j = 0; j < 8; ++j) { v[j] = v[j] * rs * gg[j]; const float pv = __shfl_xor(v[j], 4); const int ci = (lat ? p : 0) * 32 + 8 * (l16 & 3) + j; const float c = cs_lds[ci * 2], sn = cs_lds[ci * 2 + 1];
            const float rot = (chunk & 1) ? (v[j] * c + pv * sn) : (v[j] * c - pv * sn); o[j] = lat ? rot : v[j]; }
        v4u w; w.x = pk2(o[0], o[1]); w.y = pk2(o[2], o[3]); w.z = pk2(o[4], o[5]); w.w = pk2(o[6], o[7]);
        *(v4u*)ptr = w;
    }
}
constexpr int CS_OFF = 98304;
__device__ __forceinline__ void build_cs(const Ctx& X) {
    LAS float* CS = (LAS float*)(X.lds + CS_OFF);
    for (int idx = X.tid; idx < 2048; idx += NWAVES * 64) { const int p = idx >> 5, i = idx & 31; const float inv = exp2f(-(float)i * (13.287712379549449f / 32.0f)); const float a = (float)p * inv;
        float sn, cs; sincosf(a, &sn, &cs); CS[idx * 2] = cs; CS[idx * 2 + 1] = sn; }
    __syncthreads();
}

__device__ __forceinline__ void b_combine(const Ctx& X, const float* PB, const float* lamv, const float* subln, bf16* OALL) {
    const int half = X.lane >> 5, d4 = (X.lane & 31) * 4;
    f32x4 n1, n2;
#define BC_LOAD(item_, d1, d2) do { const int row_ = (item_) >> 2, hb_ = (item_) & 3; const bool lat_ = row_ < TL; const int b_ = lat_ ? (row_ >> 12) : ((row_ - TL) >> 8); const int pos_ = lat_ ? (row_ & 4095) : (SEQ + ((row_ - TL) & 255)); \
        d1 = *(const f32x4*)(PB + ((size_t)(b_ * 16 + (hb_ * 2 + 0) * 2 + half) * KVR + pos_) * 128 + d4); d2 = *(const f32x4*)(PB + ((size_t)(b_ * 16 + (hb_ * 2 + 1) * 2 + half) * KVR + pos_) * 128 + d4); } while (0)
    if (X.gw < MR * 4) BC_LOAD(X.gw, n1, n2);
    for (int item = X.gw; item < MR * 4; item += X.NGW) {
        const int row = item >> 2, hb = item & 3;
        const f32x4 o1 = n1, o2 = n2;
        if (item + X.NGW < MR * 4) BC_LOAD(item + X.NGW, n1, n2);
        const float lam = lamv[hb];
        const f32x4 v = o1 - o2 * lam;
        const float ss = wave_sum((v.x * v.x + v.y * v.y) + (v.z * v.z + v.w * v.w));
        const float rs = (1.0f - LAM_INIT) / sqrtf(ss * (1.f / 256.f) + EPS);
        const f32x4 g = *(const f32x4*)(subln + half * 128 + d4);
        const f32x4 y = v * rs * g;
        v2u o; o.x = pk2(y.x, y.y); o.y = pk2(y.z, y.w);
        *(v2u*)(OALL + (size_t)row * D + 1024 + hb * 256 + half * 128 + d4) = o;
    }
#undef BC_LOAD
}

__device__ __forceinline__ void moe_route(const Ctx& X, const int* eid, const float* egate, const bf16* H, bf16* XS, int* pos, int* rowtok, float* rowgate, int* tile_e, int* ntiles) {
    LAS int* tot = (LAS int*)X.lds;
    LAS int* pre = tot + 8;
    LAS int* base = tot + 16;
    LAS int* dst = tot + 64;
    const int tpw = (TL + X.G - 1) / X.G, t0 = X.c * tpw, t1 = (t0 + tpw) < TL ? (t0 + tpw) : TL;
    if (X.tid < 16) tot[X.tid] = 0;
    __syncthreads();
    for (int idx = X.tid; idx < 2 * TL; idx += NWAVES * 64) { const int e = eid[idx]; __hip_atomic_fetch_add(&tot[e], 1, __ATOMIC_RELAXED, __HIP_MEMORY_SCOPE_WORKGROUP); if ((idx >> 1) < t0) __hip_atomic_fetch_add(&pre[e], 1, __ATOMIC_RELAXED, __HIP_MEMORY_SCOPE_WORKGROUP); }
    __syncthreads();
    if (X.tid == 0) { int acc = 0; for (int e = 0; e < 8; ++e) { base[e] = acc; acc += (tot[e] + 255) & ~255; }
        if (X.c == 0) { *ntiles = acc >> 8; for (int e = 0; e < 8; ++e) { const int nt = (tot[e] + 255) >> 8; for (int i = 0; i < nt; ++i) tile_e[(base[e] >> 8) + i] = e; } } }
    __syncthreads();
    if (X.wave == 0) {
        int run[8];
#pragma unroll
        for (int e = 0; e < 8; ++e) run[e] = 0;
        const int n_ent = 2 * (t1 - t0);
        for (int b0 = 0; b0 < n_ent; b0 += 64) {
            const int li = b0 + X.lane; const bool valid = li < n_ent; const int idx = 2 * t0 + li; const int e = valid ? eid[idx] : -1;
            int rank = 0;
#pragma unroll
            for (int ee = 0; ee < 8; ++ee) { const unsigned long long m = __ballot(e == ee); if (e == ee) rank = run[ee] + __popcll(m & ((1ull << X.lane) - 1ull)); run[ee] += __popcll(m); }
            if (valid) { const int d = base[e] + pre[e] + rank; dst[li] = d; pos[idx] = d; rowtok[d] = idx >> 1; rowgate[d] = egate[idx]; }
        }
    }
    __syncthreads();
    { const int n_ent = 2 * (t1 - t0);
      for (int li = X.wave; li < n_ent; li += NWAVES) { const int tok = t0 + (li >> 1); const int d = dst[li];
          const v4u* s = (const v4u*)((const unsigned char*)H + (size_t)tok * D) + X.lane; v4u* o = (v4u*)((unsigned char*)XS + (size_t)d * D) + X.lane;
#pragma unroll
          for (int j = 0; j < 2; ++j) o[64 * j] = s[64 * j]; } }
    if (X.c < 8) { const int e = X.c; const int r0 = base[e] + tot[e], r1 = base[e] + ((tot[e] + 255) & ~255);
        for (int r = r0 + X.wave; r < r1; r += NWAVES) { if (X.lane == 0) { rowtok[r] = -1; rowgate[r] = 0.f; }
            v4u* o = (v4u*)((unsigned char*)XS + (size_t)r * D) + X.lane; const v4u zz = {0u, 0u, 0u, 0u};
#pragma unroll
            for (int j = 0; j < 2; ++j) o[64 * j] = zz; } }
    __syncthreads();
}

constexpr int MOE_MAIN_TILES = 64, MOE_MAIN_ROWS = MOE_MAIN_TILES * 256;
__device__ __forceinline__ void moe_final(const Ctx& X, const float* X3, const bf16* YS, const int* pos, const float* mods_l, float* out, const float* part, int ntiles) {
    int Sp, ppair; const int tail_rows = (ntiles - MOE_MAIN_TILES) * 256; pg8::tail_split(X.G, (ntiles - MOE_MAIN_TILES) * (D / 256), DFE / 128, Sp, ppair);
    int np0 = 0, np1 = 0; if (X.gw < TL) { np0 = pos[2 * X.gw]; np1 = pos[2 * X.gw + 1]; }
    for (int row = X.gw; row < TL; row += X.NGW) {
        const int p0 = np0, p1 = np1; const float* gp = mods_l + (size_t)(row >> 12) * MODW + 5 * D;
        if (row + X.NGW < TL) { np0 = pos[2 * (row + X.NGW)]; np1 = pos[2 * (row + X.NGW) + 1]; }
        f32x4 a[8], b[8];
        if (p0 < MOE_MAIN_ROWS) {
#pragma unroll
            for (int j = 0; j < 8; ++j) { const v2u w = *(const v2u*)(YS + (size_t)p0 * D + 4 * X.lane + 256 * j); a[j] = (f32x4){bflo(w.x), bfhi(w.x), bflo(w.y), bfhi(w.y)}; }
        } else {
#pragma unroll
            for (int j = 0; j < 8; ++j) a[j] = (f32x4){0.f, 0.f, 0.f, 0.f};
            for (int p = 0; p < Sp; ++p) { const float* pr = part + ((size_t)p * tail_rows + (p0 - MOE_MAIN_ROWS)) * D + 4 * X.lane;
#pragma unroll
                for (int j = 0; j < 8; ++j) a[j] += *(const f32x4*)(pr + 256 * j); }
        }
        if (p1 < MOE_MAIN_ROWS) {
#pragma unroll
            for (int j = 0; j < 8; ++j) { const v2u w = *(const v2u*)(YS + (size_t)p1 * D + 4 * X.lane + 256 * j); b[j] = (f32x4){bflo(w.x), bfhi(w.x), bflo(w.y), bfhi(w.y)}; }
        } else {
#pragma unroll
            for (int j = 0; j < 8; ++j) b[j] = (f32x4){0.f, 0.f, 0.f, 0.f};
            for (int p = 0; p < Sp; ++p) { const float* pr = part + ((size_t)p * tail_rows + (p1 - MOE_MAIN_ROWS)) * D + 4 * X.lane;
#pragma unroll
                for (int j = 0; j < 8; ++j) b[j] += *(const f32x4*)(pr + 256 * j); }
        }
#pragma unroll
        for (int j = 0; j < 8; ++j) { const int col = 4 * X.lane + 256 * j; const f32x4 x = *(const f32x4*)(X3 + (size_t)row * D + col), g = *(const f32x4*)(gp + col);
            *(f32x4*)(out + (size_t)row * D + col) = x + g * (a[j] + b[j]); }
    }
}

__device__ __forceinline__ const float* arg_in(int i) {
    auto kp = __builtin_amdgcn_kernarg_segment_ptr();
    asm volatile("" : "+s"(kp));
    return ((const float* const __attribute__((address_space(4)))*)kp)[i];
}
#define AIN(i) arg_in(i)
constexpr int NPHASE = 20;
#ifndef PHMASK
#define PHMASK 0xFFFFFu
#endif
#ifndef PHDUP
#define PHDUP 0u
#endif
#define REP(k) _Pragma("unroll") for (int rep_ = 0; rep_ < ((((PHDUP) >> (k)) & 1u) ? 2 : 1); ++rep_)
#ifndef MK_LAUNCHES
#define MK_LAUNCHES {{0, NPHASE}}
#endif
struct PhRange { int lo, hi; };
constexpr PhRange kLaunches[] = MK_LAUNCHES;
struct Args { const float* in[33]; float* out; unsigned char* ws; int ph_lo, ph_hi, li, pad; };
__global__ void __launch_bounds__(NWAVES * 64, 2) fwd_kernel(Args args) {
    extern __shared__ __attribute__((aligned(16))) unsigned char lds[];
    Ctx X;
    X.lds = (LAS unsigned char*)lds; X.tid = threadIdx.x; X.lane = X.tid & 63; X.wave = __builtin_amdgcn_readfirstlane(X.tid >> 6);
    X.G = gridDim.x; X.c = blockIdx.x; X.gw = X.c * NWAVES + X.wave; X.NGW = X.G * NWAVES;
    unsigned char* ws = args.ws;
    gu32* ctl = (gu32*)(ws + WS_CTL);
    volatile LAS unsigned* MISC = (volatile LAS unsigned*)(X.lds + MISC_OFF);
    for (int u = X.tid; u < (LDS_BYTES - LDSCTL_OFF) / 4; u += NWAVES * 64) ((LAS unsigned*)(X.lds + LDSCTL_OFF))[u] = 0u;
    __syncthreads();
    const int lo = args.ph_lo, hi = args.ph_hi;
    XcdBarrier bar; bar.bar = (unsigned*)(ctl + CW_BAR) + args.li * XCD_BAR_WORDS; bar.x = 0; bar.st = nullptr;
    if (hi - lo > 1) bar = xcd_barrier_post((unsigned*)(ctl + CW_BAR) + args.li * XCD_BAR_WORDS, MISC + 8);
#define GRID_BAR() xcd_barrier(bar)
#define IN(k) ((((PHMASK) >> (k)) & 1u) && lo <= (k) && (k) < hi)
#define BOTH(k) (IN(k) && ((k) + 1) < hi)

#define x_in (AIN(0))
#define c_in (AIN(1))
#define ctx_in (AIN(2))
#define cctx_in (AIN(3))
#define mods0 ((float*)(ws + WS_MODS))
#define mods1 ((float*)(ws + WS_MODS) + 3 * MODW)
#define lamv ((float*)(ws + WS_LAM))
#define WT_EIN ((bf16*)(ws + WS_WT_EIN))
#define WT_EOUT ((bf16*)(ws + WS_WT_EOUT))
#define WT_EF1 ((bf16*)(ws + WS_WT_EF1))
#define WT_EF2 ((bf16*)(ws + WS_WT_EF2))
#define WT_OIN ((bf16*)(ws + WS_WT_OIN))
#define WT_OOUT ((bf16*)(ws + WS_WT_OOUT))
#define WT_X1 ((bf16*)(ws + WS_WT_X1))
#define WT_X2 ((bf16*)(ws + WS_WT_X2))
#define H ((bf16*)(ws + WS_H))
#define Z ((bf16*)(ws + WS_Z))
#define QKV ((bf16*)(ws + WS_QKV))
#define PB ((float*)(ws + WS_PB))
#define OALL ((bf16*)(ws + WS_OALL))
#define X1 ((float*)(ws + WS_X1))
#define X3 ((float*)(ws + WS_X3))
#define ACT ((bf16*)(ws + WS_ACT))
#define XS ((bf16*)(ws + WS_XS))
#define ACT2 ((bf16*)(ws + WS_ACT2))
#define YS ((bf16*)(ws + WS_YS))
#define PART ((float*)(ws + WS_PART))
#define EID ((int*)(ws + RT_EID))
#define EGATE ((float*)(ws + RT_GATE))
#define POS ((int*)(ws + RT_POS))
#define ROWTOK ((int*)(ws + RT_ROWTOK))
#define ROWGATE ((float*)(ws + RT_ROWGATE))
#define TILE_E ((int*)(ws + RT_TILE_E))
#define NTILES ((int*)(ws + RT_NTILES))

    if (IN(0)) {
    REP(0) { if (rep_) __syncthreads();
    {
        mod_fill_silu(X, c_in, cctx_in);
        for (int task = X.c; task < MOD_TASKS; task += X.G) { const int l = task / (MODW / 32); mod_task(X, task, l ? AIN(24) : AIN(6), l ? AIN(25) : AIN(7), l ? mods1 : mods0); }
        if (X.c == X.G - 1 && X.wave == 0) {
            for (int h = 0; h < 4; ++h) { const float* q1 = AIN(15) + h * 128; const float* k1 = AIN(16) + h * 128; const float* q2 = AIN(17) + h * 128; const float* k2 = AIN(18) + h * 128;
                const float s1 = wave_sum(q1[X.lane] * k1[X.lane] + q1[X.lane + 64] * k1[X.lane + 64]); const float s2 = wave_sum(q2[X.lane] * k2[X.lane] + q2[X.lane + 64] * k2[X.lane + 64]);
                if (X.lane == 0) lamv[h] = expf(s1) - expf(s2) + LAM_INIT; }
        }
        LAS float* scr = (LAS float*)(X.lds + X.wave * 16896);
        int tbase = 0;
#define TPASS(Wp, K_, N_, WTp, kind_, nexp) { constexpr int per_ = ((K_) / 64) * ((N_) / 64), tot_ = per_ * (nexp); int j_ = (X.gw - tbase) % X.NGW; if (j_ < 0) j_ += X.NGW; \
            for (; j_ < tot_; j_ += X.NGW) { const int e_ = j_ / per_, q_ = j_ - e_ * per_; transpose_item((Wp) + (size_t)e_ * (K_) * (N_), (K_), (N_), (WTp) + (size_t)e_ * (N_) * (K_), q_, (kind_), scr, X.lane); } tbase += tot_; }
#define TPASS8(Wp, K_, N_, WTp, kind_, nexp) { constexpr int per_ = ((K_) / 128) * ((N_) / 32), tot_ = per_ * (nexp); int j_ = (X.gw - tbase) % X.NGW; if (j_ < 0) j_ += X.NGW; \
            for (; j_ < tot_; j_ += X.NGW) { const int e_ = j_ / per_, q_ = j_ - e_ * per_; transpose_item8((Wp) + (size_t)e_ * (K_) * (N_), (K_), (N_), (WTp) + (size_t)e_ * (N_) * (K_), q_, (kind_), scr, X.lane); } tbase += tot_; }
        TPASS(AIN(8), D, EVEN_IN, WT_EIN, 0, 1)
        TPASS(AIN(9), D, D, WT_EOUT, 0, 1)
        TPASS(AIN(20), D, 2 * DFF, WT_EF1, 1, 1)
        TPASS(AIN(21), DFF, D, WT_EF2, 0, 1)
        TPASS(AIN(26), D, ODD_IN, WT_OIN, 0, 1)
        TPASS(AIN(27), D, D, WT_OOUT, 0, 1)
        TPASS8(AIN(31), D, 2 * DFE, (unsigned char*)WT_X1, 1, NE)
        TPASS8(AIN(32), DFE, D, (unsigned char*)WT_X2, 0, NE)
#undef TPASS
#undef TPASS8
    }
    }
    if (BOTH(0)) GRID_BAR();
    }
    if (IN(1)) {
    REP(1) { if (rep_) __syncthreads();
    norm_mod_rows<false>(X, x_in, ctx_in, MR, AIN(4), mods0, 0, 1, H, nullptr, nullptr, nullptr);
    }
    if (BOTH(1)) GRID_BAR();
    }
    if (IN(2)) {
    REP(2) { if (rep_) __syncthreads();
    { pg8::Gemm g{H, WT_EIN, MR, EVEN_IN, D}; pg8::StaticOrder S; S.init(MR, EVEN_IN, D / 64, X.G, X.c); pg8::EpiSlots E{QKV, NSLOT0, KVR};
      pg8::gemm_phase<pg8::EpiSlots, pg8::StaticOrder, true, true>(X.lds, g, S, E); }
    }
    if (BOTH(2)) GRID_BAR();
    }
    if (IN(3)) {
    REP(3) { if (rep_) __syncthreads();
    build_cs(X); k_post<NSLOT0>(X, QKV, AIN(11), AIN(14), (const float*)(lds + CS_OFF));
    }
    if (BOTH(3)) GRID_BAR();
    }
    if (IN(4)) {
    REP(4) { if (rep_) __syncthreads();
    {
        build_cs(X); const float* csp = (const float*)(lds + CS_OFF);
        const att::bf16* Q0 = (const att::bf16*)QKV;
        for (int u = X.c; u < 544; u += X.G) {
            const bool isl = u < 512; const int b = isl ? (u >> 8) : ((u - 512) >> 4), vh = isl ? ((u >> 4) & 15) : ((u - 512) & 15), qb = isl ? (u & 15) : 16;
            const int hb = vh >> 2, map = (vh >> 1) & 1, half = vh & 1;
            const att::bf16* Qp = Q0 + ((size_t)(b * NSLOT0 + 12 + 2 * hb + map) * KVR + qb * 256) * 128;
            const att::bf16* Kp = Q0 + ((size_t)(b * NSLOT0 + 20 + 2 * hb + map) * KVR) * 128;
            const att::bf16* Vp = Q0 + ((size_t)(b * NSLOT0 + 28 + 2 * hb + half) * KVR) * 128;
            float* Op = PB + ((size_t)(b * 16 + vh) * KVR + qb * 256) * 128;
            att::attn_unit<false, false>(Qp, Kp, Vp, (void*)Op, 128, 0, isl ? 68 : 0, isl ? 68 : 4, qb * 256, -1e30f, 0.f, (char*)lds, AIN(13), isl, csp);
        }
        const int ca = (X.c + X.G - 32) % X.G;
        for (int u = ca; u < 272; u += X.G) {
            const bool isl = u < 256; const int b = isl ? (u >> 7) : ((u - 256) >> 3), h = isl ? ((u >> 4) & 7) : ((u - 256) & 7), qb = isl ? (u & 15) : 16;
            const int q0 = qb * 256; const int klo = isl ? (q0 >= 128 ? q0 - 128 : 0) : 0; const int khi = (q0 + 384) < SEQ ? (q0 + 384) : SEQ; const int nt1 = isl ? ((khi - klo) >> 6) : 0;
            const att::bf16* Qp = Q0 + ((size_t)(b * NSLOT0 + h) * KVR + q0) * 128;
            const att::bf16* Kp = Q0 + ((size_t)(b * NSLOT0 + 8 + (h >> 2)) * KVR) * 128;
            const att::bf16* Vp = Q0 + ((size_t)(b * NSLOT0 + 10 + (h >> 2)) * KVR) * 128;
            bf16* Op = OALL + (size_t)(isl ? (b * SEQ + q0) : (TL + b * CTXL)) * D + h * 128;
            const float sink = AIN(12)[h];
            att::attn_unit<true, true>(Qp, Kp, Vp, (void*)Op, D, klo, nt1, nt1 + 4, q0, sink * (1.0f / att::SCALE), 1.f, (char*)lds, AIN(10), isl, csp);
        }
    }
    }
    if (BOTH(4)) GRID_BAR();
    }
    if (IN(5)) {
    REP(5) { if (rep_) __syncthreads();
    b_combine(X, PB, lamv, AIN(19), OALL);
    }
    if (BOTH(5)) GRID_BAR();
    }
    if (IN(6)) {
    REP(6) { if (rep_) __syncthreads();
    { pg8::Gemm g{OALL, WT_EOUT, MR, D, D}; pg8::TailOrder S; S.init(TL / 256, TC / 256, D / 256, D / 64, X.G, X.c, nullptr); pg8::EpiRes E{x_in, ctx_in, X1, D, mods0 + 2 * D, MODW, PART, TL, TC, 1.0f};
      pg8::gemm_phase<pg8::EpiRes, pg8::TailOrder, true, true>(X.lds, g, S, E); }
    }
    if (BOTH(6)) GRID_BAR();
    }
    if (IN(7)) {
    REP(7) { if (rep_) __syncthreads();
    { int Sp, pp; pg8::tail_split(X.G, (TC / 256) * (D / 256), D / 64, Sp, pp);
      norm_mod_rows<false, true>(X, X1, ctx_in, MR, AIN(5), mods0, 3, 4, H, nullptr, nullptr, nullptr, PART, Sp, mods0 + 2 * MODW + 2 * D, X1 + (size_t)TL * D); }
    }
    if (BOTH(7)) GRID_BAR();
    }
    if (IN(8)) {
    REP(8) { if (rep_) __syncthreads();
    { pg8::Gemm g{H, WT_EF1, MR, 2 * DFF, D}; pg8::StaticOrder S; S.init(MR, 2 * DFF, D / 64, X.G, X.c); pg8::EpiSwiglu E{ACT, DFF, 1.0f};
      pg8::gemm_phase<pg8::EpiSwiglu, pg8::StaticOrder, true, true>(X.lds, g, S, E); }
    }
    if (BOTH(8)) GRID_BAR();
    }
    if (IN(9)) {
    REP(9) { if (rep_) __syncthreads();
    { pg8::Gemm g{ACT, WT_EF2, MR, D, DFF}; pg8::TailOrder S; S.init(TL / 256, TC / 256, D / 256, DFF / 64, X.G, X.c, nullptr); pg8::EpiRes E{X1, X1 + (size_t)TL * D, X1, D, mods0 + 5 * D, MODW, PART, TL, TC, 1.0f};
      pg8::gemm_phase<pg8::EpiRes, pg8::TailOrder, true, true>(X.lds, g, S, E); }
    }
    if (BOTH(9)) GRID_BAR();
    }
    if (IN(10)) {
    REP(10) { if (rep_) __syncthreads();
    { int Sp, pp; pg8::tail_split(X.G, (TC / 256) * (D / 256), DFF / 64, Sp, pp);
      norm_mod_rows<false, true>(X, X1, X1 + (size_t)TL * D, MR, AIN(22), mods1, 0, 1, H, nullptr, nullptr, nullptr, PART, Sp, mods0 + 2 * MODW + 5 * D, nullptr); }
    }
    if (BOTH(10)) GRID_BAR();
    }
    if (IN(11)) {
    REP(11) { if (rep_) __syncthreads();
    { pg8::Gemm g{H, WT_OIN, MR, ODD_IN, D}; pg8::StaticOrder S; S.init(MR, ODD_IN, D / 64, X.G, X.c); pg8::EpiSlots E{QKV, NSLOT1, KVR};
      pg8::gemm_phase<pg8::EpiSlots, pg8::StaticOrder, true, true>(X.lds, g, S, E); }
    }
    if (BOTH(11)) GRID_BAR();
    }
    if (IN(12)) {
    REP(12) { if (rep_) __syncthreads();
    build_cs(X); k_post<NSLOT1>(X, QKV, AIN(29), nullptr, (const float*)(lds + CS_OFF));
    }
    if (BOTH(12)) GRID_BAR();
    }
    if (IN(13)) {
    REP(13) { if (rep_) __syncthreads();
    {
        build_cs(X); const float* csp = (const float*)(lds + CS_OFF);
        const att::bf16* Q0 = (const att::bf16*)QKV;
        for (int u = X.c; u < 512; u += X.G) {
            const int b = u >> 8, h = (u >> 4) & 15, qb = u & 15;
            const att::bf16* Qp = Q0 + ((size_t)(b * NSLOT1 + h) * KVR + qb * 256) * 128;
            const att::bf16* Kp = Q0 + ((size_t)(b * NSLOT1 + 16 + (h >> 2)) * KVR) * 128;
            const att::bf16* Vp = Q0 + ((size_t)(b * NSLOT1 + 20 + (h >> 2)) * KVR) * 128;
            bf16* Op = OALL + (size_t)(b * SEQ + qb * 256) * D + h * 128;
            const int ntc = 68 + (X.G >> 20);
            att::attn_unit<false, true>(Qp, Kp, Vp, (void*)Op, D, 0, ntc, ntc, qb * 256, -1e30f, 0.f, (char*)lds, AIN(28), true, csp);
        }
    }
    }
    if (BOTH(13)) GRID_BAR();
    }
    if (IN(14)) {
    REP(14) { if (rep_) __syncthreads();
    { pg8::Gemm g{OALL, WT_OOUT, TL, D, D}; pg8::StaticOrder S; S.init(TL, D, D / 64, X.G, X.c); pg8::EpiRes E{X1, X1, X3, D, mods1 + 2 * D, MODW, nullptr, 0, 0, 1.0f};
      pg8::gemm_phase<pg8::EpiRes, pg8::StaticOrder, true, true>(X.lds, g, S, E); }
    }
    if (BOTH(14)) GRID_BAR();
    }
    if (IN(15)) {
    REP(15) { if (rep_) __syncthreads();
    norm_mod_rows<true, false, true>(X, X3, X3, TL, AIN(23), mods1, 3, 4, H, AIN(30), EID, EGATE);
    }
    if (BOTH(15)) GRID_BAR();
    }
    if (IN(16)) {
    REP(16) { if (rep_) __syncthreads();
    moe_route(X, EID, EGATE, H, XS, POS, ROWTOK, ROWGATE, TILE_E, NTILES);
    }
    if (BOTH(16)) GRID_BAR();
    }
    if (IN(17)) {
    REP(17) { if (rep_) __syncthreads();
    { const int nt = *(volatile int*)NTILES; pg8::Gemm g{XS, WT_X1, XROWS, 2 * DFE, D}; pg8::TailOrder S; S.init(nt, 0, 2 * DFE / 256, D / 128, X.G, X.c, TILE_E); pg8::EpiSwiglu8 E{ACT2, DFE, 1.0f / W8_SCALE};
      pg8::gemm_phase<pg8::EpiSwiglu8, pg8::TailOrder, true, true, true>(X.lds, g, S, E); }
    }
    if (BOTH(17)) GRID_BAR();
    }
    if (IN(18)) {
    REP(18) { if (rep_) __syncthreads();
    { const int nt = *(volatile int*)NTILES; pg8::Gemm g{ACT2, WT_X2, XROWS, D, DFE}; pg8::TailOrder S; S.init(MOE_MAIN_TILES, nt - MOE_MAIN_TILES, D / 256, DFE / 128, X.G, X.c, TILE_E); pg8::EpiRowScale E{(pg8::bf16_t*)YS, D, ROWGATE, PART, MOE_MAIN_ROWS, (nt - MOE_MAIN_TILES) * 256, 1.0f / W8_SCALE};
      pg8::gemm_phase<pg8::EpiRowScale, pg8::TailOrder, true, true, true>(X.lds, g, S, E); }
    }
    if (BOTH(18)) GRID_BAR();
    }
    if (IN(19)) {
    REP(19) { if (rep_) __syncthreads();
    moe_final(X, X3, YS, POS, mods1, args.out, PART, *(volatile int*)NTILES);
    }
    }
}

extern "C" void kernel_launch(void* const* d_in, const int* in_sizes, int n_in, void* d_out, int out_size, void* d_ws, size_t ws_size, hipStream_t stream) {
    static int grid = 0;
    if (grid == 0) {
        if (n_in != 33 || in_sizes[0] != TL * D || out_size != TL * D || ws_size < WS_END) { fprintf(stderr, "kernel_launch: unexpected shapes (n_in %d, in0 %d, out %d, ws %zu)\n", n_in, n_in > 0 ? in_sizes[0] : -1, out_size, ws_size); grid = -1; return; }
        int dev = 0, cus = 0, per_cu = 0;
        if (hipGetDevice(&dev) != hipSuccess || hipDeviceGetAttribute(&cus, hipDeviceAttributeMultiprocessorCount, dev) != hipSuccess) { grid = -1; return; }
        if (hipFuncSetAttribute((const void*)fwd_kernel, hipFuncAttributeMaxDynamicSharedMemorySize, LDS_BYTES) != hipSuccess) { fprintf(stderr, "kernel_launch: hipFuncSetAttribute failed\n"); grid = -1; return; }
        if (hipOccupancyMaxActiveBlocksPerMultiprocessor(&per_cu, (const void*)fwd_kernel, NWAVES * 64, LDS_BYTES) != hipSuccess || per_cu < 1) { fprintf(stderr, "kernel_launch: occupancy query says %d blocks per CU\n", per_cu); }
        (void)hipGetLastError();
        grid = cus;
    }
    if (grid < 0) return;
    constexpr int NL = sizeof(kLaunches) / sizeof(kLaunches[0]);
    if (hipMemsetAsync((char*)d_ws + WS_CTL, 0, NL == 1 ? (size_t)65536 : CTL_ZERO_BYTES, stream) != hipSuccess) return;
    Args a{};
    for (int i = 0; i < 33; ++i) a.in[i] = (const float*)d_in[i];
    a.out = (float*)d_out; a.ws = (unsigned char*)d_ws;
    for (int li = 0; li < NL; ++li) {
        a.ph_lo = kLaunches[li].lo; a.ph_hi = kLaunches[li].hi; a.li = li; a.pad = 0;
        hipLaunchKernelGGL(fwd_kernel, dim3(grid), dim3(NWAVES * 64), LDS_BYTES, stream, a);
        const hipError_t le = hipPeekAtLastError();
        if (le != hipSuccess) { fprintf(stderr, "kernel_launch: launch %d failed: %s\n", li, hipGetErrorName(le)); break; }
    }
}
```

```cpp
#include <hip/hip_runtime.h>
#include <hip/hip_bf16.h>
#include <cstdio>
#include <cstdint>

namespace pg8 {
#define PG8_LAS __attribute__((address_space(3)))
typedef unsigned short bf16_t;
typedef short bf16x8 __attribute__((ext_vector_type(8)));
typedef float f32x4 __attribute__((ext_vector_type(4)));
typedef unsigned u32x4 __attribute__((ext_vector_type(4)));
constexpr int BM = 256, BK = 64, HALF = 128, HTB = HALF * BK * 2  , STAGE_BYTES = 8 * HTB, NXCD = 8, WGM = 8;

__host__ __device__ __forceinline__ int lds_byte(int r, int c) { const int st = (r >> 4) * 2 + (c >> 5), rr = r & 15, cc = c & 31, ob = rr * 64 + cc * 2; return st * 1024 + (ob ^ (((ob >> 9) & 1) << 5)); }
__host__ __device__ __forceinline__ void stage_rc(int b, int& R, int& C) { const int st = b / 1024, sb = b % 1024, swz = sb ^ (((sb >> 9) & 1) << 5); R = (st >> 1) * 16 + swz / 64; C = (st & 1) * 32 + (swz % 64) / 2; }
__host__ __device__ __forceinline__ int perm32(int rho) { const int n = rho >> 4, i = rho & 15; return 8 * (i >> 2) + 4 * n + (i & 3); }

struct Unit { int pm, pn, pnb, kt0, nkt, part; };
struct Gemm { const void* A; const void* Bt; int M, N, K; };

struct StaticOrder {
    int nM, nN, nwg, G, c, KT;
    __host__ __device__ __forceinline__ void init(int M, int N, int KT_, int G_, int c_) { nM = M / BM; nN = N / BM; nwg = nM * nN; G = G_; c = c_; KT = KT_; }
    __host__ __device__ __forceinline__ bool next(int i, Unit& u) const {
        const long L = (long)i * G + c; if (L >= nwg) return false;
        int wgid = (int)L; { const int q = nwg / NXCD, r = nwg % NXCD, xcd = wgid % NXCD, off = wgid / NXCD; wgid = (xcd < r ? xcd * (q + 1) : r * (q + 1) + (xcd - r) * q) + off; }
        const int nig = WGM * nN, gid = wgid / nig, fm = gid * WGM, gsz = (nM - fm) < WGM ? (nM - fm) : WGM;
        u.pm = fm + ((wgid % nig) % gsz); u.pn = (wgid % nig) / gsz; u.pnb = u.pn; u.kt0 = 0; u.nkt = KT; u.part = -1; return true;
    }
    __device__ __forceinline__ void a_ready(const Unit&) const {}
    __device__ __forceinline__ void done(const Unit&) const {}
};
__host__ __device__ __forceinline__ void tail_split(int G, int T, int KT, int& Sp, int& ppair) {
    if (T <= 0) { Sp = 0; ppair = 0; return; }
    int S = G / T; if (S < 1) S = 1; const int pairs = KT >> 1; ppair = (pairs + S - 1) / S; if (ppair < 2) ppair = 2; Sp = (pairs + ppair - 1) / ppair;
}
struct TailOrder {
    StaticOrder so; int T, Sp, ppair; const int* tile_e;
    __device__ __forceinline__ void init(int nMm, int nTm, int nN, int KT, int G_, int c_, const int* te) { so.nM = nMm; so.nN = nN; so.nwg = nMm * nN; so.G = G_; so.c = c_; so.KT = KT; T = nTm * nN; tile_e = te; tail_split(G_, T, KT, Sp, ppair); }
    __device__ __forceinline__ bool next(int i, Unit& u) const {
        const int nm = so.c < so.nwg ? (so.nwg - so.c + so.G - 1) / so.G : 0;
        const int cc = so.G - 1 - so.c;
        int pm, pn, kt0 = 0, nkt = so.KT, part = -1;
        if (i < nm) { Unit t; so.next(i, t); pm = t.pm; pn = t.pn; }
        else if (i == nm && cc < T * Sp) { const int tu = cc / Sp, j = cc - tu * Sp; pm = so.nM + tu / so.nN; pn = tu % so.nN; kt0 = 2 * ppair * j; nkt = (so.KT - kt0) < 2 * ppair ? (so.KT - kt0) : 2 * ppair; part = j; }
        else return false;
        int e = 0; if (tile_e) e = __builtin_amdgcn_readfirstlane(tile_e[pm]);
        u.pm = pm; u.pn = pn; u.pnb = e * so.nN + pn; u.kt0 = kt0; u.nkt = nkt; u.part = part; return true;
    }
    __device__ __forceinline__ void a_ready(const Unit&) const {}
    __device__ __forceinline__ void done(const Unit&) const {}
};

__device__ __forceinline__ unsigned cvt_pk_bf16(float lo, float hi) { unsigned r; asm volatile("v_cvt_pk_bf16_f32 %0, %1, %2" : "=v"(r) : "v"(lo), "v"(hi)); return r; }

struct EpiBf16 {
    static constexpr bool PERM = true, AFTER_DRAIN = false;
    bf16_t* O; int ldc; float scale;
    __device__ __forceinline__ void operator()(const f32x4 (&acc)[2][2][4][2], const Unit& u, int wr, int wc, int fr, int fq) const {
        const int row0 = u.pm * BM + wr * 64 + fr; const int col0 = u.pn * BM + wc * 32 + 8 * fq;
#pragma unroll
        for (int ai = 0; ai < 2; ++ai)
#pragma unroll
            for (int m = 0; m < 4; ++m) { bf16_t* rowp = O + (size_t)(row0 + ai * HALF + m * 16) * ldc + col0;
#pragma unroll
                for (int bj = 0; bj < 2; ++bj) { const f32x4 v0 = acc[ai][bj][m][0] * scale, v1 = acc[ai][bj][m][1] * scale;
                    u32x4 w; w.x = cvt_pk_bf16(v0[0], v0[1]); w.y = cvt_pk_bf16(v0[2], v0[3]); w.z = cvt_pk_bf16(v1[0], v1[1]); w.w = cvt_pk_bf16(v1[2], v1[3]);
                    *(u32x4*)(rowp + bj * HALF) = w; } }
    }
};
struct EpiSlots {
    static constexpr bool PERM = true, AFTER_DRAIN = false;
    bf16_t* QKV; int NG; int kvr;
    __device__ __forceinline__ void operator()(const f32x4 (&acc)[2][2][4][2], const Unit& u, int wr, int wc, int fr, int fq) const {
        const int prow = u.pm * BM; const bool lat = prow < 8192; const int b = lat ? (prow >> 12) : ((prow - 8192) >> 8); const int pos0 = lat ? (prow & 4095) : 4096;
        const int rl0 = wr * 64 + fr;
#pragma unroll
        for (int bj = 0; bj < 2; ++bj) { bf16_t* gbase = QKV + ((size_t)(b * NG + 2 * u.pn + bj) * kvr + pos0 + rl0) * 128 + wc * 32 + 8 * fq;
#pragma unroll
            for (int ai = 0; ai < 2; ++ai)
#pragma unroll
                for (int m = 0; m < 4; ++m) { const f32x4 v0 = acc[ai][bj][m][0], v1 = acc[ai][bj][m][1];
                    u32x4 w; w.x = cvt_pk_bf16(v0[0], v0[1]); w.y = cvt_pk_bf16(v0[2], v0[3]); w.z = cvt_pk_bf16(v1[0], v1[1]); w.w = cvt_pk_bf16(v1[2], v1[3]);
                    *(u32x4*)(gbase + (size_t)(ai * HALF + m * 16) * 128) = w; } }
    }
};
__device__ __forceinline__ float clamp448(float x) { return __builtin_fminf(__builtin_fmaxf(x, -448.f), 448.f); }
__device__ __forceinline__ unsigned pk4_fp8(float a, float b, float c, float d) {
    int w = __builtin_amdgcn_cvt_pk_fp8_f32(clamp448(a), clamp448(b), 0, false); w = __builtin_amdgcn_cvt_pk_fp8_f32(clamp448(c), clamp448(d), w, true); return (unsigned)w; }
__device__ __forceinline__ float silu_mul(float g, float u) { return g * u * __builtin_amdgcn_rcpf(1.0f + __builtin_amdgcn_exp2f(-1.4426950408889634f * g)); }
template <bool OUT8> struct EpiSwigluT {
    static constexpr bool PERM = true, AFTER_DRAIN = false;
    void* O; int ldc; float scale;
    __device__ __forceinline__ void operator()(const f32x4 (&acc)[2][2][4][2], const Unit& u, int wr, int wc, int fr, int fq) const {
        const int row0 = u.pm * BM + wr * 64 + fr; const int col0 = u.pn * HALF + wc * 32 + 8 * fq;
#pragma unroll
        for (int ai = 0; ai < 2; ++ai)
#pragma unroll
            for (int m = 0; m < 4; ++m) { const size_t eo = (size_t)(row0 + ai * HALF + m * 16) * ldc + col0;
                const f32x4 g0 = acc[ai][0][m][0] * scale, g1 = acc[ai][0][m][1] * scale, u0 = acc[ai][1][m][0] * scale, u1 = acc[ai][1][m][1] * scale;
                const float r0 = silu_mul(g0[0], u0[0]), r1 = silu_mul(g0[1], u0[1]), r2 = silu_mul(g0[2], u0[2]), r3 = silu_mul(g0[3], u0[3]);
                const float r4 = silu_mul(g1[0], u1[0]), r5 = silu_mul(g1[1], u1[1]), r6 = silu_mul(g1[2], u1[2]), r7 = silu_mul(g1[3], u1[3]);
                if constexpr (OUT8) { typedef unsigned u32x2 __attribute__((ext_vector_type(2))); u32x2 w; w.x = pk4_fp8(r0, r1, r2, r3); w.y = pk4_fp8(r4, r5, r6, r7); *(u32x2*)((unsigned char*)O + eo) = w; }
                else { u32x4 w; w.x = cvt_pk_bf16(r0, r1); w.y = cvt_pk_bf16(r2, r3); w.z = cvt_pk_bf16(r4, r5); w.w = cvt_pk_bf16(r6, r7); *(u32x4*)((bf16_t*)O + eo) = w; } }
    }
};
typedef EpiSwigluT<false> EpiSwiglu; typedef EpiSwigluT<true> EpiSwiglu8;
struct EpiRes {
    static constexpr bool PERM = false, AFTER_DRAIN = false;
    const float* base_lat; const float* base_ctx; float* out; int ldc; const float* gate; int gate_stride;
    float* part; int part_row0, part_rows; float scale;
    __device__ __forceinline__ void operator()(const f32x4 (&acc)[2][2][4][2], const Unit& u, int wr, int wc, int fr, int fq) const {
        if (u.part >= 0) {
            float* pp = part + ((long)u.part * part_rows + (u.pm * BM - part_row0)) * (long)ldc; const int rl0 = wr * 64 + fr, col0 = u.pn * BM + wc * 32 + 4 * fq;
#pragma unroll
            for (int ai = 0; ai < 2; ++ai)
#pragma unroll
                for (int m = 0; m < 4; ++m) { const size_t ro = (size_t)(rl0 + ai * HALF + m * 16) * ldc;
#pragma unroll
                    for (int bj = 0; bj < 2; ++bj)
#pragma unroll
                        for (int n = 0; n < 2; ++n) *(f32x4*)(pp + ro + col0 + bj * HALF + 16 * n) = acc[ai][bj][m][n] * scale; }
            return;
        }
        const int prow = u.pm * BM; const int cond = prow < 4096 ? 0 : (prow < 8192 ? 1 : 2);
        const float* bp = prow < 8192 ? base_lat + (size_t)prow * ldc : base_ctx + (size_t)(prow - 8192) * ldc;
        float* op = out + (size_t)prow * ldc; const float* gp = gate + (size_t)cond * gate_stride;
        const int rl0 = wr * 64 + fr, col0 = u.pn * BM + wc * 32 + 4 * fq;
        f32x4 gv[2][2];
#pragma unroll
        for (int bj = 0; bj < 2; ++bj)
#pragma unroll
            for (int n = 0; n < 2; ++n) gv[bj][n] = *(const f32x4*)(gp + col0 + bj * HALF + 16 * n) * scale;
#pragma unroll
        for (int ai = 0; ai < 2; ++ai)
#pragma unroll
            for (int m = 0; m < 4; ++m) { const size_t ro = (size_t)(rl0 + ai * HALF + m * 16) * ldc;
#pragma unroll
                for (int bj = 0; bj < 2; ++bj)
#pragma unroll
                    for (int n = 0; n < 2; ++n) { const int col = col0 + bj * HALF + 16 * n; const f32x4 b = *(const f32x4*)(bp + ro + col);
                        *(f32x4*)(op + ro + col) = b + gv[bj][n] * acc[ai][bj][m][n]; } }
    }
};
struct EpiRowScale {
    static constexpr bool PERM = true, AFTER_DRAIN = false;
    bf16_t* out; int ldc; const float* rs; float* part; int part_row0, part_rows; float scale;
    __device__ __forceinline__ void operator()(const f32x4 (&acc)[2][2][4][2], const Unit& u, int wr, int wc, int fr, int fq) const {
        const int row0 = u.pm * BM + wr * 64 + fr, col0 = u.pn * BM + wc * 32 + 8 * fq;
#pragma unroll
        for (int ai = 0; ai < 2; ++ai)
#pragma unroll
            for (int m = 0; m < 4; ++m) { const int row = row0 + ai * HALF + m * 16; const float s = rs[row] * scale;
                if (u.part >= 0) { float* rp = part + ((long)u.part * part_rows - part_row0 + row) * (long)ldc + col0;
#pragma unroll
                    for (int bj = 0; bj < 2; ++bj) { *(f32x4*)(rp + bj * HALF) = acc[ai][bj][m][0] * s; *(f32x4*)(rp + bj * HALF + 4) = acc[ai][bj][m][1] * s; } }
                else { bf16_t* rp = out + (size_t)row * ldc + col0;
#pragma unroll
                    for (int bj = 0; bj < 2; ++bj) { const f32x4 v0 = acc[ai][bj][m][0] * s, v1 = acc[ai][bj][m][1] * s;
                        u32x4 w; w.x = cvt_pk_bf16(v0[0], v0[1]); w.y = cvt_pk_bf16(v0[2], v0[3]); w.z = cvt_pk_bf16(v1[0], v1[1]); w.w = cvt_pk_bf16(v1[2], v1[3]);
                        *(u32x4*)(rp + bj * HALF) = w; } } }
    }
};

typedef int v8i __attribute__((ext_vector_type(8)));
__device__ __forceinline__ v8i cat8(bf16x8 a, bf16x8 b) { struct P { bf16x8 a, b; } p{a, b}; return __builtin_bit_cast(v8i, p); }
template <class Epi, class Sched, bool ALIGN_EPI = false, bool SP2 = false, bool FP8 = false>
__device__ __forceinline__ void gemm_phase(PG8_LAS unsigned char* lds, const Gemm g, const Sched& S, const Epi& E) {
    int tid = threadIdx.x; asm volatile("" : "+v"(tid));
    const int wid = __builtin_amdgcn_readfirstlane(tid >> 6), lane = tid & 63, wr = wid >> 2, wc = wid & 3, fr = lane & 15, fq = lane >> 4;
    const int K = g.K; const int pitch = FP8 ? K : K * 2;
    unsigned voffA[2], voffB[2];
#pragma unroll
    for (int i = 0; i < 2; ++i) { int R, C; stage_rc(tid * 16 + i * 8192, R, C); const int Rb = Epi::PERM ? ((R & ~31) + perm32(R & 31)) : R;
        voffA[i] = (unsigned)(R * pitch + C * 2); voffB[i] = (unsigned)(Rb * pitch + C * 2); }
    const size_t kstep = (size_t)(BK * 2);
    const size_t hstep = (size_t)HALF * pitch;
    const size_t tstep = 2 * hstep;
    const unsigned ldsw = (unsigned)wid * 1024u;
    const int aoff = lds_byte(wr * 64 + fr, fq * 8), boff = lds_byte(wc * 32 + fr, fq * 8);
#define PG8_SA(b, h) (((b) * 2 + (h)) * HTB)
#define PG8_SB(b, h) ((4 + (b) * 2 + (h)) * HTB)
#define PG8_STAGE(bufoff, gbase, voff) do { _Pragma("unroll") for (int _i = 0; _i < 2; ++_i) \
        __builtin_amdgcn_global_load_lds((const unsigned*)((const char*)(gbase) + (voff)[_i]), (PG8_LAS unsigned*)(lds + (bufoff) + ldsw + _i * 8192), 16, 0, 0); } while (0)
#define PG8_LDA(dst, b, h) do { _Pragma("unroll") for (int m = 0; m < 4; ++m) _Pragma("unroll") for (int k = 0; k < 2; ++k) dst[m][k] = *(const PG8_LAS bf16x8*)(lds + PG8_SA(b, h) + aoff + m * 2048 + k * 1024); } while (0)
#define PG8_LDB(dst, b, h) do { _Pragma("unroll") for (int n = 0; n < 2; ++n) _Pragma("unroll") for (int k = 0; k < 2; ++k) dst[n][k] = *(const PG8_LAS bf16x8*)(lds + PG8_SB(b, h) + boff + n * 2048 + k * 1024); } while (0)
#define PG8_MMA(ai, bj, At, Bt) do { __builtin_amdgcn_s_setprio(1); if constexpr (FP8) { _Pragma("unroll") for (int m = 0; m < 4; ++m) _Pragma("unroll") for (int n = 0; n < 2; ++n) \
        asm volatile("v_mfma_f32_16x16x128_f8f6f4 %0, %1, %2, %0" : "+v"(acc[ai][bj][m][n]) : "v"(cat8(Bt[n][0], Bt[n][1])), "v"(cat8(At[m][0], At[m][1]))); } \
      else { _Pragma("unroll") for (int m = 0; m < 4; ++m) _Pragma("unroll") for (int n = 0; n < 2; ++n) _Pragma("unroll") for (int k = 0; k < 2; ++k) \
        acc[ai][bj][m][n] = __builtin_amdgcn_mfma_f32_16x16x32_bf16(Bt[n][k], At[m][k], acc[ai][bj][m][n], 0, 0, 0); } __builtin_amdgcn_s_setprio(0); } while (0)
#define PG8_WAIT_V(n) asm volatile("s_waitcnt vmcnt(" #n ")" ::: "memory")
#define PG8_WAIT_L(n) asm volatile("s_waitcnt lgkmcnt(" #n ")" ::: "memory")
#define PG8_BAR __builtin_amdgcn_s_barrier()
#define PG8_SCHED __builtin_amdgcn_sched_barrier(0)
    Unit cur, nxt; int ui = 0;
    if (!S.next(0, cur)) return;
    f32x4 acc[2][2][4][2];
#pragma unroll
    for (int a = 0; a < 2; ++a)
#pragma unroll
        for (int b = 0; b < 2; ++b)
#pragma unroll
            for (int m = 0; m < 4; ++m)
#pragma unroll
                for (int n = 0; n < 2; ++n) acc[a][b][m][n] = (f32x4){0.f, 0.f, 0.f, 0.f};
    bf16x8 At[4][2], B0[2][2], B1[2][2];
    const char* cA = (const char*)g.A + (size_t)cur.pm * tstep + (size_t)cur.kt0 * kstep; const char* cB = (const char*)g.Bt + (size_t)cur.pnb * tstep + (size_t)cur.kt0 * kstep;
    S.a_ready(cur);
    if constexpr (SP2) {
        PG8_STAGE(PG8_SB(0, 0), cB, voffB); PG8_STAGE(PG8_SB(0, 1), cB + hstep, voffB); PG8_STAGE(PG8_SA(0, 0), cA, voffA); PG8_STAGE(PG8_SA(0, 1), cA + hstep, voffA);
        if (wr == 1) PG8_BAR;
        PG8_WAIT_V(2); PG8_BAR;
        PG8_STAGE(PG8_SB(1, 0), cB + kstep, voffB); PG8_STAGE(PG8_SA(1, 0), cA + kstep, voffA); PG8_STAGE(PG8_SB(1, 1), cB + hstep + kstep, voffB);
        PG8_WAIT_V(6); PG8_BAR;
    } else {
        PG8_STAGE(PG8_SB(0, 0), cB, voffB); PG8_STAGE(PG8_SA(0, 0), cA, voffA); PG8_STAGE(PG8_SB(0, 1), cB + hstep, voffB); PG8_STAGE(PG8_SA(0, 1), cA + hstep, voffA);
        if (wr == 1) PG8_BAR;
        PG8_WAIT_V(4); PG8_BAR;
        PG8_STAGE(PG8_SB(1, 0), cB + kstep, voffB); PG8_STAGE(PG8_SA(1, 0), cA + kstep, voffA); PG8_STAGE(PG8_SB(1, 1), cB + hstep + kstep, voffB);
        PG8_WAIT_V(6); PG8_BAR;
    }
    for (;;) {
        const bool has_next = S.next(ui + 1, nxt);
        const char* nA = has_next ? (const char*)g.A + (size_t)nxt.pm * tstep + (size_t)nxt.kt0 * kstep : cA; const char* nB = has_next ? (const char*)g.Bt + (size_t)nxt.pnb * tstep + (size_t)nxt.kt0 * kstep : cB;
        const int nt = cur.nkt;
        for (int t = 0; t < nt; t += 2) {
            const bool last = (t == nt - 2);
            const char* a1 = cA + (size_t)(t + 1) * kstep;
            const char* a2 = last ? nA : cA + (size_t)(t + 2) * kstep; const char* b2 = last ? nB : cB + (size_t)(t + 2) * kstep;
            const char* a3 = a2 + kstep; const char* b3 = b2 + kstep;
            if (last && has_next) S.a_ready(nxt);
            if constexpr (SP2) {
            PG8_LDB(B0, 0, 0); PG8_LDB(B1, 0, 1); PG8_SCHED; PG8_LDA(At, 0, 0); PG8_STAGE(PG8_SA(1, 1), a1 + hstep, voffA);
            PG8_WAIT_V(8); PG8_WAIT_L(0); PG8_BAR; PG8_MMA(0, 0, At, B0); PG8_MMA(0, 1, At, B1); PG8_BAR; PG8_SCHED;
            PG8_LDA(At, 0, 1); PG8_STAGE(PG8_SB(0, 0), b2, voffB); PG8_STAGE(PG8_SB(0, 1), b2 + hstep, voffB); PG8_STAGE(PG8_SA(0, 0), a2, voffA);
            PG8_WAIT_V(8); PG8_WAIT_L(0); PG8_BAR; PG8_MMA(1, 0, At, B0); PG8_MMA(1, 1, At, B1); PG8_BAR; PG8_SCHED;
            PG8_LDB(B0, 1, 0); PG8_LDB(B1, 1, 1); PG8_SCHED; PG8_LDA(At, 1, 0); PG8_STAGE(PG8_SA(0, 1), a2 + hstep, voffA);
            PG8_WAIT_V(8); PG8_WAIT_L(0); PG8_BAR; PG8_MMA(0, 0, At, B0); PG8_MMA(0, 1, At, B1); PG8_BAR; PG8_SCHED;
            PG8_LDA(At, 1, 1); PG8_STAGE(PG8_SB(1, 0), b3, voffB); PG8_STAGE(PG8_SB(1, 1), b3 + hstep, voffB); PG8_STAGE(PG8_SA(1, 0), a3, voffA);
            PG8_WAIT_V(8); PG8_WAIT_L(0); PG8_BAR; PG8_MMA(1, 0, At, B0); PG8_MMA(1, 1, At, B1); PG8_BAR; PG8_SCHED;
            } else {
            PG8_LDB(B0, 0, 0); PG8_SCHED; PG8_LDA(At, 0, 0); PG8_STAGE(PG8_SA(1, 1), a1 + hstep, voffA);
            PG8_WAIT_L(8); PG8_BAR; PG8_WAIT_L(0); PG8_MMA(0, 0, At, B0); PG8_BAR; PG8_SCHED;
            PG8_LDB(B1, 0, 1); PG8_STAGE(PG8_SB(0, 0), b2, voffB);
            PG8_BAR; PG8_WAIT_L(0); PG8_MMA(0, 1, At, B1); PG8_BAR;
            PG8_LDA(At, 0, 1); PG8_STAGE(PG8_SA(0, 0), a2, voffA);
            PG8_BAR; PG8_WAIT_L(0); PG8_MMA(1, 0, At, B0); PG8_BAR; PG8_SCHED;
            PG8_STAGE(PG8_SB(0, 1), b2 + hstep, voffB);
            PG8_WAIT_V(6); PG8_BAR; PG8_MMA(1, 1, At, B1); PG8_BAR;
            PG8_LDB(B0, 1, 0); PG8_SCHED; PG8_LDA(At, 1, 0); PG8_STAGE(PG8_SA(0, 1), a2 + hstep, voffA);
            PG8_WAIT_L(8); PG8_BAR; PG8_WAIT_L(0); PG8_MMA(0, 0, At, B0); PG8_BAR; PG8_SCHED;
            PG8_LDB(B1, 1, 1); PG8_STAGE(PG8_SB(1, 0), b3, voffB);
            PG8_BAR; PG8_WAIT_L(0); PG8_MMA(0, 1, At, B1); PG8_BAR;
            PG8_LDA(At, 1, 1); PG8_STAGE(PG8_SA(1, 0), a3, voffA);
            PG8_BAR; PG8_WAIT_L(0); PG8_MMA(1, 0, At, B0); PG8_BAR; PG8_SCHED;
            PG8_STAGE(PG8_SB(1, 1), b3 + hstep, voffB);
            PG8_WAIT_V(6); PG8_BAR; PG8_MMA(1, 1, At, B1); PG8_BAR;
            }
        }
        if constexpr (FP8) asm volatile("s_nop 15\n\ts_nop 15" ::: "memory");
        if constexpr (ALIGN_EPI) { if (wr == 0) PG8_BAR; }
        if constexpr (!Epi::AFTER_DRAIN) { E(acc, cur, wr, wc, fr, fq); S.done(cur); }
        if (!has_next) break;
#pragma unroll
        for (int a = 0; a < 2; ++a)
#pragma unroll
            for (int b = 0; b < 2; ++b)
#pragma unroll
                for (int m = 0; m < 4; ++m)
#pragma unroll
                    for (int n = 0; n < 2; ++n) acc[a][b][m][n] = (f32x4){0.f, 0.f, 0.f, 0.f};
        cur = nxt; cA = nA; cB = nB; ++ui;
        if constexpr (ALIGN_EPI) { if (wr == 1) PG8_BAR; }
    }
    PG8_WAIT_V(0);
    if constexpr (!ALIGN_EPI) { if (wr == 0) PG8_BAR; }
    PG8_BAR;
    if constexpr (Epi::AFTER_DRAIN) { E.fused(acc, cur, wr, wc, fr, fq, lds, wid, lane); S.done(cur); }
#undef PG8_SA
#undef PG8_SB
#undef PG8_STAGE
#undef PG8_LDA
#undef PG8_LDB
#undef PG8_MMA
#undef PG8_WAIT_V
#undef PG8_WAIT_L
#undef PG8_BAR
#undef PG8_SCHED
}
}


namespace att {
using bf16 = __hip_bfloat16;
constexpr int   D = 128, NW = 8, QBLK = 32, KVBLK = 64;
constexpr float SCALE = 0.088388347648318440f;
constexpr float THR = 8.f;
constexpr int LDQ = 128, LDK = 128;
constexpr size_t SHM_V = KVBLK * D * 2, SHM_K = KVBLK * D * 2, SHM_ATTN = 2 * SHM_V + 2 * SHM_K + NW * 64 * 4;
using bf16x8 = __attribute__((ext_vector_type(8))) short;
using s16x4  = __attribute__((ext_vector_type(4))) short;
using f32x16 = __attribute__((ext_vector_type(16))) float;
using u32x4  = __attribute__((ext_vector_type(4))) unsigned;
#define KSWZ(row, colB) ((row) * 256 + ((colB) ^ (((row) & 7) << 4)))
#define SBAR() __builtin_amdgcn_sched_barrier(0)
__device__ __forceinline__ int crow(int r, int hi) { return (r & 3) + 8 * (r >> 2) + 4 * hi; }
__device__ __forceinline__ unsigned cvtpk(float lo, float hi) {
  unsigned r; asm volatile("v_cvt_pk_bf16_f32 %0, %1, %2" : "=v"(r) : "v"(lo), "v"(hi)); return r;
}
__device__ __forceinline__ void partialSM(f32x16& p0, f32x16& p1, float& m_reg, float& mn, float& alpha) {
  constexpr float C = SCALE * 1.4426950408889634f;
  float pmax = p0[0];
#pragma unroll
  for (int r = 1; r < 16; ++r) pmax = fmaxf(pmax, p0[r]);
#pragma unroll
  for (int r = 0; r < 16; ++r) pmax = fmaxf(pmax, p1[r]);
  { auto rr = __builtin_amdgcn_permlane32_swap(__float_as_uint(pmax), __float_as_uint(pmax), false, false);
    pmax = fmaxf(__uint_as_float(rr[0]), __uint_as_float(rr[1])); }
  if (__builtin_expect(__all(pmax - m_reg <= THR / SCALE), 1)) { mn = m_reg; alpha = 1.f; }
  else { mn = fmaxf(m_reg, pmax); alpha = __builtin_amdgcn_exp2f((m_reg - mn) * C); m_reg = mn; }
  float mnC = -mn * C;
#pragma unroll
  for (int r = 0; r < 16; ++r) p0[r] = fmaf(p0[r], C, mnC);
#pragma unroll
  for (int r = 0; r < 16; ++r) p1[r] = fmaf(p1[r], C, mnC);
#pragma unroll
  for (int r = 0; r < 16; ++r) p0[r] = __builtin_amdgcn_exp2f(p0[r]);
}
__device__ __forceinline__ void finishSM(f32x16& p0, f32x16& p1, float alpha, float& l_reg, bf16x8& pa0, bf16x8& pa1, bf16x8& pa2, bf16x8& pa3) {
#pragma unroll
  for (int r = 0; r < 16; ++r) p1[r] = __builtin_amdgcn_exp2f(p1[r]);
  float ps = 0;
#pragma unroll
  for (int r = 0; r < 16; ++r) ps += p0[r];
#pragma unroll
  for (int r = 0; r < 16; ++r) ps += p1[r];
  { auto rr = __builtin_amdgcn_permlane32_swap(__float_as_uint(ps), __float_as_uint(ps), false, false);
    ps = __uint_as_float(rr[0]) + __uint_as_float(rr[1]); }
  l_reg = l_reg * alpha + ps;
#define PK4(P, BASE, OUT) do { unsigned a0 = cvtpk(P[BASE + 0], P[BASE + 1]), a1 = cvtpk(P[BASE + 2], P[BASE + 3]);   \
    unsigned b0 = cvtpk(P[BASE + 4], P[BASE + 5]), b1 = cvtpk(P[BASE + 6], P[BASE + 7]);                              \
    auto r0 = __builtin_amdgcn_permlane32_swap(a0, b0, false, false); auto r1 = __builtin_amdgcn_permlane32_swap(a1, b1, false, false); \
    u32x4 w = {r0[0], r1[0], r0[1], r1[1]}; OUT = *reinterpret_cast<bf16x8*>(&w); } while (0)
  PK4(p0, 0, pa0); PK4(p0, 8, pa1); PK4(p1, 0, pa2); PK4(p1, 8, pa3);
#undef PK4
}
__device__ __forceinline__ void qkt(f32x16& p0, f32x16& p1, const bf16* Ks, const bf16x8* qr, int r32, int hi) {
  p0 = f32x16{}; p1 = f32x16{};
#pragma unroll
  for (int d0 = 0; d0 < 8; ++d0) { int cb = (d0 * 16 + hi * 8) * 2;
    bf16x8 b0 = *reinterpret_cast<const bf16x8*>((const char*)Ks + KSWZ(r32, cb));
    bf16x8 b1 = *reinterpret_cast<const bf16x8*>((const char*)Ks + KSWZ(32 + r32, cb));
    p0 = __builtin_amdgcn_mfma_f32_32x32x16_bf16(b0, qr[d0], p0, 0, 0, 0);
    p1 = __builtin_amdgcn_mfma_f32_32x32x16_bf16(b1, qr[d0], p1, 0, 0, 0); }
}
__device__ __forceinline__ void maskt(f32x16& p0, f32x16& p1, int kbase, int qpos, int hi) {
#pragma unroll
  for (int r = 0; r < 16; ++r) { const int d0 = qpos - (kbase + crow(r, hi)); const int d1 = d0 - 32;
    if (d0 > 128 || d0 < -128) p0[r] = -1e30f;
    if (d1 > 128 || d1 < -128) p1[r] = -1e30f; }
}
__device__ __forceinline__ int v_st(int k, int c) { const int kk = (k & ~0xC) | ((k & 4) << 1) | ((k & 8) >> 1); return ((kk >> 3) * 4 + (c >> 5)) * 512 + ((kk & 7) * 32 + (c & 31)) * 2; }
__device__ __forceinline__ int v_rd_base(int lane) { return ((lane & 3) << 3) | (((lane >> 2) & 3) << 6) | (((lane >> 4) & 1) << 5) | (((lane >> 5) & 1) << 8); }
constexpr int v_rd_off(int d0, int ks, int half) { return d0 * 512 + ks * 4096 + half * 2048; }
template <int OFF> __device__ __forceinline__ s16x4 tr_read(int vb) {
  s16x4 r; asm volatile("ds_read_b64_tr_b16 %0, %1 offset:%2" : "=&v"(r) : "v"(vb), "i"(OFF) : "memory"); return r;
}
template <int D0> __device__ __forceinline__ void pv_one(f32x16& od, int vb, bf16x8 pa0, bf16x8 pa1, bf16x8 pa2, bf16x8 pa3) {
  const s16x4 l0 = tr_read<v_rd_off(D0, 0, 0)>(vb), h0 = tr_read<v_rd_off(D0, 0, 1)>(vb), l1 = tr_read<v_rd_off(D0, 1, 0)>(vb), h1 = tr_read<v_rd_off(D0, 1, 1)>(vb);
  const s16x4 l2 = tr_read<v_rd_off(D0, 2, 0)>(vb), h2 = tr_read<v_rd_off(D0, 2, 1)>(vb), l3 = tr_read<v_rd_off(D0, 3, 0)>(vb), h3 = tr_read<v_rd_off(D0, 3, 1)>(vb);
  asm volatile("s_waitcnt lgkmcnt(0)" ::: "memory"); SBAR();
#define PK(L, H) (bf16x8){L[0], L[1], L[2], L[3], H[0], H[1], H[2], H[3]}
  od = __builtin_amdgcn_mfma_f32_32x32x16_bf16(pa0, PK(l0, h0), od, 0, 0, 0);
  od = __builtin_amdgcn_mfma_f32_32x32x16_bf16(pa1, PK(l1, h1), od, 0, 0, 0);
  od = __builtin_amdgcn_mfma_f32_32x32x16_bf16(pa2, PK(l2, h2), od, 0, 0, 0);
  od = __builtin_amdgcn_mfma_f32_32x32x16_bf16(pa3, PK(l3, h3), od, 0, 0, 0);
#undef PK
}
__device__ __forceinline__ void pv_d0(f32x16* o, int vb, bf16x8 pa0, bf16x8 pa1, bf16x8 pa2, bf16x8 pa3) {
  pv_one<0>(o[0], vb, pa0, pa1, pa2, pa3); pv_one<1>(o[1], vb, pa0, pa1, pa2, pa3); pv_one<2>(o[2], vb, pa0, pa1, pa2, pa3); pv_one<3>(o[3], vb, pa0, pa1, pa2, pa3);
}

template <bool MASK, bool OUT_BF16>
__device__ __forceinline__ void attn_unit(const bf16* __restrict__ Qb, const bf16* __restrict__ Kh, const bf16* __restrict__ Vh, void* __restrict__ Ob, int ldo,
                                          int klo, int nt1, int NT, int qpos0, float m_init, float l_init, char* lds, const float* __restrict__ qgain, bool qrope, const float* cs) {
  int tid = threadIdx.x; asm volatile("" : "+v"(tid));
  const int wid = tid >> 6, lane = tid & 63, r32 = lane & 31, hi = lane >> 5;
  bf16* V_lds = (bf16*)lds; bf16* K_lds = (bf16*)(lds + 2 * SHM_V);
  float* ws = (float*)(lds + 2 * SHM_V + 2 * SHM_K) + wid * 64; float* li_l = ws; float* al_l = ws + 32;
  float m_reg = m_init, l_reg = l_init; f32x16 o[4] = {}; bf16x8 qr[8];
  const bf16* Qw = Qb + (long)(wid * QBLK + r32) * LDQ + hi * 8;
#pragma unroll
  for (int d0 = 0; d0 < 8; ++d0) qr[d0] = *reinterpret_cast<const bf16x8*>(Qw + d0 * 16);
  const int qpos = qpos0 + wid * QBLK + r32;
  {
    float f[8][8]; float ss = 0.f;
#pragma unroll
    for (int d0 = 0; d0 < 8; ++d0)
#pragma unroll
      for (int j = 0; j < 8; ++j) { const unsigned short h = (unsigned short)qr[d0][j]; f[d0][j] = __uint_as_float((unsigned)h << 16); ss += f[d0][j] * f[d0][j]; }
    ss += __shfl_xor(ss, 32);
    const float rs = 1.0f / sqrtf(ss * (1.f / 128.f) + 1e-6f);
#pragma unroll
    for (int d0 = 0; d0 < 8; ++d0)
#pragma unroll
      for (int j = 0; j < 8; ++j) f[d0][j] *= rs * qgain[d0 * 16 + hi * 8 + j];
    if (qrope) {
      const int prow = qpos >> 6, pcol = qpos & 63;
#pragma unroll
      for (int dd = 0; dd < 4; ++dd) { const int d0 = (dd & 1) + 4 * (dd >> 1); const int p = (dd >> 1) ? pcol : prow;
#pragma unroll
        for (int j = 0; j < 8; ++j) { const int i = (d0 & 1) * 16 + hi * 8 + j; const float c = cs[(p * 32 + i) * 2], s = cs[(p * 32 + i) * 2 + 1];
          const float x1 = f[d0][j], x2 = f[d0 + 2][j]; f[d0][j] = x1 * c - x2 * s; f[d0 + 2][j] = x2 * c + x1 * s; } }
    }
#pragma unroll
    for (int d0 = 0; d0 < 8; ++d0) { u32x4 w = {cvtpk(f[d0][0], f[d0][1]), cvtpk(f[d0][2], f[d0][3]), cvtpk(f[d0][4], f[d0][5]), cvtpk(f[d0][6], f[d0][7])}; qr[d0] = *reinterpret_cast<bf16x8*>(&w); }
  }
  const int sr = tid >> 4, sc = (tid & 15) * 8, vst0 = v_st(sr, sc), vst1 = v_st(32 + sr, sc);
  const int vb0 = (int)(uintptr_t)V_lds + v_rd_base(lane);
  struct { bf16x8 vs0, vs1, ks0, ks1; } sr_[2];
#define KROW(t) ((t) < nt1 ? klo + (t) * KVBLK : 4096 + ((t) - nt1) * KVBLK)
#define SLOAD(i, t) do { const int k0_ = KROW(t); sr_[i].vs0 = *reinterpret_cast<const bf16x8*>(&Vh[(long)(k0_ + sr) * LDK + sc]); sr_[i].vs1 = *reinterpret_cast<const bf16x8*>(&Vh[(long)(k0_ + 32 + sr) * LDK + sc]); \
    sr_[i].ks0 = *reinterpret_cast<const bf16x8*>(&Kh[(long)(k0_ + sr) * LDK + sc]); sr_[i].ks1 = *reinterpret_cast<const bf16x8*>(&Kh[(long)(k0_ + 32 + sr) * LDK + sc]); } while (0)
#define SWRITE(b, i) do { *(bf16x8*)((char*)V_lds + (b) * SHM_V + vst0) = sr_[i].vs0;          \
    *(bf16x8*)((char*)V_lds + (b) * SHM_V + vst1) = sr_[i].vs1; int kc = sc * 2;               \
    *(bf16x8*)((char*)K_lds + (b) * SHM_K + KSWZ(sr, kc)) = sr_[i].ks0;                       \
    *(bf16x8*)((char*)K_lds + (b) * SHM_K + KSWZ(32 + sr, kc)) = sr_[i].ks1; } while (0)
#define SWAIT() asm volatile("s_waitcnt vmcnt(4)" ::: "memory")
#define RESC(a) do { if (__any((a) < 1.f)) { if (hi == 0) al_l[r32] = (a); asm volatile("s_waitcnt lgkmcnt(0)" ::: "memory"); \
    _Pragma("unroll") for (int d = 0; d < 4; ++d) _Pragma("unroll") for (int r = 0; r < 16; ++r) o[d][r] *= al_l[crow(r, hi)]; } } while (0)
#define MASKT(P0, P1, t) do { if (MASK) { if ((t) < nt1) maskt(P0, P1, klo + (t) * KVBLK, qpos, hi); } } while (0)
  f32x16 pA0, pA1, pB0, pB1; float mnA, mnB, alA, alB; bf16x8 pa0, pa1, pa2, pa3;
  constexpr int SE = 0, SO = 1;
  SLOAD(SE, 0); asm volatile("s_waitcnt vmcnt(0)" ::: "memory"); SWRITE(0, SE); __syncthreads();
  qkt(pA0, pA1, K_lds, qr, r32, hi); MASKT(pA0, pA1, 0); partialSM(pA0, pA1, m_reg, mnA, alA);
  SLOAD(SO, 1); if (2 < NT) SLOAD(SE, 2);
  SWAIT(); SWRITE(1, SO); __syncthreads();
  for (int j = 1; j + 1 < NT; j += 2) {
    SBAR(); qkt(pB0, pB1, (bf16*)((char*)K_lds + SHM_K), qr, r32, hi);
    finishSM(pA0, pA1, alA, l_reg, pa0, pa1, pa2, pa3); SBAR();
    SLOAD(SO, j + 2); SBAR();
    pv_d0(o, vb0, pa0, pa1, pa2, pa3); MASKT(pB0, pB1, j); partialSM(pB0, pB1, m_reg, mnB, alB);
    __syncthreads(); SWAIT(); SWRITE(0, SE);
    RESC(alB); __syncthreads();
    SBAR(); qkt(pA0, pA1, K_lds, qr, r32, hi);
    finishSM(pB0, pB1, alB, l_reg, pa0, pa1, pa2, pa3); SBAR();
    if (j + 3 < NT) SLOAD(SE, j + 3); SBAR();
    pv_d0(o, vb0 + (int)SHM_V, pa0, pa1, pa2, pa3); MASKT(pA0, pA1, j + 1); partialSM(pA0, pA1, m_reg, mnA, alA);
    __syncthreads(); SWAIT(); SWRITE(1, SO);
    RESC(alA); __syncthreads();
  }
  SBAR(); qkt(pB0, pB1, (bf16*)((char*)K_lds + SHM_K), qr, r32, hi);
  finishSM(pA0, pA1, alA, l_reg, pa0, pa1, pa2, pa3); SBAR();
  pv_d0(o, vb0, pa0, pa1, pa2, pa3); MASKT(pB0, pB1, NT - 1); partialSM(pB0, pB1, m_reg, mnB, alB);
  __syncthreads(); RESC(alB);
  finishSM(pB0, pB1, alB, l_reg, pa0, pa1, pa2, pa3); SBAR();
  pv_d0(o, vb0 + (int)SHM_V, pa0, pa1, pa2, pa3);
  if (hi == 0) li_l[r32] = l_reg; asm volatile("s_waitcnt lgkmcnt(0)" ::: "memory");
  float rli[16];
#pragma unroll
  for (int r = 0; r < 16; ++r) rli[r] = __builtin_amdgcn_rcpf(li_l[crow(r, hi)]);
  if constexpr (OUT_BF16) {
    bf16* Ow = (bf16*)Ob + (long)(wid * QBLK) * ldo;
#pragma unroll
    for (int r = 0; r < 16; ++r) { int orow = crow(r, hi);
#pragma unroll
      for (int d0 = 0; d0 < 4; ++d0) { const float ov = o[d0][r] * rli[r]; ((unsigned short*)Ow)[(long)orow * ldo + d0 * 32 + r32] = (unsigned short)cvtpk(ov, ov); } }
  } else {
    float* Ow = (float*)Ob + (long)(wid * QBLK) * ldo;
#pragma unroll
    for (int r = 0; r < 16; ++r) { int orow = crow(r, hi);
#pragma unroll
      for (int d0 = 0; d0 < 4; ++d0) Ow[(long)orow * ldo + d0 * 32 + r32] = o[d0][r] * rli[r]; }
  }
  __syncthreads();
#undef KROW
#undef SLOAD
#undef SWRITE
#undef SWAIT
#undef RESC
#undef MASKT
}
#undef KSWZ
#undef SBAR
}

constexpr int NWAVES = 8;
constexpr int D = 2048, NB = 2, SEQ = 4096, CTXL = 256;
constexpr int TL = NB * SEQ, TC = NB * CTXL, MR = TL + TC;
constexpr int KVR = SEQ + CTXL;
constexpr int EVEN_IN = 4608, ODD_IN = 3072, DFF = 5632, DFE = 7168, NE = 8, MODW = 6 * D;
constexpr int NSLOT0 = 36, NSLOT1 = 24;
constexpr int MAXT = 72, XROWS = MAXT * 256;
constexpr float EPS = 1e-6f;
constexpr float LAM_INIT = 0.2f;

constexpr size_t MiB = 1u << 20;
constexpr size_t WS_CTL = 0, CTL_ZERO_BYTES = 1 * MiB;
constexpr size_t WS_MODS = 1 * MiB;
constexpr size_t WS_LAM = WS_MODS + 512 * 1024;
constexpr size_t WS_ROUTE = 2 * MiB;
constexpr size_t RT_EID = WS_ROUTE, RT_GATE = WS_ROUTE + 64 * 1024, RT_POS = WS_ROUTE + 128 * 1024, RT_ROWTOK = WS_ROUTE + 192 * 1024, RT_ROWGATE = WS_ROUTE + 272 * 1024,
                 RT_TILE_E = WS_ROUTE + 352 * 1024, RT_NTILES = WS_ROUTE + 353 * 1024;
constexpr size_t WS_WT_EIN = 4 * MiB, WS_WT_EOUT = 22 * MiB, WS_WT_EF1 = 30 * MiB, WS_WT_EF2 = 74 * MiB, WS_WT_OIN = 96 * MiB, WS_WT_OOUT = 108 * MiB,
                 WS_WT_X1 = 116 * MiB, WS_WT_X2 = 564 * MiB;
constexpr size_t WS_H = 788 * MiB, WS_Z = 822 * MiB, WS_QKV = 900 * MiB, WS_PB = 978 * MiB, WS_OALL = 1046 * MiB, WS_X1 = 1080 * MiB, WS_X3 = 1148 * MiB,
                 WS_ACT = 1212 * MiB, WS_XS = 1306 * MiB, WS_ACT2 = 1378 * MiB, WS_YS = 1630 * MiB, WS_PART = 1774 * MiB, WS_END = 1838 * MiB;
static_assert(WS_WT_EIN + (size_t)EVEN_IN * D * 2 <= WS_WT_EOUT && WS_WT_EF1 + (size_t)2 * DFF * D * 2 <= WS_WT_EF2 && WS_WT_EF2 + (size_t)D * DFF * 2 <= WS_WT_OIN &&
              WS_WT_OIN + (size_t)ODD_IN * D * 2 <= WS_WT_OOUT && WS_WT_X1 + (size_t)NE * 2 * DFE * D * 2 <= WS_WT_X2 && WS_WT_X2 + (size_t)NE * D * DFE * 2 <= WS_H &&
              WS_H + (size_t)MR * D * 2 <= WS_Z && WS_Z + (size_t)MR * EVEN_IN * 2 <= WS_QKV && WS_QKV + (size_t)NB * NSLOT0 * KVR * 128 * 2 <= WS_PB &&
              WS_PB + (size_t)NB * 16 * KVR * 128 * 4 <= WS_OALL && WS_OALL + (size_t)MR * D * 2 <= WS_X1 && WS_X1 + (size_t)MR * D * 4 <= WS_X3 && WS_X3 + (size_t)TL * D * 4 <= WS_ACT &&
              WS_ACT + (size_t)MR * DFF * 2 <= WS_XS && WS_XS + (size_t)XROWS * D * 2 <= WS_ACT2 && WS_ACT2 + (size_t)XROWS * DFE * 2 <= WS_YS && WS_YS + (size_t)XROWS * D * 4 <= WS_PART && WS_PART + 64 * MiB <= WS_END, "d_ws map");
constexpr int CW_BAR = 4096;

constexpr int RING_BYTES = 131072;
constexpr int LDSCTL_OFF = 143360, MISC_OFF = LDSCTL_OFF + 320;
constexpr int LDS_BYTES = 147456;

#define GAS __attribute__((address_space(1)))
#define LAS __attribute__((address_space(3)))
typedef unsigned short bf16;
typedef unsigned v4u __attribute__((ext_vector_type(4)));
typedef unsigned v2u __attribute__((ext_vector_type(2)));
typedef float f32x4 __attribute__((ext_vector_type(4)));
typedef GAS unsigned gu32;
#define RLX_AGENT __ATOMIC_RELAXED, __HIP_MEMORY_SCOPE_AGENT
#define LDS_WAIT() asm volatile("s_waitcnt lgkmcnt(0)" ::: "memory")
#define VM_WAIT() asm volatile("s_waitcnt vmcnt(0)" ::: "memory")
__device__ __forceinline__ unsigned f2bf(float f) { unsigned u = __builtin_bit_cast(unsigned, f); return (u + 0x7fffu + ((u >> 16) & 1u)) >> 16; }
__device__ __forceinline__ unsigned pk2(float lo, float hi) { return f2bf(lo) | (f2bf(hi) << 16); }
using pg8::pk4_fp8;
constexpr float W8_SCALE = 64.f;
__device__ __forceinline__ float bflo(unsigned w) { return __builtin_bit_cast(float, w << 16); }
__device__ __forceinline__ float bfhi(unsigned w) { return __builtin_bit_cast(float, w & 0xffff0000u); }
__device__ __forceinline__ float wave_sum(float v) {
#pragma unroll
    for (int o = 1; o < 64; o <<= 1) v += __shfl_xor(v, o);
    return v;
}

#define XB_TMO      128
#define XB_XCNT(j)  (256  + 64 * (j))
#define XB_XSUB(j)  (1280 + 64 * (j))
#define XB_XGEN(j)  (2304 + 64 * (j))
#define XB_TOP      3328
#define XB_TOPGEN   3392
#define XCD_BAR_WORDS 3456
#define XB_SPIN_CAP (1u << 18)

__device__ __forceinline__ unsigned xb_ld(unsigned* p)              { return __hip_atomic_load(p, __ATOMIC_RELAXED, __HIP_MEMORY_SCOPE_AGENT); }
__device__ __forceinline__ unsigned xb_add(unsigned* p, unsigned v) { return __hip_atomic_fetch_add(p, v, __ATOMIC_RELAXED, __HIP_MEMORY_SCOPE_AGENT); }
__device__ __forceinline__ unsigned xb_xcc_id() { return (unsigned)__builtin_amdgcn_s_getreg((3 << 11) | 20) & 0xFu; }
#define XB_SPIN(cond, bar) do { unsigned _sp = 0; while (cond) { __builtin_amdgcn_s_sleep(1); \
    if ((++_sp & 255u) == 0u) { if (xb_ld(&(bar)[XB_TMO])) break; if (_sp > XB_SPIN_CAP) { atomicAdd(&(bar)[XB_TMO], 1u); break; } } } } while (0)

struct XcdBarrier {
    unsigned* bar; unsigned x;
    volatile LAS unsigned* st;
};

__device__ __forceinline__ XcdBarrier xcd_barrier_post(unsigned* bar, volatile LAS unsigned* st) {
    XcdBarrier b; b.bar = bar; b.x = xb_xcc_id(); b.st = st;
    if (threadIdx.x == 0) (void)xb_add(&bar[XB_XCNT(b.x)], 1u);
    return b;
}
__device__ __forceinline__ void xcd_barrier_complete(unsigned* bar, unsigned x, unsigned& nloc, unsigned& nx) {
    const unsigned G = gridDim.x * gridDim.y * gridDim.z;
    unsigned sum, cnt, mine, sp = 0u;
    for (;;) {
        sum = 0u; cnt = 0u; mine = 0u;
#pragma unroll
        for (unsigned j = 0; j < 16; ++j) { const unsigned c = xb_ld(&bar[XB_XCNT(j)]); sum += c; cnt += (c > 0u) ? 1u : 0u; mine = (j == x) ? c : mine; }
        if (sum == G) break;
        __builtin_amdgcn_s_sleep(1);
        if ((++sp & 255u) == 0u) { if (xb_ld(&bar[XB_TMO])) break; if (sp > XB_SPIN_CAP) { atomicAdd(&bar[XB_TMO], 1u); break; } }
    }
    nloc = mine > 0u ? mine : 1u; nx = cnt > 0u ? cnt : 1u;
}

__device__ __forceinline__ void xcd_barrier(const XcdBarrier& b) {
    asm volatile("s_waitcnt vmcnt(0)" ::: "memory");
    __syncthreads();
    if (threadIdx.x == 0) {
        unsigned* bar = b.bar;
        __builtin_amdgcn_s_waitcnt(0);
        unsigned nloc = b.st[0], nx = b.st[1];
        if (nloc == 0u) { xcd_barrier_complete(bar, b.x, nloc, nx); b.st[0] = nloc; b.st[1] = nx; }
        const unsigned old = xb_add(&bar[XB_XSUB(b.x)], 1u);
        const unsigned gen = old / nloc;
        if (old + 1u == (gen + 1u) * nloc) {
            __builtin_amdgcn_fence(__ATOMIC_RELEASE, "agent");
            asm volatile("s_waitcnt vmcnt(0)" ::: "memory");
            const unsigned og = xb_add(&bar[XB_TOP], 1u);
            const unsigned tg = og / nx;
            if (og + 1u == (tg + 1u) * nx) xb_add(&bar[XB_TOPGEN], 1u);
            else XB_SPIN(xb_ld(&bar[XB_TOPGEN]) == tg, bar);
            __builtin_amdgcn_fence(__ATOMIC_ACQUIRE, "agent");
            xb_add(&bar[XB_XGEN(b.x)], 1u);
            asm volatile("s_waitcnt vmcnt(0)" ::: "memory");
        } else {
            XB_SPIN(xb_ld(&bar[XB_XGEN(b.x)]) == gen, bar);
            __builtin_amdgcn_fence(__ATOMIC_ACQUIRE, "agent");
            asm volatile("s_waitcnt vmcnt(0)" ::: "memory");
        }
    }
    __syncthreads();
}


struct Ctx {
    LAS unsigned char* lds; int tid, lane, wave, G, c, gw, NGW;
};

__device__ __forceinline__ void transpose_item(const float* __restrict__ W, int K, int N, bf16* __restrict__ WT, int q, int kind, LAS float* scr, int lane) {
    const int nblk = N >> 6, kb = q / nblk, nb = q - kb * nblk, k0 = kb * 64, n0 = nb * 64;
    int dest0 = n0;
    if (kind) { const int hf = N >> 1; const int j = n0 < hf ? n0 : n0 - hf; dest0 = (j >> 7) * 256 + (j & 127) + (n0 < hf ? 0 : 128); }
    const int l16 = lane & 15, kq = lane >> 4;
    f32x4 v[16];
#pragma unroll
    for (int i = 0; i < 16; ++i) v[i] = __builtin_nontemporal_load((const f32x4*)(W + (size_t)(k0 + 4 * i + kq) * N + n0 + 4 * l16));
#pragma unroll
    for (int i = 0; i < 16; ++i) { LAS float* p = scr + (4 * i + kq) * 65 + 4 * l16; p[0] = v[i].x; p[1] = v[i].y; p[2] = v[i].z; p[3] = v[i].w; }
    LDS_WAIT(); asm volatile("" ::: "memory");
    const int c = lane & 7, nn = lane >> 3;
#pragma unroll
    for (int jj = 0; jj < 8; ++jj) { const int n = nn + 8 * jj; const LAS float* s = scr + (8 * c) * 65 + n;
        v4u o; o.x = pk2(s[0 * 65], s[1 * 65]); o.y = pk2(s[2 * 65], s[3 * 65]); o.z = pk2(s[4 * 65], s[5 * 65]); o.w = pk2(s[6 * 65], s[7 * 65]);
        __builtin_nontemporal_store(o, (v4u*)(WT + (size_t)(dest0 + n) * K + k0 + 8 * c)); }
    LDS_WAIT(); asm volatile("" ::: "memory");
}

__device__ __forceinline__ void transpose_item8(const float* __restrict__ W, int K, int N, unsigned char* __restrict__ WT, int q, int kind, LAS float* scr, int lane) {
    const int nblk = N >> 5, kb = q / nblk, nb = q - kb * nblk, k0 = kb * 128, n0 = nb * 32;
    int dest0 = n0;
    if (kind) { const int hf = N >> 1; const int j = n0 < hf ? n0 : n0 - hf; dest0 = (j >> 7) * 256 + (j & 127) + (n0 < hf ? 0 : 128); }
    const int l8 = lane & 7, kq = lane >> 3;
    f32x4 v[16];
#pragma unroll
    for (int i = 0; i < 16; ++i) v[i] = __builtin_nontemporal_load((const f32x4*)(W + (size_t)(k0 + 8 * i + kq) * N + n0 + 4 * l8));
#pragma unroll
    for (int i = 0; i < 16; ++i) { LAS float* p = scr + (8 * i + kq) * 33 + 4 * l8; p[0] = v[i].x; p[1] = v[i].y; p[2] = v[i].z; p[3] = v[i].w; }
    LDS_WAIT(); asm volatile("" ::: "memory");
    const int c = lane & 7, nn = lane >> 3;
#pragma unroll
    for (int jj = 0; jj < 4; ++jj) { const int n = nn + 8 * jj; const LAS float* s = scr + (16 * c) * 33 + n;
        v4u o; o.x = pk4_fp8(s[0 * 33] * W8_SCALE, s[1 * 33] * W8_SCALE, s[2 * 33] * W8_SCALE, s[3 * 33] * W8_SCALE); o.y = pk4_fp8(s[4 * 33] * W8_SCALE, s[5 * 33] * W8_SCALE, s[6 * 33] * W8_SCALE, s[7 * 33] * W8_SCALE);
        o.z = pk4_fp8(s[8 * 33] * W8_SCALE, s[9 * 33] * W8_SCALE, s[10 * 33] * W8_SCALE, s[11 * 33] * W8_SCALE); o.w = pk4_fp8(s[12 * 33] * W8_SCALE, s[13 * 33] * W8_SCALE, s[14 * 33] * W8_SCALE, s[15 * 33] * W8_SCALE);
        __builtin_nontemporal_store(o, (v4u*)(WT + (size_t)(dest0 + n) * K + k0 + 16 * c)); }
    LDS_WAIT(); asm volatile("" ::: "memory");
}

constexpr int MOD_TASKS = 2 * (MODW / 32);
__device__ __forceinline__ void mod_fill_silu(const Ctx& X, const float* cvec, const float* cctx) {
    LAS float* S = (LAS float*)X.lds;
    for (int idx = X.tid; idx < 3 * 2048; idx += NWAVES * 64) { const int i = idx >> 11, k = idx & 2047; const float cv = i < 2 ? cvec[i * 2048 + k] : cctx[k]; S[idx] = cv / (1.f + expf(-cv)); }
    __syncthreads();
}
__device__ __forceinline__ void mod_task(const Ctx& X, int task, const float* Wm, const float* bm, float* mods_l) {
    const int ch = task % (MODW / 32);
    LAS float* S = (LAS float*)X.lds;
    LAS float* R = S + 3 * 2048;
    const int kq = X.lane >> 3, c4 = X.lane & 7;
    f32x4 a0 = {0.f, 0.f, 0.f, 0.f}, a1 = a0, a2 = a0;
    const float* wp = Wm + (size_t)(X.wave * 256 + kq) * MODW + ch * 32 + 4 * c4;
    for (int k = 0; k < 256; k += 64) {
        f32x4 w[8];
#pragma unroll
        for (int u = 0; u < 8; ++u) w[u] = __builtin_nontemporal_load((const f32x4*)(wp + (size_t)(k + 8 * u) * MODW));
#pragma unroll
        for (int u = 0; u < 8; ++u) { const int kk = X.wave * 256 + k + 8 * u + kq; a0 += w[u] * S[kk]; a1 += w[u] * S[2048 + kk]; a2 += w[u] * S[4096 + kk]; }
    }
#pragma unroll
    for (int j = 0; j < 4; ++j) {
#pragma unroll
        for (int o = 8; o < 64; o <<= 1) { a0[j] += __shfl_xor(a0[j], o); a1[j] += __shfl_xor(a1[j], o); a2[j] += __shfl_xor(a2[j], o); } }
    if (kq == 0) {
#pragma unroll
        for (int j = 0; j < 4; ++j) { R[(X.wave * 3 + 0) * 32 + 4 * c4 + j] = a0[j]; R[(X.wave * 3 + 1) * 32 + 4 * c4 + j] = a1[j]; R[(X.wave * 3 + 2) * 32 + 4 * c4 + j] = a2[j]; } }
    __syncthreads();
    if (X.tid < 96) { const int i = X.tid >> 5, col = X.tid & 31; float s = 0.f;
#pragma unroll
        for (int w = 0; w < 8; ++w) s += R[(w * 3 + i) * 32 + col];
        mods_l[(size_t)i * MODW + ch * 32 + col] = s + bm[ch * 32 + col]; }
    __syncthreads();
}

template <bool ROUTER, bool PSUM = false, bool OUT8 = false>
__device__ __forceinline__ void norm_mod_rows(const Ctx& X, const float* src_lat, const float* src_ctx, int nrows, const float* gain, const float* mods_l, int sh_i, int sc_i, bf16* H,
                                              const float* wrouter, int* eid, float* egate, const float* part = nullptr, int Sp = 0, const float* pgate = nullptr, float* wb = nullptr) {
    LAS float* WR = (LAS float*)X.lds;
    if (ROUTER) { for (int idx = X.tid; idx < 8 * 2048; idx += NWAVES * 64) { const int k = idx >> 3, e = idx & 7; WR[e * 2048 + k] = wrouter[idx]; } __syncthreads(); }
    f32x4 vn[8];
    if (X.gw < nrows) { const float* xr = X.gw < TL ? src_lat + (size_t)X.gw * D : src_ctx + (size_t)(X.gw - TL) * D;
#pragma unroll
        for (int j = 0; j < 8; ++j) vn[j] = __builtin_nontemporal_load((const f32x4*)(xr + 4 * X.lane + 256 * j)); }
    for (int row = X.gw; row < nrows; row += X.NGW) {
        const int cond = row < SEQ ? 0 : (row < TL ? 1 : 2);
        const float* shp = mods_l + (size_t)cond * MODW + sh_i * D; const float* scp = mods_l + (size_t)cond * MODW + sc_i * D;
        f32x4 v[8]; float ss = 0.f;
#pragma unroll
        for (int j = 0; j < 8; ++j) v[j] = vn[j];
        { const int nr = row + X.NGW; if (nr < nrows) { const float* xr = nr < TL ? src_lat + (size_t)nr * D : src_ctx + (size_t)(nr - TL) * D;
#pragma unroll
            for (int j = 0; j < 8; ++j) vn[j] = __builtin_nontemporal_load((const f32x4*)(xr + 4 * X.lane + 256 * j)); } }
        if (PSUM) { if (row >= TL) {
            f32x4 a[8];
#pragma unroll
            for (int j = 0; j < 8; ++j) a[j] = (f32x4){0.f, 0.f, 0.f, 0.f};
            for (int p = 0; p < Sp; ++p) { const float* pr = part + ((size_t)p * TC + (row - TL)) * D + 4 * X.lane;
#pragma unroll
                for (int j = 0; j < 8; ++j) a[j] += __builtin_nontemporal_load((const f32x4*)(pr + 256 * j)); }
#pragma unroll
            for (int j = 0; j < 8; ++j) { v[j] += a[j] * *(const f32x4*)(pgate + 4 * X.lane + 256 * j); if (wb) *(f32x4*)(wb + (size_t)(row - TL) * D + 4 * X.lane + 256 * j) = v[j]; }
        } }
#pragma unroll
        for (int j = 0; j < 8; ++j) ss += (v[j].x * v[j].x + v[j].y * v[j].y) + (v[j].z * v[j].z + v[j].w * v[j].w);
        const float rstd = 1.0f / sqrtf(wave_sum(ss) * (1.f / D) + EPS);
#pragma unroll
        for (int j = 0; j < 8; ++j) { const int col = 4 * X.lane + 256 * j; const f32x4 g = *(const f32x4*)(gain + col), sc = *(const f32x4*)(scp + col), sh = *(const f32x4*)(shp + col);
            v[j] = (v[j] * rstd * g) * (sc + 1.0f) + sh;
            if (OUT8) { *(unsigned*)((unsigned char*)H + (size_t)row * D + col) = pk4_fp8(v[j].x, v[j].y, v[j].z, v[j].w); }
            else { v2u o; o.x = pk2(v[j].x, v[j].y); o.y = pk2(v[j].z, v[j].w); *(v2u*)(H + (size_t)row * D + col) = o; } }
        if (ROUTER) {
            float v1 = -3.0e38f, v2 = -3.0e38f; int i1 = 0, i2 = 0;
#pragma unroll 1
            for (int e = 0; e < 8; ++e) { float a = 0.f;
#pragma unroll
                for (int j = 0; j < 8; ++j) { const f32x4 w = *(const LAS f32x4*)(WR + e * 2048 + 4 * X.lane + 256 * j); a += (v[j].x * w.x + v[j].y * w.y) + (v[j].z * w.z + v[j].w * w.w); }
                const float s = wave_sum(a);
                if (s > v1) { v2 = v1; i2 = i1; v1 = s; i1 = e; } else if (s > v2) { v2 = s; i2 = e; } }
            const float ex = expf(v2 - v1), g1 = 1.f / (1.f + ex), g2 = ex / (1.f + ex);
            if (X.lane == 0) { eid[row * 2] = i1; eid[row * 2 + 1] = i2; egate[row * 2] = g1; egate[row * 2 + 1] = g2; }
        }
    }
}

template <int NG>
__device__ __forceinline__ void qkv_post(const Ctx& X, const bf16* z, bf16* QKV, const float* qn_a, const float* kn_a, const float* qn_b, const float* kn_b) {
    typedef float f32x2 __attribute__((ext_vector_type(2)));
    LAS f32x2* CS = (LAS f32x2*)X.lds;
    for (int idx = X.tid; idx < 2048; idx += NWAVES * 64) { const int p = idx >> 5, i = idx & 31; const float inv = exp2f(-(float)i * (13.287712379549449f / 32.0f)); const float a = (float)p * inv;
        float sn, cs; sincosf(a, &sn, &cs); CS[idx] = (f32x2){cs, sn}; }
    __syncthreads();
    const int l16 = X.lane & 15, gq = X.lane >> 4, chunk = l16 >> 2;
    v4u rawn = {0u, 0u, 0u, 0u};
    if (X.gw < MR) rawn = *(const v4u*)(z + (size_t)X.gw * (NG * 128) + gq * 128 + 8 * l16);
    for (int row = X.gw; row < MR; row += X.NGW) {
        const bool lat = row < TL; const int b = lat ? (row >> 12) : ((row - TL) >> 8); const int pos = lat ? (row & 4095) : (SEQ + ((row - TL) & 255));
        const int p = (chunk < 2) ? (pos >> 6) : (pos & 63);
#pragma unroll 1
        for (int it = 0; it < NG / 4; ++it) {
            const int g = it * 4 + gq;
            const float* gp; bool hn;
            if (NG == NSLOT0) { hn = !(g == 10 || g == 11 || g >= 28); gp = g < 8 ? qn_a : (g < 12 ? kn_a : (g < 20 ? qn_b : kn_b)); }
            else { hn = g < 20; gp = g < 16 ? qn_a : kn_a; }
            const v4u raw = rawn;
            { const bool same = it + 1 < NG / 4; const int nrow = same ? row : row + X.NGW, ng = same ? g + 4 : gq; if (nrow < MR) rawn = *(const v4u*)(z + (size_t)nrow * (NG * 128) + ng * 128 + 8 * l16); }
            float v[8] = {bflo(raw.x), bfhi(raw.x), bflo(raw.y), bfhi(raw.y), bflo(raw.z), bfhi(raw.z), bflo(raw.w), bfhi(raw.w)};
            float ss = 0.f;
#pragma unroll
            for (int j = 0; j < 8; ++j) ss += v[j] * v[j];
            ss += __shfl_xor(ss, 1); ss += __shfl_xor(ss, 2); ss += __shfl_xor(ss, 4); ss += __shfl_xor(ss, 8);
            const float rs = 1.0f / sqrtf(ss * (1.f / 128.f) + EPS);
            const f32x4 ga = *(const f32x4*)(gp + 8 * l16), gb = *(const f32x4*)(gp + 8 * l16 + 4);
            const float gg[8] = {ga.x, ga.y, ga.z, ga.w, gb.x, gb.y, gb.z, gb.w};
#pragma unroll
            for (int j = 0; j < 8; ++j) v[j] = hn ? v[j] * rs * gg[j] : v[j];
            float o[8];
#pragma unroll
            for (int j = 0; j < 8; ++j) { const float pv = __shfl_xor(v[j], 4); const f32x2 cs = CS[p * 32 + 8 * (l16 & 3) + j];
                const float rot = (chunk & 1) ? (v[j] * cs.x + pv * cs.y) : (v[j] * cs.x - pv * cs.y); o[j] = (hn && lat) ? rot : v[j]; }
            v4u w; w.x = pk2(o[0], o[1]); w.y = pk2(o[2], o[3]); w.z = pk2(o[4], o[5]); w.w = pk2(o[6], o[7]);
            *(v4u*)(QKV + ((size_t)(b * NG + g) * KVR + pos) * 128 + 8 * l16) = w;
        }
    }
}

template <int NG>
__device__ __forceinline__ void k_post(const Ctx& X, bf16* QKV, const float* kn_a, const float* kn_b, const float* cs_lds) {
    constexpr int NK = (NG == NSLOT0) ? 10 : 4;
    const int l16 = X.lane & 15, rq = X.lane >> 4, chunk = l16 >> 2;
    for (int item = X.gw; item < NB * NK * (KVR / 4); item += X.NGW) {
        const int p4 = item % (KVR / 4), t = item / (KVR / 4), kgi = t % NK, b = t / NK;
        const int g = (NG == NSLOT0) ? (kgi < 2 ? 8 + kgi : 18 + kgi) : 16 + kgi;
        const float* gp = (NG == NSLOT0) ? (kgi < 2 ? kn_a : kn_b) : kn_a;
        const int pos = p4 * 4 + rq; const bool lat = pos < SEQ; const int p = (chunk < 2) ? (pos >> 6) : (pos & 63);
        bf16* ptr = QKV + ((size_t)(b * NG + g) * KVR + pos) * 128 + 8 * l16;
        const v4u raw = *(const v4u*)ptr;
        float v[8] = {bflo(raw.x), bfhi(raw.x), bflo(raw.y), bfhi(raw.y), bflo(raw.z), bfhi(raw.z), bflo(raw.w), bfhi(raw.w)};
        float ss = 0.f;
#pragma unroll
        for (int j = 0; j < 8; ++j) ss += v[j] * v[j];
        ss += __shfl_xor(ss, 1); ss += __shfl_xor(ss, 2); ss += __shfl_xor(ss, 4); ss += __shfl_xor(ss, 8);
        const float rs = 1.0f / sqrtf(ss * (1.f / 128.f) + EPS);
        const f32x4 ga = *(const f32x4*)(gp + 8 * l16), gb = *(const f32x4*)(gp + 8 * l16 + 4);
        const float gg[8] = {ga.x, ga.y, ga.z, ga.w, gb.x, gb.y, gb.z, gb.w};
        float o[8];
#pragma unroll
        for (int j = 0; j < 8; ++j) { v[j] = v[j] * rs * gg[j]; const float pv = __shfl_xor(v[j], 4); const int ci = (lat ? p : 0) * 32 + 8 * (l16 & 3) + j; const float c = cs_lds[ci * 2], sn = cs_lds[ci * 2 + 1];
            const float rot = (chunk & 1) ? (v[j] * c + pv * sn) : (v[j] * c - pv * sn); o[j] = lat ? rot : v[j]; }
        v4u w; w.x = pk2(o[0], o[1]); w.y = pk2(o[2], o[3]); w.z = pk2(o[4], o[5]); w.w = pk2(o[6], o[7]);
        *(v4u*)ptr = w;
    }
}
constexpr int CS_OFF = 98304;
__device__ __forceinline__ void build_cs(const Ctx& X) {
    LAS float* CS = (LAS float*)(X.lds + CS_OFF);
    for (int idx = X.tid; idx < 2048; idx += NWAVES * 64) { const int p = idx >> 5, i = idx & 31; const float inv = exp2f(-(float)i * (13.287712379549449f / 32.0f)); const float a = (float)p * inv;
        float sn, cs; sincosf(a, &sn, &cs); CS[idx * 2] = cs; CS[idx * 2 + 1] = sn; }
    __syncthreads();
}

__device__ __forceinline__ void b_combine(const Ctx& X, const float* PB, const float* lamv, const float* subln, bf16* OALL) {
    const int half = X.lane >> 5, d4 = (X.lane & 31) * 4;
    f32x4 n1, n2;
#define BC_LOAD(item_, d1, d2) do { const int row_ = (item_) >> 2, hb_ = (item_) & 3; const bool lat_ = row_ < TL; const int b_ = lat_ ? (row_ >> 12) : ((row_ - TL) >> 8); const int pos_ = lat_ ? (row_ & 4095) : (SEQ + ((row_ - TL) & 255)); \
        d1 = __builtin_nontemporal_load((const f32x4*)(PB + ((size_t)(b_ * 16 + (hb_ * 2 + 0) * 2 + half) * KVR + pos_) * 128 + d4)); d2 = __builtin_nontemporal_load((const f32x4*)(PB + ((size_t)(b_ * 16 + (hb_ * 2 + 1) * 2 + half) * KVR + pos_) * 128 + d4)); } while (0)
    if (X.gw < MR * 4) BC_LOAD(X.gw, n1, n2);
    for (int item = X.gw; item < MR * 4; item += X.NGW) {
        const int row = item >> 2, hb = item & 3;
        const f32x4 o1 = n1, o2 = n2;
        if (item + X.NGW < MR * 4) BC_LOAD(item + X.NGW, n1, n2);
        const float lam = lamv[hb];
        const f32x4 v = o1 - o2 * lam;
        const float ss = wave_sum((v.x * v.x + v.y * v.y) + (v.z * v.z + v.w * v.w));
        const float rs = (1.0f - LAM_INIT) / sqrtf(ss * (1.f / 256.f) + EPS);
        const f32x4 g = *(const f32x4*)(subln + half * 128 + d4);
        const f32x4 y = v * rs * g;
        v2u o; o.x = pk2(y.x, y.y); o.y = pk2(y.z, y.w);
        *(v2u*)(OALL + (size_t)row * D + 1024 + hb * 256 + half * 128 + d4) = o;
    }
#undef BC_LOAD
}

__device__ __forceinline__ void moe_route(const Ctx& X, const int* eid, const float* egate, const bf16* H, bf16* XS, int* pos, int* rowtok, float* rowgate, int* tile_e, int* ntiles) {
    LAS int* tot = (LAS int*)X.lds;
    LAS int* pre = tot + 8;
    LAS int* base = tot + 16;
    LAS int* dst = tot + 64;
    const int tpw = (TL + X.G - 1) / X.G, t0 = X.c * tpw, t1 = (t0 + tpw) < TL ? (t0 + tpw) : TL;
    if (X.tid < 16) tot[X.tid] = 0;
    __syncthreads();
    for (int idx = X.tid; idx < 2 * TL; idx += NWAVES * 64) { const int e = eid[idx]; __hip_atomic_fetch_add(&tot[e], 1, __ATOMIC_RELAXED, __HIP_MEMORY_SCOPE_WORKGROUP); if ((idx >> 1) < t0) __hip_atomic_fetch_add(&pre[e], 1, __ATOMIC_RELAXED, __HIP_MEMORY_SCOPE_WORKGROUP); }
    __syncthreads();
    if (X.tid == 0) { int acc = 0; for (int e = 0; e < 8; ++e) { base[e] = acc; acc += (tot[e] + 255) & ~255; }
        if (X.c == 0) { *ntiles = acc >> 8; for (int e = 0; e < 8; ++e) { const int nt = (tot[e] + 255) >> 8; for (int i = 0; i < nt; ++i) tile_e[(base[e] >> 8) + i] = e; } } }
    __syncthreads();
    if (X.wave == 0) {
        int run[8];
#pragma unroll
        for (int e = 0; e < 8; ++e) run[e] = 0;
        const int n_ent = 2 * (t1 - t0);
        for (int b0 = 0; b0 < n_ent; b0 += 64) {
            const int li = b0 + X.lane; const bool valid = li < n_ent; const int idx = 2 * t0 + li; const int e = valid ? eid[idx] : -1;
            int rank = 0;
#pragma unroll
            for (int ee = 0; ee < 8; ++ee) { const unsigned long long m = __ballot(e == ee); if (e == ee) rank = run[ee] + __popcll(m & ((1ull << X.lane) - 1ull)); run[ee] += __popcll(m); }
            if (valid) { const int d = base[e] + pre[e] + rank; dst[li] = d; pos[idx] = d; rowtok[d] = idx >> 1; rowgate[d] = egate[idx]; }
        }
    }
    __syncthreads();
    { const int n_ent = 2 * (t1 - t0);
      for (int li = X.wave; li < n_ent; li += NWAVES) { const int tok = t0 + (li >> 1); const int d = dst[li];
          const v4u* s = (const v4u*)((const unsigned char*)H + (size_t)tok * D) + X.lane; v4u* o = (v4u*)((unsigned char*)XS + (size_t)d * D) + X.lane;
#pragma unroll
          for (int j = 0; j < 2; ++j) o[64 * j] = s[64 * j]; } }
    if (X.c < 8) { const int e = X.c; const int r0 = base[e] + tot[e], r1 = base[e] + ((tot[e] + 255) & ~255);
        for (int r = r0 + X.wave; r < r1; r += NWAVES) { if (X.lane == 0) { rowtok[r] = -1; rowgate[r] = 0.f; }
            v4u* o = (v4u*)((unsigned char*)XS + (size_t)r * D) + X.lane; const v4u zz = {0u, 0u, 0u, 0u};
#pragma unroll
            for (int j = 0; j < 2; ++j) o[64 * j] = zz; } }
    __syncthreads();
}

constexpr int MOE_MAIN_TILES = 64, MOE_MAIN_ROWS = MOE_MAIN_TILES * 256;
__device__ __forceinline__ void moe_final(const Ctx& X, const float* X3, const bf16* YS, const int* pos, const float* mods_l, float* out, const float* part, int ntiles) {
    int Sp, ppair; const int tail_rows = (ntiles - MOE_MAIN_TILES) * 256; pg8::tail_split(X.G, (ntiles - MOE_MAIN_TILES) * (D / 256), DFE / 128, Sp, ppair);
    int np0 = 0, np1 = 0; if (X.gw < TL) { np0 = pos[2 * X.gw]; np1 = pos[2 * X.gw + 1]; }
    for (int row = X.gw; row < TL; row += X.NGW) {
        const int p0 = np0, p1 = np1; const float* gp = mods_l + (size_t)(row >> 12) * MODW + 5 * D;
        if (row + X.NGW < TL) { np0 = pos[2 * (row + X.NGW)]; np1 = pos[2 * (row + X.NGW) + 1]; }
        f32x4 a[8], b[8];
        if (p0 < MOE_MAIN_ROWS) {
#pragma unroll
            for (int j = 0; j < 8; ++j) { const v2u w = __builtin_nontemporal_load((const v2u*)(YS + (size_t)p0 * D + 4 * X.lane + 256 * j)); a[j] = (f32x4){bflo(w.x), bfhi(w.x), bflo(w.y), bfhi(w.y)}; }
        } else {
#pragma unroll
            for (int j = 0; j < 8; ++j) a[j] = (f32x4){0.f, 0.f, 0.f, 0.f};
            for (int p = 0; p < Sp; ++p) { const float* pr = part + ((size_t)p * tail_rows + (p0 - MOE_MAIN_ROWS)) * D + 4 * X.lane;
#pragma unroll
                for (int j = 0; j < 8; ++j) a[j] += *(const f32x4*)(pr + 256 * j); }
        }
        if (p1 < MOE_MAIN_ROWS) {
#pragma unroll
            for (int j = 0; j < 8; ++j) { const v2u w = __builtin_nontemporal_load((const v2u*)(YS + (size_t)p1 * D + 4 * X.lane + 256 * j)); b[j] = (f32x4){bflo(w.x), bfhi(w.x), bflo(w.y), bfhi(w.y)}; }
        } else {
#pragma unroll
            for (int j = 0; j < 8; ++j) b[j] = (f32x4){0.f, 0.f, 0.f, 0.f};
            for (int p = 0; p < Sp; ++p) { const float* pr = part + ((size_t)p * tail_rows + (p1 - MOE_MAIN_ROWS)) * D + 4 * X.lane;
#pragma unroll
                for (int j = 0; j < 8; ++j) b[j] += *(const f32x4*)(pr + 256 * j); }
        }
#pragma unroll
        for (int j = 0; j < 8; ++j) { const int col = 4 * X.lane + 256 * j; const f32x4 x = __builtin_nontemporal_load((const f32x4*)(X3 + (size_t)row * D + col)), g = *(const f32x4*)(gp + col);
            __builtin_nontemporal_store(x + g * (a[j] + b[j]), (f32x4*)(out + (size_t)row * D + col)); }
    }
}

__device__ __forceinline__ const float* arg_in(int i) {
    auto kp = __builtin_amdgcn_kernarg_segment_ptr();
    asm volatile("" : "+s"(kp));
    return ((const float* const __attribute__((address_space(4)))*)kp)[i];
}
#define AIN(i) arg_in(i)
constexpr int NPHASE = 20;
#ifndef PHMASK
#define PHMASK 0xFFFFFu
#endif
#ifndef PHDUP
#define PHDUP 0u
#endif
#define REP(k) _Pragma("unroll") for (int rep_ = 0; rep_ < ((((PHDUP) >> (k)) & 1u) ? 2 : 1); ++rep_)
#ifndef MK_LAUNCHES
#define MK_LAUNCHES {{0, NPHASE}}
#endif
struct PhRange { int lo, hi; };
constexpr PhRange kLaunches[] = MK_LAUNCHES;
struct Args { const float* in[33]; float* out; unsigned char* ws; int ph_lo, ph_hi, li, pad; };
__global__ void __launch_bounds__(NWAVES * 64, 2) fwd_kernel(Args args) {
    extern __shared__ __attribute__((aligned(16))) unsigned char lds[];
    Ctx X;
    X.lds = (LAS unsigned char*)lds; X.tid = threadIdx.x; X.lane = X.tid & 63; X.wave = __builtin_amdgcn_readfirstlane(X.tid >> 6);
    X.G = gridDim.x; X.c = blockIdx.x; X.gw = X.c * NWAVES + X.wave; X.NGW = X.G * NWAVES;
    unsigned char* ws = args.ws;
    gu32* ctl = (gu32*)(ws + WS_CTL);
    volatile LAS unsigned* MISC = (volatile LAS unsigned*)(X.lds + MISC_OFF);
    for (int u = X.tid; u < (LDS_BYTES - LDSCTL_OFF) / 4; u += NWAVES * 64) ((LAS unsigned*)(X.lds + LDSCTL_OFF))[u] = 0u;
    __syncthreads();
    const int lo = args.ph_lo, hi = args.ph_hi;
    XcdBarrier bar; bar.bar = (unsigned*)(ctl + CW_BAR) + args.li * XCD_BAR_WORDS; bar.x = 0; bar.st = nullptr;
    if (hi - lo > 1) bar = xcd_barrier_post((unsigned*)(ctl + CW_BAR) + args.li * XCD_BAR_WORDS, MISC + 8);
#define GRID_BAR() xcd_barrier(bar)
#define IN(k) ((((PHMASK) >> (k)) & 1u) && lo <= (k) && (k) < hi)
#define BOTH(k) (IN(k) && ((k) + 1) < hi)

#define x_in (AIN(0))
#define c_in (AIN(1))
#define ctx_in (AIN(2))
#define cctx_in (AIN(3))
#define mods0 ((float*)(ws + WS_MODS))
#define mods1 ((float*)(ws + WS_MODS) + 3 * MODW)
#define lamv ((float*)(ws + WS_LAM))
#define WT_EIN ((bf16*)(ws + WS_WT_EIN))
#define WT_EOUT ((bf16*)(ws + WS_WT_EOUT))
#define WT_EF1 ((bf16*)(ws + WS_WT_EF1))
#define WT_EF2 ((bf16*)(ws + WS_WT_EF2))
#define WT_OIN ((bf16*)(ws + WS_WT_OIN))
#define WT_OOUT ((bf16*)(ws + WS_WT_OOUT))
#define WT_X1 ((bf16*)(ws + WS_WT_X1))
#define WT_X2 ((bf16*)(ws + WS_WT_X2))
#define H ((bf16*)(ws + WS_H))
#define Z ((bf16*)(ws + WS_Z))
#define QKV ((bf16*)(ws + WS_QKV))
#define PB ((float*)(ws + WS_PB))
#define OALL ((bf16*)(ws + WS_OALL))
#define X1 ((float*)(ws + WS_X1))
#define X3 ((float*)(ws + WS_X3))
#define ACT ((bf16*)(ws + WS_ACT))
#define XS ((bf16*)(ws + WS_XS))
#define ACT2 ((bf16*)(ws + WS_ACT2))
#define YS ((bf16*)(ws + WS_YS))
#define PART ((float*)(ws + WS_PART))
#define EID ((int*)(ws + RT_EID))
#define EGATE ((float*)(ws + RT_GATE))
#define POS ((int*)(ws + RT_POS))
#define ROWTOK ((int*)(ws + RT_ROWTOK))
#define ROWGATE ((float*)(ws + RT_ROWGATE))
#define TILE_E ((int*)(ws + RT_TILE_E))
#define NTILES ((int*)(ws + RT_NTILES))

    if (IN(0)) {
    REP(0) { if (rep_) __syncthreads();
    {
        mod_fill_silu(X, c_in, cctx_in);
        for (int task = X.c; task < MOD_TASKS; task += X.G) { const int l = task / (MODW / 32); mod_task(X, task, l ? AIN(24) : AIN(6), l ? AIN(25) : AIN(7), l ? mods1 : mods0); }
        if (X.c == X.G - 1 && X.wave == 0) {
            for (int h = 0; h < 4; ++h) { const float* q1 = AIN(15) + h * 128; const float* k1 = AIN(16) + h * 128; const float* q2 = AIN(17) + h * 128; const float* k2 = AIN(18) + h * 128;
                const float s1 = wave_sum(q1[X.lane] * k1[X.lane] + q1[X.lane + 64] * k1[X.lane + 64]); const float s2 = wave_sum(q2[X.lane] * k2[X.lane] + q2[X.lane + 64] * k2[X.lane + 64]);
                if (X.lane == 0) lamv[h] = expf(s1) - expf(s2) + LAM_INIT; }
        }
        LAS float* scr = (LAS float*)(X.lds + X.wave * 16896);
        int tbase = 0;
#define TPASS(Wp, K_, N_, WTp, kind_, nexp) { constexpr int per_ = ((K_) / 64) * ((N_) / 64), tot_ = per_ * (nexp); int j_ = (X.gw - tbase) % X.NGW; if (j_ < 0) j_ += X.NGW; \
            for (; j_ < tot_; j_ += X.NGW) { const int e_ = j_ / per_, q_ = j_ - e_ * per_; transpose_item((Wp) + (size_t)e_ * (K_) * (N_), (K_), (N_), (WTp) + (size_t)e_ * (N_) * (K_), q_, (kind_), scr, X.lane); } tbase += tot_; }
#define TPASS8(Wp, K_, N_, WTp, kind_, nexp) { constexpr int per_ = ((K_) / 128) * ((N_) / 32), tot_ = per_ * (nexp); int j_ = (X.gw - tbase) % X.NGW; if (j_ < 0) j_ += X.NGW; \
            for (; j_ < tot_; j_ += X.NGW) { const int e_ = j_ / per_, q_ = j_ - e_ * per_; transpose_item8((Wp) + (size_t)e_ * (K_) * (N_), (K_), (N_), (WTp) + (size_t)e_ * (N_) * (K_), q_, (kind_), scr, X.lane); } tbase += tot_; }
        TPASS(AIN(8), D, EVEN_IN, WT_EIN, 0, 1)
        TPASS(AIN(9), D, D, WT_EOUT, 0, 1)
        TPASS(AIN(20), D, 2 * DFF, WT_EF1, 1, 1)
        TPASS(AIN(21), DFF, D, WT_EF2, 0, 1)
        TPASS(AIN(26), D, ODD_IN, WT_OIN, 0, 1)
        TPASS(AIN(27), D, D, WT_OOUT, 0, 1)
        TPASS8(AIN(31), D, 2 * DFE, (unsigned char*)WT_X1, 1, NE)
        TPASS8(AIN(32), DFE, D, (unsigned char*)WT_X2, 0, NE)
#undef TPASS
#undef TPASS8
    }
    }
    if (BOTH(0)) GRID_BAR();
    }
    if (IN(1)) {
    REP(1) { if (rep_) __syncthreads();
    norm_mod_rows<false>(X, x_in, ctx_in, MR, AIN(4), mods0, 0, 1, H, nullptr, nullptr, nullptr);
    }
    if (BOTH(1)) GRID_BAR();
    }
    if (IN(2)) {
    REP(2) { if (rep_) __syncthreads();
    { pg8::Gemm g{H, WT_EIN, MR, EVEN_IN, D}; pg8::StaticOrder S; S.init(MR, EVEN_IN, D / 64, X.G, X.c); pg8::EpiSlots E{QKV, NSLOT0, KVR};
      pg8::gemm_phase<pg8::EpiSlots, pg8::StaticOrder, true, true>(X.lds, g, S, E); }
    }
    if (BOTH(2)) GRID_BAR();
    }
    if (IN(3)) {
    REP(3) { if (rep_) __syncthreads();
    build_cs(X); k_post<NSLOT0>(X, QKV, AIN(11), AIN(14), (const float*)(lds + CS_OFF));
    }
    if (BOTH(3)) GRID_BAR();
    }
    if (IN(4)) {
    REP(4) { if (rep_) __syncthreads();
    {
        build_cs(X); const float* csp = (const float*)(lds + CS_OFF);
        const att::bf16* Q0 = (const att::bf16*)QKV;
        for (int u = X.c; u < 544; u += X.G) {
            const bool isl = u < 512; const int b = isl ? (u >> 8) : ((u - 512) >> 4), vh = isl ? ((u >> 4) & 15) : ((u - 512) & 15), qb = isl ? (u & 15) : 16;
            const int hb = vh >> 2, map = (vh >> 1) & 1, half = vh & 1;
            const att::bf16* Qp = Q0 + ((size_t)(b * NSLOT0 + 12 + 2 * hb + map) * KVR + qb * 256) * 128;
            const att::bf16* Kp = Q0 + ((size_t)(b * NSLOT0 + 20 + 2 * hb + map) * KVR) * 128;
            const att::bf16* Vp = Q0 + ((size_t)(b * NSLOT0 + 28 + 2 * hb + half) * KVR) * 128;
            float* Op = PB + ((size_t)(b * 16 + vh) * KVR + qb * 256) * 128;
            att::attn_unit<false, false>(Qp, Kp, Vp, (void*)Op, 128, 0, isl ? 68 : 0, isl ? 68 : 4, qb * 256, -1e30f, 0.f, (char*)lds, AIN(13), isl, csp);
        }
        const int ca = (X.c + X.G - 32) % X.G;
        for (int u = ca; u < 272; u += X.G) {
            const bool isl = u < 256; const int b = isl ? (u >> 7) : ((u - 256) >> 3), h = isl ? ((u >> 4) & 7) : ((u - 256) & 7), qb = isl ? (u & 15) : 16;
            const int q0 = qb * 256; const int klo = isl ? (q0 >= 128 ? q0 - 128 : 0) : 0; const int khi = (q0 + 384) < SEQ ? (q0 + 384) : SEQ; const int nt1 = isl ? ((khi - klo) >> 6) : 0;
            const att::bf16* Qp = Q0 + ((size_t)(b * NSLOT0 + h) * KVR + q0) * 128;
            const att::bf16* Kp = Q0 + ((size_t)(b * NSLOT0 + 8 + (h >> 2)) * KVR) * 128;
            const att::bf16* Vp = Q0 + ((size_t)(b * NSLOT0 + 10 + (h >> 2)) * KVR) * 128;
            bf16* Op = OALL + (size_t)(isl ? (b * SEQ + q0) : (TL + b * CTXL)) * D + h * 128;
            const float sink = AIN(12)[h];
            att::attn_unit<true, true>(Qp, Kp, Vp, (void*)Op, D, klo, nt1, nt1 + 4, q0, sink * (1.0f / att::SCALE), 1.f, (char*)lds, AIN(10), isl, csp);
        }
    }
    }
    if (BOTH(4)) GRID_BAR();
    }
    if (IN(5)) {
    REP(5) { if (rep_) __syncthreads();
    b_combine(X, PB, lamv, AIN(19), OALL);
    }
    if (BOTH(5)) GRID_BAR();
    }
    if (IN(6)) {
    REP(6) { if (rep_) __syncthreads();
    { pg8::Gemm g{OALL, WT_EOUT, MR, D, D}; pg8::TailOrder S; S.init(TL / 256, TC / 256, D / 256, D / 64, X.G, X.c, nullptr); pg8::EpiRes E{x_in, ctx_in, X1, D, mods0 + 2 * D, MODW, PART, TL, TC, 1.0f};
      pg8::gemm_phase<pg8::EpiRes, pg8::TailOrder, true, true>(X.lds, g, S, E); }
    }
    if (BOTH(6)) GRID_BAR();
    }
    if (IN(7)) {
    REP(7) { if (rep_) __syncthreads();
    { int Sp, pp; pg8::tail_split(X.G, (TC / 256) * (D / 256), D / 64, Sp, pp);
      norm_mod_rows<false, true>(X, X1, ctx_in, MR, AIN(5), mods0, 3, 4, H, nullptr, nullptr, nullptr, PART, Sp, mods0 + 2 * MODW + 2 * D, X1 + (size_t)TL * D); }
    }
    if (BOTH(7)) GRID_BAR();
    }
    if (IN(8)) {
    REP(8) { if (rep_) __syncthreads();
    { pg8::Gemm g{H, WT_EF1, MR, 2 * DFF, D}; pg8::StaticOrder S; S.init(MR, 2 * DFF, D / 64, X.G, X.c); pg8::EpiSwiglu E{ACT, DFF, 1.0f};
      pg8::gemm_phase<pg8::EpiSwiglu, pg8::StaticOrder, true, true>(X.lds, g, S, E); }
    }
    if (BOTH(8)) GRID_BAR();
    }
    if (IN(9)) {
    REP(9) { if (rep_) __syncthreads();
    { pg8::Gemm g{ACT, WT_EF2, MR, D, DFF}; pg8::TailOrder S; S.init(TL / 256, TC / 256, D / 256, DFF / 64, X.G, X.c, nullptr); pg8::EpiRes E{X1, X1 + (size_t)TL * D, X1, D, mods0 + 5 * D, MODW, PART, TL, TC, 1.0f};
      pg8::gemm_phase<pg8::EpiRes, pg8::TailOrder, true, true>(X.lds, g, S, E); }
    }
    if (BOTH(9)) GRID_BAR();
    }
    if (IN(10)) {
    REP(10) { if (rep_) __syncthreads();
    { int Sp, pp; pg8::tail_split(X.G, (TC / 256) * (D / 256), DFF / 64, Sp, pp);
      norm_mod_rows<false, true>(X, X1, X1 + (size_t)TL * D, MR, AIN(22), mods1, 0, 1, H, nullptr, nullptr, nullptr, PART, Sp, mods0 + 2 * MODW + 5 * D, nullptr); }
    }
    if (BOTH(10)) GRID_BAR();
    }
    if (IN(11)) {
    REP(11) { if (rep_) __syncthreads();
    { pg8::Gemm g{H, WT_OIN, MR, ODD_IN, D}; pg8::StaticOrder S; S.init(MR, ODD_IN, D / 64, X.G, X.c); pg8::EpiSlots E{QKV, NSLOT1, KVR};
      pg8::gemm_phase<pg8::EpiSlots, pg8::StaticOrder, true, true>(X.lds, g, S, E); }
    }
    if (BOTH(11)) GRID_BAR();
    }
    if (IN(12)) {
    REP(12) { if (rep_) __syncthreads();
    build_cs(X); k_post<NSLOT1>(X, QKV, AIN(29), nullptr, (const float*)(lds + CS_OFF));
    }
    if (BOTH(12)) GRID_BAR();
    }
    if (IN(13)) {
    REP(13) { if (rep_) __syncthreads();
    {
        build_cs(X); const float* csp = (const float*)(lds + CS_OFF);
        const att::bf16* Q0 = (const att::bf16*)QKV;
        for (int u = X.c; u < 512; u += X.G) {
            const int b = u >> 8, h = (u >> 4) & 15, qb = u & 15;
            const att::bf16* Qp = Q0 + ((size_t)(b * NSLOT1 + h) * KVR + qb * 256) * 128;
            const att::bf16* Kp = Q0 + ((size_t)(b * NSLOT1 + 16 + (h >> 2)) * KVR) * 128;
            const att::bf16* Vp = Q0 + ((size_t)(b * NSLOT1 + 20 + (h >> 2)) * KVR) * 128;
            bf16* Op = OALL + (size_t)(b * SEQ + qb * 256) * D + h * 128;
            const int ntc = 68 + (X.G >> 20);
            att::attn_unit<false, true>(Qp, Kp, Vp, (void*)Op, D, 0, ntc, ntc, qb * 256, -1e30f, 0.f, (char*)lds, AIN(28), true, csp);
        }
    }
    }
    if (BOTH(13)) GRID_BAR();
    }
    if (IN(14)) {
    REP(14) { if (rep_) __syncthreads();
    { pg8::Gemm g{OALL, WT_OOUT, TL, D, D}; pg8::StaticOrder S; S.init(TL, D, D / 64, X.G, X.c); pg8::EpiRes E{X1, X1, X3, D, mods1 + 2 * D, MODW, nullptr, 0, 0, 1.0f};
      pg8::gemm_phase<pg8::EpiRes, pg8::StaticOrder, true, true>(X.lds, g, S, E); }
    }
    if (BOTH(14)) GRID_BAR();
    }
    if (IN(15)) {
    REP(15) { if (rep_) __syncthreads();
    norm_mod_rows<true, false, true>(X, X3, X3, TL, AIN(23), mods1, 3, 4, H, AIN(30), EID, EGATE);
    }
    if (BOTH(15)) GRID_BAR();
    }
    if (IN(16)) {
    REP(16) { if (rep_) __syncthreads();
    moe_route(X, EID, EGATE, H, XS, POS, ROWTOK, ROWGATE, TILE_E, NTILES);
    }
    if (BOTH(16)) GRID_BAR();
    }
    if (IN(17)) {
    REP(17) { if (rep_) __syncthreads();
    { const int nt = *(volatile int*)NTILES; pg8::Gemm g{XS, WT_X1, XROWS, 2 * DFE, D}; pg8::TailOrder S; S.init(nt, 0, 2 * DFE / 256, D / 128, X.G, X.c, TILE_E); pg8::EpiSwiglu8 E{ACT2, DFE, 1.0f / W8_SCALE};
      pg8::gemm_phase<pg8::EpiSwiglu8, pg8::TailOrder, true, true, true>(X.lds, g, S, E); }
    }
    if (BOTH(17)) GRID_BAR();
    }
    if (IN(18)) {
    REP(18) { if (rep_) __syncthreads();
    { const int nt = *(volatile int*)NTILES; pg8::Gemm g{ACT2, WT_X2, XROWS, D, DFE}; pg8::TailOrder S; S.init(MOE_MAIN_TILES, nt - MOE_MAIN_TILES, D / 256, DFE / 128, X.G, X.c, TILE_E); pg8::EpiRowScale E{(pg8::bf16_t*)YS, D, ROWGATE, PART, MOE_MAIN_ROWS, (nt - MOE_MAIN_TILES) * 256, 1.0f / W8_SCALE};
      pg8::gemm_phase<pg8::EpiRowScale, pg8::TailOrder, true, true, true>(X.lds, g, S, E); }
    }
    if (BOTH(18)) GRID_BAR();
    }
    if (IN(19)) {
    REP(19) { if (rep_) __syncthreads();
    moe_final(X, X3, YS, POS, mods1, args.out, PART, *(volatile int*)NTILES);
    }
    }
}

extern "C" void kernel_launch(void* const* d_in, const int* in_sizes, int n_in, void* d_out, int out_size, void* d_ws, size_t ws_size, hipStream_t stream) {
    static int grid = 0;
    if (grid == 0) {
        if (n_in != 33 || in_sizes[0] != TL * D || out_size != TL * D || ws_size < WS_END) { fprintf(stderr, "kernel_launch: unexpected shapes (n_in %d, in0 %d, out %d, ws %zu)\n", n_in, n_in > 0 ? in_sizes[0] : -1, out_size, ws_size); grid = -1; return; }
        int dev = 0, cus = 0, per_cu = 0;
        if (hipGetDevice(&dev) != hipSuccess || hipDeviceGetAttribute(&cus, hipDeviceAttributeMultiprocessorCount, dev) != hipSuccess) { grid = -1; return; }
        if (hipFuncSetAttribute((const void*)fwd_kernel, hipFuncAttributeMaxDynamicSharedMemorySize, LDS_BYTES) != hipSuccess) { fprintf(stderr, "kernel_launch: hipFuncSetAttribute failed\n"); grid = -1; return; }
        if (hipOccupancyMaxActiveBlocksPerMultiprocessor(&per_cu, (const void*)fwd_kernel, NWAVES * 64, LDS_BYTES) != hipSuccess || per_cu < 1) { fprintf(stderr, "kernel_launch: occupancy query says %d blocks per CU\n", per_cu); }
        (void)hipGetLastError();
        grid = cus;
    }
    if (grid < 0) return;
    constexpr int NL = sizeof(kLaunches) / sizeof(kLaunches[0]);
    if (hipMemsetAsync((char*)d_ws + WS_CTL, 0, NL == 1 ? (size_t)65536 : CTL_ZERO_BYTES, stream) != hipSuccess) return;
    Args a{};
    for (int i = 0; i < 33; ++i) a.in[i] = (const float*)d_in[i];
    a.out = (float*)d_out; a.ws = (unsigned char*)d_ws;
    for (int li = 0; li < NL; ++li) {
        a.ph_lo = kLaunches[li].lo; a.ph_hi = kLaunches[li].hi; a.li = li; a.pad = 0;
        hipLaunchKernelGGL(fwd_kernel, dim3(grid), dim3(NWAVES * 64), LDS_BYTES, stream, a);
        const hipError_t le = hipPeekAtLastError();
        if (le != hipSuccess) { fprintf(stderr, "kernel_launch: launch %d failed: %s\n", li, hipGetErrorName(le)); break; }
    }
}
```

```cpp
#include <hip/hip_runtime.h>
#include <hip/hip_bf16.h>
#include <cstdio>
#include <cstdint>

namespace pg8 {
#define PG8_LAS __attribute__((address_space(3)))
typedef unsigned short bf16_t;
typedef short bf16x8 __attribute__((ext_vector_type(8)));
typedef float f32x4 __attribute__((ext_vector_type(4)));
typedef unsigned u32x4 __attribute__((ext_vector_type(4)));
constexpr int BM = 256, BK = 64, HALF = 128, HTB = HALF * BK * 2  , STAGE_BYTES = 8 * HTB, NXCD = 8, WGM = 8;

__host__ __device__ __forceinline__ int lds_byte(int r, int c) { const int st = (r >> 4) * 2 + (c >> 5), rr = r & 15, cc = c & 31, ob = rr * 64 + cc * 2; return st * 1024 + (ob ^ (((ob >> 9) & 1) << 5)); }
__host__ __device__ __forceinline__ void stage_rc(int b, int& R, int& C) { const int st = b / 1024, sb = b % 1024, swz = sb ^ (((sb >> 9) & 1) << 5); R = (st >> 1) * 16 + swz / 64; C = (st & 1) * 32 + (swz % 64) / 2; }
__host__ __device__ __forceinline__ int perm32(int rho) { const int n = rho >> 4, i = rho & 15; return 8 * (i >> 2) + 4 * n + (i & 3); }

struct Unit { int pm, pn, pnb, kt0, nkt, part, lt; };
struct Gemm { const void* A; const void* Bt; int M, N, K; };

struct StaticOrder {
    int nM, nN, nwg, G, c, KT;
    __host__ __device__ __forceinline__ void init(int M, int N, int KT_, int G_, int c_) { nM = M / BM; nN = N / BM; nwg = nM * nN; G = G_; c = c_; KT = KT_; }
    __host__ __device__ __forceinline__ bool next(int i, Unit& u) const {
        const long L = (long)i * G + c; if (L >= nwg) return false;
        int wgid = (int)L; { const int q = nwg / NXCD, r = nwg % NXCD, xcd = wgid % NXCD, off = wgid / NXCD; wgid = (xcd < r ? xcd * (q + 1) : r * (q + 1) + (xcd - r) * q) + off; }
        const int nig = WGM * nN, gid = wgid / nig, fm = gid * WGM, gsz = (nM - fm) < WGM ? (nM - fm) : WGM;
        u.pm = fm + ((wgid % nig) % gsz); u.pn = (wgid % nig) / gsz; u.pnb = u.pn; u.kt0 = 0; u.nkt = KT; u.part = -1; u.lt = u.pm; return true;
    }
    __device__ __forceinline__ void a_ready(const Unit&) const {}
    __device__ __forceinline__ void done(const Unit&) const {}
};
__host__ __device__ __forceinline__ void tail_split(int G, int T, int KT, int& Sp, int& ppair) {
    if (T <= 0) { Sp = 0; ppair = 0; return; }
    int S = G / T; if (S < 1) S = 1; const int pairs = KT >> 1; ppair = (pairs + S - 1) / S; if (ppair < 2) ppair = 2; Sp = (pairs + ppair - 1) / ppair;
}
struct TailOrder {
    StaticOrder so; int T, Sp, ppair; const int* tile_e; const int* tile_p;
    __device__ __forceinline__ void init(int nMm, int nTm, int nN, int KT, int G_, int c_, const int* te, const int* tp = nullptr) { so.nM = nMm; so.nN = nN; so.nwg = nMm * nN; so.G = G_; so.c = c_; so.KT = KT; T = nTm * nN; tile_e = te; tile_p = tp; tail_split(G_, T, KT, Sp, ppair); }
    __device__ __forceinline__ bool next(int i, Unit& u) const {
        const int nm = so.c < so.nwg ? (so.nwg - so.c + so.G - 1) / so.G : 0;
        const int cc = so.G - 1 - so.c;
        int pm, pn, kt0 = 0, nkt = so.KT, part = -1;
        if (i < nm) { Unit t; so.next(i, t); pm = t.pm; pn = t.pn; }
        else if (i == nm && cc < T * Sp) { const int tu = cc / Sp, j = cc - tu * Sp; pm = so.nM + tu / so.nN; pn = tu % so.nN; kt0 = 2 * ppair * j; nkt = (so.KT - kt0) < 2 * ppair ? (so.KT - kt0) : 2 * ppair; part = j; }
        else return false;
        int e = 0; if (tile_e) e = __builtin_amdgcn_readfirstlane(tile_e[pm]);
        u.lt = pm; if (tile_p) pm = __builtin_amdgcn_readfirstlane(tile_p[pm]);
        u.pm = pm; u.pn = pn; u.pnb = e * so.nN + pn; u.kt0 = kt0; u.nkt = nkt; u.part = part; return true;
    }
    __device__ __forceinline__ void a_ready(const Unit&) const {}
    __device__ __forceinline__ void done(const Unit&) const {}
};

__device__ __forceinline__ unsigned cvt_pk_bf16(float lo, float hi) { unsigned r; asm volatile("v_cvt_pk_bf16_f32 %0, %1, %2" : "=v"(r) : "v"(lo), "v"(hi)); return r; }

struct EpiBf16 {
    static constexpr bool PERM = true, AFTER_DRAIN = false;
    bf16_t* O; int ldc; float scale;
    __device__ __forceinline__ void operator()(const f32x4 (&acc)[2][2][4][2], const Unit& u, int wr, int wc, int fr, int fq) const {
        const int row0 = u.pm * BM + wr * 64 + fr; const int col0 = u.pn * BM + wc * 32 + 8 * fq;
#pragma unroll
        for (int ai = 0; ai < 2; ++ai)
#pragma unroll
            for (int m = 0; m < 4; ++m) { bf16_t* rowp = O + (size_t)(row0 + ai * HALF + m * 16) * ldc + col0;
#pragma unroll
                for (int bj = 0; bj < 2; ++bj) { const f32x4 v0 = acc[ai][bj][m][0] * scale, v1 = acc[ai][bj][m][1] * scale;
                    u32x4 w; w.x = cvt_pk_bf16(v0[0], v0[1]); w.y = cvt_pk_bf16(v0[2], v0[3]); w.z = cvt_pk_bf16(v1[0], v1[1]); w.w = cvt_pk_bf16(v1[2], v1[3]);
                    *(u32x4*)(rowp + bj * HALF) = w; } }
    }
};
struct EpiSlots {
    static constexpr bool PERM = true, AFTER_DRAIN = false;
    bf16_t* QKV; int NG; int kvr;
    __device__ __forceinline__ void operator()(const f32x4 (&acc)[2][2][4][2], const Unit& u, int wr, int wc, int fr, int fq) const {
        const int prow = u.pm * BM; const bool lat = prow < 8192; const int b = lat ? (prow >> 12) : ((prow - 8192) >> 8); const int pos0 = lat ? (prow & 4095) : 4096;
        const int rl0 = wr * 64 + fr;
#pragma unroll
        for (int bj = 0; bj < 2; ++bj) { bf16_t* gbase = QKV + ((size_t)(b * NG + 2 * u.pn + bj) * kvr + pos0 + rl0) * 128 + wc * 32 + 8 * fq;
#pragma unroll
            for (int ai = 0; ai < 2; ++ai)
#pragma unroll
                for (int m = 0; m < 4; ++m) { const f32x4 v0 = acc[ai][bj][m][0], v1 = acc[ai][bj][m][1];
                    u32x4 w; w.x = cvt_pk_bf16(v0[0], v0[1]); w.y = cvt_pk_bf16(v0[2], v0[3]); w.z = cvt_pk_bf16(v1[0], v1[1]); w.w = cvt_pk_bf16(v1[2], v1[3]);
                    *(u32x4*)(gbase + (size_t)(ai * HALF + m * 16) * 128) = w; } }
    }
};
struct EpiSlotsNR {
    static constexpr bool PERM = true, AFTER_DRAIN = false;
    bf16_t* QKV; int NG, kvr, cfg; const float* gtab; const float* cst;
    PG8_LAS float* xl;
    __device__ __forceinline__ void operator()(const f32x4 (&acc)[2][2][4][2], const Unit& u, int wr, int wc, int fr, int fq) const {
        const int prow = u.pm * BM; const bool lat = prow < 8192; const int b = lat ? (prow >> 12) : ((prow - 8192) >> 8); const int pos0 = lat ? (prow & 4095) : 4096;
        const int rl0 = wr * 64 + fr, g0 = 2 * u.pn;
        const bool isv = cfg == 0 ? (g0 == 10 || g0 >= 28) : (g0 >= 20);
        if (isv) {
#pragma unroll
            for (int bj = 0; bj < 2; ++bj) { bf16_t* gbase = QKV + ((size_t)(b * NG + g0 + bj) * kvr + pos0 + rl0) * 128 + wc * 32 + 8 * fq;
#pragma unroll
                for (int ai = 0; ai < 2; ++ai)
#pragma unroll
                    for (int m = 0; m < 4; ++m) { const f32x4 v0 = acc[ai][bj][m][0], v1 = acc[ai][bj][m][1];
                        u32x4 w; w.x = cvt_pk_bf16(v0[0], v0[1]); w.y = cvt_pk_bf16(v0[2], v0[3]); w.z = cvt_pk_bf16(v1[0], v1[1]); w.w = cvt_pk_bf16(v1[2], v1[3]);
                        *(u32x4*)(gbase + (size_t)(ai * HALF + m * 16) * 128) = w; } }
            return;
        }
        const int gi = cfg == 0 ? (g0 < 8 ? 0 : (g0 < 10 ? 1 : (g0 < 20 ? 2 : 3))) : (g0 < 16 ? 4 : 5); const float* gp = gtab + gi * 128;
#pragma unroll
        for (int bj = 0; bj < 2; ++bj)
#pragma unroll
            for (int ai = 0; ai < 2; ++ai)
#pragma unroll
                for (int m = 0; m < 4; ++m) { const f32x4 a = acc[ai][bj][m][0], c = acc[ai][bj][m][1];
                    float s = ((a[0] * a[0] + a[1] * a[1]) + (a[2] * a[2] + a[3] * a[3])) + ((c[0] * c[0] + c[1] * c[1]) + (c[2] * c[2] + c[3] * c[3]));
                    s += __shfl_xor(s, 16); s += __shfl_xor(s, 32);
                    if (fq == 0) xl[((bj * 256 + ai * HALF + rl0 + m * 16) << 2) + wc] = s; }
        asm volatile("s_waitcnt lgkmcnt(0)" ::: "memory"); __builtin_amdgcn_s_barrier(); asm volatile("" ::: "memory");
        const int pi = wc >> 1, idx0 = 16 * (wc & 1) + 4 * fq;
        const f32x4 ga = *(const f32x4*)(gp + (2 * pi) * 32 + idx0), gb = *(const f32x4*)(gp + (2 * pi + 1) * 32 + idx0);
#pragma unroll
        for (int ai = 0; ai < 2; ++ai)
#pragma unroll
            for (int m = 0; m < 4; ++m) { const int rl = rl0 + ai * HALF + m * 16; const int pos = pos0 + rl; const int pp = pi ? (pos & 63) : (pos >> 6);
                f32x4 c4 = {1.f, 1.f, 1.f, 1.f}, s4 = {0.f, 0.f, 0.f, 0.f};
                if (lat) { c4 = *(const f32x4*)(cst + pp * 32 + idx0); s4 = *(const f32x4*)(cst + 2048 + pp * 32 + idx0); }
#pragma unroll
                for (int bj = 0; bj < 2; ++bj) { const f32x4 t = *(const PG8_LAS f32x4*)(xl + ((bj * 256 + rl) << 2));
                    const float rs = __builtin_amdgcn_rsqf(((t[0] + t[1]) + (t[2] + t[3])) * (1.0f / 128.0f) + 1e-6f);
                    const f32x4 v0 = acc[ai][bj][m][0] * rs * ga, v1 = acc[ai][bj][m][1] * rs * gb;
                    const f32x4 o0 = v0 * c4 - v1 * s4, o1 = v1 * c4 + v0 * s4;
                    bf16_t* dst = QKV + ((size_t)(b * NG + g0 + bj) * kvr + pos) * 128 + (2 * pi) * 32 + idx0;
                    typedef unsigned u32x2 __attribute__((ext_vector_type(2)));
                    u32x2 w0, w1; w0.x = cvt_pk_bf16(o0[0], o0[1]); w0.y = cvt_pk_bf16(o0[2], o0[3]); w1.x = cvt_pk_bf16(o1[0], o1[1]); w1.y = cvt_pk_bf16(o1[2], o1[3]);
                    *(u32x2*)dst = w0; *(u32x2*)(dst + 32) = w1; } }
    }
};
__device__ __forceinline__ float clamp448(float x) { return __builtin_amdgcn_fmed3f(x, -448.f, 448.f); }
__device__ __forceinline__ unsigned pk4_fp8(float a, float b, float c, float d) {
    int w = __builtin_amdgcn_cvt_pk_fp8_f32(clamp448(a), clamp448(b), 0, false); w = __builtin_amdgcn_cvt_pk_fp8_f32(clamp448(c), clamp448(d), w, true); return (unsigned)w; }
__device__ __forceinline__ float silu_mul(float g, float u) { return g * u * __builtin_amdgcn_rcpf(1.0f + __builtin_amdgcn_exp2f(-1.4426950408889634f * g)); }
__device__ __forceinline__ f32x4 silu_mul4(f32x4 g, f32x4 u, float nls  , float s2  ) {
    const f32x4 t = g * nls;
    f32x4 e; e[0] = __builtin_amdgcn_exp2f(t[0]); e[1] = __builtin_amdgcn_exp2f(t[1]); e[2] = __builtin_amdgcn_exp2f(t[2]); e[3] = __builtin_amdgcn_exp2f(t[3]);
    const f32x4 d = e + 1.0f;
    f32x4 r; r[0] = __builtin_amdgcn_rcpf(d[0]); r[1] = __builtin_amdgcn_rcpf(d[1]); r[2] = __builtin_amdgcn_rcpf(d[2]); r[3] = __builtin_amdgcn_rcpf(d[3]);
    return (g * u) * (r * s2);
}
template <bool OUT8> struct EpiSwigluT {
    static constexpr bool PERM = true, AFTER_DRAIN = false;
    void* O; int ldc; float scale;
    __device__ __forceinline__ void operator()(const f32x4 (&acc)[2][2][4][2], const Unit& u, int wr, int wc, int fr, int fq) const {
        const int row0 = u.pm * BM + wr * 64 + fr; const int col0 = u.pn * HALF + wc * 32 + 8 * fq;
        const float nls = -1.4426950408889634f * scale, s2 = scale * scale;
#pragma unroll
        for (int ai = 0; ai < 2; ++ai)
#pragma unroll
            for (int m = 0; m < 4; ++m) { const size_t eo = (size_t)(row0 + ai * HALF + m * 16) * ldc + col0;
                const f32x4 a = silu_mul4(acc[ai][0][m][0], acc[ai][1][m][0], nls, s2), b = silu_mul4(acc[ai][0][m][1], acc[ai][1][m][1], nls, s2);
                if constexpr (OUT8) { typedef unsigned u32x2 __attribute__((ext_vector_type(2))); u32x2 w; w.x = pk4_fp8(a[0], a[1], a[2], a[3]); w.y = pk4_fp8(b[0], b[1], b[2], b[3]); *(u32x2*)((unsigned char*)O + eo) = w; }
                else { u32x4 w; w.x = cvt_pk_bf16(a[0], a[1]); w.y = cvt_pk_bf16(a[2], a[3]); w.z = cvt_pk_bf16(b[0], b[1]); w.w = cvt_pk_bf16(b[2], b[3]); *(u32x4*)((bf16_t*)O + eo) = w; } }
    }
};
typedef EpiSwigluT<false> EpiSwiglu; typedef EpiSwigluT<true> EpiSwiglu8;
struct EpiRes {
    static constexpr bool PERM = false, AFTER_DRAIN = false;
    const float* base_lat; const float* base_ctx; float* out; int ldc; const float* gate; int gate_stride;
    float* part; int part_row0, part_rows; float scale;
    __device__ __forceinline__ void operator()(const f32x4 (&acc)[2][2][4][2], const Unit& u, int wr, int wc, int fr, int fq) const {
        if (u.part >= 0) {
            float* pp = part + ((long)u.part * part_rows + (u.lt * BM - part_row0)) * (long)ldc; const int rl0 = wr * 64 + fr, col0 = u.pn * BM + wc * 32 + 4 * fq;
#pragma unroll
            for (int ai = 0; ai < 2; ++ai)
#pragma unroll
                for (int m = 0; m < 4; ++m) { const size_t ro = (size_t)(rl0 + ai * HALF + m * 16) * ldc;
#pragma unroll
                    for (int bj = 0; bj < 2; ++bj)
#pragma unroll
                        for (int n = 0; n < 2; ++n) *(f32x4*)(pp + ro + col0 + bj * HALF + 16 * n) = acc[ai][bj][m][n] * scale; }
            return;
        }
        const int prow = u.pm * BM; const int cond = prow < 4096 ? 0 : (prow < 8192 ? 1 : 2);
        const float* bp = prow < 8192 ? base_lat + (size_t)prow * ldc : base_ctx + (size_t)(prow - 8192) * ldc;
        float* op = out + (size_t)prow * ldc; const float* gp = gate + (size_t)cond * gate_stride;
        const int rl0 = wr * 64 + fr, col0 = u.pn * BM + wc * 32 + 4 * fq;
        f32x4 gv[2][2];
#pragma unroll
        for (int bj = 0; bj < 2; ++bj)
#pragma unroll
            for (int n = 0; n < 2; ++n) gv[bj][n] = *(const f32x4*)(gp + col0 + bj * HALF + 16 * n) * scale;
#pragma unroll
        for (int ai = 0; ai < 2; ++ai)
#pragma unroll
            for (int m = 0; m < 4; ++m) { const size_t ro = (size_t)(rl0 + ai * HALF + m * 16) * ldc;
#pragma unroll
                for (int bj = 0; bj < 2; ++bj)
#pragma unroll
                    for (int n = 0; n < 2; ++n) { const int col = col0 + bj * HALF + 16 * n; const f32x4 b = *(const f32x4*)(bp + ro + col);
                        *(f32x4*)(op + ro + col) = b + gv[bj][n] * acc[ai][bj][m][n]; } }
    }
};
struct EpiRowScale {
    static constexpr bool PERM = true, AFTER_DRAIN = false;
    bf16_t* out; int ldc; const float* rs; float* part; int part_row0, part_rows; float scale;
    __device__ __forceinline__ void operator()(const f32x4 (&acc)[2][2][4][2], const Unit& u, int wr, int wc, int fr, int fq) const {
        const int row0 = u.pm * BM + wr * 64 + fr, col0 = u.pn * BM + wc * 32 + 8 * fq;
#pragma unroll
        for (int ai = 0; ai < 2; ++ai)
#pragma unroll
            for (int m = 0; m < 4; ++m) { const int row = row0 + ai * HALF + m * 16; const float s = rs[row] * scale;
                if (u.part >= 0) { float* rp = part + ((long)u.part * part_rows - part_row0 + (row - u.pm * BM) + u.lt * BM) * (long)ldc + col0;
#pragma unroll
                    for (int bj = 0; bj < 2; ++bj) { *(f32x4*)(rp + bj * HALF) = acc[ai][bj][m][0] * s; *(f32x4*)(rp + bj * HALF + 4) = acc[ai][bj][m][1] * s; } }
                else { bf16_t* rp = out + (size_t)row * ldc + col0;
#pragma unroll
                    for (int bj = 0; bj < 2; ++bj) { const f32x4 v0 = acc[ai][bj][m][0] * s, v1 = acc[ai][bj][m][1] * s;
                        u32x4 w; w.x = cvt_pk_bf16(v0[0], v0[1]); w.y = cvt_pk_bf16(v0[2], v0[3]); w.z = cvt_pk_bf16(v1[0], v1[1]); w.w = cvt_pk_bf16(v1[2], v1[3]);
                        *(u32x4*)(rp + bj * HALF) = w; } } }
    }
};

typedef int v8i __attribute__((ext_vector_type(8)));
__device__ __forceinline__ v8i cat8(bf16x8 a, bf16x8 b) { struct P { bf16x8 a, b; } p{a, b}; return __builtin_bit_cast(v8i, p); }
template <class Epi, class Sched, bool ALIGN_EPI = false, bool SP2 = false, bool FP8 = false>
__device__ __forceinline__ void gemm_phase(PG8_LAS unsigned char* lds, const Gemm g, const Sched& S, const Epi& E) {
    int tid = threadIdx.x; asm volatile("" : "+v"(tid));
    const int wid = __builtin_amdgcn_readfirstlane(tid >> 6), lane = tid & 63, wr = wid >> 2, wc = wid & 3, fr = lane & 15, fq = lane >> 4;
    const int K = g.K; const int pitch = FP8 ? K : K * 2;
    unsigned voffA[2], voffB[2];
#pragma unroll
    for (int i = 0; i < 2; ++i) { int R, C; stage_rc(tid * 16 + i * 8192, R, C); const int Rb = Epi::PERM ? ((R & ~31) + perm32(R & 31)) : R;
        voffA[i] = (unsigned)(R * pitch + C * 2); voffB[i] = (unsigned)(Rb * pitch + C * 2); }
    const size_t kstep = (size_t)(BK * 2);
    const size_t hstep = (size_t)HALF * pitch;
    const size_t tstep = 2 * hstep;
    const unsigned ldsw = (unsigned)wid * 1024u;
    const int aoff = lds_byte(wr * 64 + fr, fq * 8), boff = lds_byte(wc * 32 + fr, fq * 8);
#define PG8_SA(b, h) (((b) * 2 + (h)) * HTB)
#define PG8_SB(b, h) ((4 + (b) * 2 + (h)) * HTB)
#define PG8_STAGE(bufoff, gbase, voff) do { _Pragma("unroll") for (int _i = 0; _i < 2; ++_i) \
        __builtin_amdgcn_global_load_lds((const unsigned*)((const char*)(gbase) + (voff)[_i]), (PG8_LAS unsigned*)(lds + (bufoff) + ldsw + _i * 8192), 16, 0, 0); } while (0)
#define PG8_LDA(dst, b, h) do { _Pragma("unroll") for (int m = 0; m < 4; ++m) _Pragma("unroll") for (int k = 0; k < 2; ++k) dst[m][k] = *(const PG8_LAS bf16x8*)(lds + PG8_SA(b, h) + aoff + m * 2048 + k * 1024); } while (0)
#define PG8_LDB(dst, b, h) do { _Pragma("unroll") for (int n = 0; n < 2; ++n) _Pragma("unroll") for (int k = 0; k < 2; ++k) dst[n][k] = *(const PG8_LAS bf16x8*)(lds + PG8_SB(b, h) + boff + n * 2048 + k * 1024); } while (0)
#define PG8_MMA(ai, bj, At, Bt) do { __builtin_amdgcn_s_setprio(1); if constexpr (FP8) { _Pragma("unroll") for (int m = 0; m < 4; ++m) _Pragma("unroll") for (int n = 0; n < 2; ++n) \
        asm volatile("v_mfma_f32_16x16x128_f8f6f4 %0, %1, %2, %0" : "+v"(acc[ai][bj][m][n]) : "v"(cat8(Bt[n][0], Bt[n][1])), "v"(cat8(At[m][0], At[m][1]))); } \
      else { _Pragma("unroll") for (int m = 0; m < 4; ++m) _Pragma("unroll") for (int n = 0; n < 2; ++n) _Pragma("unroll") for (int k = 0; k < 2; ++k) \
        acc[ai][bj][m][n] = __builtin_amdgcn_mfma_f32_16x16x32_bf16(Bt[n][k], At[m][k], acc[ai][bj][m][n], 0, 0, 0); } __builtin_amdgcn_s_setprio(0); } while (0)
#define PG8_WAIT_V(n) asm volatile("s_waitcnt vmcnt(" #n ")" ::: "memory")
#define PG8_WAIT_L(n) asm volatile("s_waitcnt lgkmcnt(" #n ")" ::: "memory")
#define PG8_BAR __builtin_amdgcn_s_barrier()
#define PG8_SCHED __builtin_amdgcn_sched_barrier(0)
    Unit cur, nxt; int ui = 0;
    if (!S.next(0, cur)) return;
    f32x4 acc[2][2][4][2];
#pragma unroll
    for (int a = 0; a < 2; ++a)
#pragma unroll
        for (int b = 0; b < 2; ++b)
#pragma unroll
            for (int m = 0; m < 4; ++m)
#pragma unroll
                for (int n = 0; n < 2; ++n) acc[a][b][m][n] = (f32x4){0.f, 0.f, 0.f, 0.f};
    bf16x8 At[4][2], B0[2][2], B1[2][2];
    const char* cA = (const char*)g.A + (size_t)cur.pm * tstep + (size_t)cur.kt0 * kstep; const char* cB = (const char*)g.Bt + (size_t)cur.pnb * tstep + (size_t)cur.kt0 * kstep;
    S.a_ready(cur);
    if constexpr (SP2) {
        PG8_STAGE(PG8_SB(0, 0), cB, voffB); PG8_STAGE(PG8_SB(0, 1), cB + hstep, voffB); PG8_STAGE(PG8_SA(0, 0), cA, voffA); PG8_STAGE(PG8_SA(0, 1), cA + hstep, voffA);
        if (wr == 1) PG8_BAR;
        PG8_WAIT_V(2); PG8_BAR;
        PG8_STAGE(PG8_SB(1, 0), cB + kstep, voffB); PG8_STAGE(PG8_SA(1, 0), cA + kstep, voffA); PG8_STAGE(PG8_SB(1, 1), cB + hstep + kstep, voffB);
        PG8_WAIT_V(6); PG8_BAR;
    } else {
        PG8_STAGE(PG8_SB(0, 0), cB, voffB); PG8_STAGE(PG8_SA(0, 0), cA, voffA); PG8_STAGE(PG8_SB(0, 1), cB + hstep, voffB); PG8_STAGE(PG8_SA(0, 1), cA + hstep, voffA);
        if (wr == 1) PG8_BAR;
        PG8_WAIT_V(4); PG8_BAR;
        PG8_STAGE(PG8_SB(1, 0), cB + kstep, voffB); PG8_STAGE(PG8_SA(1, 0), cA + kstep, voffA); PG8_STAGE(PG8_SB(1, 1), cB + hstep + kstep, voffB);
        PG8_WAIT_V(6); PG8_BAR;
    }
    for (;;) {
        const bool has_next = S.next(ui + 1, nxt);
        const char* nA = has_next ? (const char*)g.A + (size_t)nxt.pm * tstep + (size_t)nxt.kt0 * kstep : cA; const char* nB = has_next ? (const char*)g.Bt + (size_t)nxt.pnb * tstep + (size_t)nxt.kt0 * kstep : cB;
        const int nt = cur.nkt;
        for (int t = 0; t < nt; t += 2) {
            const bool last = (t == nt - 2);
            const char* a1 = cA + (size_t)(t + 1) * kstep;
            const char* a2 = last ? nA : cA + (size_t)(t + 2) * kstep; const char* b2 = last ? nB : cB + (size_t)(t + 2) * kstep;
            const char* a3 = a2 + kstep; const char* b3 = b2 + kstep;
            if (last && has_next) S.a_ready(nxt);
            if constexpr (SP2) {
            PG8_LDB(B0, 0, 0); PG8_LDB(B1, 0, 1); PG8_SCHED; PG8_LDA(At, 0, 0); PG8_STAGE(PG8_SA(1, 1), a1 + hstep, voffA);
            PG8_WAIT_V(8); PG8_WAIT_L(0); PG8_BAR; PG8_MMA(0, 0, At, B0); PG8_MMA(0, 1, At, B1); PG8_BAR; PG8_SCHED;
            PG8_LDA(At, 0, 1); PG8_STAGE(PG8_SB(0, 0), b2, voffB); PG8_STAGE(PG8_SB(0, 1), b2 + hstep, voffB); PG8_STAGE(PG8_SA(0, 0), a2, voffA);
            PG8_WAIT_V(8); PG8_WAIT_L(0); PG8_BAR; PG8_MMA(1, 0, At, B0); PG8_MMA(1, 1, At, B1); PG8_BAR; PG8_SCHED;
            PG8_LDB(B0, 1, 0); PG8_LDB(B1, 1, 1); PG8_SCHED; PG8_LDA(At, 1, 0); PG8_STAGE(PG8_SA(0, 1), a2 + hstep, voffA);
            PG8_WAIT_V(8); PG8_WAIT_L(0); PG8_BAR; PG8_MMA(0, 0, At, B0); PG8_MMA(0, 1, At, B1); PG8_BAR; PG8_SCHED;
            PG8_LDA(At, 1, 1); PG8_STAGE(PG8_SB(1, 0), b3, voffB); PG8_STAGE(PG8_SB(1, 1), b3 + hstep, voffB); PG8_STAGE(PG8_SA(1, 0), a3, voffA);
            PG8_WAIT_V(8); PG8_WAIT_L(0); PG8_BAR; PG8_MMA(1, 0, At, B0); PG8_MMA(1, 1, At, B1); PG8_BAR; PG8_SCHED;
            } else {
            PG8_LDB(B0, 0, 0); PG8_SCHED; PG8_LDA(At, 0, 0); PG8_STAGE(PG8_SA(1, 1), a1 + hstep, voffA);
            PG8_WAIT_L(8); PG8_BAR; PG8_WAIT_L(0); PG8_MMA(0, 0, At, B0); PG8_BAR; PG8_SCHED;
            PG8_LDB(B1, 0, 1); PG8_STAGE(PG8_SB(0, 0), b2, voffB);
            PG8_BAR; PG8_WAIT_L(0); PG8_MMA(0, 1, At, B1); PG8_BAR;
            PG8_LDA(At, 0, 1); PG8_STAGE(PG8_SA(0, 0), a2, voffA);
            PG8_BAR; PG8_WAIT_L(0); PG8_MMA(1, 0, At, B0); PG8_BAR; PG8_SCHED;
            PG8_STAGE(PG8_SB(0, 1), b2 + hstep, voffB);
            PG8_WAIT_V(6); PG8_BAR; PG8_MMA(1, 1, At, B1); PG8_BAR;
            PG8_LDB(B0, 1, 0); PG8_SCHED; PG8_LDA(At, 1, 0); PG8_STAGE(PG8_SA(0, 1), a2 + hstep, voffA);
            PG8_WAIT_L(8); PG8_BAR; PG8_WAIT_L(0); PG8_MMA(0, 0, At, B0); PG8_BAR; PG8_SCHED;
            PG8_LDB(B1, 1, 1); PG8_STAGE(PG8_SB(1, 0), b3, voffB);
            PG8_BAR; PG8_WAIT_L(0); PG8_MMA(0, 1, At, B1); PG8_BAR;
            PG8_LDA(At, 1, 1); PG8_STAGE(PG8_SA(1, 0), a3, voffA);
            PG8_BAR; PG8_WAIT_L(0); PG8_MMA(1, 0, At, B0); PG8_BAR; PG8_SCHED;
            PG8_STAGE(PG8_SB(1, 1), b3 + hstep, voffB);
            PG8_WAIT_V(6); PG8_BAR; PG8_MMA(1, 1, At, B1); PG8_BAR;
            }
        }
        if constexpr (FP8) asm volatile("s_nop 15\n\ts_nop 15" ::: "memory");
        if constexpr (ALIGN_EPI) { if (wr == 0) PG8_BAR; }
        if constexpr (!Epi::AFTER_DRAIN) { E(acc, cur, wr, wc, fr, fq); S.done(cur); }
        if (!has_next) break;
#pragma unroll
        for (int a = 0; a < 2; ++a)
#pragma unroll
            for (int b = 0; b < 2; ++b)
#pragma unroll
                for (int m = 0; m < 4; ++m)
#pragma unroll
                    for (int n = 0; n < 2; ++n) acc[a][b][m][n] = (f32x4){0.f, 0.f, 0.f, 0.f};
        cur = nxt; cA = nA; cB = nB; ++ui;
        if constexpr (ALIGN_EPI) { if (wr == 1) PG8_BAR; }
    }
    PG8_WAIT_V(0);
    if constexpr (!ALIGN_EPI) { if (wr == 0) PG8_BAR; }
    PG8_BAR;
    if constexpr (Epi::AFTER_DRAIN) { E.fused(acc, cur, wr, wc, fr, fq, lds, wid, lane); S.done(cur); }
#undef PG8_SA
#undef PG8_SB
#undef PG8_STAGE
#undef PG8_LDA
#undef PG8_LDB
#undef PG8_MMA
#undef PG8_WAIT_V
#undef PG8_WAIT_L
#undef PG8_BAR
#undef PG8_SCHED
}
}


namespace att {
using bf16 = __hip_bfloat16;
constexpr int   D = 128, NW = 8, QBLK = 32, KVBLK = 64;
constexpr float SCALE = 0.088388347648318440f;
constexpr float THR = 8.f;
constexpr int LDQ = 128, LDK = 128;
constexpr size_t SHM_V = KVBLK * D * 2, SHM_K = KVBLK * D * 2, SHM_ATTN = 2 * SHM_V + 2 * SHM_K + NW * 64 * 4;
using bf16x8 = __attribute__((ext_vector_type(8))) short;
using s16x4  = __attribute__((ext_vector_type(4))) short;
using f32x16 = __attribute__((ext_vector_type(16))) float;
using u32x4  = __attribute__((ext_vector_type(4))) unsigned;
#define KSWZ(row, colB) ((row) * 256 + ((colB) ^ (((row) & 7) << 4)))
#define SBAR() __builtin_amdgcn_sched_barrier(0)
__device__ __forceinline__ int crow(int r, int hi) { return (r & 3) + 8 * (r >> 2) + 4 * hi; }
__device__ __forceinline__ unsigned cvtpk(float lo, float hi) {
  unsigned r; asm volatile("v_cvt_pk_bf16_f32 %0, %1, %2" : "=v"(r) : "v"(lo), "v"(hi)); return r;
}
__device__ __forceinline__ void partialSM(f32x16& p0, f32x16& p1, float& m_reg, float& mn, float& alpha) {
  constexpr float C = SCALE * 1.4426950408889634f;
  float pmax = p0[0];
#pragma unroll
  for (int r = 1; r < 16; ++r) pmax = fmaxf(pmax, p0[r]);
#pragma unroll
  for (int r = 0; r < 16; ++r) pmax = fmaxf(pmax, p1[r]);
  { auto rr = __builtin_amdgcn_permlane32_swap(__float_as_uint(pmax), __float_as_uint(pmax), false, false);
    pmax = fmaxf(__uint_as_float(rr[0]), __uint_as_float(rr[1])); }
  if (__builtin_expect(__all(pmax - m_reg <= THR / SCALE), 1)) { mn = m_reg; alpha = 1.f; }
  else { mn = fmaxf(m_reg, pmax); alpha = __builtin_amdgcn_exp2f((m_reg - mn) * C); m_reg = mn; }
  float mnC = -mn * C;
#pragma unroll
  for (int r = 0; r < 16; ++r) p0[r] = fmaf(p0[r], C, mnC);
#pragma unroll
  for (int r = 0; r < 16; ++r) p1[r] = fmaf(p1[r], C, mnC);
#pragma unroll
  for (int r = 0; r < 16; ++r) p0[r] = __builtin_amdgcn_exp2f(p0[r]);
}
__device__ __forceinline__ void finishSM(f32x16& p0, f32x16& p1, float alpha, float& l_reg, bf16x8& pa0, bf16x8& pa1, bf16x8& pa2, bf16x8& pa3) {
#pragma unroll
  for (int r = 0; r < 16; ++r) p1[r] = __builtin_amdgcn_exp2f(p1[r]);
  float ps = 0;
#pragma unroll
  for (int r = 0; r < 16; ++r) ps += p0[r];
#pragma unroll
  for (int r = 0; r < 16; ++r) ps += p1[r];
  { auto rr = __builtin_amdgcn_permlane32_swap(__float_as_uint(ps), __float_as_uint(ps), false, false);
    ps = __uint_as_float(rr[0]) + __uint_as_float(rr[1]); }
  l_reg = l_reg * alpha + ps;
#define PK4(P, BASE, OUT) do { unsigned a0 = cvtpk(P[BASE + 0], P[BASE + 1]), a1 = cvtpk(P[BASE + 2], P[BASE + 3]);   \
    unsigned b0 = cvtpk(P[BASE + 4], P[BASE + 5]), b1 = cvtpk(P[BASE + 6], P[BASE + 7]);                              \
    auto r0 = __builtin_amdgcn_permlane32_swap(a0, b0, false, false); auto r1 = __builtin_amdgcn_permlane32_swap(a1, b1, false, false); \
    u32x4 w = {r0[0], r1[0], r0[1], r1[1]}; OUT = *reinterpret_cast<bf16x8*>(&w); } while (0)
  PK4(p0, 0, pa0); PK4(p0, 8, pa1); PK4(p1, 0, pa2); PK4(p1, 8, pa3);
#undef PK4
}
__device__ __forceinline__ void qkt(f32x16& p0, f32x16& p1, const bf16* Ks, const bf16x8* qr, int r32, int hi) {
  p0 = f32x16{}; p1 = f32x16{};
#pragma unroll
  for (int d0 = 0; d0 < 8; ++d0) { int cb = (d0 * 16 + hi * 8) * 2;
    bf16x8 b0 = *reinterpret_cast<const bf16x8*>((const char*)Ks + KSWZ(r32, cb));
    bf16x8 b1 = *reinterpret_cast<const bf16x8*>((const char*)Ks + KSWZ(32 + r32, cb));
    p0 = __builtin_amdgcn_mfma_f32_32x32x16_bf16(b0, qr[d0], p0, 0, 0, 0);
    p1 = __builtin_amdgcn_mfma_f32_32x32x16_bf16(b1, qr[d0], p1, 0, 0, 0); }
}
__device__ __forceinline__ void maskt(f32x16& p0, f32x16& p1, int kbase, int qpos, int hi) {
#pragma unroll
  for (int r = 0; r < 16; ++r) { const int d0 = qpos - (kbase + crow(r, hi)); const int d1 = d0 - 32;
    if (d0 > 128 || d0 < -128) p0[r] = -1e30f;
    if (d1 > 128 || d1 < -128) p1[r] = -1e30f; }
}
__device__ __forceinline__ int v_st(int k, int c) { const int kk = (k & ~0xC) | ((k & 4) << 1) | ((k & 8) >> 1); return ((kk >> 3) * 4 + (c >> 5)) * 512 + ((kk & 7) * 32 + (c & 31)) * 2; }
__device__ __forceinline__ int v_rd_base(int lane) { return ((lane & 3) << 3) | (((lane >> 2) & 3) << 6) | (((lane >> 4) & 1) << 5) | (((lane >> 5) & 1) << 8); }
constexpr int v_rd_off(int d0, int ks, int half) { return d0 * 512 + ks * 4096 + half * 2048; }
template <int OFF> __device__ __forceinline__ s16x4 tr_read(int vb) {
  s16x4 r; asm volatile("ds_read_b64_tr_b16 %0, %1 offset:%2" : "=&v"(r) : "v"(vb), "i"(OFF) : "memory"); return r;
}
template <int D0> __device__ __forceinline__ void pv_one(f32x16& od, int vb, bf16x8 pa0, bf16x8 pa1, bf16x8 pa2, bf16x8 pa3) {
  const s16x4 l0 = tr_read<v_rd_off(D0, 0, 0)>(vb), h0 = tr_read<v_rd_off(D0, 0, 1)>(vb), l1 = tr_read<v_rd_off(D0, 1, 0)>(vb), h1 = tr_read<v_rd_off(D0, 1, 1)>(vb);
  const s16x4 l2 = tr_read<v_rd_off(D0, 2, 0)>(vb), h2 = tr_read<v_rd_off(D0, 2, 1)>(vb), l3 = tr_read<v_rd_off(D0, 3, 0)>(vb), h3 = tr_read<v_rd_off(D0, 3, 1)>(vb);
  asm volatile("s_waitcnt lgkmcnt(0)" ::: "memory"); SBAR();
#define PK(L, H) (bf16x8){L[0], L[1], L[2], L[3], H[0], H[1], H[2], H[3]}
  od = __builtin_amdgcn_mfma_f32_32x32x16_bf16(pa0, PK(l0, h0), od, 0, 0, 0);
  od = __builtin_amdgcn_mfma_f32_32x32x16_bf16(pa1, PK(l1, h1), od, 0, 0, 0);
  od = __builtin_amdgcn_mfma_f32_32x32x16_bf16(pa2, PK(l2, h2), od, 0, 0, 0);
  od = __builtin_amdgcn_mfma_f32_32x32x16_bf16(pa3, PK(l3, h3), od, 0, 0, 0);
#undef PK
}
__device__ __forceinline__ void pv_d0(f32x16* o, int vb, bf16x8 pa0, bf16x8 pa1, bf16x8 pa2, bf16x8 pa3) {
  pv_one<0>(o[0], vb, pa0, pa1, pa2, pa3); pv_one<1>(o[1], vb, pa0, pa1, pa2, pa3); pv_one<2>(o[2], vb, pa0, pa1, pa2, pa3); pv_one<3>(o[3], vb, pa0, pa1, pa2, pa3);
}

template <bool MASK, bool OUT_BF16>
__device__ __forceinline__ void attn_unit(const bf16* __restrict__ Qb, const bf16* __restrict__ Kh, const bf16* __restrict__ Vh, void* __restrict__ Ob, int ldo,
                                          int klo, int nt1, int NT, int qpos0, float m_init, float l_init, char* lds, const int tid  ) {
  const int wid = tid >> 6, lane = tid & 63, r32 = lane & 31, hi = lane >> 5;
  bf16* V_lds = (bf16*)lds; bf16* K_lds = (bf16*)(lds + 2 * SHM_V);
  float* ws = (float*)(lds + 2 * SHM_V + 2 * SHM_K) + wid * 64; float* li_l = ws; float* al_l = ws + 32;
  float m_reg = m_init, l_reg = l_init; f32x16 o[4] = {}; bf16x8 qr[8];
  const bf16* Qw = Qb + (long)(wid * QBLK + r32) * LDQ + hi * 8;
#pragma unroll
  for (int d0 = 0; d0 < 8; ++d0) qr[d0] = *reinterpret_cast<const bf16x8*>(Qw + d0 * 16);
  const int sr = tid >> 4, sc = (tid & 15) * 8, vst0 = v_st(sr, sc), vst1 = v_st(32 + sr, sc);
  const int vb0 = (int)(uintptr_t)V_lds + v_rd_base(lane);
  struct { bf16x8 vs0, vs1, ks0, ks1; } sr_[2];
#define KROW(t) ((t) < nt1 ? klo + (t) * KVBLK : 4096 + ((t) - nt1) * KVBLK)
#define SLOAD(i, t) do { const int k0_ = KROW(t); sr_[i].vs0 = *reinterpret_cast<const bf16x8*>(&Vh[(long)(k0_ + sr) * LDK + sc]); sr_[i].vs1 = *reinterpret_cast<const bf16x8*>(&Vh[(long)(k0_ + 32 + sr) * LDK + sc]); \
    sr_[i].ks0 = *reinterpret_cast<const bf16x8*>(&Kh[(long)(k0_ + sr) * LDK + sc]); sr_[i].ks1 = *reinterpret_cast<const bf16x8*>(&Kh[(long)(k0_ + 32 + sr) * LDK + sc]); } while (0)
#define SWRITE(b, i) do { *(bf16x8*)((char*)V_lds + (b) * SHM_V + vst0) = sr_[i].vs0;          \
    *(bf16x8*)((char*)V_lds + (b) * SHM_V + vst1) = sr_[i].vs1; int kc = sc * 2;               \
    *(bf16x8*)((char*)K_lds + (b) * SHM_K + KSWZ(sr, kc)) = sr_[i].ks0;                       \
    *(bf16x8*)((char*)K_lds + (b) * SHM_K + KSWZ(32 + sr, kc)) = sr_[i].ks1; } while (0)
#define SWAIT() asm volatile("s_waitcnt vmcnt(4)" ::: "memory")
#define RESC(a) do { if (__any((a) < 1.f)) { if (hi == 0) al_l[r32] = (a); asm volatile("s_waitcnt lgkmcnt(0)" ::: "memory"); \
    _Pragma("unroll") for (int d = 0; d < 4; ++d) _Pragma("unroll") for (int r = 0; r < 16; ++r) o[d][r] *= al_l[crow(r, hi)]; } } while (0)
#define MASKT(P0, P1, t) do { if (MASK) { if ((t) < nt1) maskt(P0, P1, klo + (t) * KVBLK, qpos0 + wid * QBLK + r32, hi); } } while (0)
  f32x16 pA0, pA1, pB0, pB1; float mnA, mnB, alA, alB; bf16x8 pa0, pa1, pa2, pa3;
  constexpr int SE = 0, SO = 1;
  SLOAD(SE, 0); asm volatile("s_waitcnt vmcnt(0)" ::: "memory"); SWRITE(0, SE); __syncthreads();
  qkt(pA0, pA1, K_lds, qr, r32, hi); MASKT(pA0, pA1, 0); partialSM(pA0, pA1, m_reg, mnA, alA);
  SLOAD(SO, 1); if (2 < NT) SLOAD(SE, 2);
  SWAIT(); SWRITE(1, SO); __syncthreads();
  for (int j = 1; j + 1 < NT; j += 2) {
    SBAR(); qkt(pB0, pB1, (bf16*)((char*)K_lds + SHM_K), qr, r32, hi);
    finishSM(pA0, pA1, alA, l_reg, pa0, pa1, pa2, pa3); SBAR();
    SLOAD(SO, j + 2); SBAR();
    pv_d0(o, vb0, pa0, pa1, pa2, pa3); MASKT(pB0, pB1, j); partialSM(pB0, pB1, m_reg, mnB, alB);
    __syncthreads(); SWAIT(); SWRITE(0, SE);
    RESC(alB); __syncthreads();
    SBAR(); qkt(pA0, pA1, K_lds, qr, r32, hi);
    finishSM(pB0, pB1, alB, l_reg, pa0, pa1, pa2, pa3); SBAR();
    if (j + 3 < NT) SLOAD(SE, j + 3); SBAR();
    pv_d0(o, vb0 + (int)SHM_V, pa0, pa1, pa2, pa3); MASKT(pA0, pA1, j + 1); partialSM(pA0, pA1, m_reg, mnA, alA);
    __syncthreads(); SWAIT(); SWRITE(1, SO);
    RESC(alA); __syncthreads();
  }
  SBAR(); qkt(pB0, pB1, (bf16*)((char*)K_lds + SHM_K), qr, r32, hi);
  finishSM(pA0, pA1, alA, l_reg, pa0, pa1, pa2, pa3); SBAR();
  pv_d0(o, vb0, pa0, pa1, pa2, pa3); MASKT(pB0, pB1, NT - 1); partialSM(pB0, pB1, m_reg, mnB, alB);
  __syncthreads(); RESC(alB);
  finishSM(pB0, pB1, alB, l_reg, pa0, pa1, pa2, pa3); SBAR();
  pv_d0(o, vb0 + (int)SHM_V, pa0, pa1, pa2, pa3);
  if (hi == 0) li_l[r32] = l_reg; asm volatile("s_waitcnt lgkmcnt(0)" ::: "memory");
  float rli[16];
#pragma unroll
  for (int r = 0; r < 16; ++r) rli[r] = __builtin_amdgcn_rcpf(li_l[crow(r, hi)]);
  if constexpr (OUT_BF16) {
    bf16* Ow = (bf16*)Ob + (long)(wid * QBLK) * ldo;
#pragma unroll
    for (int r = 0; r < 16; ++r) { int orow = crow(r, hi);
#pragma unroll
      for (int d0 = 0; d0 < 4; ++d0) { const float ov = o[d0][r] * rli[r]; ((unsigned short*)Ow)[(long)orow * ldo + d0 * 32 + r32] = (unsigned short)cvtpk(ov, ov); } }
  } else {
    float* Ow = (float*)Ob + (long)(wid * QBLK) * ldo;
#pragma unroll
    for (int r = 0; r < 16; ++r) { int orow = crow(r, hi);
#pragma unroll
      for (int d0 = 0; d0 < 4; ++d0) Ow[(long)orow * ldo + d0 * 32 + r32] = o[d0][r] * rli[r]; }
  }
  __syncthreads();
#undef KROW
#undef SLOAD
#undef SWRITE
#undef SWAIT
#undef RESC
#undef MASKT
}
#undef KSWZ
#undef SBAR
}

constexpr int NWAVES = 8;
constexpr int D = 2048, NB = 2, SEQ = 4096, CTXL = 256;
constexpr int TL = NB * SEQ, TC = NB * CTXL, MR = TL + TC;
constexpr int KVR = SEQ + CTXL;
constexpr int EVEN_IN = 4608, ODD_IN = 3072, DFF = 5632, DFE = 7168, NE = 8, MODW = 6 * D;
constexpr int NSLOT0 = 36, NSLOT1 = 24;
constexpr int MAXT = 72, RTILES = 32, RROWS = RTILES * 256, XROWS = NE * RROWS;
constexpr float EPS = 1e-6f;
constexpr float LAM_INIT = 0.2f;

constexpr size_t MiB = 1u << 20;
constexpr size_t WS_CTL = 0, CTL_ZERO_BYTES = 1 * MiB;
constexpr size_t WS_MODS = 1 * MiB;
constexpr size_t WS_LAM = WS_MODS + 512 * 1024;
constexpr size_t WS_ROUTE = 2 * MiB;
constexpr size_t RT_EID = WS_ROUTE, RT_GATE = WS_ROUTE + 64 * 1024, RT_POS = WS_ROUTE + 128 * 1024, RT_ROWTOK = WS_ROUTE + 192 * 1024, RT_ROWGATE = WS_ROUTE + 272 * 1024,
                 RT_TILE_E = WS_ROUTE + 352 * 1024, RT_NTILES = WS_ROUTE + 353 * 1024;
constexpr size_t WS_WT_EIN = 4 * MiB, WS_WT_EOUT = 22 * MiB, WS_WT_EF1 = 30 * MiB, WS_WT_EF2 = 74 * MiB, WS_WT_OIN = 96 * MiB, WS_WT_OOUT = 108 * MiB,
                 WS_WT_X1 = 116 * MiB, WS_WT_X2 = 564 * MiB;
constexpr size_t WS_H = 788 * MiB, WS_Z = 822 * MiB, WS_QKV = 900 * MiB, WS_PB = 978 * MiB, WS_OALL = 1046 * MiB, WS_X1 = 1080 * MiB, WS_X3 = 1148 * MiB,
                 WS_ACT = 1212 * MiB, WS_XS = 1306 * MiB, WS_ACT2 = 1434 * MiB, WS_YS = 1882 * MiB, WS_PART = 2138 * MiB, WS_RGATE = 2202 * MiB, WS_END = 2203 * MiB;
static_assert(WS_WT_EIN + (size_t)EVEN_IN * D * 2 <= WS_WT_EOUT && WS_WT_EF1 + (size_t)2 * DFF * D * 2 <= WS_WT_EF2 && WS_WT_EF2 + (size_t)D * DFF * 2 <= WS_WT_OIN &&
              WS_WT_OIN + (size_t)ODD_IN * D * 2 <= WS_WT_OOUT && WS_WT_X1 + (size_t)NE * 2 * DFE * D * 2 <= WS_WT_X2 && WS_WT_X2 + (size_t)NE * D * DFE * 2 <= WS_H &&
              WS_H + (size_t)MR * D * 2 <= WS_Z && WS_Z + (size_t)MR * EVEN_IN * 2 <= WS_QKV && WS_QKV + (size_t)NB * NSLOT0 * KVR * 128 * 2 <= WS_PB &&
              WS_PB + (size_t)NB * 16 * KVR * 128 * 4 <= WS_OALL && WS_OALL + (size_t)MR * D * 2 <= WS_X1 && WS_X1 + (size_t)MR * D * 4 <= WS_X3 && WS_X3 + (size_t)TL * D * 4 <= WS_ACT &&
              WS_ACT + (size_t)MR * DFF * 2 <= WS_XS && WS_XS + (size_t)XROWS * D <= WS_ACT2 && WS_ACT2 + (size_t)XROWS * DFE <= WS_YS && WS_YS + (size_t)XROWS * D * 2 <= WS_PART && WS_PART + 64 * MiB <= WS_RGATE && WS_RGATE + (size_t)XROWS * 4 <= WS_END, "d_ws map");
constexpr int CW_BAR = 4096, CW_WORK = 8192, CW_GCNT = 8192 + 256;
constexpr int TAB_OFF = 139520;

constexpr int RING_BYTES = 131072;
constexpr int LDSCTL_OFF = 143360, MISC_OFF = LDSCTL_OFF + 320;
constexpr int LDS_BYTES = 147456;

#define GAS __attribute__((address_space(1)))
#define LAS __attribute__((address_space(3)))
typedef unsigned short bf16;
typedef unsigned v4u __attribute__((ext_vector_type(4)));
typedef unsigned v2u __attribute__((ext_vector_type(2)));
typedef float f32x4 __attribute__((ext_vector_type(4)));
typedef GAS unsigned gu32;
#define RLX_AGENT __ATOMIC_RELAXED, __HIP_MEMORY_SCOPE_AGENT
#define LDS_WAIT() asm volatile("s_waitcnt lgkmcnt(0)" ::: "memory")
#define VM_WAIT() asm volatile("s_waitcnt vmcnt(0)" ::: "memory")
__device__ __forceinline__ unsigned f2bf(float f) { unsigned u = __builtin_bit_cast(unsigned, f); return (u + 0x7fffu + ((u >> 16) & 1u)) >> 16; }
__device__ __forceinline__ unsigned pk2(float lo, float hi) { return f2bf(lo) | (f2bf(hi) << 16); }
using pg8::pk4_fp8;
constexpr float W8_SCALE = 64.f;
__device__ __forceinline__ float bflo(unsigned w) { return __builtin_bit_cast(float, w << 16); }
__device__ __forceinline__ float bfhi(unsigned w) { return __builtin_bit_cast(float, w & 0xffff0000u); }
__device__ __forceinline__ float wave_sum(float v) {
#pragma unroll
    for (int o = 1; o < 64; o <<= 1) v += __shfl_xor(v, o);
    return v;
}

#define XB_TMO      128
#define XB_XCNT(j)  (256  + 64 * (j))
#define XB_XSUB(j)  (1280 + 64 * (j))
#define XB_XGEN(j)  (2304 + 64 * (j))
#define XB_TOP      3328
#define XB_TOPGEN   3392
#define XCD_BAR_WORDS 3456
#define XB_SPIN_CAP (1u << 18)

__device__ __forceinline__ unsigned xb_ld(unsigned* p)              { return __hip_atomic_load(p, __ATOMIC_RELAXED, __HIP_MEMORY_SCOPE_AGENT); }
__device__ __forceinline__ unsigned xb_add(unsigned* p, unsigned v) { return __hip_atomic_fetch_add(p, v, __ATOMIC_RELAXED, __HIP_MEMORY_SCOPE_AGENT); }
__device__ __forceinline__ unsigned xb_xcc_id() { return (unsigned)__builtin_amdgcn_s_getreg((3 << 11) | 20) & 0xFu; }
#define XB_SPIN(cond, bar) do { unsigned _sp = 0; while (cond) { __builtin_amdgcn_s_sleep(1); \
    if ((++_sp & 255u) == 0u) { if (xb_ld(&(bar)[XB_TMO])) break; if (_sp > XB_SPIN_CAP) { atomicAdd(&(bar)[XB_TMO], 1u); break; } } } } while (0)

struct XcdBarrier {
    unsigned* bar; unsigned x;
    volatile LAS unsigned* st;
};

__device__ __forceinline__ XcdBarrier xcd_barrier_post(unsigned* bar, volatile LAS unsigned* st) {
    XcdBarrier b; b.bar = bar; b.x = xb_xcc_id(); b.st = st;
    if (threadIdx.x == 0) (void)xb_add(&bar[XB_XCNT(b.x)], 1u);
    return b;
}
__device__ __forceinline__ void xcd_barrier_complete(unsigned* bar, unsigned x, unsigned& nloc, unsigned& nx) {
    const unsigned G = gridDim.x * gridDim.y * gridDim.z;
    unsigned sum, cnt, mine, sp = 0u;
    for (;;) {
        sum = 0u; cnt = 0u; mine = 0u;
#pragma unroll
        for (unsigned j = 0; j < 16; ++j) { const unsigned c = xb_ld(&bar[XB_XCNT(j)]); sum += c; cnt += (c > 0u) ? 1u : 0u; mine = (j == x) ? c : mine; }
        if (sum == G) break;
        __builtin_amdgcn_s_sleep(1);
        if ((++sp & 255u) == 0u) { if (xb_ld(&bar[XB_TMO])) break; if (sp > XB_SPIN_CAP) { atomicAdd(&bar[XB_TMO], 1u); break; } }
    }
    nloc = mine > 0u ? mine : 1u; nx = cnt > 0u ? cnt : 1u;
}

__device__ __forceinline__ void xcd_barrier(const XcdBarrier& b) {
    asm volatile("s_waitcnt vmcnt(0)" ::: "memory");
    __syncthreads();
    if (threadIdx.x == 0) {
        unsigned* bar = b.bar;
        __builtin_amdgcn_s_waitcnt(0);
        unsigned nloc = b.st[0], nx = b.st[1];
        if (nloc == 0u) { xcd_barrier_complete(bar, b.x, nloc, nx); b.st[0] = nloc; b.st[1] = nx; }
        const unsigned old = xb_add(&bar[XB_XSUB(b.x)], 1u);
        const unsigned gen = old / nloc;
        if (old + 1u == (gen + 1u) * nloc) {
            __builtin_amdgcn_fence(__ATOMIC_RELEASE, "agent");
            asm volatile("s_waitcnt vmcnt(0)" ::: "memory");
            const unsigned og = xb_add(&bar[XB_TOP], 1u);
            const unsigned tg = og / nx;
            if (og + 1u == (tg + 1u) * nx) xb_add(&bar[XB_TOPGEN], 1u);
            else XB_SPIN(xb_ld(&bar[XB_TOPGEN]) == tg, bar);
            __builtin_amdgcn_fence(__ATOMIC_ACQUIRE, "agent");
            xb_add(&bar[XB_XGEN(b.x)], 1u);
            asm volatile("s_waitcnt vmcnt(0)" ::: "memory");
        } else {
            XB_SPIN(xb_ld(&bar[XB_XGEN(b.x)]) == gen, bar);
            __builtin_amdgcn_fence(__ATOMIC_ACQUIRE, "agent");
            asm volatile("s_waitcnt vmcnt(0)" ::: "memory");
        }
    }
    __syncthreads();
}


struct Ctx {
    LAS unsigned char* lds; int tid, lane, wave, G, c, gw, NGW;
};

__device__ __forceinline__ void transpose_item(const float* __restrict__ W, int K, int N, bf16* __restrict__ WT, int q, int kind, LAS float* scr, int lane) {
    const int nblk = N >> 6, kb = q / nblk, nb = q - kb * nblk, k0 = kb * 64, n0 = nb * 64;
    int dest0 = n0;
    if (kind == 1) { const int hf = N >> 1; const int j = n0 < hf ? n0 : n0 - hf; dest0 = (j >> 7) * 256 + (j & 127) + (n0 < hf ? 0 : 128); }
    bool rperm = false; if (kind >= 2) { const int g = n0 >> 7; rperm = kind == 2 ? !(g == 10 || g == 11 || g >= 28) : (g < 20); }
    const int l16 = lane & 15, kq = lane >> 4;
    f32x4 v[16];
#pragma unroll
    for (int i = 0; i < 16; ++i) v[i] = __builtin_nontemporal_load((const f32x4*)(W + (size_t)(k0 + 4 * i + kq) * N + n0 + 4 * l16));
#pragma unroll
    for (int i = 0; i < 16; ++i) { LAS float* p = scr + (4 * i + kq) * 65 + 4 * l16; p[0] = v[i].x; p[1] = v[i].y; p[2] = v[i].z; p[3] = v[i].w; }
    LDS_WAIT(); asm volatile("" ::: "memory");
    const int c = lane & 7, nn = lane >> 3;
#pragma unroll
    for (int jj = 0; jj < 8; ++jj) { const int n = nn + 8 * jj; const LAS float* s = scr + (8 * c) * 65 + n;
        v4u o; o.x = pk2(s[0 * 65], s[1 * 65]); o.y = pk2(s[2 * 65], s[3 * 65]); o.z = pk2(s[4 * 65], s[5 * 65]); o.w = pk2(s[6 * 65], s[7 * 65]);
        const int idx_ = n & 31; const int nd = rperm ? (32 * (idx_ >> 4) + 8 * ((idx_ >> 2) & 3) + 4 * (n >> 5) + (idx_ & 3)) : n;
        __builtin_nontemporal_store(o, (v4u*)(WT + (size_t)(dest0 + nd) * K + k0 + 8 * c)); }
    LDS_WAIT(); asm volatile("" ::: "memory");
}

__device__ __forceinline__ void transpose_item8(const float* __restrict__ W, int K, int N, unsigned char* __restrict__ WT, int q, int kind, LAS float* scr, int lane) {
    const int nblk = N >> 5, kb = q / nblk, nb = q - kb * nblk, k0 = kb * 128, n0 = nb * 32;
    int dest0 = n0;
    if (kind) { const int hf = N >> 1; const int j = n0 < hf ? n0 : n0 - hf; dest0 = (j >> 7) * 256 + (j & 127) + (n0 < hf ? 0 : 128); }
    const int l8 = lane & 7, kq = lane >> 3;
    f32x4 v[16];
#pragma unroll
    for (int i = 0; i < 16; ++i) v[i] = __builtin_nontemporal_load((const f32x4*)(W + (size_t)(k0 + 8 * i + kq) * N + n0 + 4 * l8));
#pragma unroll
    for (int i = 0; i < 16; ++i) { LAS float* p = scr + (8 * i + kq) * 33 + 4 * l8; p[0] = v[i].x; p[1] = v[i].y; p[2] = v[i].z; p[3] = v[i].w; }
    LDS_WAIT(); asm volatile("" ::: "memory");
    const int c = lane & 7, nn = lane >> 3;
#pragma unroll
    for (int jj = 0; jj < 4; ++jj) { const int n = nn + 8 * jj; const LAS float* s = scr + (16 * c) * 33 + n;
        v4u o; o.x = pk4_fp8(s[0 * 33] * W8_SCALE, s[1 * 33] * W8_SCALE, s[2 * 33] * W8_SCALE, s[3 * 33] * W8_SCALE); o.y = pk4_fp8(s[4 * 33] * W8_SCALE, s[5 * 33] * W8_SCALE, s[6 * 33] * W8_SCALE, s[7 * 33] * W8_SCALE);
        o.z = pk4_fp8(s[8 * 33] * W8_SCALE, s[9 * 33] * W8_SCALE, s[10 * 33] * W8_SCALE, s[11 * 33] * W8_SCALE); o.w = pk4_fp8(s[12 * 33] * W8_SCALE, s[13 * 33] * W8_SCALE, s[14 * 33] * W8_SCALE, s[15 * 33] * W8_SCALE);
        __builtin_nontemporal_store(o, (v4u*)(WT + (size_t)(dest0 + n) * K + k0 + 16 * c)); }
    LDS_WAIT(); asm volatile("" ::: "memory");
}

constexpr int MOD_TASKS = 2 * (MODW / 32);
__device__ __forceinline__ void mod_fill_silu(const Ctx& X, const float* cvec, const float* cctx) {
    LAS float* S = (LAS float*)X.lds;
    for (int idx = X.tid; idx < 3 * 2048; idx += NWAVES * 64) { const int i = idx >> 11, k = idx & 2047; const float cv = i < 2 ? cvec[i * 2048 + k] : cctx[k]; S[idx] = cv / (1.f + expf(-cv)); }
    __syncthreads();
}
__device__ __forceinline__ void mod_task(const Ctx& X, int task, const float* Wm, const float* bm, float* mods_l) {
    const int ch = task % (MODW / 32);
    LAS float* S = (LAS float*)X.lds;
    LAS float* R = S + 3 * 2048;
    const int kq = X.lane >> 3, c4 = X.lane & 7;
    f32x4 a0 = {0.f, 0.f, 0.f, 0.f}, a1 = a0, a2 = a0;
    const float* wp = Wm + (size_t)(X.wave * 256 + kq) * MODW + ch * 32 + 4 * c4;
    for (int k = 0; k < 256; k += 64) {
        f32x4 w[8];
#pragma unroll
        for (int u = 0; u < 8; ++u) w[u] = __builtin_nontemporal_load((const f32x4*)(wp + (size_t)(k + 8 * u) * MODW));
#pragma unroll
        for (int u = 0; u < 8; ++u) { const int kk = X.wave * 256 + k + 8 * u + kq; a0 += w[u] * S[kk]; a1 += w[u] * S[2048 + kk]; a2 += w[u] * S[4096 + kk]; }
    }
#pragma unroll
    for (int j = 0; j < 4; ++j) {
#pragma unroll
        for (int o = 8; o < 64; o <<= 1) { a0[j] += __shfl_xor(a0[j], o); a1[j] += __shfl_xor(a1[j], o); a2[j] += __shfl_xor(a2[j], o); } }
    if (kq == 0) {
#pragma unroll
        for (int j = 0; j < 4; ++j) { R[(X.wave * 3 + 0) * 32 + 4 * c4 + j] = a0[j]; R[(X.wave * 3 + 1) * 32 + 4 * c4 + j] = a1[j]; R[(X.wave * 3 + 2) * 32 + 4 * c4 + j] = a2[j]; } }
    __syncthreads();
    if (X.tid < 96) { const int i = X.tid >> 5, col = X.tid & 31; float s = 0.f;
#pragma unroll
        for (int w = 0; w < 8; ++w) s += R[(w * 3 + i) * 32 + col];
        mods_l[(size_t)i * MODW + ch * 32 + col] = s + bm[ch * 32 + col]; }
    __syncthreads();
}

template <bool ROUTER, bool PSUM = false, bool OUT8 = false>
__device__ __forceinline__ void norm_mod_rows(const Ctx& X, const float* src_lat, const float* src_ctx, int nrows, const float* gain, const float* mods_l, int sh_i, int sc_i, bf16* H,
                                              const float* wrouter, int* eid, float* egate, const float* part = nullptr, int Sp = 0, const float* pgate = nullptr, float* wb = nullptr) {
    LAS float* WR = (LAS float*)X.lds;
    if (ROUTER) { for (int idx = X.tid; idx < 8 * 2048; idx += NWAVES * 64) { const int k = idx >> 3, e = idx & 7; WR[e * 2048 + k] = wrouter[idx]; } __syncthreads(); }
    int first = X.gw, stride = X.NGW, limit = nrows;
    if (PSUM && (X.NGW >> 2) == TC && nrows == MR) {
        if ((X.gw & 3) == 0) { first = TL + (X.gw >> 2); limit = first + 1; stride = 1 << 28; }
        else { first = X.gw - (X.gw >> 2) - 1; stride = X.NGW - (X.NGW >> 2); limit = TL; }
    }
    f32x4 vn[8];
    if (first < limit) { const float* xr = first < TL ? src_lat + (size_t)first * D : src_ctx + (size_t)(first - TL) * D;
#pragma unroll
        for (int j = 0; j < 8; ++j) vn[j] = __builtin_nontemporal_load((const f32x4*)(xr + 4 * X.lane + 256 * j)); }
    for (int row = first; row < limit; row += stride) {
        const int cond = row < SEQ ? 0 : (row < TL ? 1 : 2);
        const float* shp = mods_l + (size_t)cond * MODW + sh_i * D; const float* scp = mods_l + (size_t)cond * MODW + sc_i * D;
        f32x4 v[8]; float ss = 0.f;
#pragma unroll
        for (int j = 0; j < 8; ++j) v[j] = vn[j];
        { const int nr = row + stride; if (nr < limit) { const float* xr = nr < TL ? src_lat + (size_t)nr * D : src_ctx + (size_t)(nr - TL) * D;
#pragma unroll
            for (int j = 0; j < 8; ++j) vn[j] = __builtin_nontemporal_load((const f32x4*)(xr + 4 * X.lane + 256 * j)); } }
        if (PSUM) { if (row >= TL) {
            f32x4 a[8];
#pragma unroll
            for (int j = 0; j < 8; ++j) a[j] = (f32x4){0.f, 0.f, 0.f, 0.f};
            { int p = 0;
              for (; p + 2 <= Sp; p += 2) { const float* pr = part + ((size_t)p * TC + (row - TL)) * D + 4 * X.lane; f32x4 t[2][8];
#pragma unroll
                  for (int q = 0; q < 2; ++q)
#pragma unroll
                      for (int j = 0; j < 8; ++j) t[q][j] = __builtin_nontemporal_load((const f32x4*)(pr + (size_t)q * TC * D + 256 * j));
#pragma unroll
                  for (int j = 0; j < 8; ++j) a[j] += t[0][j] + t[1][j]; }
              for (; p < Sp; ++p) { const float* pr = part + ((size_t)p * TC + (row - TL)) * D + 4 * X.lane;
#pragma unroll
                  for (int j = 0; j < 8; ++j) a[j] += __builtin_nontemporal_load((const f32x4*)(pr + 256 * j)); } }
#pragma unroll
            for (int j = 0; j < 8; ++j) { v[j] += a[j] * *(const f32x4*)(pgate + 4 * X.lane + 256 * j); if (wb) *(f32x4*)(wb + (size_t)(row - TL) * D + 4 * X.lane + 256 * j) = v[j]; }
        } }
#pragma unroll
        for (int j = 0; j < 8; ++j) ss += (v[j].x * v[j].x + v[j].y * v[j].y) + (v[j].z * v[j].z + v[j].w * v[j].w);
        const float rstd = 1.0f / sqrtf(wave_sum(ss) * (1.f / D) + EPS);
#pragma unroll
        for (int j = 0; j < 8; ++j) { const int col = 4 * X.lane + 256 * j; const f32x4 g = *(const f32x4*)(gain + col), sc = *(const f32x4*)(scp + col), sh = *(const f32x4*)(shp + col);
            v[j] = (v[j] * rstd * g) * (sc + 1.0f) + sh;
            if (OUT8) { *(unsigned*)((unsigned char*)H + (size_t)row * D + col) = pk4_fp8(v[j].x, v[j].y, v[j].z, v[j].w); }
            else { v2u o; o.x = pk2(v[j].x, v[j].y); o.y = pk2(v[j].z, v[j].w); *(v2u*)(H + (size_t)row * D + col) = o; } }
        if (ROUTER) {
            float v1 = -3.0e38f, v2 = -3.0e38f; int i1 = 0, i2 = 0;
#pragma unroll 1
            for (int e = 0; e < 8; ++e) { float a = 0.f;
#pragma unroll
                for (int j = 0; j < 8; ++j) { const f32x4 w = *(const LAS f32x4*)(WR + e * 2048 + 4 * X.lane + 256 * j); a += (v[j].x * w.x + v[j].y * w.y) + (v[j].z * w.z + v[j].w * w.w); }
                const float s = wave_sum(a);
                if (s > v1) { v2 = v1; i2 = i1; v1 = s; i1 = e; } else if (s > v2) { v2 = s; i2 = e; } }
            const float ex = expf(v2 - v1), g1 = 1.f / (1.f + ex), g2 = ex / (1.f + ex);
            if (X.lane == 0) { eid[row * 2] = i1; eid[row * 2 + 1] = i2; egate[row * 2] = g1; egate[row * 2 + 1] = g2; }
        }
    }
}

template <int NG>
__device__ __forceinline__ void qkv_post(const Ctx& X, const bf16* z, bf16* QKV, const float* qn_a, const float* kn_a, const float* qn_b, const float* kn_b) {
    typedef float f32x2 __attribute__((ext_vector_type(2)));
    LAS f32x2* CS = (LAS f32x2*)X.lds;
    for (int idx = X.tid; idx < 2048; idx += NWAVES * 64) { const int p = idx >> 5, i = idx & 31; const float inv = exp2f(-(float)i * (13.287712379549449f / 32.0f)); const float a = (float)p * inv;
        float sn, cs; sincosf(a, &sn, &cs); CS[idx] = (f32x2){cs, sn}; }
    __syncthreads();
    const int l16 = X.lane & 15, gq = X.lane >> 4, chunk = l16 >> 2;
    v4u rawn = {0u, 0u, 0u, 0u};
    if (X.gw < MR) rawn = *(const v4u*)(z + (size_t)X.gw * (NG * 128) + gq * 128 + 8 * l16);
    for (int row = X.gw; row < MR; row += X.NGW) {
        const bool lat = row < TL; const int b = lat ? (row >> 12) : ((row - TL) >> 8); const int pos = lat ? (row & 4095) : (SEQ + ((row - TL) & 255));
        const int p = (chunk < 2) ? (pos >> 6) : (pos & 63);
#pragma unroll 1
        for (int it = 0; it < NG / 4; ++it) {
            const int g = it * 4 + gq;
            const float* gp; bool hn;
            if (NG == NSLOT0) { hn = !(g == 10 || g == 11 || g >= 28); gp = g < 8 ? qn_a : (g < 12 ? kn_a : (g < 20 ? qn_b : kn_b)); }
            else { hn = g < 20; gp = g < 16 ? qn_a : kn_a; }
            const v4u raw = rawn;
            { const bool same = it + 1 < NG / 4; const int nrow = same ? row : row + X.NGW, ng = same ? g + 4 : gq; if (nrow < MR) rawn = *(const v4u*)(z + (size_t)nrow * (NG * 128) + ng * 128 + 8 * l16); }
            float v[8] = {bflo(raw.x), bfhi(raw.x), bflo(raw.y), bfhi(raw.y), bflo(raw.z), bfhi(raw.z), bflo(raw.w), bfhi(raw.w)};
            float ss = 0.f;
#pragma unroll
            for (int j = 0; j < 8; ++j) ss += v[j] * v[j];
            ss += __shfl_xor(ss, 1); ss += __shfl_xor(ss, 2); ss += __shfl_xor(ss, 4); ss += __shfl_xor(ss, 8);
            const float rs = 1.0f / sqrtf(ss * (1.f / 128.f) + EPS);
            const f32x4 ga = *(const f32x4*)(gp + 8 * l16), gb = *(const f32x4*)(gp + 8 * l16 + 4);
            const float gg[8] = {ga.x, ga.y, ga.z, ga.w, gb.x, gb.y, gb.z, gb.w};
#pragma unroll
            for (int j = 0; j < 8; ++j) v[j] = hn ? v[j] * rs * gg[j] : v[j];
            float o[8];
#pragma unroll
            for (int j = 0; j < 8; ++j) { const float pv = __shfl_xor(v[j], 4); const f32x2 cs = CS[p * 32 + 8 * (l16 & 3) + j];
                const float rot = (chunk & 1) ? (v[j] * cs.x + pv * cs.y) : (v[j] * cs.x - pv * cs.y); o[j] = (hn && lat) ? rot : v[j]; }
            v4u w; w.x = pk2(o[0], o[1]); w.y = pk2(o[2], o[3]); w.z = pk2(o[4], o[5]); w.w = pk2(o[6], o[7]);
            *(v4u*)(QKV + ((size_t)(b * NG + g) * KVR + pos) * 128 + 8 * l16) = w;
        }
    }
}

template <int NG>
__device__ __forceinline__ void k_post(const Ctx& X, bf16* QKV, const float* kn_a, const float* kn_b, const float* cs_lds) {
    constexpr int NK = (NG == NSLOT0) ? 10 : 4;
    const int l16 = X.lane & 15, rq = X.lane >> 4, chunk = l16 >> 2;
    for (int item = X.gw; item < NB * NK * (KVR / 4); item += X.NGW) {
        const int p4 = item % (KVR / 4), t = item / (KVR / 4), kgi = t % NK, b = t / NK;
        const int g = (NG == NSLOT0) ? (kgi < 2 ? 8 + kgi : 18 + kgi) : 16 + kgi;
        const float* gp = (NG == NSLOT0) ? (kgi < 2 ? kn_a : kn_b) : kn_a;
        const int pos = p4 * 4 + rq; const bool lat = pos < SEQ; const int p = (chunk < 2) ? (pos >> 6) : (pos & 63);
        bf16* ptr = QKV + ((size_t)(b * NG + g) * KVR + pos) * 128 + 8 * l16;
        const v4u raw = *(const v4u*)ptr;
        float v[8] = {bflo(raw.x), bfhi(raw.x), bflo(raw.y), bfhi(raw.y), bflo(raw.z), bfhi(raw.z), bflo(raw.w), bfhi(raw.w)};
        float ss = 0.f;
#pragma unroll
        for (int j = 0; j < 8; ++j) ss += v[j] * v[j];
        ss += __shfl_xor(ss, 1); ss += __shfl_xor(ss, 2); ss += __shfl_xor(ss, 4); ss += __shfl_xor(ss, 8);
        const float rs = 1.0f / sqrtf(ss * (1.f / 128.f) + EPS);
        const f32x4 ga = *(const f32x4*)(gp + 8 * l16), gb = *(const f32x4*)(gp + 8 * l16 + 4);
        const float gg[8] = {ga.x, ga.y, ga.z, ga.w, gb.x, gb.y, gb.z, gb.w};
        float o[8];
#pragma unroll
        for (int j = 0; j < 8; ++j) { v[j] = v[j] * rs * gg[j]; const float pv = __shfl_xor(v[j], 4); const int ci = (lat ? p : 0) * 32 + 8 * (l16 & 3) + j; const float c = cs_lds[ci * 2], sn = cs_lds[ci * 2 + 1];
            const float rot = (chunk & 1) ? (v[j] * c + pv * sn) : (v[j] * c - pv * sn); o[j] = lat ? rot : v[j]; }
        v4u w; w.x = pk2(o[0], o[1]); w.y = pk2(o[2], o[3]); w.z = pk2(o[4], o[5]); w.w = pk2(o[6], o[7]);
        *(v4u*)ptr = w;
    }
}
constexpr int CS_OFF = 98304;
__device__ __forceinline__ void build_cs(const Ctx& X) {
    LAS float* CS = (LAS float*)(X.lds + CS_OFF);
    for (int idx = X.tid; idx < 2048; idx += NWAVES * 64) { const int p = idx >> 5, i = idx & 31; const float inv = exp2f(-(float)i * (13.287712379549449f / 32.0f)); const float a = (float)p * inv;
        float sn, cs; sincosf(a, &sn, &cs); CS[idx * 2] = cs; CS[idx * 2 + 1] = sn; }
    __syncthreads();
}

__device__ __forceinline__ void b_combine(const Ctx& X, const float* PB, const float* lamv, const float* subln, bf16* OALL) {
    const int half = X.lane >> 5, d4 = (X.lane & 31) * 4;
    f32x4 n1, n2;
#define BC_LOAD(item_, d1, d2) do { const int row_ = (item_) >> 2, hb_ = (item_) & 3; const bool lat_ = row_ < TL; const int b_ = lat_ ? (row_ >> 12) : ((row_ - TL) >> 8); const int pos_ = lat_ ? (row_ & 4095) : (SEQ + ((row_ - TL) & 255)); \
        d1 = __builtin_nontemporal_load((const f32x4*)(PB + ((size_t)(b_ * 16 + (hb_ * 2 + 0) * 2 + half) * KVR + pos_) * 128 + d4)); d2 = __builtin_nontemporal_load((const f32x4*)(PB + ((size_t)(b_ * 16 + (hb_ * 2 + 1) * 2 + half) * KVR + pos_) * 128 + d4)); } while (0)
    if (X.gw < MR * 4) BC_LOAD(X.gw, n1, n2);
    for (int item = X.gw; item < MR * 4; item += X.NGW) {
        const int row = item >> 2, hb = item & 3;
        const f32x4 o1 = n1, o2 = n2;
        if (item + X.NGW < MR * 4) BC_LOAD(item + X.NGW, n1, n2);
        const float lam = lamv[hb];
        const f32x4 v = o1 - o2 * lam;
        const float ss = wave_sum((v.x * v.x + v.y * v.y) + (v.z * v.z + v.w * v.w));
        const float rs = (1.0f - LAM_INIT) / sqrtf(ss * (1.f / 256.f) + EPS);
        const f32x4 g = *(const f32x4*)(subln + half * 128 + d4);
        const f32x4 y = v * rs * g;
        v2u o; o.x = pk2(y.x, y.y); o.y = pk2(y.z, y.w);
        *(v2u*)(OALL + (size_t)row * D + 1024 + hb * 256 + half * 128 + d4) = o;
    }
#undef BC_LOAD
}

__device__ __forceinline__ void moe_route(const Ctx& X, const int* eid, const float* egate, const bf16* H, bf16* XS, int* pos, int* rowtok, float* rowgate, int* tile_e, int* ntiles) {
    LAS int* tot = (LAS int*)X.lds;
    LAS int* pre = tot + 8;
    LAS int* base = tot + 16;
    LAS int* dst = tot + 64;
    const int tpw = (TL + X.G - 1) / X.G, t0 = X.c * tpw, t1 = (t0 + tpw) < TL ? (t0 + tpw) : TL;
    if (X.tid < 16) tot[X.tid] = 0;
    __syncthreads();
    {
        int ct[8], cp[8];
#pragma unroll
        for (int e = 0; e < 8; ++e) { ct[e] = 0; cp[e] = 0; }
        for (int idx = X.tid; idx < 2 * TL; idx += NWAVES * 64) { const int e = eid[idx]; const bool before = (idx >> 1) < t0;
#pragma unroll
            for (int ee = 0; ee < 8; ++ee) { ct[ee] += __popcll(__ballot(e == ee)); cp[ee] += __popcll(__ballot(e == ee && before)); } }
        if (X.lane == 0) {
#pragma unroll
            for (int e = 0; e < 8; ++e) { __hip_atomic_fetch_add(&tot[e], ct[e], __ATOMIC_RELAXED, __HIP_MEMORY_SCOPE_WORKGROUP); __hip_atomic_fetch_add(&pre[e], cp[e], __ATOMIC_RELAXED, __HIP_MEMORY_SCOPE_WORKGROUP); } }
    }
    __syncthreads();
    if (X.tid == 0) { int acc = 0; for (int e = 0; e < 8; ++e) { base[e] = acc; acc += (tot[e] + 255) & ~255; }
        if (X.c == 0) { *ntiles = acc >> 8; for (int e = 0; e < 8; ++e) { const int nt = (tot[e] + 255) >> 8; for (int i = 0; i < nt; ++i) tile_e[(base[e] >> 8) + i] = e; } } }
    __syncthreads();
    if (X.wave == 0) {
        int run[8];
#pragma unroll
        for (int e = 0; e < 8; ++e) run[e] = 0;
        const int n_ent = 2 * (t1 - t0);
        for (int b0 = 0; b0 < n_ent; b0 += 64) {
            const int li = b0 + X.lane; const bool valid = li < n_ent; const int idx = 2 * t0 + li; const int e = valid ? eid[idx] : -1;
            int rank = 0;
#pragma unroll
            for (int ee = 0; ee < 8; ++ee) { const unsigned long long m = __ballot(e == ee); if (e == ee) rank = run[ee] + __popcll(m & ((1ull << X.lane) - 1ull)); run[ee] += __popcll(m); }
            if (valid) { const int d = base[e] + pre[e] + rank; dst[li] = d; pos[idx] = d; rowtok[d] = idx >> 1; rowgate[d] = egate[idx]; }
        }
    }
    __syncthreads();
    { const int n_tok = t1 - t0;
      for (int tb = X.wave * 4; tb < n_tok; tb += NWAVES * 4) {
          v4u rbuf[4][2];
#pragma unroll
          for (int i = 0; i < 4; ++i) { const int tk_ = (tb + i) < n_tok ? (tb + i) : (n_tok - 1); const v4u* s_ = (const v4u*)((const unsigned char*)H + (size_t)(t0 + tk_) * D) + X.lane;
              rbuf[i][0] = s_[0]; rbuf[i][1] = s_[64]; }
#pragma unroll
          for (int i = 0; i < 4; ++i) if (tb + i < n_tok) {
#pragma unroll
              for (int k = 0; k < 2; ++k) { const int d = dst[2 * (tb + i) + k]; v4u* o_ = (v4u*)((unsigned char*)XS + (size_t)d * D) + X.lane;
                  __builtin_nontemporal_store(rbuf[i][0], o_); __builtin_nontemporal_store(rbuf[i][1], o_ + 64); } } } }
    if (X.c < 8) { const int e = X.c; const int r0 = base[e] + tot[e], r1 = base[e] + ((tot[e] + 255) & ~255);
        for (int r = r0 + X.wave; r < r1; r += NWAVES) { if (X.lane == 0) { rowtok[r] = -1; rowgate[r] = 0.f; }
            v4u* o = (v4u*)((unsigned char*)XS + (size_t)r * D) + X.lane; const v4u zz = {0u, 0u, 0u, 0u};
#pragma unroll
            for (int j = 0; j < 2; ++j) o[64 * j] = zz; } }
    __syncthreads();
}

__device__ __forceinline__ void norm_route_rows(const Ctx& X, const float* X3, const float* gain, const float* mods_l, int sh_i, int sc_i, const float* wrouter, unsigned* gcnt, unsigned char* xs, int* pos, float* rowgate) {
    LAS float* WR = (LAS float*)X.lds;
    LAS int* ENT_E = (LAS int*)(X.lds + 65536);
    LAS float* ENT_G = (LAS float*)(X.lds + 65536 + 256);
    LAS int* ENT_P = (LAS int*)(X.lds + 65536 + 512);
    LAS int* BASE = (LAS int*)(X.lds + 65536 + 768);
    for (int idx = X.tid; idx < 8 * 2048; idx += NWAVES * 64) { const int k = idx >> 3, e = idx & 7; WR[e * 2048 + k] = wrouter[idx]; }
    __syncthreads();
    const int rpw = (TL + X.NGW - 1) / X.NGW;
    for (int p0 = 0; p0 < rpw; p0 += 4) {
        unsigned pk[4][8]; f32x4 nxt[8];
        { const int row = X.gw + p0 * X.NGW; const float* xr = X3 + (size_t)(row < TL ? row : X.gw) * D;
#pragma unroll
          for (int j = 0; j < 8; ++j) nxt[j] = __builtin_nontemporal_load((const f32x4*)(xr + 4 * X.lane + 256 * j)); }
#pragma unroll
        for (int i = 0; i < 4; ++i) {
            const int row = X.gw + (p0 + i) * X.NGW; const bool valid = (p0 + i) < rpw && row < TL;
            int i1 = -1, i2 = -1; float g1 = 0.f, g2 = 0.f;
            f32x4 cur[8];
#pragma unroll
            for (int j = 0; j < 8; ++j) cur[j] = nxt[j];
            if (i < 3) { const int rn = X.gw + (p0 + i + 1) * X.NGW; const float* xr = X3 + (size_t)(((p0 + i + 1) < rpw && rn < TL) ? rn : X.gw) * D;
#pragma unroll
                for (int j = 0; j < 8; ++j) nxt[j] = __builtin_nontemporal_load((const f32x4*)(xr + 4 * X.lane + 256 * j)); }
            if (valid) {
                const int cond = row < SEQ ? 0 : 1;
                const float* shp = mods_l + (size_t)cond * MODW + sh_i * D; const float* scp = mods_l + (size_t)cond * MODW + sc_i * D;
                f32x4 v[8]; float ss = 0.f;
#pragma unroll
                for (int j = 0; j < 8; ++j) v[j] = cur[j];
#pragma unroll
                for (int j = 0; j < 8; ++j) ss += (v[j].x * v[j].x + v[j].y * v[j].y) + (v[j].z * v[j].z + v[j].w * v[j].w);
                const float rstd = 1.0f / sqrtf(wave_sum(ss) * (1.f / D) + EPS);
#pragma unroll
                for (int j = 0; j < 8; ++j) { const int col = 4 * X.lane + 256 * j; const f32x4 g = *(const f32x4*)(gain + col), sc = *(const f32x4*)(scp + col), sh = *(const f32x4*)(shp + col);
                    v[j] = (v[j] * rstd * g) * (sc + 1.0f) + sh; pk[i][j] = pk4_fp8(v[j].x, v[j].y, v[j].z, v[j].w); }
                float v1 = -3.0e38f, v2 = -3.0e38f; i1 = 0; i2 = 0;
#pragma unroll 1
                for (int e = 0; e < 8; ++e) { float a = 0.f;
#pragma unroll
                    for (int j = 0; j < 8; ++j) { const f32x4 w = *(const LAS f32x4*)(WR + e * 2048 + 4 * X.lane + 256 * j); a += (v[j].x * w.x + v[j].y * w.y) + (v[j].z * w.z + v[j].w * w.w); }
                    const float sl = wave_sum(a);
                    if (sl > v1) { v2 = v1; i2 = i1; v1 = sl; i1 = e; } else if (sl > v2) { v2 = sl; i2 = e; } }
                const float ex = expf(v2 - v1); g1 = 1.f / (1.f + ex); g2 = ex / (1.f + ex);
            } else {
#pragma unroll
                for (int j = 0; j < 8; ++j) pk[i][j] = 0u;
            }
            if (X.lane == 0) { const int sl2 = 2 * (8 * i + X.wave); ENT_E[sl2] = i1; ENT_E[sl2 + 1] = i2; ENT_G[sl2] = g1; ENT_G[sl2 + 1] = g2; }
        }
        __syncthreads();
        if (X.wave == 0) {
            const int e = ENT_E[X.lane]; int rank = 0, mycnt = 0;
#pragma unroll
            for (int ee = 0; ee < 8; ++ee) { const unsigned long long m = __ballot(e == ee); const int c = __popcll(m); if (e == ee) rank = __popcll(m & ((1ull << X.lane) - 1ull)); if (X.lane == ee) mycnt = c; }
            if (X.lane < 8) { int b = 0; if (mycnt > 0) b = (int)__hip_atomic_fetch_add(gcnt + 64 * X.lane, (unsigned)mycnt, __ATOMIC_RELAXED, __HIP_MEMORY_SCOPE_AGENT); BASE[X.lane] = b; }
            LDS_WAIT(); asm volatile("" ::: "memory");
            if (e >= 0) { const int phys = e * RROWS + BASE[e] + rank; ENT_P[X.lane] = phys;
                const int slot = X.lane >> 1; const int row = (X.c * NWAVES + (slot & 7)) + (p0 + (slot >> 3)) * X.NGW;
                pos[2 * row + (X.lane & 1)] = phys; rowgate[phys] = ENT_G[X.lane]; }
        }
        __syncthreads();
#pragma unroll
        for (int i = 0; i < 4; ++i) {
            const int sl2 = 2 * (8 * i + X.wave);
#pragma unroll
            for (int k = 0; k < 2; ++k) if (ENT_E[sl2 + k] >= 0) { unsigned* o = (unsigned*)(xs + (size_t)ENT_P[sl2 + k] * D) + X.lane;
#pragma unroll
                for (int j = 0; j < 8; ++j) o[64 * j] = pk[i][j]; }
        }
        __syncthreads();
    }
}
__device__ __forceinline__ int build_moe_tables(const Ctx& X, const unsigned* gcnt) {
    LAS int* TE = (LAS int*)(X.lds + TAB_OFF); LAS int* TP = TE + MAXT; LAS int* PRE = TP + MAXT;
    if (X.tid == 0) { int acc = 0;
        for (int e = 0; e < NE; ++e) { const int nt = ((int)gcnt[64 * e] + 255) >> 8; PRE[e] = acc; for (int j = 0; j < nt; ++j) { TE[acc + j] = e; TP[acc + j] = e * RTILES + j; } acc += nt; }
        PRE[NE] = acc; }
    __syncthreads();
    return __builtin_amdgcn_readfirstlane(PRE[NE]);
}
constexpr int MOE_MAIN_TILES = 64, MOE_MAIN_ROWS = MOE_MAIN_TILES * 256;
__device__ __forceinline__ void moe_final(const Ctx& X, const float* X3, const bf16* YS, const int* pos, const float* mods_l, float* out, const float* part, int ntiles) {
    const LAS int* PRE = (const LAS int*)(X.lds + TAB_OFF) + 2 * MAXT;
    int Sp, ppair; const int tail_rows = (ntiles - MOE_MAIN_TILES) * 256; pg8::tail_split(X.G, (ntiles - MOE_MAIN_TILES) * (D / 256), DFE / 128, Sp, ppair);
    int np0 = 0, np1 = 0; if (X.gw < TL) { np0 = pos[2 * X.gw]; np1 = pos[2 * X.gw + 1]; }
    for (int row = X.gw; row < TL; row += X.NGW) {
        const int p0 = np0, p1 = np1; const float* gp = mods_l + (size_t)(row >> 12) * MODW + 5 * D;
        const int l0 = (PRE[p0 >> 13] + ((p0 & (RROWS - 1)) >> 8)) * 256 + (p0 & 255), l1 = (PRE[p1 >> 13] + ((p1 & (RROWS - 1)) >> 8)) * 256 + (p1 & 255);
        if (row + X.NGW < TL) { np0 = pos[2 * (row + X.NGW)]; np1 = pos[2 * (row + X.NGW) + 1]; }
        f32x4 a[8], b[8];
        if (l0 < MOE_MAIN_ROWS) {
#pragma unroll
            for (int j = 0; j < 8; ++j) { const v2u w = __builtin_nontemporal_load((const v2u*)(YS + (size_t)p0 * D + 4 * X.lane + 256 * j)); a[j] = (f32x4){bflo(w.x), bfhi(w.x), bflo(w.y), bfhi(w.y)}; }
        } else {
#pragma unroll
            for (int j = 0; j < 8; ++j) a[j] = (f32x4){0.f, 0.f, 0.f, 0.f};
            { int p = 0;
              for (; p + 2 <= Sp; p += 2) { const float* pr = part + ((size_t)p * tail_rows + (l0 - MOE_MAIN_ROWS)) * D + 4 * X.lane; f32x4 t[2][8];
#pragma unroll
                  for (int q = 0; q < 2; ++q)
#pragma unroll
                      for (int j = 0; j < 8; ++j) t[q][j] = __builtin_nontemporal_load((const f32x4*)(pr + (size_t)q * tail_rows * D + 256 * j));
#pragma unroll
                  for (int j = 0; j < 8; ++j) a[j] += t[0][j] + t[1][j]; }
              for (; p < Sp; ++p) { const float* pr = part + ((size_t)p * tail_rows + (l0 - MOE_MAIN_ROWS)) * D + 4 * X.lane;
#pragma unroll
                  for (int j = 0; j < 8; ++j) a[j] += __builtin_nontemporal_load((const f32x4*)(pr + 256 * j)); } }
        }
        if (l1 < MOE_MAIN_ROWS) {
#pragma unroll
            for (int j = 0; j < 8; ++j) { const v2u w = __builtin_nontemporal_load((const v2u*)(YS + (size_t)p1 * D + 4 * X.lane + 256 * j)); b[j] = (f32x4){bflo(w.x), bfhi(w.x), bflo(w.y), bfhi(w.y)}; }
        } else {
#pragma unroll
            for (int j = 0; j < 8; ++j) b[j] = (f32x4){0.f, 0.f, 0.f, 0.f};
            { int p = 0;
              for (; p + 2 <= Sp; p += 2) { const float* pr = part + ((size_t)p * tail_rows + (l1 - MOE_MAIN_ROWS)) * D + 4 * X.lane; f32x4 t[2][8];
#pragma unroll
                  for (int q = 0; q < 2; ++q)
#pragma unroll
                      for (int j = 0; j < 8; ++j) t[q][j] = __builtin_nontemporal_load((const f32x4*)(pr + (size_t)q * tail_rows * D + 256 * j));
#pragma unroll
                  for (int j = 0; j < 8; ++j) b[j] += t[0][j] + t[1][j]; }
              for (; p < Sp; ++p) { const float* pr = part + ((size_t)p * tail_rows + (l1 - MOE_MAIN_ROWS)) * D + 4 * X.lane;
#pragma unroll
                  for (int j = 0; j < 8; ++j) b[j] += __builtin_nontemporal_load((const f32x4*)(pr + 256 * j)); } }
        }
#pragma unroll
        for (int j = 0; j < 8; ++j) { const int col = 4 * X.lane + 256 * j; const f32x4 x = __builtin_nontemporal_load((const f32x4*)(X3 + (size_t)row * D + col)), g = *(const f32x4*)(gp + col);
            __builtin_nontemporal_store(x + g * (a[j] + b[j]), (f32x4*)(out + (size_t)row * D + col)); }
    }
}

__device__ __forceinline__ int grab_items(unsigned* head, int n, int lane) {
    int v = 0; if (lane == 0) v = (int)__hip_atomic_fetch_add(head, (unsigned)n, __ATOMIC_RELAXED, __HIP_MEMORY_SCOPE_AGENT);
    return __builtin_amdgcn_readfirstlane(v);
}
__device__ __forceinline__ int idle_units(int nunits, int G, int c) { const int maxu = (nunits + G - 1) / G, mine = c < nunits ? (nunits - c + G - 1) / G : 0; return maxu - mine; }
__device__ __forceinline__ const float* arg_in(int i) {
    auto kp = __builtin_amdgcn_kernarg_segment_ptr();
    asm volatile("" : "+s"(kp));
    return ((const float* const __attribute__((address_space(4)))*)kp)[i];
}
#define AIN(i) arg_in(i)
constexpr int PX1_ITEMS = (D / 128) * (2 * DFE / 32), PX2_ITEMS = (DFE / 128) * (D / 32), NQ1 = NE * PX1_ITEMS, NDEF = NQ1 + NE * PX2_ITEMS;
__device__ __forceinline__ void def_item(int it, unsigned char* ws, LAS float* scr, int lane) {
    const bool up = it < NQ1; const int r = up ? it : it - NQ1; const int per = up ? PX1_ITEMS : PX2_ITEMS; const int e = r / per, q = r - e * per;
    const float* W = (up ? AIN(31) : AIN(32)) + (size_t)e * ((size_t)D * DFE * (up ? 2 : 1));
    unsigned char* WT = ws + (up ? WS_WT_X1 : WS_WT_X2) + (size_t)e * ((size_t)D * DFE * (up ? 2 : 1));
    transpose_item8(W, up ? D : DFE, up ? 2 * DFE : D, WT, q, up ? 1 : 0, scr, lane);
}
__device__ __forceinline__ void drain_deferred(const Ctx& X, gu32* ctl, unsigned char* ws, int max_batches, int limit) {
    unsigned* head = (unsigned*)(ctl + CW_WORK + 64);
    volatile LAS int* tk = (volatile LAS int*)(X.lds + 139264);
    LAS float* scr = (LAS float*)(X.lds + X.wave * 16896);
    int par = 0;
    if (max_batches > 0) { volatile LAS unsigned* pend = (volatile LAS unsigned*)(X.lds + MISC_OFF + 4 * (8 + 5));
      if (X.tid == 0) { tk[2] = (int)pend[0] - 1; pend[0] = 0u; }
      __syncthreads();
      const int pb = tk[2];
      if (pb >= 0) { const int it = pb + X.wave; if (it < NDEF) def_item(it, ws, scr, X.lane); } }
    for (int b = 0; b < max_batches; ++b) {
        if (X.tid == 0) tk[par] = (int)__hip_atomic_fetch_add(head, 16u, __ATOMIC_RELAXED, __HIP_MEMORY_SCOPE_AGENT);
        __syncthreads();
        const int base = tk[par]; par ^= 1;
        if (base >= NDEF) break;
#pragma unroll 1
        for (int i = 0; i < 2; ++i) { const int it = base + X.wave + 8 * i; if (it < NDEF) def_item(it, ws, scr, X.lane); }
        if (base >= limit) break;
    }
    __syncthreads();
}
__device__ __forceinline__ void xcd_barrier_h(const XcdBarrier& b, const Ctx& X, gu32* ctl, unsigned char* ws) {
    asm volatile("s_waitcnt vmcnt(0)" ::: "memory");
    __syncthreads();
    if (threadIdx.x == 0) {
        unsigned* bar = b.bar;
        __builtin_amdgcn_s_waitcnt(0);
        unsigned nloc = b.st[0], nx = b.st[1];
        if (nloc == 0u) { xcd_barrier_complete(bar, b.x, nloc, nx); b.st[0] = nloc; b.st[1] = nx; }
        const unsigned old = xb_add(&bar[XB_XSUB(b.x)], 1u);
        const unsigned gen = old / nloc;
        if (old + 1u == (gen + 1u) * nloc) {
            __builtin_amdgcn_fence(__ATOMIC_RELEASE, "agent");
            asm volatile("s_waitcnt vmcnt(0)" ::: "memory");
            const unsigned og = xb_add(&bar[XB_TOP], 1u);
            const unsigned tg = og / nx;
            if (og + 1u == (tg + 1u) * nx) xb_add(&bar[XB_TOPGEN], 1u);
            else XB_SPIN(xb_ld(&bar[XB_TOPGEN]) == tg, bar);
            __builtin_amdgcn_fence(__ATOMIC_ACQUIRE, "agent");
            xb_add(&bar[XB_XGEN(b.x)], 1u);
            asm volatile("s_waitcnt vmcnt(0)" ::: "memory");
            b.st[2] = 0u;
        } else { b.st[2] = 1u; b.st[3] = gen; }
    }
    __syncthreads();
    if (b.st[2]) {
        unsigned* head = (unsigned*)(ctl + CW_WORK + 64);
        int ht = threadIdx.x; asm volatile("" : "+v"(ht));
        const int hlane = ht & 63, hwave = __builtin_amdgcn_readfirstlane(ht >> 6);
        LAS float* scr = (LAS float*)(X.lds + hwave * 16896);
        int par = 0;
        int nxt = -1; if (ht == 0) { const unsigned p_ = b.st[5]; nxt = p_ ? (int)p_ - 1 : -1; }
        for (;;) {
            if (ht == 0) {
                unsigned* bar = b.bar; const unsigned gen = b.st[3], nloc = b.st[0], nx = b.st[1];
                int cmd = -1; unsigned sp = 0u;
                for (;;) {
                    const unsigned xg = xb_ld(&bar[XB_XGEN(b.x)]), xs = xb_ld(&bar[XB_XSUB(b.x)]), xt = xb_ld(&bar[XB_TOP]);
                    if (xg != gen) break;
                    if (b.st[4] == 0u) {
                        const unsigned la = xs - gen * nloc;
                        bool go = la + 1u <= nloc;
                        if (!go && la == nloc) go = (xt - gen * nx) + 1u <= nx;
                        if (go) {
                            if (nxt < 0) nxt = (int)__hip_atomic_fetch_add(head, 8u, __ATOMIC_RELAXED, __HIP_MEMORY_SCOPE_AGENT);
                            if (nxt < NDEF) { cmd = nxt; nxt = (int)__hip_atomic_fetch_add(head, 8u, __ATOMIC_RELAXED, __HIP_MEMORY_SCOPE_AGENT); break; }
                            b.st[4] = 1u; nxt = -1;
                        }
                    }
                    __builtin_amdgcn_s_sleep(1);
                    if ((++sp & 255u) == 0u) { if (xb_ld(&bar[XB_TMO])) break; if (sp > XB_SPIN_CAP) { atomicAdd(&bar[XB_TMO], 1u); break; } }
                }
                b.st[6 + par] = (unsigned)cmd;
            }
            __syncthreads();
            const int cmd = (int)b.st[6 + par]; par ^= 1;
            if (cmd < 0) break;
            const int it = cmd + hwave; if (it < NDEF) def_item(it, ws, scr, hlane);
        }
        if (ht == 0) b.st[5] = (nxt >= 0 && nxt < NDEF) ? (unsigned)(nxt + 1) : 0u;
        if (threadIdx.x == 0) {
            __builtin_amdgcn_fence(__ATOMIC_ACQUIRE, "agent");
            asm volatile("s_waitcnt vmcnt(0)" ::: "memory");
        }
        __syncthreads();
    }
}
constexpr int NPHASE = 20;
#ifndef PHMASK
#define PHMASK 0xFFFFFu
#endif
#ifndef PHDUP
#define PHDUP 0u
#endif
#define REP(k) _Pragma("unroll") for (int rep_ = 0; rep_ < ((((PHDUP) >> (k)) & 1u) ? 2 : 1); ++rep_)
#ifndef MK_LAUNCHES
#define MK_LAUNCHES {{0, NPHASE}}
#endif
struct PhRange { int lo, hi; };
constexpr PhRange kLaunches[] = MK_LAUNCHES;
struct Args { const float* in[33]; float* out; unsigned char* ws; int ph_lo, ph_hi, li, pad; };
__global__ void __launch_bounds__(NWAVES * 64, 2) fwd_kernel(Args args) {
    extern __shared__ __attribute__((aligned(16))) unsigned char lds[];
    Ctx X;
    X.lds = (LAS unsigned char*)lds; X.tid = threadIdx.x; X.lane = X.tid & 63; X.wave = __builtin_amdgcn_readfirstlane(X.tid >> 6);
    X.G = gridDim.x; X.c = blockIdx.x; X.gw = X.c * NWAVES + X.wave; X.NGW = X.G * NWAVES;
    unsigned char* ws = args.ws;
    gu32* ctl = (gu32*)(ws + WS_CTL);
    volatile LAS unsigned* MISC = (volatile LAS unsigned*)(X.lds + MISC_OFF);
    for (int u = X.tid; u < (LDS_BYTES - LDSCTL_OFF) / 4; u += NWAVES * 64) ((LAS unsigned*)(X.lds + LDSCTL_OFF))[u] = 0u;
    __syncthreads();
    const int lo = args.ph_lo, hi = args.ph_hi;
    XcdBarrier bar; bar.bar = (unsigned*)(ctl + CW_BAR) + args.li * XCD_BAR_WORDS; bar.x = 0; bar.st = nullptr;
    if (hi - lo > 1) bar = xcd_barrier_post((unsigned*)(ctl + CW_BAR) + args.li * XCD_BAR_WORDS, MISC + 8);
#ifdef PROBE_SEL
    volatile LAS unsigned long long* TS = (volatile LAS unsigned long long*)(X.lds + LDSCTL_OFF + 1024);
    const bool stamper = (blockIdx.x == PROBE_BLK && X.tid == 0);
    if (stamper) TS[63] = __builtin_amdgcn_s_memrealtime();
#define GRID_BAR_K(k) do { if (stamper) TS[2 * (k)] = __builtin_amdgcn_s_memrealtime(); xcd_barrier_h(bar, X, ctl, ws); if (stamper) TS[2 * (k) + 1] = __builtin_amdgcn_s_memrealtime(); } while (0)
#else
#define GRID_BAR_K(k) xcd_barrier_h(bar, X, ctl, ws)
#endif
#define GRID_BAR() xcd_barrier(bar)
#define REFRESH_X() do { int t_ = threadIdx.x; asm volatile("" : "+v"(t_)); X.tid = t_; X.lane = t_ & 63; } while (0)
#define IN(k) ((((PHMASK) >> (k)) & 1u) && lo <= (k) && (k) < hi)
#define BOTH(k) (IN(k) && ((k) + 1) < hi)

#define x_in (AIN(0))
#define c_in (AIN(1))
#define ctx_in (AIN(2))
#define cctx_in (AIN(3))
#define mods0 ((float*)(ws + WS_MODS))
#define mods1 ((float*)(ws + WS_MODS) + 3 * MODW)
#define lamv ((float*)(ws + WS_LAM))
#define CSTAB ((float*)(ws + WS_LAM + 4096))
#define GTAB ((float*)(ws + WS_LAM + 4096 + 16384))
#define WT_EIN ((bf16*)(ws + WS_WT_EIN))
#define WT_EOUT ((bf16*)(ws + WS_WT_EOUT))
#define WT_EF1 ((bf16*)(ws + WS_WT_EF1))
#define WT_EF2 ((bf16*)(ws + WS_WT_EF2))
#define WT_OIN ((bf16*)(ws + WS_WT_OIN))
#define WT_OOUT ((bf16*)(ws + WS_WT_OOUT))
#define WT_X1 ((bf16*)(ws + WS_WT_X1))
#define WT_X2 ((bf16*)(ws + WS_WT_X2))
#define H ((bf16*)(ws + WS_H))
#define Z ((bf16*)(ws + WS_Z))
#define QKV ((bf16*)(ws + WS_QKV))
#define PB ((float*)(ws + WS_PB))
#define OALL ((bf16*)(ws + WS_OALL))
#define X1 ((float*)(ws + WS_X1))
#define X3 ((float*)(ws + WS_X3))
#define ACT ((bf16*)(ws + WS_ACT))
#define XS ((bf16*)(ws + WS_XS))
#define ACT2 ((bf16*)(ws + WS_ACT2))
#define YS ((bf16*)(ws + WS_YS))
#define PART ((float*)(ws + WS_PART))
#define EID ((int*)(ws + RT_EID))
#define EGATE ((float*)(ws + RT_GATE))
#define POS ((int*)(ws + RT_POS))
#define ROWTOK ((int*)(ws + RT_ROWTOK))
#define ROWGATE ((float*)(ws + WS_RGATE))
#define TILE_E ((int*)(ws + RT_TILE_E))
#define NTILES ((int*)(ws + RT_NTILES))

    if (IN(0)) { REFRESH_X();
    REP(0) { if (rep_) __syncthreads();
    {
        mod_fill_silu(X, c_in, cctx_in);
        for (int task = X.c; task < MOD_TASKS; task += X.G) { const int l = task / (MODW / 32); mod_task(X, task, l ? AIN(24) : AIN(6), l ? AIN(25) : AIN(7), l ? mods1 : mods0); }
        if (X.c == (X.G > 1 ? X.G - 2 : 0)) {
            for (int idx = X.tid; idx < 2048; idx += NWAVES * 64) { const int pp = idx >> 5, i = idx & 31; const float inv = exp2f(-(float)i * (13.287712379549449f / 32.0f)); float sn, cs; sincosf((float)pp * inv, &sn, &cs);
                CSTAB[idx] = cs; CSTAB[2048 + idx] = sn; }
            for (int idx = X.tid; idx < 6 * 128; idx += NWAVES * 64) { const int gi = idx >> 7, j = idx & 127;
                const float* src = gi == 0 ? AIN(10) : gi == 1 ? AIN(11) : gi == 2 ? AIN(13) : gi == 3 ? AIN(14) : gi == 4 ? AIN(28) : AIN(29); GTAB[idx] = src[j]; }
        }
        if (X.c == X.G - 1 && X.wave == 0) {
            for (int h = 0; h < 4; ++h) { const float* q1 = AIN(15) + h * 128; const float* k1 = AIN(16) + h * 128; const float* q2 = AIN(17) + h * 128; const float* k2 = AIN(18) + h * 128;
                const float s1 = wave_sum(q1[X.lane] * k1[X.lane] + q1[X.lane + 64] * k1[X.lane + 64]); const float s2 = wave_sum(q2[X.lane] * k2[X.lane] + q2[X.lane + 64] * k2[X.lane + 64]);
                if (X.lane == 0) lamv[h] = expf(s1) - expf(s2) + LAM_INIT; }
        }
        LAS float* scr = (LAS float*)(X.lds + X.wave * 16896);
        constexpr int I0 = (D / 64) * (EVEN_IN / 64), I1 = I0 + (D / 64) * (D / 64), I2 = I1 + (D / 128) * (2 * DFF / 32), I3 = I2 + (DFF / 64) * (D / 64), I4 = I3 + (D / 64) * (ODD_IN / 64), I5 = I4 + (D / 64) * (D / 64);
        constexpr int NITEMS = I5;
        constexpr int NA = (NITEMS * 3 / 4) & ~7, CHA = 8, CHB = 2;
        unsigned* wq = (unsigned*)(ctl + CW_WORK);
#define GRAB(word, n) grab_items(wq + 64 * (word), (n), X.lane)
#define DO_ITEM(it_) do { int r_ = (it_); \
            if (r_ < I0) { transpose_item(AIN(8), D, EVEN_IN, WT_EIN, r_, 2, scr, X.lane); } \
            else if (r_ < I1) { transpose_item(AIN(9), D, D, WT_EOUT, r_ - I0, 0, scr, X.lane); } \
            else if (r_ < I2) { transpose_item8(AIN(20), D, 2 * DFF, (unsigned char*)WT_EF1, r_ - I1, 1, scr, X.lane); } \
            else if (r_ < I3) { transpose_item(AIN(21), DFF, D, WT_EF2, r_ - I2, 0, scr, X.lane); } \
            else if (r_ < I4) { transpose_item(AIN(26), D, ODD_IN, WT_OIN, r_ - I3, 3, scr, X.lane); } \
            else { transpose_item(AIN(27), D, D, WT_OOUT, r_ - I4, 0, scr, X.lane); } } while (0)
        {
            constexpr int CH = 2;
            volatile LAS int* tk = (volatile LAS int*)(X.lds + 139264);
            int par = 0; int nxt = 0; if (X.tid == 0) nxt = (int)__hip_atomic_fetch_add(wq, (unsigned)(8 * CH), __ATOMIC_RELAXED, __HIP_MEMORY_SCOPE_AGENT);
            for (;;) {
                if (X.tid == 0) { tk[par] = nxt; nxt = (int)__hip_atomic_fetch_add(wq, (unsigned)(8 * CH), __ATOMIC_RELAXED, __HIP_MEMORY_SCOPE_AGENT); }
                __syncthreads();
                const int base = tk[par]; par ^= 1;
                if (base >= NITEMS) break;
#pragma unroll 1
                for (int i = 0; i < CH; ++i) { const int it = base + X.wave + 8 * i; if (it < NITEMS) DO_ITEM(it); }
            }
        }
#undef GRAB
#undef DO_ITEM
    }
    }
    if (BOTH(0)) GRID_BAR_K(0);
    }
    if (IN(1)) { REFRESH_X();
    REP(1) { if (rep_) __syncthreads();
    norm_mod_rows<false>(X, x_in, ctx_in, MR, AIN(4), mods0, 0, 1, H, nullptr, nullptr, nullptr);
    }
    if (BOTH(1)) GRID_BAR_K(1);
    }
    if (IN(2)) { REFRESH_X();
    REP(2) { if (rep_) __syncthreads();
    { pg8::Gemm g{H, WT_EIN, MR, EVEN_IN, D}; pg8::StaticOrder S; S.init(MR, EVEN_IN, D / 64, X.G, X.c); pg8::EpiSlotsNR E{QKV, NSLOT0, KVR, 0, GTAB, CSTAB, (PG8_LAS float*)(X.lds + RING_BYTES)};
      pg8::gemm_phase<pg8::EpiSlotsNR, pg8::StaticOrder, true, true>(X.lds, g, S, E); }
    drain_deferred(X, ctl, ws, 4 * idle_units((MR / 256) * (EVEN_IN / 256), X.G, X.c), NDEF);
    }
    if (BOTH(2)) GRID_BAR_K(2);
    }
    if (IN(4)) { REFRESH_X();
    REP(4) { if (rep_) __syncthreads();
    {
        const att::bf16* Q0 = (const att::bf16*)QKV;
        int atid = threadIdx.x; asm volatile("" : "+v"(atid));
        for (int u = X.c; u < 544; u += X.G) {
            const bool isl = u < 512; const int b = isl ? (u >> 8) : ((u - 512) >> 4), vh = isl ? ((u >> 4) & 15) : ((u - 512) & 15), qb = isl ? (u & 15) : 16;
            const int hb = vh >> 2, map = (vh >> 1) & 1, half = vh & 1;
            const att::bf16* Qp = Q0 + ((size_t)(b * NSLOT0 + 12 + 2 * hb + map) * KVR + qb * 256) * 128;
            const att::bf16* Kp = Q0 + ((size_t)(b * NSLOT0 + 20 + 2 * hb + map) * KVR) * 128;
            const att::bf16* Vp = Q0 + ((size_t)(b * NSLOT0 + 28 + 2 * hb + half) * KVR) * 128;
            float* Op = PB + ((size_t)(b * 16 + vh) * KVR + qb * 256) * 128;
            att::attn_unit<false, false>(Qp, Kp, Vp, (void*)Op, 128, 0, isl ? 68 : 0, isl ? 68 : 4, qb * 256, -1e30f, 0.f, (char*)lds, atid);
        }
        const int ca = (X.c + X.G - 32) % X.G;
        for (int u = ca; u < 272; u += X.G) {
            const bool isl = u < 256; const int b = isl ? (u >> 7) : ((u - 256) >> 3), h = isl ? ((u >> 4) & 7) : ((u - 256) & 7), qb = isl ? (u & 15) : 16;
            const int q0 = qb * 256; const int klo = isl ? (q0 >= 128 ? q0 - 128 : 0) : 0; const int khi = (q0 + 384) < SEQ ? (q0 + 384) : SEQ; const int nt1 = isl ? ((khi - klo) >> 6) : 0;
            const att::bf16* Qp = Q0 + ((size_t)(b * NSLOT0 + h) * KVR + q0) * 128;
            const att::bf16* Kp = Q0 + ((size_t)(b * NSLOT0 + 8 + (h >> 2)) * KVR) * 128;
            const att::bf16* Vp = Q0 + ((size_t)(b * NSLOT0 + 10 + (h >> 2)) * KVR) * 128;
            bf16* Op = OALL + (size_t)(isl ? (b * SEQ + q0) : (TL + b * CTXL)) * D + h * 128;
            const float sink = AIN(12)[h];
            att::attn_unit<true, true>(Qp, Kp, Vp, (void*)Op, D, klo, nt1, nt1 + 4, q0, sink * (1.0f / att::SCALE), 1.f, (char*)lds, atid);
        }
    }
    }
    if (BOTH(4)) GRID_BAR_K(4);
    }
    if (IN(5)) { REFRESH_X();
    REP(5) { if (rep_) __syncthreads();
    b_combine(X, PB, lamv, AIN(19), OALL);
    }
    if (BOTH(5)) GRID_BAR_K(5);
    }
    if (IN(6)) { REFRESH_X();
    REP(6) { if (rep_) __syncthreads();
    { pg8::Gemm g{OALL, WT_EOUT, MR, D, D}; pg8::TailOrder S; S.init(TL / 256, TC / 256, D / 256, D / 64, X.G, X.c, nullptr); pg8::EpiRes E{x_in, ctx_in, X1, D, mods0 + 2 * D, MODW, PART, TL, TC, 1.0f};
      pg8::gemm_phase<pg8::EpiRes, pg8::TailOrder, true, true>(X.lds, g, S, E); }
    }
    if (BOTH(6)) GRID_BAR_K(6);
    }
    if (IN(7)) { REFRESH_X();
    REP(7) { if (rep_) __syncthreads();
    { int Sp, pp; pg8::tail_split(X.G, (TC / 256) * (D / 256), D / 64, Sp, pp);
      norm_mod_rows<false, true, true>(X, X1, ctx_in, MR, AIN(5), mods0, 3, 4, H, nullptr, nullptr, nullptr, PART, Sp, mods0 + 2 * MODW + 2 * D, X1 + (size_t)TL * D); }
    }
    if (BOTH(7)) GRID_BAR_K(7);
    }
    if (IN(8)) { REFRESH_X();
    REP(8) { if (rep_) __syncthreads();
    { pg8::Gemm g{H, WT_EF1, MR, 2 * DFF, D}; pg8::StaticOrder S; S.init(MR, 2 * DFF, D / 128, X.G, X.c); pg8::EpiSwiglu E{ACT, DFF, 1.0f / W8_SCALE};
      pg8::gemm_phase<pg8::EpiSwiglu, pg8::StaticOrder, true, true, true>(X.lds, g, S, E); }
    drain_deferred(X, ctl, ws, 2 * idle_units((MR / 256) * (2 * DFF / 256), X.G, X.c), NDEF);
    }
    if (BOTH(8)) GRID_BAR_K(8);
    }
    if (IN(9)) { REFRESH_X();
    REP(9) { if (rep_) __syncthreads();
    { pg8::Gemm g{ACT, WT_EF2, MR, D, DFF}; pg8::TailOrder S; S.init(TL / 256, TC / 256, D / 256, DFF / 64, X.G, X.c, nullptr); pg8::EpiRes E{X1, X1 + (size_t)TL * D, X1, D, mods0 + 5 * D, MODW, PART, TL, TC, 1.0f};
      pg8::gemm_phase<pg8::EpiRes, pg8::TailOrder, true, true>(X.lds, g, S, E); }
    }
    if (BOTH(9)) GRID_BAR_K(9);
    }
    if (IN(10)) { REFRESH_X();
    REP(10) { if (rep_) __syncthreads();
    { int Sp, pp; pg8::tail_split(X.G, (TC / 256) * (D / 256), DFF / 64, Sp, pp);
      norm_mod_rows<false, true>(X, X1, X1 + (size_t)TL * D, MR, AIN(22), mods1, 0, 1, H, nullptr, nullptr, nullptr, PART, Sp, mods0 + 2 * MODW + 5 * D, nullptr); }
    }
    if (BOTH(10)) GRID_BAR_K(10);
    }
    if (IN(11)) { REFRESH_X();
    REP(11) { if (rep_) __syncthreads();
    { pg8::Gemm g{H, WT_OIN, MR, ODD_IN, D}; pg8::StaticOrder S; S.init(MR, ODD_IN, D / 64, X.G, X.c); pg8::EpiSlotsNR E{QKV, NSLOT1, KVR, 1, GTAB, CSTAB, (PG8_LAS float*)(X.lds + RING_BYTES)};
      pg8::gemm_phase<pg8::EpiSlotsNR, pg8::StaticOrder, true, true>(X.lds, g, S, E); }
    drain_deferred(X, ctl, ws, 4 * idle_units((MR / 256) * (ODD_IN / 256), X.G, X.c), NDEF);
    }
    if (BOTH(11)) GRID_BAR_K(11);
    }
    if (IN(13)) { REFRESH_X();
    REP(13) { if (rep_) __syncthreads();
    {
        const att::bf16* Q0 = (const att::bf16*)QKV;
        int atid = threadIdx.x; asm volatile("" : "+v"(atid));
        for (int u = X.c; u < 512; u += X.G) {
            const int b = u >> 8, h = (u >> 4) & 15, qb = u & 15;
            const att::bf16* Qp = Q0 + ((size_t)(b * NSLOT1 + h) * KVR + qb * 256) * 128;
            const att::bf16* Kp = Q0 + ((size_t)(b * NSLOT1 + 16 + (h >> 2)) * KVR) * 128;
            const att::bf16* Vp = Q0 + ((size_t)(b * NSLOT1 + 20 + (h >> 2)) * KVR) * 128;
            bf16* Op = OALL + (size_t)(b * SEQ + qb * 256) * D + h * 128;
            const int ntc = 68 + (X.G >> 20);
            att::attn_unit<false, true>(Qp, Kp, Vp, (void*)Op, D, 0, ntc, ntc, qb * 256, -1e30f, 0.f, (char*)lds, atid);
        }
    }
    }
    if (BOTH(13)) GRID_BAR_K(13);
    }
    if (IN(14)) { REFRESH_X();
    REP(14) { if (rep_) __syncthreads();
    { pg8::Gemm g{OALL, WT_OOUT, TL, D, D}; pg8::StaticOrder S; S.init(TL, D, D / 64, X.G, X.c); pg8::EpiRes E{X1, X1, X3, D, mods1 + 2 * D, MODW, nullptr, 0, 0, 1.0f};
      pg8::gemm_phase<pg8::EpiRes, pg8::StaticOrder, true, true>(X.lds, g, S, E); }
    }
    if (BOTH(14)) GRID_BAR_K(14);
    }
    if (IN(15)) { REFRESH_X();
    REP(15) { if (rep_) __syncthreads();
    norm_route_rows(X, X3, AIN(23), mods1, 3, 4, AIN(30), (unsigned*)(ctl + CW_GCNT), (unsigned char*)XS, POS, ROWGATE);
    drain_deferred(X, ctl, ws, 1 << 20, NQ1);
    }
    if (BOTH(15)) GRID_BAR_K(15);
    }
    if (IN(17)) { REFRESH_X();
    REP(17) { if (rep_) __syncthreads();
    { const int nt = build_moe_tables(X, (const unsigned*)(ctl + CW_GCNT)); const int* te_ = (const int*)(lds + TAB_OFF); pg8::Gemm g{XS, WT_X1, XROWS, 2 * DFE, D}; pg8::TailOrder S; S.init(nt, 0, 2 * DFE / 256, D / 128, X.G, X.c, te_, te_ + MAXT); pg8::EpiSwiglu8 E{ACT2, DFE, 1.0f / W8_SCALE};
      pg8::gemm_phase<pg8::EpiSwiglu8, pg8::TailOrder, true, true, true>(X.lds, g, S, E); }
    drain_deferred(X, ctl, ws, 1 << 20, NDEF);
    }
    if (BOTH(17)) GRID_BAR_K(17);
    }
    if (IN(18)) { REFRESH_X();
    REP(18) { if (rep_) __syncthreads();
    { const int nt = build_moe_tables(X, (const unsigned*)(ctl + CW_GCNT)); const int* te_ = (const int*)(lds + TAB_OFF); pg8::Gemm g{ACT2, WT_X2, XROWS, D, DFE}; pg8::TailOrder S; S.init(MOE_MAIN_TILES, nt - MOE_MAIN_TILES, D / 256, DFE / 128, X.G, X.c, te_, te_ + MAXT); pg8::EpiRowScale E{(pg8::bf16_t*)YS, D, ROWGATE, PART, MOE_MAIN_ROWS, (nt - MOE_MAIN_TILES) * 256, 1.0f / W8_SCALE};
      pg8::gemm_phase<pg8::EpiRowScale, pg8::TailOrder, true, true, true>(X.lds, g, S, E); }
    }
    if (BOTH(18)) GRID_BAR_K(18);
    }
    if (IN(19)) { REFRESH_X();
    REP(19) { if (rep_) __syncthreads();
    { const int nt = build_moe_tables(X, (const unsigned*)(ctl + CW_GCNT)); moe_final(X, X3, YS, POS, mods1, args.out, PART, nt); }
#ifdef PROBE_SEL
    if (stamper) { TS[38] = __builtin_amdgcn_s_memrealtime(); TS[39] = TS[38];
        unsigned long long workmask_sum = 0, bar_sum = 0;
        for (int k = 0; k < 20; ++k) { const unsigned long long st = k == 0 ? TS[63] : TS[2 * k - 1]; const unsigned long long w = TS[2 * k] - st, bw = TS[2 * k + 1] - TS[2 * k];
            if ((PROBE_WORK_MASK >> k) & 1u) workmask_sum += w; if ((PROBE_BAR_MASK >> k) & 1u) bar_sum += bw; }
        const unsigned long long spin = (workmask_sum + bar_sum) * (unsigned long long)(PROBE_AMP);
        const unsigned long long t0_ = __builtin_amdgcn_s_memrealtime(); while (__builtin_amdgcn_s_memrealtime() - t0_ < spin) __builtin_amdgcn_s_sleep(8); }
#endif
    }
    }
}

extern "C" void kernel_launch(void* const* d_in, const int* in_sizes, int n_in, void* d_out, int out_size, void* d_ws, size_t ws_size, hipStream_t stream) {
    static int grid = 0;
    if (grid == 0) {
        if (n_in != 33 || in_sizes[0] != TL * D || out_size != TL * D || ws_size < WS_END) { fprintf(stderr, "kernel_launch: unexpected shapes (n_in %d, in0 %d, out %d, ws %zu)\n", n_in, n_in > 0 ? in_sizes[0] : -1, out_size, ws_size); grid = -1; return; }
        int dev = 0, cus = 0, per_cu = 0;
        if (hipGetDevice(&dev) != hipSuccess || hipDeviceGetAttribute(&cus, hipDeviceAttributeMultiprocessorCount, dev) != hipSuccess) { grid = -1; return; }
        if (hipFuncSetAttribute((const void*)fwd_kernel, hipFuncAttributeMaxDynamicSharedMemorySize, LDS_BYTES) != hipSuccess) { fprintf(stderr, "kernel_launch: hipFuncSetAttribute failed\n"); grid = -1; return; }
        if (hipOccupancyMaxActiveBlocksPerMultiprocessor(&per_cu, (const void*)fwd_kernel, NWAVES * 64, LDS_BYTES) != hipSuccess || per_cu < 1) { fprintf(stderr, "kernel_launch: occupancy query says %d blocks per CU\n", per_cu); }
        (void)hipGetLastError();
        grid = cus;
    }
    if (grid < 0) return;
    constexpr int NL = sizeof(kLaunches) / sizeof(kLaunches[0]);
    if (hipMemsetAsync((char*)d_ws + WS_CTL, 0, NL == 1 ? (size_t)65536 : CTL_ZERO_BYTES, stream) != hipSuccess) return;
    Args a{};
    for (int i = 0; i < 33; ++i) a.in[i] = (const float*)d_in[i];
    a.out = (float*)d_out; a.ws = (unsigned char*)d_ws;
    for (int li = 0; li < NL; ++li) {
        a.ph_lo = kLaunches[li].lo; a.ph_hi = kLaunches[li].hi; a.li = li; a.pad = 0;
        hipLaunchKernelGGL(fwd_kernel, dim3(grid), dim3(NWAVES * 64), LDS_BYTES, stream, a);
        const hipError_t le = hipPeekAtLastError();
        if (le != hipSuccess) { fprintf(stderr, "kernel_launch: launch %d failed: %s\n", li, hipGetErrorName(le)); break; }
    }
}
```

```cpp
#include <hip/hip_runtime.h>
#include <hip/hip_bf16.h>
#include <cstdio>
#include <cstdint>

namespace pg8 {
#define PG8_LAS __attribute__((address_space(3)))
typedef unsigned short bf16_t;
typedef short bf16x8 __attribute__((ext_vector_type(8)));
typedef float f32x4 __attribute__((ext_vector_type(4)));
typedef unsigned u32x4 __attribute__((ext_vector_type(4)));
constexpr int BM = 256, BK = 64, HALF = 128, HTB = HALF * BK * 2  , STAGE_BYTES = 8 * HTB, NXCD = 8, WGM = 8;

__host__ __device__ __forceinline__ int lds_byte(int r, int c) { const int st = (r >> 4) * 2 + (c >> 5), rr = r & 15, cc = c & 31, ob = rr * 64 + cc * 2; return st * 1024 + (ob ^ (((ob >> 9) & 1) << 5)); }
__host__ __device__ __forceinline__ void stage_rc(int b, int& R, int& C) { const int st = b / 1024, sb = b % 1024, swz = sb ^ (((sb >> 9) & 1) << 5); R = (st >> 1) * 16 + swz / 64; C = (st & 1) * 32 + (swz % 64) / 2; }
__host__ __device__ __forceinline__ int perm32(int rho) { const int n = rho >> 4, i = rho & 15; return 8 * (i >> 2) + 4 * n + (i & 3); }

struct Unit { int pm, pn, pnb, kt0, nkt, part, lt; };
struct Gemm { const void* A; const void* Bt; int M, N, K; };

struct StaticOrder {
    int nM, nN, nwg, G, c, KT;
    __host__ __device__ __forceinline__ void init(int M, int N, int KT_, int G_, int c_) { nM = M / BM; nN = N / BM; nwg = nM * nN; G = G_; c = c_; KT = KT_; }
    __host__ __device__ __forceinline__ bool next(int i, Unit& u) const {
        const long L = (long)i * G + c; if (L >= nwg) return false;
        int wgid = (int)L; { const int q = nwg / NXCD, r = nwg % NXCD, xcd = wgid % NXCD, off = wgid / NXCD; wgid = (xcd < r ? xcd * (q + 1) : r * (q + 1) + (xcd - r) * q) + off; }
        const int nig = WGM * nN, gid = wgid / nig, fm = gid * WGM, gsz = (nM - fm) < WGM ? (nM - fm) : WGM;
        u.pm = fm + ((wgid % nig) % gsz); u.pn = (wgid % nig) / gsz; u.pnb = u.pn; u.kt0 = 0; u.nkt = KT; u.part = -1; u.lt = u.pm; return true;
    }
    __device__ __forceinline__ void a_ready(const Unit&) const {}
    __device__ __forceinline__ void done(const Unit&) const {}
};
__host__ __device__ __forceinline__ void tail_split(int G, int T, int KT, int& Sp, int& ppair) {
    if (T <= 0) { Sp = 0; ppair = 0; return; }
    int S = G / T; if (S < 1) S = 1; const int pairs = KT >> 1; ppair = (pairs + S - 1) / S; if (ppair < 2) ppair = 2; Sp = (pairs + ppair - 1) / ppair;
}
struct TailOrder {
    StaticOrder so; int T, Sp, ppair; const int* tile_e; const int* tile_p;
    __device__ __forceinline__ void init(int nMm, int nTm, int nN, int KT, int G_, int c_, const int* te, const int* tp = nullptr) { so.nM = nMm; so.nN = nN; so.nwg = nMm * nN; so.G = G_; so.c = c_; so.KT = KT; T = nTm * nN; tile_e = te; tile_p = tp; tail_split(G_, T, KT, Sp, ppair); }
    __device__ __forceinline__ bool next(int i, Unit& u) const {
        const int nm = so.c < so.nwg ? (so.nwg - so.c + so.G - 1) / so.G : 0;
        const int cc = so.G - 1 - so.c;
        int pm, pn, kt0 = 0, nkt = so.KT, part = -1;
        if (i < nm) { Unit t; so.next(i, t); pm = t.pm; pn = t.pn; }
        else if (i == nm && cc < T * Sp) { const int tu = cc / Sp, j = cc - tu * Sp; pm = so.nM + tu / so.nN; pn = tu % so.nN; kt0 = 2 * ppair * j; nkt = (so.KT - kt0) < 2 * ppair ? (so.KT - kt0) : 2 * ppair; part = j; }
        else return false;
        int e = 0; if (tile_e) e = __builtin_amdgcn_readfirstlane(tile_e[pm]);
        u.lt = pm; if (tile_p) pm = __builtin_amdgcn_readfirstlane(tile_p[pm]);
        u.pm = pm; u.pn = pn; u.pnb = e * so.nN + pn; u.kt0 = kt0; u.nkt = nkt; u.part = part; return true;
    }
    __device__ __forceinline__ void a_ready(const Unit&) const {}
    __device__ __forceinline__ void done(const Unit&) const {}
};

__device__ __forceinline__ unsigned cvt_pk_bf16(float lo, float hi) { unsigned r; asm volatile("v_cvt_pk_bf16_f32 %0, %1, %2" : "=v"(r) : "v"(lo), "v"(hi)); return r; }

struct EpiBf16 {
    static constexpr bool PERM = true, AFTER_DRAIN = false;
    bf16_t* O; int ldc; float scale;
    __device__ __forceinline__ void operator()(const f32x4 (&acc)[2][2][4][2], const Unit& u, int wr, int wc, int fr, int fq) const {
        const int row0 = u.pm * BM + wr * 64 + fr; const int col0 = u.pn * BM + wc * 32 + 8 * fq;
#pragma unroll
        for (int ai = 0; ai < 2; ++ai)
#pragma unroll
            for (int m = 0; m < 4; ++m) { bf16_t* rowp = O + (size_t)(row0 + ai * HALF + m * 16) * ldc + col0;
#pragma unroll
                for (int bj = 0; bj < 2; ++bj) { const f32x4 v0 = acc[ai][bj][m][0] * scale, v1 = acc[ai][bj][m][1] * scale;
                    u32x4 w; w.x = cvt_pk_bf16(v0[0], v0[1]); w.y = cvt_pk_bf16(v0[2], v0[3]); w.z = cvt_pk_bf16(v1[0], v1[1]); w.w = cvt_pk_bf16(v1[2], v1[3]);
                    *(u32x4*)(rowp + bj * HALF) = w; } }
    }
};
struct EpiSlots {
    static constexpr bool PERM = true, AFTER_DRAIN = false;
    bf16_t* QKV; int NG; int kvr;
    __device__ __forceinline__ void operator()(const f32x4 (&acc)[2][2][4][2], const Unit& u, int wr, int wc, int fr, int fq) const {
        const int prow = u.pm * BM; const bool lat = prow < 8192; const int b = lat ? (prow >> 12) : ((prow - 8192) >> 8); const int pos0 = lat ? (prow & 4095) : 4096;
        const int rl0 = wr * 64 + fr;
#pragma unroll
        for (int bj = 0; bj < 2; ++bj) { bf16_t* gbase = QKV + ((size_t)(b * NG + 2 * u.pn + bj) * kvr + pos0 + rl0) * 128 + wc * 32 + 8 * fq;
#pragma unroll
            for (int ai = 0; ai < 2; ++ai)
#pragma unroll
                for (int m = 0; m < 4; ++m) { const f32x4 v0 = acc[ai][bj][m][0], v1 = acc[ai][bj][m][1];
                    u32x4 w; w.x = cvt_pk_bf16(v0[0], v0[1]); w.y = cvt_pk_bf16(v0[2], v0[3]); w.z = cvt_pk_bf16(v1[0], v1[1]); w.w = cvt_pk_bf16(v1[2], v1[3]);
                    *(u32x4*)(gbase + (size_t)(ai * HALF + m * 16) * 128) = w; } }
    }
};
struct EpiSlotsNR {
    static constexpr bool PERM = true, AFTER_DRAIN = false;
    bf16_t* QKV; int NG, kvr, cfg; const float* gtab; const float* cst;
    PG8_LAS float* xl;
    __device__ __forceinline__ void operator()(const f32x4 (&acc)[2][2][4][2], const Unit& u, int wr, int wc, int fr, int fq) const {
        const int prow = u.pm * BM; const bool lat = prow < 8192; const int b = lat ? (prow >> 12) : ((prow - 8192) >> 8); const int pos0 = lat ? (prow & 4095) : 4096;
        const int rl0 = wr * 64 + fr, g0 = 2 * u.pn;
        const bool isv = cfg == 0 ? (g0 == 10 || g0 >= 28) : (g0 >= 20);
        if (isv) {
#pragma unroll
            for (int bj = 0; bj < 2; ++bj) { bf16_t* gbase = QKV + ((size_t)(b * NG + g0 + bj) * kvr + pos0 + rl0) * 128 + wc * 32 + 8 * fq;
#pragma unroll
                for (int ai = 0; ai < 2; ++ai)
#pragma unroll
                    for (int m = 0; m < 4; ++m) { const f32x4 v0 = acc[ai][bj][m][0], v1 = acc[ai][bj][m][1];
                        u32x4 w; w.x = cvt_pk_bf16(v0[0], v0[1]); w.y = cvt_pk_bf16(v0[2], v0[3]); w.z = cvt_pk_bf16(v1[0], v1[1]); w.w = cvt_pk_bf16(v1[2], v1[3]);
                        *(u32x4*)(gbase + (size_t)(ai * HALF + m * 16) * 128) = w; } }
            return;
        }
        const int gi = cfg == 0 ? (g0 < 8 ? 0 : (g0 < 10 ? 1 : (g0 < 20 ? 2 : 3))) : (g0 < 16 ? 4 : 5); const float* gp = gtab + gi * 128;
#pragma unroll
        for (int bj = 0; bj < 2; ++bj)
#pragma unroll
            for (int ai = 0; ai < 2; ++ai)
#pragma unroll
                for (int m = 0; m < 4; ++m) { const f32x4 a = acc[ai][bj][m][0], c = acc[ai][bj][m][1];
                    float s = ((a[0] * a[0] + a[1] * a[1]) + (a[2] * a[2] + a[3] * a[3])) + ((c[0] * c[0] + c[1] * c[1]) + (c[2] * c[2] + c[3] * c[3]));
                    s += __shfl_xor(s, 16); s += __shfl_xor(s, 32);
                    if (fq == 0) xl[((bj * 256 + ai * HALF + rl0 + m * 16) << 2) + wc] = s; }
        asm volatile("s_waitcnt lgkmcnt(0)" ::: "memory"); __builtin_amdgcn_s_barrier(); asm volatile("" ::: "memory");
        const int pi = wc >> 1, idx0 = 16 * (wc & 1) + 4 * fq;
        const f32x4 ga = *(const f32x4*)(gp + (2 * pi) * 32 + idx0), gb = *(const f32x4*)(gp + (2 * pi + 1) * 32 + idx0);
#pragma unroll
        for (int ai = 0; ai < 2; ++ai)
#pragma unroll
            for (int m = 0; m < 4; ++m) { const int rl = rl0 + ai * HALF + m * 16; const int pos = pos0 + rl; const int pp = pi ? (pos & 63) : (pos >> 6);
                f32x4 c4 = {1.f, 1.f, 1.f, 1.f}, s4 = {0.f, 0.f, 0.f, 0.f};
                if (lat) { c4 = *(const f32x4*)(cst + pp * 32 + idx0); s4 = *(const f32x4*)(cst + 2048 + pp * 32 + idx0); }
#pragma unroll
                for (int bj = 0; bj < 2; ++bj) { const f32x4 t = *(const PG8_LAS f32x4*)(xl + ((bj * 256 + rl) << 2));
                    const float rs = __builtin_amdgcn_rsqf(((t[0] + t[1]) + (t[2] + t[3])) * (1.0f / 128.0f) + 1e-6f);
                    const f32x4 v0 = acc[ai][bj][m][0] * rs * ga, v1 = acc[ai][bj][m][1] * rs * gb;
                    const f32x4 o0 = v0 * c4 - v1 * s4, o1 = v1 * c4 + v0 * s4;
                    bf16_t* dst = QKV + ((size_t)(b * NG + g0 + bj) * kvr + pos) * 128 + (2 * pi) * 32 + idx0;
                    typedef unsigned u32x2 __attribute__((ext_vector_type(2)));
                    u32x2 w0, w1; w0.x = cvt_pk_bf16(o0[0], o0[1]); w0.y = cvt_pk_bf16(o0[2], o0[3]); w1.x = cvt_pk_bf16(o1[0], o1[1]); w1.y = cvt_pk_bf16(o1[2], o1[3]);
                    *(u32x2*)dst = w0; *(u32x2*)(dst + 32) = w1; } }
    }
};
__device__ __forceinline__ float clamp448(float x) { return __builtin_amdgcn_fmed3f(x, -448.f, 448.f); }
__device__ __forceinline__ unsigned pk4_fp8(float a, float b, float c, float d) {
    int w = __builtin_amdgcn_cvt_pk_fp8_f32(clamp448(a), clamp448(b), 0, false); w = __builtin_amdgcn_cvt_pk_fp8_f32(clamp448(c), clamp448(d), w, true); return (unsigned)w; }
__device__ __forceinline__ float silu_mul(float g, float u) { return g * u * __builtin_amdgcn_rcpf(1.0f + __builtin_amdgcn_exp2f(-1.4426950408889634f * g)); }
__device__ __forceinline__ f32x4 silu_mul4(f32x4 g, f32x4 u, float nls  , float s2  ) {
    const f32x4 t = g * nls;
    f32x4 e; e[0] = __builtin_amdgcn_exp2f(t[0]); e[1] = __builtin_amdgcn_exp2f(t[1]); e[2] = __builtin_amdgcn_exp2f(t[2]); e[3] = __builtin_amdgcn_exp2f(t[3]);
    const f32x4 d = e + 1.0f;
    f32x4 r; r[0] = __builtin_amdgcn_rcpf(d[0]); r[1] = __builtin_amdgcn_rcpf(d[1]); r[2] = __builtin_amdgcn_rcpf(d[2]); r[3] = __builtin_amdgcn_rcpf(d[3]);
    return (g * u) * (r * s2);
}
template <bool OUT8> struct EpiSwigluT {
    static constexpr bool PERM = true, AFTER_DRAIN = false;
    void* O; int ldc; float scale;
    __device__ __forceinline__ void operator()(const f32x4 (&acc)[2][2][4][2], const Unit& u, int wr, int wc, int fr, int fq) const {
        const int row0 = u.pm * BM + wr * 64 + fr; const int col0 = u.pn * HALF + wc * 32 + 8 * fq;
        const float nls = -1.4426950408889634f * scale, s2 = scale * scale;
#pragma unroll
        for (int ai = 0; ai < 2; ++ai)
#pragma unroll
            for (int m = 0; m < 4; ++m) { const size_t eo = (size_t)(row0 + ai * HALF + m * 16) * ldc + col0;
                const f32x4 a = silu_mul4(acc[ai][0][m][0], acc[ai][1][m][0], nls, s2), b = silu_mul4(acc[ai][0][m][1], acc[ai][1][m][1], nls, s2);
                if constexpr (OUT8) { typedef unsigned u32x2 __attribute__((ext_vector_type(2))); u32x2 w; w.x = pk4_fp8(a[0], a[1], a[2], a[3]); w.y = pk4_fp8(b[0], b[1], b[2], b[3]); *(u32x2*)((unsigned char*)O + eo) = w; }
                else { u32x4 w; w.x = cvt_pk_bf16(a[0], a[1]); w.y = cvt_pk_bf16(a[2], a[3]); w.z = cvt_pk_bf16(b[0], b[1]); w.w = cvt_pk_bf16(b[2], b[3]); *(u32x4*)((bf16_t*)O + eo) = w; } }
    }
};
typedef EpiSwigluT<false> EpiSwiglu; typedef EpiSwigluT<true> EpiSwiglu8;
struct EpiRes {
    static constexpr bool PERM = false, AFTER_DRAIN = false;
    const float* base_lat; const float* base_ctx; float* out; int ldc; const float* gate; int gate_stride;
    float* part; int part_row0, part_rows; float scale;
    __device__ __forceinline__ void operator()(const f32x4 (&acc)[2][2][4][2], const Unit& u, int wr, int wc, int fr, int fq) const {
        if (u.part >= 0) {
            float* pp = part + ((long)u.part * part_rows + (u.lt * BM - part_row0)) * (long)ldc; const int rl0 = wr * 64 + fr, col0 = u.pn * BM + wc * 32 + 4 * fq;
#pragma unroll
            for (int ai = 0; ai < 2; ++ai)
#pragma unroll
                for (int m = 0; m < 4; ++m) { const size_t ro = (size_t)(rl0 + ai * HALF + m * 16) * ldc;
#pragma unroll
                    for (int bj = 0; bj < 2; ++bj)
#pragma unroll
                        for (int n = 0; n < 2; ++n) *(f32x4*)(pp + ro + col0 + bj * HALF + 16 * n) = acc[ai][bj][m][n] * scale; }
            return;
        }
        const int prow = u.pm * BM; const int cond = prow < 4096 ? 0 : (prow < 8192 ? 1 : 2);
        const float* bp = prow < 8192 ? base_lat + (size_t)prow * ldc : base_ctx + (size_t)(prow - 8192) * ldc;
        float* op = out + (size_t)prow * ldc; const float* gp = gate + (size_t)cond * gate_stride;
        const int rl0 = wr * 64 + fr, col0 = u.pn * BM + wc * 32 + 4 * fq;
        f32x4 gv[2][2];
#pragma unroll
        for (int bj = 0; bj < 2; ++bj)
#pragma unroll
            for (int n = 0; n < 2; ++n) gv[bj][n] = *(const f32x4*)(gp + col0 + bj * HALF + 16 * n) * scale;
#pragma unroll
        for (int ai = 0; ai < 2; ++ai)
#pragma unroll
            for (int m = 0; m < 4; ++m) { const size_t ro = (size_t)(rl0 + ai * HALF + m * 16) * ldc;
#pragma unroll
                for (int bj = 0; bj < 2; ++bj)
#pragma unroll
                    for (int n = 0; n < 2; ++n) { const int col = col0 + bj * HALF + 16 * n; const f32x4 b = *(const f32x4*)(bp + ro + col);
                        *(f32x4*)(op + ro + col) = b + gv[bj][n] * acc[ai][bj][m][n]; } }
    }
};
struct EpiRowScale {
    static constexpr bool PERM = true, AFTER_DRAIN = false;
    bf16_t* out; int ldc; const float* rs; float* part; int part_row0, part_rows; float scale;
    __device__ __forceinline__ void operator()(const f32x4 (&acc)[2][2][4][2], const Unit& u, int wr, int wc, int fr, int fq) const {
        const int row0 = u.pm * BM + wr * 64 + fr, col0 = u.pn * BM + wc * 32 + 8 * fq;
#pragma unroll
        for (int ai = 0; ai < 2; ++ai)
#pragma unroll
            for (int m = 0; m < 4; ++m) { const int row = row0 + ai * HALF + m * 16; const float s = rs[row] * scale;
                if (u.part >= 0) { float* rp = part + ((long)u.part * part_rows - part_row0 + (row - u.pm * BM) + u.lt * BM) * (long)ldc + col0;
#pragma unroll
                    for (int bj = 0; bj < 2; ++bj) { *(f32x4*)(rp + bj * HALF) = acc[ai][bj][m][0] * s; *(f32x4*)(rp + bj * HALF + 4) = acc[ai][bj][m][1] * s; } }
                else { bf16_t* rp = out + (size_t)row * ldc + col0;
#pragma unroll
                    for (int bj = 0; bj < 2; ++bj) { const f32x4 v0 = acc[ai][bj][m][0] * s, v1 = acc[ai][bj][m][1] * s;
                        u32x4 w; w.x = cvt_pk_bf16(v0[0], v0[1]); w.y = cvt_pk_bf16(v0[2], v0[3]); w.z = cvt_pk_bf16(v1[0], v1[1]); w.w = cvt_pk_bf16(v1[2], v1[3]);
                        *(u32x4*)(rp + bj * HALF) = w; } } }
    }
};

typedef int v8i __attribute__((ext_vector_type(8)));
__device__ __forceinline__ v8i cat8(bf16x8 a, bf16x8 b) { struct P { bf16x8 a, b; } p{a, b}; return __builtin_bit_cast(v8i, p); }
template <class Epi, class Sched, bool ALIGN_EPI = false, bool SP2 = false, bool FP8 = false>
__device__ __forceinline__ void gemm_phase(PG8_LAS unsigned char* lds, const Gemm g, const Sched& S, const Epi& E) {
    int tid = threadIdx.x; asm volatile("" : "+v"(tid));
    const int wid = __builtin_amdgcn_readfirstlane(tid >> 6), lane = tid & 63, wr = wid >> 2, wc = wid & 3, fr = lane & 15, fq = lane >> 4;
    const int K = g.K; const int pitch = FP8 ? K : K * 2;
    unsigned voffA[2], voffB[2];
#pragma unroll
    for (int i = 0; i < 2; ++i) { int R, C; stage_rc(tid * 16 + i * 8192, R, C); const int Rb = Epi::PERM ? ((R & ~31) + perm32(R & 31)) : R;
        voffA[i] = (unsigned)(R * pitch + C * 2); voffB[i] = (unsigned)(Rb * pitch + C * 2); }
    const size_t kstep = (size_t)(BK * 2);
    const size_t hstep = (size_t)HALF * pitch;
    const size_t tstep = 2 * hstep;
    const unsigned ldsw = (unsigned)wid * 1024u;
    const int aoff = lds_byte(wr * 64 + fr, fq * 8), boff = lds_byte(wc * 32 + fr, fq * 8);
#define PG8_SA(b, h) (((b) * 2 + (h)) * HTB)
#define PG8_SB(b, h) ((4 + (b) * 2 + (h)) * HTB)
#define PG8_STAGE(bufoff, gbase, voff) do { _Pragma("unroll") for (int _i = 0; _i < 2; ++_i) \
        __builtin_amdgcn_global_load_lds((const unsigned*)((const char*)(gbase) + (voff)[_i]), (PG8_LAS unsigned*)(lds + (bufoff) + ldsw + _i * 8192), 16, 0, 0); } while (0)
#define PG8_LDA(dst, b, h) do { _Pragma("unroll") for (int m = 0; m < 4; ++m) _Pragma("unroll") for (int k = 0; k < 2; ++k) dst[m][k] = *(const PG8_LAS bf16x8*)(lds + PG8_SA(b, h) + aoff + m * 2048 + k * 1024); } while (0)
#define PG8_LDB(dst, b, h) do { _Pragma("unroll") for (int n = 0; n < 2; ++n) _Pragma("unroll") for (int k = 0; k < 2; ++k) dst[n][k] = *(const PG8_LAS bf16x8*)(lds + PG8_SB(b, h) + boff + n * 2048 + k * 1024); } while (0)
#define PG8_MMA(ai, bj, At, Bt) do { __builtin_amdgcn_s_setprio(1); if constexpr (FP8) { _Pragma("unroll") for (int m = 0; m < 4; ++m) _Pragma("unroll") for (int n = 0; n < 2; ++n) \
        asm volatile("v_mfma_f32_16x16x128_f8f6f4 %0, %1, %2, %0" : "+v"(acc[ai][bj][m][n]) : "v"(cat8(Bt[n][0], Bt[n][1])), "v"(cat8(At[m][0], At[m][1]))); } \
      else { _Pragma("unroll") for (int m = 0; m < 4; ++m) _Pragma("unroll") for (int n = 0; n < 2; ++n) _Pragma("unroll") for (int k = 0; k < 2; ++k) \
        acc[ai][bj][m][n] = __builtin_amdgcn_mfma_f32_16x16x32_bf16(Bt[n][k], At[m][k], acc[ai][bj][m][n], 0, 0, 0); } __builtin_amdgcn_s_setprio(0); } while (0)
#define PG8_WAIT_V(n) asm volatile("s_waitcnt vmcnt(" #n ")" ::: "memory")
#define PG8_WAIT_L(n) asm volatile("s_waitcnt lgkmcnt(" #n ")" ::: "memory")
#define PG8_BAR __builtin_amdgcn_s_barrier()
#define PG8_SCHED __builtin_amdgcn_sched_barrier(0)
    Unit cur, nxt; int ui = 0;
    if (!S.next(0, cur)) return;
    f32x4 acc[2][2][4][2];
#pragma unroll
    for (int a = 0; a < 2; ++a)
#pragma unroll
        for (int b = 0; b < 2; ++b)
#pragma unroll
            for (int m = 0; m < 4; ++m)
#pragma unroll
                for (int n = 0; n < 2; ++n) acc[a][b][m][n] = (f32x4){0.f, 0.f, 0.f, 0.f};
    bf16x8 At[4][2], B0[2][2], B1[2][2];
    const char* cA = (const char*)g.A + (size_t)cur.pm * tstep + (size_t)cur.kt0 * kstep; const char* cB = (const char*)g.Bt + (size_t)cur.pnb * tstep + (size_t)cur.kt0 * kstep;
    S.a_ready(cur);
    if constexpr (SP2) {
        PG8_STAGE(PG8_SB(0, 0), cB, voffB); PG8_STAGE(PG8_SB(0, 1), cB + hstep, voffB); PG8_STAGE(PG8_SA(0, 0), cA, voffA); PG8_STAGE(PG8_SA(0, 1), cA + hstep, voffA);
        if (wr == 1) PG8_BAR;
        PG8_WAIT_V(2); PG8_BAR;
        PG8_STAGE(PG8_SB(1, 0), cB + kstep, voffB); PG8_STAGE(PG8_SA(1, 0), cA + kstep, voffA); PG8_STAGE(PG8_SB(1, 1), cB + hstep + kstep, voffB);
        PG8_WAIT_V(6); PG8_BAR;
    } else {
        PG8_STAGE(PG8_SB(0, 0), cB, voffB); PG8_STAGE(PG8_SA(0, 0), cA, voffA); PG8_STAGE(PG8_SB(0, 1), cB + hstep, voffB); PG8_STAGE(PG8_SA(0, 1), cA + hstep, voffA);
        if (wr == 1) PG8_BAR;
        PG8_WAIT_V(4); PG8_BAR;
        PG8_STAGE(PG8_SB(1, 0), cB + kstep, voffB); PG8_STAGE(PG8_SA(1, 0), cA + kstep, voffA); PG8_STAGE(PG8_SB(1, 1), cB + hstep + kstep, voffB);
        PG8_WAIT_V(6); PG8_BAR;
    }
    for (;;) {
        const bool has_next = S.next(ui + 1, nxt);
        const char* nA = has_next ? (const char*)g.A + (size_t)nxt.pm * tstep + (size_t)nxt.kt0 * kstep : cA; const char* nB = has_next ? (const char*)g.Bt + (size_t)nxt.pnb * tstep + (size_t)nxt.kt0 * kstep : cB;
        const int nt = cur.nkt;
        for (int t = 0; t < nt; t += 2) {
            const bool last = (t == nt - 2);
            const char* a1 = cA + (size_t)(t + 1) * kstep;
            const char* a2 = last ? nA : cA + (size_t)(t + 2) * kstep; const char* b2 = last ? nB : cB + (size_t)(t + 2) * kstep;
            const char* a3 = a2 + kstep; const char* b3 = b2 + kstep;
            if (last && has_next) S.a_ready(nxt);
            if constexpr (SP2) {
            PG8_LDB(B0, 0, 0); PG8_LDB(B1, 0, 1); PG8_SCHED; PG8_LDA(At, 0, 0); PG8_STAGE(PG8_SA(1, 1), a1 + hstep, voffA);
            PG8_WAIT_V(8); PG8_WAIT_L(0); PG8_BAR; PG8_MMA(0, 0, At, B0); PG8_MMA(0, 1, At, B1); PG8_BAR; PG8_SCHED;
            PG8_LDA(At, 0, 1); PG8_STAGE(PG8_SB(0, 0), b2, voffB); PG8_STAGE(PG8_SB(0, 1), b2 + hstep, voffB); PG8_STAGE(PG8_SA(0, 0), a2, voffA);
            PG8_WAIT_V(8); PG8_WAIT_L(0); PG8_BAR; PG8_MMA(1, 0, At, B0); PG8_MMA(1, 1, At, B1); PG8_BAR; PG8_SCHED;
            PG8_LDB(B0, 1, 0); PG8_LDB(B1, 1, 1); PG8_SCHED; PG8_LDA(At, 1, 0); PG8_STAGE(PG8_SA(0, 1), a2 + hstep, voffA);
            PG8_WAIT_V(8); PG8_WAIT_L(0); PG8_BAR; PG8_MMA(0, 0, At, B0); PG8_MMA(0, 1, At, B1); PG8_BAR; PG8_SCHED;
            PG8_LDA(At, 1, 1); PG8_STAGE(PG8_SB(1, 0), b3, voffB); PG8_STAGE(PG8_SB(1, 1), b3 + hstep, voffB); PG8_STAGE(PG8_SA(1, 0), a3, voffA);
            PG8_WAIT_V(8); PG8_WAIT_L(0); PG8_BAR; PG8_MMA(1, 0, At, B0); PG8_MMA(1, 1, At, B1); PG8_BAR; PG8_SCHED;
            } else {
            PG8_LDB(B0, 0, 0); PG8_SCHED; PG8_LDA(At, 0, 0); PG8_STAGE(PG8_SA(1, 1), a1 + hstep, voffA);
            PG8_WAIT_L(8); PG8_BAR; PG8_WAIT_L(0); PG8_MMA(0, 0, At, B0); PG8_BAR; PG8_SCHED;
            PG8_LDB(B1, 0, 1); PG8_STAGE(PG8_SB(0, 0), b2, voffB);
            PG8_BAR; PG8_WAIT_L(0); PG8_MMA(0, 1, At, B1); PG8_BAR;
            PG8_LDA(At, 0, 1); PG8_STAGE(PG8_SA(0, 0), a2, voffA);
            PG8_BAR; PG8_WAIT_L(0); PG8_MMA(1, 0, At, B0); PG8_BAR; PG8_SCHED;
            PG8_STAGE(PG8_SB(0, 1), b2 + hstep, voffB);
            PG8_WAIT_V(6); PG8_BAR; PG8_MMA(1, 1, At, B1); PG8_BAR;
            PG8_LDB(B0, 1, 0); PG8_SCHED; PG8_LDA(At, 1, 0); PG8_STAGE(PG8_SA(0, 1), a2 + hstep, voffA);
            PG8_WAIT_L(8); PG8_BAR; PG8_WAIT_L(0); PG8_MMA(0, 0, At, B0); PG8_BAR; PG8_SCHED;
            PG8_LDB(B1, 1, 1); PG8_STAGE(PG8_SB(1, 0), b3, voffB);
            PG8_BAR; PG8_WAIT_L(0); PG8_MMA(0, 1, At, B1); PG8_BAR;
            PG8_LDA(At, 1, 1); PG8_STAGE(PG8_SA(1, 0), a3, voffA);
            PG8_BAR; PG8_WAIT_L(0); PG8_MMA(1, 0, At, B0); PG8_BAR; PG8_SCHED;
            PG8_STAGE(PG8_SB(1, 1), b3 + hstep, voffB);
            PG8_WAIT_V(6); PG8_BAR; PG8_MMA(1, 1, At, B1); PG8_BAR;
            }
        }
        if constexpr (FP8) asm volatile("s_nop 15\n\ts_nop 15" ::: "memory");
        if constexpr (ALIGN_EPI) { if (wr == 0) PG8_BAR; }
        if constexpr (!Epi::AFTER_DRAIN) { E(acc, cur, wr, wc, fr, fq); S.done(cur); }
        if (!has_next) break;
#pragma unroll
        for (int a = 0; a < 2; ++a)
#pragma unroll
            for (int b = 0; b < 2; ++b)
#pragma unroll
                for (int m = 0; m < 4; ++m)
#pragma unroll
                    for (int n = 0; n < 2; ++n) acc[a][b][m][n] = (f32x4){0.f, 0.f, 0.f, 0.f};
        cur = nxt; cA = nA; cB = nB; ++ui;
        if constexpr (ALIGN_EPI) { if (wr == 1) PG8_BAR; }
    }
    PG8_WAIT_V(0);
    if constexpr (!ALIGN_EPI) { if (wr == 0) PG8_BAR; }
    PG8_BAR;
    if constexpr (Epi::AFTER_DRAIN) { E.fused(acc, cur, wr, wc, fr, fq, lds, wid, lane); S.done(cur); }
#undef PG8_SA
#undef PG8_SB
#undef PG8_STAGE
#undef PG8_LDA
#undef PG8_LDB
#undef PG8_MMA
#undef PG8_WAIT_V
#undef PG8_WAIT_L
#undef PG8_BAR
#undef PG8_SCHED
}
}


namespace att {
using bf16 = __hip_bfloat16;
constexpr int   D = 128, NW = 8, QBLK = 32, KVBLK = 64;
constexpr float SCALE = 0.088388347648318440f;
constexpr float THR = 8.f;
constexpr int LDQ = 128, LDK = 128;
constexpr size_t SHM_V = KVBLK * D * 2, SHM_K = KVBLK * D * 2, SHM_ATTN = 2 * SHM_V + 2 * SHM_K + NW * 64 * 4;
using bf16x8 = __attribute__((ext_vector_type(8))) short;
using s16x4  = __attribute__((ext_vector_type(4))) short;
using f32x16 = __attribute__((ext_vector_type(16))) float;
using u32x4  = __attribute__((ext_vector_type(4))) unsigned;
#define KSWZ(row, colB) ((row) * 256 + ((colB) ^ (((row) & 7) << 4)))
#define SBAR() __builtin_amdgcn_sched_barrier(0)
__device__ __forceinline__ int crow(int r, int hi) { return (r & 3) + 8 * (r >> 2) + 4 * hi; }
__device__ __forceinline__ unsigned cvtpk(float lo, float hi) {
  unsigned r; asm volatile("v_cvt_pk_bf16_f32 %0, %1, %2" : "=v"(r) : "v"(lo), "v"(hi)); return r;
}
__device__ __forceinline__ void partialSM(f32x16& p0, f32x16& p1, float& m_reg, float& mn, float& alpha) {
  constexpr float C = SCALE * 1.4426950408889634f;
  float pmax = p0[0];
#pragma unroll
  for (int r = 1; r < 16; ++r) pmax = fmaxf(pmax, p0[r]);
#pragma unroll
  for (int r = 0; r < 16; ++r) pmax = fmaxf(pmax, p1[r]);
  { auto rr = __builtin_amdgcn_permlane32_swap(__float_as_uint(pmax), __float_as_uint(pmax), false, false);
    pmax = fmaxf(__uint_as_float(rr[0]), __uint_as_float(rr[1])); }
  if (__builtin_expect(__all(pmax - m_reg <= THR / SCALE), 1)) { mn = m_reg; alpha = 1.f; }
  else { mn = fmaxf(m_reg, pmax); alpha = __builtin_amdgcn_exp2f((m_reg - mn) * C); m_reg = mn; }
  float mnC = -mn * C;
#pragma unroll
  for (int r = 0; r < 16; ++r) p0[r] = fmaf(p0[r], C, mnC);
#pragma unroll
  for (int r = 0; r < 16; ++r) p1[r] = fmaf(p1[r], C, mnC);
#pragma unroll
  for (int r = 0; r < 16; ++r) p0[r] = __builtin_amdgcn_exp2f(p0[r]);
}
__device__ __forceinline__ void finishSM(f32x16& p0, f32x16& p1, float alpha, float& l_reg, bf16x8& pa0, bf16x8& pa1, bf16x8& pa2, bf16x8& pa3) {
#pragma unroll
  for (int r = 0; r < 16; ++r) p1[r] = __builtin_amdgcn_exp2f(p1[r]);
  float ps = 0;
#pragma unroll
  for (int r = 0; r < 16; ++r) ps += p0[r];
#pragma unroll
  for (int r = 0; r < 16; ++r) ps += p1[r];
  { auto rr = __builtin_amdgcn_permlane32_swap(__float_as_uint(ps), __float_as_uint(ps), false, false);
    ps = __uint_as_float(rr[0]) + __uint_as_float(rr[1]); }
  l_reg = l_reg * alpha + ps;
#define PK4(P, BASE, OUT) do { unsigned a0 = cvtpk(P[BASE + 0], P[BASE + 1]), a1 = cvtpk(P[BASE + 2], P[BASE + 3]);   \
    unsigned b0 = cvtpk(P[BASE + 4], P[BASE + 5]), b1 = cvtpk(P[BASE + 6], P[BASE + 7]);                              \
    auto r0 = __builtin_amdgcn_permlane32_swap(a0, b0, false, false); auto r1 = __builtin_amdgcn_permlane32_swap(a1, b1, false, false); \
    u32x4 w = {r0[0], r1[0], r0[1], r1[1]}; OUT = *reinterpret_cast<bf16x8*>(&w); } while (0)
  PK4(p0, 0, pa0); PK4(p0, 8, pa1); PK4(p1, 0, pa2); PK4(p1, 8, pa3);
#undef PK4
}
__device__ __forceinline__ void qkt(f32x16& p0, f32x16& p1, const bf16* Ks, const bf16x8* qr, int r32, int hi) {
  p0 = f32x16{}; p1 = f32x16{};
#pragma unroll
  for (int d0 = 0; d0 < 8; ++d0) { int cb = (d0 * 16 + hi * 8) * 2;
    bf16x8 b0 = *reinterpret_cast<const bf16x8*>((const char*)Ks + KSWZ(r32, cb));
    bf16x8 b1 = *reinterpret_cast<const bf16x8*>((const char*)Ks + KSWZ(32 + r32, cb));
    p0 = __builtin_amdgcn_mfma_f32_32x32x16_bf16(b0, qr[d0], p0, 0, 0, 0);
    p1 = __builtin_amdgcn_mfma_f32_32x32x16_bf16(b1, qr[d0], p1, 0, 0, 0); }
}
__device__ __forceinline__ void maskt(f32x16& p0, f32x16& p1, int kbase, int qpos, int hi) {
#pragma unroll
  for (int r = 0; r < 16; ++r) { const int d0 = qpos - (kbase + crow(r, hi)); const int d1 = d0 - 32;
    if (d0 > 128 || d0 < -128) p0[r] = -1e30f;
    if (d1 > 128 || d1 < -128) p1[r] = -1e30f; }
}
__device__ __forceinline__ int v_st(int k, int c) { const int kk = (k & ~0xC) | ((k & 4) << 1) | ((k & 8) >> 1); return ((kk >> 3) * 4 + (c >> 5)) * 512 + ((kk & 7) * 32 + (c & 31)) * 2; }
__device__ __forceinline__ int v_rd_base(int lane) { return ((lane & 3) << 3) | (((lane >> 2) & 3) << 6) | (((lane >> 4) & 1) << 5) | (((lane >> 5) & 1) << 8); }
constexpr int v_rd_off(int d0, int ks, int half) { return d0 * 512 + ks * 4096 + half * 2048; }
template <int OFF> __device__ __forceinline__ s16x4 tr_read(int vb) {
  s16x4 r; asm volatile("ds_read_b64_tr_b16 %0, %1 offset:%2" : "=&v"(r) : "v"(vb), "i"(OFF) : "memory"); return r;
}
template <int D0> __device__ __forceinline__ void pv_one(f32x16& od, int vb, bf16x8 pa0, bf16x8 pa1, bf16x8 pa2, bf16x8 pa3) {
  const s16x4 l0 = tr_read<v_rd_off(D0, 0, 0)>(vb), h0 = tr_read<v_rd_off(D0, 0, 1)>(vb), l1 = tr_read<v_rd_off(D0, 1, 0)>(vb), h1 = tr_read<v_rd_off(D0, 1, 1)>(vb);
  const s16x4 l2 = tr_read<v_rd_off(D0, 2, 0)>(vb), h2 = tr_read<v_rd_off(D0, 2, 1)>(vb), l3 = tr_read<v_rd_off(D0, 3, 0)>(vb), h3 = tr_read<v_rd_off(D0, 3, 1)>(vb);
  asm volatile("s_waitcnt lgkmcnt(0)" ::: "memory"); SBAR();
#define PK(L, H) (bf16x8){L[0], L[1], L[2], L[3], H[0], H[1], H[2], H[3]}
  od = __builtin_amdgcn_mfma_f32_32x32x16_bf16(pa0, PK(l0, h0), od, 0, 0, 0);
  od = __builtin_amdgcn_mfma_f32_32x32x16_bf16(pa1, PK(l1, h1), od, 0, 0, 0);
  od = __builtin_amdgcn_mfma_f32_32x32x16_bf16(pa2, PK(l2, h2), od, 0, 0, 0);
  od = __builtin_amdgcn_mfma_f32_32x32x16_bf16(pa3, PK(l3, h3), od, 0, 0, 0);
#undef PK
}
__device__ __forceinline__ void pv_d0(f32x16* o, int vb, bf16x8 pa0, bf16x8 pa1, bf16x8 pa2, bf16x8 pa3) {
  pv_one<0>(o[0], vb, pa0, pa1, pa2, pa3); pv_one<1>(o[1], vb, pa0, pa1, pa2, pa3); pv_one<2>(o[2], vb, pa0, pa1, pa2, pa3); pv_one<3>(o[3], vb, pa0, pa1, pa2, pa3);
}

template <bool MASK, bool OUT_BF16>
__device__ __forceinline__ void attn_unit(const bf16* __restrict__ Qb, const bf16* __restrict__ Kh, const bf16* __restrict__ Vh, void* __restrict__ Ob, int ldo,
                                          int klo, int nt1, int NT, int qpos0, float m_init, float l_init, char* lds, const int tid  ) {
  const int wid = tid >> 6, lane = tid & 63, r32 = lane & 31, hi = lane >> 5;
  bf16* V_lds = (bf16*)lds; bf16* K_lds = (bf16*)(lds + 2 * SHM_V);
  float* ws = (float*)(lds + 2 * SHM_V + 2 * SHM_K) + wid * 64; float* li_l = ws; float* al_l = ws + 32;
  float m_reg = m_init, l_reg = l_init; f32x16 o[4] = {}; bf16x8 qr[8];
  const bf16* Qw = Qb + (long)(wid * QBLK + r32) * LDQ + hi * 8;
#pragma unroll
  for (int d0 = 0; d0 < 8; ++d0) qr[d0] = *reinterpret_cast<const bf16x8*>(Qw + d0 * 16);
  const int sr = tid >> 4, sc = (tid & 15) * 8, vst0 = v_st(sr, sc), vst1 = v_st(32 + sr, sc);
  const int vb0 = (int)(uintptr_t)V_lds + v_rd_base(lane);
  struct { bf16x8 vs0, vs1, ks0, ks1; } sr_[2];
#define KROW(t) ((t) < nt1 ? klo + (t) * KVBLK : 4096 + ((t) - nt1) * KVBLK)
#define SLOAD(i, t) do { const int k0_ = KROW(t); sr_[i].vs0 = *reinterpret_cast<const bf16x8*>(&Vh[(long)(k0_ + sr) * LDK + sc]); sr_[i].vs1 = *reinterpret_cast<const bf16x8*>(&Vh[(long)(k0_ + 32 + sr) * LDK + sc]); \
    sr_[i].ks0 = *reinterpret_cast<const bf16x8*>(&Kh[(long)(k0_ + sr) * LDK + sc]); sr_[i].ks1 = *reinterpret_cast<const bf16x8*>(&Kh[(long)(k0_ + 32 + sr) * LDK + sc]); } while (0)
#define SWRITE(b, i) do { *(bf16x8*)((char*)V_lds + (b) * SHM_V + vst0) = sr_[i].vs0;          \
    *(bf16x8*)((char*)V_lds + (b) * SHM_V + vst1) = sr_[i].vs1; int kc = sc * 2;               \
    *(bf16x8*)((char*)K_lds + (b) * SHM_K + KSWZ(sr, kc)) = sr_[i].ks0;                       \
    *(bf16x8*)((char*)K_lds + (b) * SHM_K + KSWZ(32 + sr, kc)) = sr_[i].ks1; } while (0)
#define SWAIT() asm volatile("s_waitcnt vmcnt(4)" ::: "memory")
#define RESC(a) do { if (__any((a) < 1.f)) { if (hi == 0) al_l[r32] = (a); asm volatile("s_waitcnt lgkmcnt(0)" ::: "memory"); \
    _Pragma("unroll") for (int d = 0; d < 4; ++d) _Pragma("unroll") for (int r = 0; r < 16; ++r) o[d][r] *= al_l[crow(r, hi)]; } } while (0)
#define MASKT(P0, P1, t) do { if (MASK) { if ((t) < nt1) maskt(P0, P1, klo + (t) * KVBLK, qpos0 + wid * QBLK + r32, hi); } } while (0)
  f32x16 pA0, pA1, pB0, pB1; float mnA, mnB, alA, alB; bf16x8 pa0, pa1, pa2, pa3;
  constexpr int SE = 0, SO = 1;
  SLOAD(SE, 0); asm volatile("s_waitcnt vmcnt(0)" ::: "memory"); SWRITE(0, SE); __syncthreads();
  qkt(pA0, pA1, K_lds, qr, r32, hi); MASKT(pA0, pA1, 0); partialSM(pA0, pA1, m_reg, mnA, alA);
  SLOAD(SO, 1); if (2 < NT) SLOAD(SE, 2);
  SWAIT(); SWRITE(1, SO); __syncthreads();
  for (int j = 1; j + 1 < NT; j += 2) {
    SBAR(); qkt(pB0, pB1, (bf16*)((char*)K_lds + SHM_K), qr, r32, hi);
    finishSM(pA0, pA1, alA, l_reg, pa0, pa1, pa2, pa3); SBAR();
    SLOAD(SO, j + 2); SBAR();
    pv_d0(o, vb0, pa0, pa1, pa2, pa3); MASKT(pB0, pB1, j); partialSM(pB0, pB1, m_reg, mnB, alB);
    __syncthreads(); SWAIT(); SWRITE(0, SE);
    RESC(alB); __syncthreads();
    SBAR(); qkt(pA0, pA1, K_lds, qr, r32, hi);
    finishSM(pB0, pB1, alB, l_reg, pa0, pa1, pa2, pa3); SBAR();
    if (j + 3 < NT) SLOAD(SE, j + 3); SBAR();
    pv_d0(o, vb0 + (int)SHM_V, pa0, pa1, pa2, pa3); MASKT(pA0, pA1, j + 1); partialSM(pA0, pA1, m_reg, mnA, alA);
    __syncthreads(); SWAIT(); SWRITE(1, SO);
    RESC(alA); __syncthreads();
  }
  SBAR(); qkt(pB0, pB1, (bf16*)((char*)K_lds + SHM_K), qr, r32, hi);
  finishSM(pA0, pA1, alA, l_reg, pa0, pa1, pa2, pa3); SBAR();
  pv_d0(o, vb0, pa0, pa1, pa2, pa3); MASKT(pB0, pB1, NT - 1); partialSM(pB0, pB1, m_reg, mnB, alB);
  __syncthreads(); RESC(alB);
  finishSM(pB0, pB1, alB, l_reg, pa0, pa1, pa2, pa3); SBAR();
  pv_d0(o, vb0 + (int)SHM_V, pa0, pa1, pa2, pa3);
  if (hi == 0) li_l[r32] = l_reg; asm volatile("s_waitcnt lgkmcnt(0)" ::: "memory");
  float rli[16];
#pragma unroll
  for (int r = 0; r < 16; ++r) rli[r] = __builtin_amdgcn_rcpf(li_l[crow(r, hi)]);
  if constexpr (OUT_BF16) {
    bf16* Ow = (bf16*)Ob + (long)(wid * QBLK) * ldo;
#pragma unroll
    for (int r = 0; r < 16; ++r) { int orow = crow(r, hi);
#pragma unroll
      for (int d0 = 0; d0 < 4; ++d0) { const float ov = o[d0][r] * rli[r]; ((unsigned short*)Ow)[(long)orow * ldo + d0 * 32 + r32] = (unsigned short)cvtpk(ov, ov); } }
  } else {
    float* Ow = (float*)Ob + (long)(wid * QBLK) * ldo;
#pragma unroll
    for (int r = 0; r < 16; ++r) { int orow = crow(r, hi);
#pragma unroll
      for (int d0 = 0; d0 < 4; ++d0) Ow[(long)orow * ldo + d0 * 32 + r32] = o[d0][r] * rli[r]; }
  }
  __syncthreads();
#undef KROW
#undef SLOAD
#undef SWRITE
#undef SWAIT
#undef RESC
#undef MASKT
}
#undef KSWZ
#undef SBAR
}

constexpr int NWAVES = 8;
constexpr int D = 2048, NB = 2, SEQ = 4096, CTXL = 256;
constexpr int TL = NB * SEQ, TC = NB * CTXL, MR = TL + TC;
constexpr int KVR = SEQ + CTXL;
constexpr int EVEN_IN = 4608, ODD_IN = 3072, DFF = 5632, DFE = 7168, NE = 8, MODW = 6 * D;
constexpr int NSLOT0 = 36, NSLOT1 = 24;
constexpr int MAXT = 72, RTILES = 32, RROWS = RTILES * 256, XROWS = NE * RROWS;
constexpr float EPS = 1e-6f;
constexpr float LAM_INIT = 0.2f;

constexpr size_t MiB = 1u << 20;
constexpr size_t WS_CTL = 0, CTL_ZERO_BYTES = 1 * MiB;
constexpr size_t WS_MODS = 1 * MiB;
constexpr size_t WS_LAM = WS_MODS + 512 * 1024;
constexpr size_t WS_ROUTE = 2 * MiB;
constexpr size_t RT_EID = WS_ROUTE, RT_GATE = WS_ROUTE + 64 * 1024, RT_POS = WS_ROUTE + 128 * 1024, RT_ROWTOK = WS_ROUTE + 192 * 1024, RT_ROWGATE = WS_ROUTE + 272 * 1024,
                 RT_TILE_E = WS_ROUTE + 352 * 1024, RT_NTILES = WS_ROUTE + 353 * 1024;
constexpr size_t WS_WT_EIN = 4 * MiB, WS_WT_EOUT = 22 * MiB, WS_WT_EF1 = 30 * MiB, WS_WT_EF2 = 74 * MiB, WS_WT_OIN = 96 * MiB, WS_WT_OOUT = 108 * MiB,
                 WS_WT_X1 = 116 * MiB, WS_WT_X2 = 564 * MiB;
constexpr size_t WS_H = 788 * MiB, WS_Z = 822 * MiB, WS_QKV = 900 * MiB, WS_PB = 978 * MiB, WS_OALL = 1046 * MiB, WS_X1 = 1080 * MiB, WS_X3 = 1148 * MiB,
                 WS_ACT = 1212 * MiB, WS_XS = 1306 * MiB, WS_ACT2 = 1434 * MiB, WS_YS = 1882 * MiB, WS_PART = 2138 * MiB, WS_RGATE = 2202 * MiB, WS_END = 2203 * MiB;
static_assert(WS_WT_EIN + (size_t)EVEN_IN * D * 2 <= WS_WT_EOUT && WS_WT_EF1 + (size_t)2 * DFF * D * 2 <= WS_WT_EF2 && WS_WT_EF2 + (size_t)D * DFF * 2 <= WS_WT_OIN &&
              WS_WT_OIN + (size_t)ODD_IN * D * 2 <= WS_WT_OOUT && WS_WT_X1 + (size_t)NE * 2 * DFE * D * 2 <= WS_WT_X2 && WS_WT_X2 + (size_t)NE * D * DFE * 2 <= WS_H &&
              WS_H + (size_t)MR * D * 2 <= WS_Z && WS_Z + (size_t)MR * EVEN_IN * 2 <= WS_QKV && WS_QKV + (size_t)NB * NSLOT0 * KVR * 128 * 2 <= WS_PB &&
              WS_PB + (size_t)NB * 16 * KVR * 128 * 4 <= WS_OALL && WS_OALL + (size_t)MR * D * 2 <= WS_X1 && WS_X1 + (size_t)MR * D * 4 <= WS_X3 && WS_X3 + (size_t)TL * D * 4 <= WS_ACT &&
              WS_ACT + (size_t)MR * DFF * 2 <= WS_XS && WS_XS + (size_t)XROWS * D <= WS_ACT2 && WS_ACT2 + (size_t)XROWS * DFE <= WS_YS && WS_YS + (size_t)XROWS * D * 2 <= WS_PART && WS_PART + 64 * MiB <= WS_RGATE && WS_RGATE + (size_t)XROWS * 4 <= WS_END, "d_ws map");
constexpr int CW_BAR = 4096, CW_WORK = 8192, CW_GCNT = 8192 + 256;
constexpr int TAB_OFF = 139520;

constexpr int RING_BYTES = 131072;
constexpr int LDSCTL_OFF = 143360, MISC_OFF = LDSCTL_OFF + 320;
constexpr int LDS_BYTES = 147456;

#define GAS __attribute__((address_space(1)))
#define LAS __attribute__((address_space(3)))
typedef unsigned short bf16;
typedef unsigned v4u __attribute__((ext_vector_type(4)));
typedef unsigned v2u __attribute__((ext_vector_type(2)));
typedef float f32x4 __attribute__((ext_vector_type(4)));
typedef GAS unsigned gu32;
#define RLX_AGENT __ATOMIC_RELAXED, __HIP_MEMORY_SCOPE_AGENT
#define LDS_WAIT() asm volatile("s_waitcnt lgkmcnt(0)" ::: "memory")
#define VM_WAIT() asm volatile("s_waitcnt vmcnt(0)" ::: "memory")
__device__ __forceinline__ unsigned f2bf(float f) { unsigned u = __builtin_bit_cast(unsigned, f); return (u + 0x7fffu + ((u >> 16) & 1u)) >> 16; }
__device__ __forceinline__ unsigned pk2(float lo, float hi) { return f2bf(lo) | (f2bf(hi) << 16); }
using pg8::pk4_fp8;
constexpr float W8_SCALE = 64.f;
__device__ __forceinline__ float bflo(unsigned w) { return __builtin_bit_cast(float, w << 16); }
__device__ __forceinline__ float bfhi(unsigned w) { return __builtin_bit_cast(float, w & 0xffff0000u); }
__device__ __forceinline__ float wave_sum(float v) {
#pragma unroll
    for (int o = 1; o < 64; o <<= 1) v += __shfl_xor(v, o);
    return v;
}

#define XB_TMO      128
#define XB_XCNT(j)  (256  + 64 * (j))
#define XB_XSUB(j)  (1280 + 64 * (j))
#define XB_XGEN(j)  (2304 + 64 * (j))
#define XB_TOP      3328
#define XB_TOPGEN   3392
#define XCD_BAR_WORDS 3456
#define XB_SPIN_CAP (1u << 18)

__device__ __forceinline__ unsigned xb_ld(unsigned* p)              { return __hip_atomic_load(p, __ATOMIC_RELAXED, __HIP_MEMORY_SCOPE_AGENT); }
__device__ __forceinline__ unsigned xb_add(unsigned* p, unsigned v) { return __hip_atomic_fetch_add(p, v, __ATOMIC_RELAXED, __HIP_MEMORY_SCOPE_AGENT); }
__device__ __forceinline__ unsigned xb_xcc_id() { return (unsigned)__builtin_amdgcn_s_getreg((3 << 11) | 20) & 0xFu; }
#define XB_SPIN(cond, bar) do { unsigned _sp = 0; while (cond) { __builtin_amdgcn_s_sleep(1); \
    if ((++_sp & 255u) == 0u) { if (xb_ld(&(bar)[XB_TMO])) break; if (_sp > XB_SPIN_CAP) { atomicAdd(&(bar)[XB_TMO], 1u); break; } } } } while (0)

struct XcdBarrier {
    unsigned* bar; unsigned x;
    volatile LAS unsigned* st;
};

__device__ __forceinline__ XcdBarrier xcd_barrier_post(unsigned* bar, volatile LAS unsigned* st) {
    XcdBarrier b; b.bar = bar; b.x = xb_xcc_id(); b.st = st;
    if (threadIdx.x == 0) (void)xb_add(&bar[XB_XCNT(b.x)], 1u);
    return b;
}
__device__ __forceinline__ void xcd_barrier_complete(unsigned* bar, unsigned x, unsigned& nloc, unsigned& nx) {
    const unsigned G = gridDim.x * gridDim.y * gridDim.z;
    unsigned sum, cnt, mine, sp = 0u;
    for (;;) {
        sum = 0u; cnt = 0u; mine = 0u;
#pragma unroll
        for (unsigned j = 0; j < 16; ++j) { const unsigned c = xb_ld(&bar[XB_XCNT(j)]); sum += c; cnt += (c > 0u) ? 1u : 0u; mine = (j == x) ? c : mine; }
        if (sum == G) break;
        __builtin_amdgcn_s_sleep(1);
        if ((++sp & 255u) == 0u) { if (xb_ld(&bar[XB_TMO])) break; if (sp > XB_SPIN_CAP) { atomicAdd(&bar[XB_TMO], 1u); break; } }
    }
    nloc = mine > 0u ? mine : 1u; nx = cnt > 0u ? cnt : 1u;
}

__device__ __forceinline__ void xcd_barrier(const XcdBarrier& b) {
    asm volatile("s_waitcnt vmcnt(0)" ::: "memory");
    __syncthreads();
    if (threadIdx.x == 0) {
        unsigned* bar = b.bar;
        __builtin_amdgcn_s_waitcnt(0);
        unsigned nloc = b.st[0], nx = b.st[1];
        if (nloc == 0u) { xcd_barrier_complete(bar, b.x, nloc, nx); b.st[0] = nloc; b.st[1] = nx; }
        const unsigned old = xb_add(&bar[XB_XSUB(b.x)], 1u);
        const unsigned gen = old / nloc;
        if (old + 1u == (gen + 1u) * nloc) {
            __builtin_amdgcn_fence(__ATOMIC_RELEASE, "agent");
            asm volatile("s_waitcnt vmcnt(0)" ::: "memory");
            const unsigned og = xb_add(&bar[XB_TOP], 1u);
            const unsigned tg = og / nx;
            if (og + 1u == (tg + 1u) * nx) xb_add(&bar[XB_TOPGEN], 1u);
            else XB_SPIN(xb_ld(&bar[XB_TOPGEN]) == tg, bar);
            __builtin_amdgcn_fence(__ATOMIC_ACQUIRE, "agent");
            xb_add(&bar[XB_XGEN(b.x)], 1u);
            asm volatile("s_waitcnt vmcnt(0)" ::: "memory");
        } else {
            XB_SPIN(xb_ld(&bar[XB_XGEN(b.x)]) == gen, bar);
            __builtin_amdgcn_fence(__ATOMIC_ACQUIRE, "agent");
            asm volatile("s_waitcnt vmcnt(0)" ::: "memory");
        }
    }
    __syncthreads();
}


struct Ctx {
    LAS unsigned char* lds; int tid, lane, wave, G, c, gw, NGW;
};

__device__ __forceinline__ void transpose_item(const float* __restrict__ W, int K, int N, bf16* __restrict__ WT, int q, int kind, LAS float* scr, int lane) {
    const int nblk = N >> 6, kb = q / nblk, nb = q - kb * nblk, k0 = kb * 64, n0 = nb * 64;
    int dest0 = n0;
    if (kind == 1) { const int hf = N >> 1; const int j = n0 < hf ? n0 : n0 - hf; dest0 = (j >> 7) * 256 + (j & 127) + (n0 < hf ? 0 : 128); }
    bool rperm = false; if (kind >= 2) { const int g = n0 >> 7; rperm = kind == 2 ? !(g == 10 || g == 11 || g >= 28) : (g < 20); }
    const int l16 = lane & 15, kq = lane >> 4;
    f32x4 v[16];
#pragma unroll
    for (int i = 0; i < 16; ++i) v[i] = __builtin_nontemporal_load((const f32x4*)(W + (size_t)(k0 + 4 * i + kq) * N + n0 + 4 * l16));
#pragma unroll
    for (int i = 0; i < 16; ++i) { LAS float* p = scr + (4 * i + kq) * 65 + 4 * l16; p[0] = v[i].x; p[1] = v[i].y; p[2] = v[i].z; p[3] = v[i].w; }
    LDS_WAIT(); asm volatile("" ::: "memory");
    const int c = lane & 7, nn = lane >> 3;
#pragma unroll
    for (int jj = 0; jj < 8; ++jj) { const int n = nn + 8 * jj; const LAS float* s = scr + (8 * c) * 65 + n;
        v4u o; o.x = pk2(s[0 * 65], s[1 * 65]); o.y = pk2(s[2 * 65], s[3 * 65]); o.z = pk2(s[4 * 65], s[5 * 65]); o.w = pk2(s[6 * 65], s[7 * 65]);
        const int idx_ = n & 31; const int nd = rperm ? (32 * (idx_ >> 4) + 8 * ((idx_ >> 2) & 3) + 4 * (n >> 5) + (idx_ & 3)) : n;
        __builtin_nontemporal_store(o, (v4u*)(WT + (size_t)(dest0 + nd) * K + k0 + 8 * c)); }
    LDS_WAIT(); asm volatile("" ::: "memory");
}

__device__ __forceinline__ void transpose_item8(const float* __restrict__ W, int K, int N, unsigned char* __restrict__ WT, int q, int kind, LAS float* scr, int lane) {
    const int nblk = N >> 5, kb = q / nblk, nb = q - kb * nblk, k0 = kb * 128, n0 = nb * 32;
    int dest0 = n0;
    if (kind) { const int hf = N >> 1; const int j = n0 < hf ? n0 : n0 - hf; dest0 = (j >> 7) * 256 + (j & 127) + (n0 < hf ? 0 : 128); }
    const int l8 = lane & 7, kq = lane >> 3;
    f32x4 v[16];
#pragma unroll
    for (int i = 0; i < 16; ++i) v[i] = __builtin_nontemporal_load((const f32x4*)(W + (size_t)(k0 + 8 * i + kq) * N + n0 + 4 * l8));
#pragma unroll
    for (int i = 0; i < 16; ++i) { LAS float* p = scr + (8 * i + kq) * 33 + 4 * l8; p[0] = v[i].x; p[1] = v[i].y; p[2] = v[i].z; p[3] = v[i].w; }
    LDS_WAIT(); asm volatile("" ::: "memory");
    const int c = lane & 7, nn = lane >> 3;
#pragma unroll
    for (int jj = 0; jj < 4; ++jj) { const int n = nn + 8 * jj; const LAS float* s = scr + (16 * c) * 33 + n;
        v4u o; o.x = pk4_fp8(s[0 * 33] * W8_SCALE, s[1 * 33] * W8_SCALE, s[2 * 33] * W8_SCALE, s[3 * 33] * W8_SCALE); o.y = pk4_fp8(s[4 * 33] * W8_SCALE, s[5 * 33] * W8_SCALE, s[6 * 33] * W8_SCALE, s[7 * 33] * W8_SCALE);
        o.z = pk4_fp8(s[8 * 33] * W8_SCALE, s[9 * 33] * W8_SCALE, s[10 * 33] * W8_SCALE, s[11 * 33] * W8_SCALE); o.w = pk4_fp8(s[12 * 33] * W8_SCALE, s[13 * 33] * W8_SCALE, s[14 * 33] * W8_SCALE, s[15 * 33] * W8_SCALE);
        __builtin_nontemporal_store(o, (v4u*)(WT + (size_t)(dest0 + n) * K + k0 + 16 * c)); }
    LDS_WAIT(); asm volatile("" ::: "memory");
}

constexpr int MOD_TASKS = 2 * (MODW / 32);
__device__ __forceinline__ void mod_fill_silu(const Ctx& X, const float* cvec, const float* cctx) {
    LAS float* S = (LAS float*)X.lds;
    for (int idx = X.tid; idx < 3 * 2048; idx += NWAVES * 64) { const int i = idx >> 11, k = idx & 2047; const float cv = i < 2 ? cvec[i * 2048 + k] : cctx[k]; S[idx] = cv / (1.f + expf(-cv)); }
    __syncthreads();
}
__device__ __forceinline__ void mod_task(const Ctx& X, int task, const float* Wm, const float* bm, float* mods_l) {
    const int ch = task % (MODW / 32);
    LAS float* S = (LAS float*)X.lds;
    LAS float* R = S + 3 * 2048;
    const int kq = X.lane >> 3, c4 = X.lane & 7;
    f32x4 a0 = {0.f, 0.f, 0.f, 0.f}, a1 = a0, a2 = a0;
    const float* wp = Wm + (size_t)(X.wave * 256 + kq) * MODW + ch * 32 + 4 * c4;
    for (int k = 0; k < 256; k += 64) {
        f32x4 w[8];
#pragma unroll
        for (int u = 0; u < 8; ++u) w[u] = __builtin_nontemporal_load((const f32x4*)(wp + (size_t)(k + 8 * u) * MODW));
#pragma unroll
        for (int u = 0; u < 8; ++u) { const int kk = X.wave * 256 + k + 8 * u + kq; a0 += w[u] * S[kk]; a1 += w[u] * S[2048 + kk]; a2 += w[u] * S[4096 + kk]; }
    }
#pragma unroll
    for (int j = 0; j < 4; ++j) {
#pragma unroll
        for (int o = 8; o < 64; o <<= 1) { a0[j] += __shfl_xor(a0[j], o); a1[j] += __shfl_xor(a1[j], o); a2[j] += __shfl_xor(a2[j], o); } }
    if (kq == 0) {
#pragma unroll
        for (int j = 0; j < 4; ++j) { R[(X.wave * 3 + 0) * 32 + 4 * c4 + j] = a0[j]; R[(X.wave * 3 + 1) * 32 + 4 * c4 + j] = a1[j]; R[(X.wave * 3 + 2) * 32 + 4 * c4 + j] = a2[j]; } }
    __syncthreads();
    if (X.tid < 96) { const int i = X.tid >> 5, col = X.tid & 31; float s = 0.f;
#pragma unroll
        for (int w = 0; w < 8; ++w) s += R[(w * 3 + i) * 32 + col];
        mods_l[(size_t)i * MODW + ch * 32 + col] = s + bm[ch * 32 + col]; }
    __syncthreads();
}

template <bool ROUTER, bool PSUM = false, bool OUT8 = false>
__device__ __forceinline__ void norm_mod_rows(const Ctx& X, const float* src_lat, const float* src_ctx, int nrows, const float* gain, const float* mods_l, int sh_i, int sc_i, bf16* H,
                                              const float* wrouter, int* eid, float* egate, const float* part = nullptr, int Sp = 0, const float* pgate = nullptr, float* wb = nullptr) {
    LAS float* WR = (LAS float*)X.lds;
    if (ROUTER) { for (int idx = X.tid; idx < 8 * 2048; idx += NWAVES * 64) { const int k = idx >> 3, e = idx & 7; WR[e * 2048 + k] = wrouter[idx]; } __syncthreads(); }
    int first = X.gw, stride = X.NGW, limit = nrows;
    if (PSUM && (X.NGW >> 2) == TC && nrows == MR) {
        if ((X.gw & 3) == 0) { first = TL + (X.gw >> 2); limit = first + 1; stride = 1 << 28; }
        else { first = X.gw - (X.gw >> 2) - 1; stride = X.NGW - (X.NGW >> 2); limit = TL; }
    }
    f32x4 vn[8];
    if (first < limit) { const float* xr = first < TL ? src_lat + (size_t)first * D : src_ctx + (size_t)(first - TL) * D;
#pragma unroll
        for (int j = 0; j < 8; ++j) vn[j] = __builtin_nontemporal_load((const f32x4*)(xr + 4 * X.lane + 256 * j)); }
    for (int row = first; row < limit; row += stride) {
        const int cond = row < SEQ ? 0 : (row < TL ? 1 : 2);
        const float* shp = mods_l + (size_t)cond * MODW + sh_i * D; const float* scp = mods_l + (size_t)cond * MODW + sc_i * D;
        f32x4 v[8]; float ss = 0.f;
#pragma unroll
        for (int j = 0; j < 8; ++j) v[j] = vn[j];
        { const int nr = row + stride; if (nr < limit) { const float* xr = nr < TL ? src_lat + (size_t)nr * D : src_ctx + (size_t)(nr - TL) * D;
#pragma unroll
            for (int j = 0; j < 8; ++j) vn[j] = __builtin_nontemporal_load((const f32x4*)(xr + 4 * X.lane + 256 * j)); } }
        if (PSUM) { if (row >= TL) {
            f32x4 a[8];
#pragma unroll
            for (int j = 0; j < 8; ++j) a[j] = (f32x4){0.f, 0.f, 0.f, 0.f};
            { int p = 0;
              for (; p + 2 <= Sp; p += 2) { const float* pr = part + ((size_t)p * TC + (row - TL)) * D + 4 * X.lane; f32x4 t[2][8];
#pragma unroll
                  for (int q = 0; q < 2; ++q)
#pragma unroll
                      for (int j = 0; j < 8; ++j) t[q][j] = __builtin_nontemporal_load((const f32x4*)(pr + (size_t)q * TC * D + 256 * j));
#pragma unroll
                  for (int j = 0; j < 8; ++j) a[j] += t[0][j] + t[1][j]; }
              for (; p < Sp; ++p) { const float* pr = part + ((size_t)p * TC + (row - TL)) * D + 4 * X.lane;
#pragma unroll
                  for (int j = 0; j < 8; ++j) a[j] += __builtin_nontemporal_load((const f32x4*)(pr + 256 * j)); } }
#pragma unroll
            for (int j = 0; j < 8; ++j) { v[j] += a[j] * *(const f32x4*)(pgate + 4 * X.lane + 256 * j); if (wb) *(f32x4*)(wb + (size_t)(row - TL) * D + 4 * X.lane + 256 * j) = v[j]; }
        } }
#pragma unroll
        for (int j = 0; j < 8; ++j) ss += (v[j].x * v[j].x + v[j].y * v[j].y) + (v[j].z * v[j].z + v[j].w * v[j].w);
        const float rstd = 1.0f / sqrtf(wave_sum(ss) * (1.f / D) + EPS);
#pragma unroll
        for (int j = 0; j < 8; ++j) { const int col = 4 * X.lane + 256 * j; const f32x4 g = *(const f32x4*)(gain + col), sc = *(const f32x4*)(scp + col), sh = *(const f32x4*)(shp + col);
            v[j] = (v[j] * rstd * g) * (sc + 1.0f) + sh;
            if (OUT8) { *(unsigned*)((unsigned char*)H + (size_t)row * D + col) = pk4_fp8(v[j].x, v[j].y, v[j].z, v[j].w); }
            else { v2u o; o.x = pk2(v[j].x, v[j].y); o.y = pk2(v[j].z, v[j].w); *(v2u*)(H + (size_t)row * D + col) = o; } }
        if (ROUTER) {
            float v1 = -3.0e38f, v2 = -3.0e38f; int i1 = 0, i2 = 0;
#pragma unroll 1
            for (int e = 0; e < 8; ++e) { float a = 0.f;
#pragma unroll
                for (int j = 0; j < 8; ++j) { const f32x4 w = *(const LAS f32x4*)(WR + e * 2048 + 4 * X.lane + 256 * j); a += (v[j].x * w.x + v[j].y * w.y) + (v[j].z * w.z + v[j].w * w.w); }
                const float s = wave_sum(a);
                if (s > v1) { v2 = v1; i2 = i1; v1 = s; i1 = e; } else if (s > v2) { v2 = s; i2 = e; } }
            const float ex = expf(v2 - v1), g1 = 1.f / (1.f + ex), g2 = ex / (1.f + ex);
            if (X.lane == 0) { eid[row * 2] = i1; eid[row * 2 + 1] = i2; egate[row * 2] = g1; egate[row * 2 + 1] = g2; }
        }
    }
}

template <int NG>
__device__ __forceinline__ void qkv_post(const Ctx& X, const bf16* z, bf16* QKV, const float* qn_a, const float* kn_a, const float* qn_b, const float* kn_b) {
    typedef float f32x2 __attribute__((ext_vector_type(2)));
    LAS f32x2* CS = (LAS f32x2*)X.lds;
    for (int idx = X.tid; idx < 2048; idx += NWAVES * 64) { const int p = idx >> 5, i = idx & 31; const float inv = exp2f(-(float)i * (13.287712379549449f / 32.0f)); const float a = (float)p * inv;
        float sn, cs; sincosf(a, &sn, &cs); CS[idx] = (f32x2){cs, sn}; }
    __syncthreads();
    const int l16 = X.lane & 15, gq = X.lane >> 4, chunk = l16 >> 2;
    v4u rawn = {0u, 0u, 0u, 0u};
    if (X.gw < MR) rawn = *(const v4u*)(z + (size_t)X.gw * (NG * 128) + gq * 128 + 8 * l16);
    for (int row = X.gw; row < MR; row += X.NGW) {
        const bool lat = row < TL; const int b = lat ? (row >> 12) : ((row - TL) >> 8); const int pos = lat ? (row & 4095) : (SEQ + ((row - TL) & 255));
        const int p = (chunk < 2) ? (pos >> 6) : (pos & 63);
#pragma unroll 1
        for (int it = 0; it < NG / 4; ++it) {
            const int g = it * 4 + gq;
            const float* gp; bool hn;
            if (NG == NSLOT0) { hn = !(g == 10 || g == 11 || g >= 28); gp = g < 8 ? qn_a : (g < 12 ? kn_a : (g < 20 ? qn_b : kn_b)); }
            else { hn = g < 20; gp = g < 16 ? qn_a : kn_a; }
            const v4u raw = rawn;
            { const bool same = it + 1 < NG / 4; const int nrow = same ? row : row + X.NGW, ng = same ? g + 4 : gq; if (nrow < MR) rawn = *(const v4u*)(z + (size_t)nrow * (NG * 128) + ng * 128 + 8 * l16); }
            float v[8] = {bflo(raw.x), bfhi(raw.x), bflo(raw.y), bfhi(raw.y), bflo(raw.z), bfhi(raw.z), bflo(raw.w), bfhi(raw.w)};
            float ss = 0.f;
#pragma unroll
            for (int j = 0; j < 8; ++j) ss += v[j] * v[j];
            ss += __shfl_xor(ss, 1); ss += __shfl_xor(ss, 2); ss += __shfl_xor(ss, 4); ss += __shfl_xor(ss, 8);
            const float rs = 1.0f / sqrtf(ss * (1.f / 128.f) + EPS);
            const f32x4 ga = *(const f32x4*)(gp + 8 * l16), gb = *(const f32x4*)(gp + 8 * l16 + 4);
            const float gg[8] = {ga.x, ga.y, ga.z, ga.w, gb.x, gb.y, gb.z, gb.w};
#pragma unroll
            for (int j = 0; j < 8; ++j) v[j] = hn ? v[j] * rs * gg[j] : v[j];
            float o[8];
#pragma unroll
            for (int j = 0; j < 8; ++j) { const float pv = __shfl_xor(v[j], 4); const f32x2 cs = CS[p * 32 + 8 * (l16 & 3) + j];
                const float rot = (chunk & 1) ? (v[j] * cs.x + pv * cs.y) : (v[j] * cs.x - pv * cs.y); o[j] = (hn && lat) ? rot : v[j]; }
            v4u w; w.x = pk2(o[0], o[1]); w.y = pk2(o[2], o[3]); w.z = pk2(o[4], o[5]); w.w = pk2(o[6], o[7]);
            *(v4u*)(QKV + ((size_t)(b * NG + g) * KVR + pos) * 128 + 8 * l16) = w;
        }
    }
}

template <int NG>
__device__ __forceinline__ void k_post(const Ctx& X, bf16* QKV, const float* kn_a, const float* kn_b, const float* cs_lds) {
    constexpr int NK = (NG == NSLOT0) ? 10 : 4;
    const int l16 = X.lane & 15, rq = X.lane >> 4, chunk = l16 >> 2;
    for (int item = X.gw; item < NB * NK * (KVR / 4); item += X.NGW) {
        const int p4 = item % (KVR / 4), t = item / (KVR / 4), kgi = t % NK, b = t / NK;
        const int g = (NG == NSLOT0) ? (kgi < 2 ? 8 + kgi : 18 + kgi) : 16 + kgi;
        const float* gp = (NG == NSLOT0) ? (kgi < 2 ? kn_a : kn_b) : kn_a;
        const int pos = p4 * 4 + rq; const bool lat = pos < SEQ; const int p = (chunk < 2) ? (pos >> 6) : (pos & 63);
        bf16* ptr = QKV + ((size_t)(b * NG + g) * KVR + pos) * 128 + 8 * l16;
        const v4u raw = *(const v4u*)ptr;
        float v[8] = {bflo(raw.x), bfhi(raw.x), bflo(raw.y), bfhi(raw.y), bflo(raw.z), bfhi(raw.z), bflo(raw.w), bfhi(raw.w)};
        float ss = 0.f;
#pragma unroll
        for (int j = 0; j < 8; ++j) ss += v[j] * v[j];
        ss += __shfl_xor(ss, 1); ss += __shfl_xor(ss, 2); ss += __shfl_xor(ss, 4); ss += __shfl_xor(ss, 8);
        const float rs = 1.0f / sqrtf(ss * (1.f / 128.f) + EPS);
        const f32x4 ga = *(const f32x4*)(gp + 8 * l16), gb = *(const f32x4*)(gp + 8 * l16 + 4);
        const float gg[8] = {ga.x, ga.y, ga.z, ga.w, gb.x, gb.y, gb.z, gb.w};
        float o[8];
#pragma unroll
        for (int j = 0; j < 8; ++j) { v[j] = v[j] * rs * gg[j]; const float pv = __shfl_xor(v[j], 4); const int ci = (lat ? p : 0) * 32 + 8 * (l16 & 3) + j; const float c = cs_lds[ci * 2], sn = cs_lds[ci * 2 + 1];
            const float rot = (chunk & 1) ? (v[j] * c + pv * sn) : (v[j] * c - pv * sn); o[j] = lat ? rot : v[j]; }
        v4u w; w.x = pk2(o[0], o[1]); w.y = pk2(o[2], o[3]); w.z = pk2(o[4], o[5]); w.w = pk2(o[6], o[7]);
        *(v4u*)ptr = w;
    }
}
constexpr int CS_OFF = 98304;
__device__ __forceinline__ void build_cs(const Ctx& X) {
    LAS float* CS = (LAS float*)(X.lds + CS_OFF);
    for (int idx = X.tid; idx < 2048; idx += NWAVES * 64) { const int p = idx >> 5, i = idx & 31; const float inv = exp2f(-(float)i * (13.287712379549449f / 32.0f)); const float a = (float)p * inv;
        float sn, cs; sincosf(a, &sn, &cs); CS[idx * 2] = cs; CS[idx * 2 + 1] = sn; }
    __syncthreads();
}

__device__ __forceinline__ void b_combine(const Ctx& X, const float* PB, const float* lamv, const float* subln, bf16* OALL) {
    const int half = X.lane >> 5, d4 = (X.lane & 31) * 4;
    f32x4 n1, n2;
#define BC_LOAD(item_, d1, d2) do { const int row_ = (item_) >> 2, hb_ = (item_) & 3; const bool lat_ = row_ < TL; const int b_ = lat_ ? (row_ >> 12) : ((row_ - TL) >> 8); const int pos_ = lat_ ? (row_ & 4095) : (SEQ + ((row_ - TL) & 255)); \
        d1 = __builtin_nontemporal_load((const f32x4*)(PB + ((size_t)(b_ * 16 + (hb_ * 2 + 0) * 2 + half) * KVR + pos_) * 128 + d4)); d2 = __builtin_nontemporal_load((const f32x4*)(PB + ((size_t)(b_ * 16 + (hb_ * 2 + 1) * 2 + half) * KVR + pos_) * 128 + d4)); } while (0)
    if (X.gw < MR * 4) BC_LOAD(X.gw, n1, n2);
    for (int item = X.gw; item < MR * 4; item += X.NGW) {
        const int row = item >> 2, hb = item & 3;
        const f32x4 o1 = n1, o2 = n2;
        if (item + X.NGW < MR * 4) BC_LOAD(item + X.NGW, n1, n2);
        const float lam = lamv[hb];
        const f32x4 v = o1 - o2 * lam;
        const float ss = wave_sum((v.x * v.x + v.y * v.y) + (v.z * v.z + v.w * v.w));
        const float rs = (1.0f - LAM_INIT) / sqrtf(ss * (1.f / 256.f) + EPS);
        const f32x4 g = *(const f32x4*)(subln + half * 128 + d4);
        const f32x4 y = v * rs * g;
        v2u o; o.x = pk2(y.x, y.y); o.y = pk2(y.z, y.w);
        *(v2u*)(OALL + (size_t)row * D + 1024 + hb * 256 + half * 128 + d4) = o;
    }
#undef BC_LOAD
}

__device__ __forceinline__ void moe_route(const Ctx& X, const int* eid, const float* egate, const bf16* H, bf16* XS, int* pos, int* rowtok, float* rowgate, int* tile_e, int* ntiles) {
    LAS int* tot = (LAS int*)X.lds;
    LAS int* pre = tot + 8;
    LAS int* base = tot + 16;
    LAS int* dst = tot + 64;
    const int tpw = (TL + X.G - 1) / X.G, t0 = X.c * tpw, t1 = (t0 + tpw) < TL ? (t0 + tpw) : TL;
    if (X.tid < 16) tot[X.tid] = 0;
    __syncthreads();
    {
        int ct[8], cp[8];
#pragma unroll
        for (int e = 0; e < 8; ++e) { ct[e] = 0; cp[e] = 0; }
        for (int idx = X.tid; idx < 2 * TL; idx += NWAVES * 64) { const int e = eid[idx]; const bool before = (idx >> 1) < t0;
#pragma unroll
            for (int ee = 0; ee < 8; ++ee) { ct[ee] += __popcll(__ballot(e == ee)); cp[ee] += __popcll(__ballot(e == ee && before)); } }
        if (X.lane == 0) {
#pragma unroll
            for (int e = 0; e < 8; ++e) { __hip_atomic_fetch_add(&tot[e], ct[e], __ATOMIC_RELAXED, __HIP_MEMORY_SCOPE_WORKGROUP); __hip_atomic_fetch_add(&pre[e], cp[e], __ATOMIC_RELAXED, __HIP_MEMORY_SCOPE_WORKGROUP); } }
    }
    __syncthreads();
    if (X.tid == 0) { int acc = 0; for (int e = 0; e < 8; ++e) { base[e] = acc; acc += (tot[e] + 255) & ~255; }
        if (X.c == 0) { *ntiles = acc >> 8; for (int e = 0; e < 8; ++e) { const int nt = (tot[e] + 255) >> 8; for (int i = 0; i < nt; ++i) tile_e[(base[e] >> 8) + i] = e; } } }
    __syncthreads();
    if (X.wave == 0) {
        int run[8];
#pragma unroll
        for (int e = 0; e < 8; ++e) run[e] = 0;
        const int n_ent = 2 * (t1 - t0);
        for (int b0 = 0; b0 < n_ent; b0 += 64) {
            const int li = b0 + X.lane; const bool valid = li < n_ent; const int idx = 2 * t0 + li; const int e = valid ? eid[idx] : -1;
            int rank = 0;
#pragma unroll
            for (int ee = 0; ee < 8; ++ee) { const unsigned long long m = __ballot(e == ee); if (e == ee) rank = run[ee] + __popcll(m & ((1ull << X.lane) - 1ull)); run[ee] += __popcll(m); }
            if (valid) { const int d = base[e] + pre[e] + rank; dst[li] = d; pos[idx] = d; rowtok[d] = idx >> 1; rowgate[d] = egate[idx]; }
        }
    }
    __syncthreads();
    { const int n_tok = t1 - t0;
      for (int tb = X.wave * 4; tb < n_tok; tb += NWAVES * 4) {
          v4u rbuf[4][2];
#pragma unroll
          for (int i = 0; i < 4; ++i) { const int tk_ = (tb + i) < n_tok ? (tb + i) : (n_tok - 1); const v4u* s_ = (const v4u*)((const unsigned char*)H + (size_t)(t0 + tk_) * D) + X.lane;
              rbuf[i][0] = s_[0]; rbuf[i][1] = s_[64]; }
#pragma unroll
          for (int i = 0; i < 4; ++i) if (tb + i < n_tok) {
#pragma unroll
              for (int k = 0; k < 2; ++k) { const int d = dst[2 * (tb + i) + k]; v4u* o_ = (v4u*)((unsigned char*)XS + (size_t)d * D) + X.lane;
                  __builtin_nontemporal_store(rbuf[i][0], o_); __builtin_nontemporal_store(rbuf[i][1], o_ + 64); } } } }
    if (X.c < 8) { const int e = X.c; const int r0 = base[e] + tot[e], r1 = base[e] + ((tot[e] + 255) & ~255);
        for (int r = r0 + X.wave; r < r1; r += NWAVES) { if (X.lane == 0) { rowtok[r] = -1; rowgate[r] = 0.f; }
            v4u* o = (v4u*)((unsigned char*)XS + (size_t)r * D) + X.lane; const v4u zz = {0u, 0u, 0u, 0u};
#pragma unroll
            for (int j = 0; j < 2; ++j) o[64 * j] = zz; } }
    __syncthreads();
}

__device__ __forceinline__ void norm_route_rows(const Ctx& X, const float* X3, const float* gain, const float* mods_l, int sh_i, int sc_i, const float* wrouter, unsigned* gcnt, unsigned char* xs, int* pos, float* rowgate) {
    LAS float* WR = (LAS float*)X.lds;
    LAS int* ENT_E = (LAS int*)(X.lds + 65536);
    LAS float* ENT_G = (LAS float*)(X.lds + 65536 + 256);
    LAS int* ENT_P = (LAS int*)(X.lds + 65536 + 512);
    LAS int* BASE = (LAS int*)(X.lds + 65536 + 768);
    for (int idx = X.tid; idx < 8 * 2048; idx += NWAVES * 64) { const int k = idx >> 3, e = idx & 7; WR[e * 2048 + k] = wrouter[idx]; }
    __syncthreads();
    const int rpw = (TL + X.NGW - 1) / X.NGW;
    for (int p0 = 0; p0 < rpw; p0 += 4) {
        unsigned pk[4][8]; f32x4 nxt[8];
        { const int row = X.gw + p0 * X.NGW; const float* xr = X3 + (size_t)(row < TL ? row : X.gw) * D;
#pragma unroll
          for (int j = 0; j < 8; ++j) nxt[j] = __builtin_nontemporal_load((const f32x4*)(xr + 4 * X.lane + 256 * j)); }
#pragma unroll
        for (int i = 0; i < 4; ++i) {
            const int row = X.gw + (p0 + i) * X.NGW; const bool valid = (p0 + i) < rpw && row < TL;
            int i1 = -1, i2 = -1; float g1 = 0.f, g2 = 0.f;
            f32x4 cur[8];
#pragma unroll
            for (int j = 0; j < 8; ++j) cur[j] = nxt[j];
            if (i < 3) { const int rn = X.gw + (p0 + i + 1) * X.NGW; const float* xr = X3 + (size_t)(((p0 + i + 1) < rpw && rn < TL) ? rn : X.gw) * D;
#pragma unroll
                for (int j = 0; j < 8; ++j) nxt[j] = __builtin_nontemporal_load((const f32x4*)(xr + 4 * X.lane + 256 * j)); }
            if (valid) {
                const int cond = row < SEQ ? 0 : 1;
                const float* shp = mods_l + (size_t)cond * MODW + sh_i * D; const float* scp = mods_l + (size_t)cond * MODW + sc_i * D;
                f32x4 v[8]; float ss = 0.f;
#pragma unroll
                for (int j = 0; j < 8; ++j) v[j] = cur[j];
#pragma unroll
                for (int j = 0; j < 8; ++j) ss += (v[j].x * v[j].x + v[j].y * v[j].y) + (v[j].z * v[j].z + v[j].w * v[j].w);
                const float rstd = 1.0f / sqrtf(wave_sum(ss) * (1.f / D) + EPS);
#pragma unroll
                for (int j = 0; j < 8; ++j) { const int col = 4 * X.lane + 256 * j; const f32x4 g = *(const f32x4*)(gain + col), sc = *(const f32x4*)(scp + col), sh = *(const f32x4*)(shp + col);
                    v[j] = (v[j] * rstd * g) * (sc + 1.0f) + sh; pk[i][j] = pk4_fp8(v[j].x, v[j].y, v[j].z, v[j].w); }
                float v1 = -3.0e38f, v2 = -3.0e38f; i1 = 0; i2 = 0;
#pragma unroll 1
                for (int e = 0; e < 8; ++e) { float a = 0.f;
#pragma unroll
                    for (int j = 0; j < 8; ++j) { const f32x4 w = *(const LAS f32x4*)(WR + e * 2048 + 4 * X.lane + 256 * j); a += (v[j].x * w.x + v[j].y * w.y) + (v[j].z * w.z + v[j].w * w.w); }
                    const float sl = wave_sum(a);
                    if (sl > v1) { v2 = v1; i2 = i1; v1 = sl; i1 = e; } else if (sl > v2) { v2 = sl; i2 = e; } }
                const float ex = expf(v2 - v1); g1 = 1.f / (1.f + ex); g2 = ex / (1.f + ex);
            } else {
#pragma unroll
                for (int j = 0; j < 8; ++j) pk[i][j] = 0u;
            }
            if (X.lane == 0) { const int sl2 = 2 * (8 * i + X.wave); ENT_E[sl2] = i1; ENT_E[sl2 + 1] = i2; ENT_G[sl2] = g1; ENT_G[sl2 + 1] = g2; }
        }
        __syncthreads();
        if (X.wave == 0) {
            const int e = ENT_E[X.lane]; int rank = 0, mycnt = 0;
#pragma unroll
            for (int ee = 0; ee < 8; ++ee) { const unsigned long long m = __ballot(e == ee); const int c = __popcll(m); if (e == ee) rank = __popcll(m & ((1ull << X.lane) - 1ull)); if (X.lane == ee) mycnt = c; }
            if (X.lane < 8) { int b = 0; if (mycnt > 0) b = (int)__hip_atomic_fetch_add(gcnt + 64 * X.lane, (unsigned)mycnt, __ATOMIC_RELAXED, __HIP_MEMORY_SCOPE_AGENT); BASE[X.lane] = b; }
            LDS_WAIT(); asm volatile("" ::: "memory");
            if (e >= 0) { const int phys = e * RROWS + BASE[e] + rank; ENT_P[X.lane] = phys;
                const int slot = X.lane >> 1; const int row = (X.c * NWAVES + (slot & 7)) + (p0 + (slot >> 3)) * X.NGW;
                pos[2 * row + (X.lane & 1)] = phys; rowgate[phys] = ENT_G[X.lane]; }
        }
        __syncthreads();
#pragma unroll
        for (int i = 0; i < 4; ++i) {
            const int sl2 = 2 * (8 * i + X.wave);
#pragma unroll
            for (int k = 0; k < 2; ++k) if (ENT_E[sl2 + k] >= 0) { unsigned* o = (unsigned*)(xs + (size_t)ENT_P[sl2 + k] * D) + X.lane;
#pragma unroll
                for (int j = 0; j < 8; ++j) o[64 * j] = pk[i][j]; }
        }
        __syncthreads();
    }
}
__device__ __forceinline__ int build_moe_tables(const Ctx& X, const unsigned* gcnt) {
    LAS int* TE = (LAS int*)(X.lds + TAB_OFF); LAS int* TP = TE + MAXT; LAS int* PRE = TP + MAXT;
    if (X.tid == 0) { int acc = 0;
        for (int e = 0; e < NE; ++e) { const int nt = ((int)gcnt[64 * e] + 255) >> 8; PRE[e] = acc; for (int j = 0; j < nt; ++j) { TE[acc + j] = e; TP[acc + j] = e * RTILES + j; } acc += nt; }
        PRE[NE] = acc; }
    __syncthreads();
    return __builtin_amdgcn_readfirstlane(PRE[NE]);
}
constexpr int MOE_MAIN_TILES = 64, MOE_MAIN_ROWS = MOE_MAIN_TILES * 256;
__device__ __forceinline__ void moe_final(const Ctx& X, const float* X3, const bf16* YS, const int* pos, const float* mods_l, float* out, const float* part, int ntiles) {
    const LAS int* PRE = (const LAS int*)(X.lds + TAB_OFF) + 2 * MAXT;
    int Sp, ppair; const int tail_rows = (ntiles - MOE_MAIN_TILES) * 256; pg8::tail_split(X.G, (ntiles - MOE_MAIN_TILES) * (D / 256), DFE / 128, Sp, ppair);
    int np0 = 0, np1 = 0; if (X.gw < TL) { np0 = pos[2 * X.gw]; np1 = pos[2 * X.gw + 1]; }
    for (int row = X.gw; row < TL; row += X.NGW) {
        const int p0 = np0, p1 = np1; const float* gp = mods_l + (size_t)(row >> 12) * MODW + 5 * D;
        const int l0 = (PRE[p0 >> 13] + ((p0 & (RROWS - 1)) >> 8)) * 256 + (p0 & 255), l1 = (PRE[p1 >> 13] + ((p1 & (RROWS - 1)) >> 8)) * 256 + (p1 & 255);
        if (row + X.NGW < TL) { np0 = pos[2 * (row + X.NGW)]; np1 = pos[2 * (row + X.NGW) + 1]; }
        f32x4 a[8], b[8];
        if (l0 < MOE_MAIN_ROWS) {
#pragma unroll
            for (int j = 0; j < 8; ++j) { const v2u w = __builtin_nontemporal_load((const v2u*)(YS + (size_t)p0 * D + 4 * X.lane + 256 * j)); a[j] = (f32x4){bflo(w.x), bfhi(w.x), bflo(w.y), bfhi(w.y)}; }
        } else {
#pragma unroll
            for (int j = 0; j < 8; ++j) a[j] = (f32x4){0.f, 0.f, 0.f, 0.f};
            { int p = 0;
              for (; p + 2 <= Sp; p += 2) { const float* pr = part + ((size_t)p * tail_rows + (l0 - MOE_MAIN_ROWS)) * D + 4 * X.lane; f32x4 t[2][8];
#pragma unroll
                  for (int q = 0; q < 2; ++q)
#pragma unroll
                      for (int j = 0; j < 8; ++j) t[q][j] = __builtin_nontemporal_load((const f32x4*)(pr + (size_t)q * tail_rows * D + 256 * j));
#pragma unroll
                  for (int j = 0; j < 8; ++j) a[j] += t[0][j] + t[1][j]; }
              for (; p < Sp; ++p) { const float* pr = part + ((size_t)p * tail_rows + (l0 - MOE_MAIN_ROWS)) * D + 4 * X.lane;
#pragma unroll
                  for (int j = 0; j < 8; ++j) a[j] += __builtin_nontemporal_load((const f32x4*)(pr + 256 * j)); } }
        }
        if (l1 < MOE_MAIN_ROWS) {
#pragma unroll
            for (int j = 0; j < 8; ++j) { const v2u w = __builtin_nontemporal_load((const v2u*)(YS + (size_t)p1 * D + 4 * X.lane + 256 * j)); b[j] = (f32x4){bflo(w.x), bfhi(w.x), bflo(w.y), bfhi(w.y)}; }
        } else {
#pragma unroll
            for (int j = 0; j < 8; ++j) b[j] = (f32x4){0.f, 0.f, 0.f, 0.f};
            { int p = 0;
              for (; p + 2 <= Sp; p += 2) { const float* pr = part + ((size_t)p * tail_rows + (l1 - MOE_MAIN_ROWS)) * D + 4 * X.lane; f32x4 t[2][8];
#pragma unroll
                  for (int q = 0; q < 2; ++q)
#pragma unroll
                      for (int j = 0; j < 8; ++j) t[q][j] = __builtin_nontemporal_load((const f32x4*)(pr + (size_t)q * tail_rows * D + 256 * j));
#pragma unroll
                  for (int j = 0; j < 8; ++j) b[j] += t[0][j] + t[1][j]; }
              for (; p < Sp; ++p) { const float* pr = part + ((size_t)p * tail_rows + (l1 - MOE_MAIN_ROWS)) * D + 4 * X.lane;
#pragma unroll
                  for (int j = 0; j < 8; ++j) b[j] += __builtin_nontemporal_load((const f32x4*)(pr + 256 * j)); } }
        }
#pragma unroll
        for (int j = 0; j < 8; ++j) { const int col = 4 * X.lane + 256 * j; const f32x4 x = __builtin_nontemporal_load((const f32x4*)(X3 + (size_t)row * D + col)), g = *(const f32x4*)(gp + col);
            __builtin_nontemporal_store(x + g * (a[j] + b[j]), (f32x4*)(out + (size_t)row * D + col)); }
    }
}

__device__ __forceinline__ int grab_items(unsigned* head, int n, int lane) {
    int v = 0; if (lane == 0) v = (int)__hip_atomic_fetch_add(head, (unsigned)n, __ATOMIC_RELAXED, __HIP_MEMORY_SCOPE_AGENT);
    return __builtin_amdgcn_readfirstlane(v);
}
__device__ __forceinline__ int idle_units(int nunits, int G, int c) { const int maxu = (nunits + G - 1) / G, mine = c < nunits ? (nunits - c + G - 1) / G : 0; return maxu - mine; }
__device__ __forceinline__ const float* arg_in(int i) {
    auto kp = __builtin_amdgcn_kernarg_segment_ptr();
    asm volatile("" : "+s"(kp));
    return ((const float* const __attribute__((address_space(4)))*)kp)[i];
}
#define AIN(i) arg_in(i)
constexpr int DN1 = (D / 128) * (2 * DFF / 32), DN2 = DN1 + (DFF / 64) * (D / 64), DN3 = DN2 + (D / 64) * (ODD_IN / 64), DN4 = DN3 + (D / 64) * (D / 64);
constexpr int PX1_ITEMS = (D / 128) * (2 * DFE / 32), PX2_ITEMS = (DFE / 128) * (D / 32), NQ1 = DN4 + NE * PX1_ITEMS, NDEF = NQ1 + NE * PX2_ITEMS;
static_assert(DN1 % 16 == 0 && DN2 % 16 == 0 && DN3 % 16 == 0 && DN4 % 16 == 0 && NQ1 % 16 == 0 && NDEF % 16 == 0, "deferred queue sections");
__device__ __forceinline__ void def_item(int it, unsigned char* ws, LAS float* scr, int lane) {
    if (it < DN1 || it >= DN4) {
        const float* W; unsigned char* WT; int K, N, q, kind;
        if (it < DN1) { W = AIN(20); WT = ws + WS_WT_EF1; K = D; N = 2 * DFF; q = it; kind = 1; }
        else { const int r0 = it - DN4; const bool up = r0 < NE * PX1_ITEMS; const int r = up ? r0 : r0 - NE * PX1_ITEMS; const int per = up ? PX1_ITEMS : PX2_ITEMS; const int e = r / per; q = r - e * per;
            W = (up ? AIN(31) : AIN(32)) + (size_t)e * ((size_t)D * DFE * (up ? 2 : 1)); WT = ws + (up ? WS_WT_X1 : WS_WT_X2) + (size_t)e * ((size_t)D * DFE * (up ? 2 : 1));
            K = up ? D : DFE; N = up ? 2 * DFE : D; kind = up ? 1 : 0; }
        transpose_item8(W, K, N, WT, q, kind, scr, lane);
    } else {
        const float* W; bf16* WT; int K, N, q, kind;
        if (it < DN2) { W = AIN(21); WT = (bf16*)(ws + WS_WT_EF2); K = DFF; N = D; q = it - DN1; kind = 0; }
        else if (it < DN3) { W = AIN(26); WT = (bf16*)(ws + WS_WT_OIN); K = D; N = ODD_IN; q = it - DN2; kind = 3; }
        else { W = AIN(27); WT = (bf16*)(ws + WS_WT_OOUT); K = D; N = D; q = it - DN3; kind = 0; }
        transpose_item(W, K, N, WT, q, kind, scr, lane);
    }
}
__device__ __forceinline__ void drain_deferred(const Ctx& X, gu32* ctl, unsigned char* ws, int max_batches, int limit) {
    unsigned* head = (unsigned*)(ctl + CW_WORK + 64);
    volatile LAS int* tk = (volatile LAS int*)(X.lds + 139264);
    volatile LAS unsigned* seen = (volatile LAS unsigned*)(X.lds + MISC_OFF + 4 * (8 + 5));
    int dt = threadIdx.x; asm volatile("" : "+v"(dt));
    const int dlane = dt & 63, dwave = __builtin_amdgcn_readfirstlane(dt >> 6);
    LAS float* scr = (LAS float*)(X.lds + dwave * 16896);
    int par = 0;
    for (int b = 0; b < max_batches; ++b) {
        if (dt == 0) { int t = NDEF; unsigned sn = seen[0];
            if (sn < (unsigned)limit && limit < NDEF) { const unsigned h = __hip_atomic_load(head, __ATOMIC_RELAXED, __HIP_MEMORY_SCOPE_AGENT); sn = h > sn ? h : sn; }
            if (sn < (unsigned)limit) { t = (int)__hip_atomic_fetch_add(head, 16u, __ATOMIC_RELAXED, __HIP_MEMORY_SCOPE_AGENT); sn = (unsigned)t + 16u; }
            seen[0] = sn; tk[par] = t; }
        __syncthreads();
        const int base = tk[par]; par ^= 1;
        if (base >= NDEF) break;
#pragma unroll 1
        for (int i = 0; i < 2; ++i) { const int it = base + dwave + 8 * i; if (it < NDEF) def_item(it, ws, scr, dlane); }
    }
    __syncthreads();
}
__device__ __forceinline__ void xcd_barrier_h(const XcdBarrier& b, const Ctx& X, gu32* ctl, unsigned char* ws) {
    asm volatile("s_waitcnt vmcnt(0)" ::: "memory");
    __syncthreads();
    if (threadIdx.x == 0) {
        unsigned* bar = b.bar;
        __builtin_amdgcn_s_waitcnt(0);
        unsigned nloc = b.st[0], nx = b.st[1];
        if (nloc == 0u) { xcd_barrier_complete(bar, b.x, nloc, nx); b.st[0] = nloc; b.st[1] = nx; }
        const unsigned old = xb_add(&bar[XB_XSUB(b.x)], 1u);
        const unsigned gen = old / nloc;
        if (old + 1u == (gen + 1u) * nloc) {
            __builtin_amdgcn_fence(__ATOMIC_RELEASE, "agent");
            asm volatile("s_waitcnt vmcnt(0)" ::: "memory");
            const unsigned og = xb_add(&bar[XB_TOP], 1u);
            const unsigned tg = og / nx;
            if (og + 1u == (tg + 1u) * nx) xb_add(&bar[XB_TOPGEN], 1u);
            else XB_SPIN(xb_ld(&bar[XB_TOPGEN]) == tg, bar);
            __builtin_amdgcn_fence(__ATOMIC_ACQUIRE, "agent");
            xb_add(&bar[XB_XGEN(b.x)], 1u);
            asm volatile("s_waitcnt vmcnt(0)" ::: "memory");
            b.st[2] = 0u;
        } else { b.st[2] = 1u; b.st[3] = gen; }
    }
    __syncthreads();
    if (b.st[2]) {
        unsigned* head = (unsigned*)(ctl + CW_WORK + 64);
        int ht = threadIdx.x; asm volatile("" : "+v"(ht));
        const int hlane = ht & 63, hwave = __builtin_amdgcn_readfirstlane(ht >> 6);
        LAS float* scr = (LAS float*)(X.lds + hwave * 16896);
        int par = 0;
        for (;;) {
            if (ht == 0) {
                unsigned* bar = b.bar; const unsigned gen = b.st[3], nloc = b.st[0], nx = b.st[1];
                int cmd = -1; unsigned sp = 0u;
                for (;;) {
                    if (xb_ld(&bar[XB_XGEN(b.x)]) != gen) break;
                    if (b.st[4] == 0u) {
                        const unsigned la = xb_ld(&bar[XB_XSUB(b.x)]) - gen * nloc;
                        bool go = la + 1u <= nloc;
                        if (!go && la == nloc) go = (xb_ld(&bar[XB_TOP]) - gen * nx) + 1u <= nx;
                        if (go) { const int t = (int)__hip_atomic_fetch_add(head, 8u, __ATOMIC_RELAXED, __HIP_MEMORY_SCOPE_AGENT); b.st[5] = (unsigned)t + 8u; if (t < NDEF) { cmd = t; break; } b.st[4] = 1u; }
                    }
                    __builtin_amdgcn_s_sleep(1);
                    if ((++sp & 255u) == 0u) { if (xb_ld(&bar[XB_TMO])) break; if (sp > XB_SPIN_CAP) { atomicAdd(&bar[XB_TMO], 1u); break; } }
                }
                b.st[6 + par] = (unsigned)cmd;
            }
            __syncthreads();
            const int cmd = (int)b.st[6 + par]; par ^= 1;
            if (cmd < 0) break;
            const int it = cmd + hwave; if (it < NDEF) def_item(it, ws, scr, hlane);
        }
        if (threadIdx.x == 0) {
            __builtin_amdgcn_fence(__ATOMIC_ACQUIRE, "agent");
            asm volatile("s_waitcnt vmcnt(0)" ::: "memory");
        }
        __syncthreads();
    }
}
constexpr int NPHASE = 20;
#ifndef PHMASK
#define PHMASK 0xFFFFFu
#endif
#ifndef PHDUP
#define PHDUP 0u
#endif
#define REP(k) _Pragma("unroll") for (int rep_ = 0; rep_ < ((((PHDUP) >> (k)) & 1u) ? 2 : 1); ++rep_)
#ifndef MK_LAUNCHES
#define MK_LAUNCHES {{0, NPHASE}}
#endif
struct PhRange { int lo, hi; };
constexpr PhRange kLaunches[] = MK_LAUNCHES;
struct Args { const float* in[33]; float* out; unsigned char* ws; int ph_lo, ph_hi, li, pad; };
__global__ void __launch_bounds__(NWAVES * 64, 2) fwd_kernel(Args args) {
    extern __shared__ __attribute__((aligned(16))) unsigned char lds[];
    Ctx X;
    X.lds = (LAS unsigned char*)lds; X.tid = threadIdx.x; X.lane = X.tid & 63; X.wave = __builtin_amdgcn_readfirstlane(X.tid >> 6);
    X.G = gridDim.x; X.c = blockIdx.x; X.gw = X.c * NWAVES + X.wave; X.NGW = X.G * NWAVES;
    unsigned char* ws = args.ws;
    gu32* ctl = (gu32*)(ws + WS_CTL);
    volatile LAS unsigned* MISC = (volatile LAS unsigned*)(X.lds + MISC_OFF);
    for (int u = X.tid; u < (LDS_BYTES - LDSCTL_OFF) / 4; u += NWAVES * 64) ((LAS unsigned*)(X.lds + LDSCTL_OFF))[u] = 0u;
    __syncthreads();
    const int lo = args.ph_lo, hi = args.ph_hi;
    XcdBarrier bar; bar.bar = (unsigned*)(ctl + CW_BAR) + args.li * XCD_BAR_WORDS; bar.x = 0; bar.st = nullptr;
    if (hi - lo > 1) bar = xcd_barrier_post((unsigned*)(ctl + CW_BAR) + args.li * XCD_BAR_WORDS, MISC + 8);
#ifdef PROBE_SEL
#define stamper (blockIdx.x == PROBE_BLK && threadIdx.x == 0)
#define TS ((volatile LAS unsigned long long*)(X.lds + LDSCTL_OFF + 1024))
    if (stamper) TS[63] = __builtin_amdgcn_s_memrealtime();
#define GRID_BAR_K(k) do { if (stamper) TS[2 * (k)] = __builtin_amdgcn_s_memrealtime(); xcd_barrier_h(bar, X, ctl, ws); if (stamper) TS[2 * (k) + 1] = __builtin_amdgcn_s_memrealtime(); } while (0)
#else
#define GRID_BAR_K(k) xcd_barrier_h(bar, X, ctl, ws)
#endif
#define GRID_BAR() xcd_barrier(bar)
#define REFRESH_X() do { int t_ = threadIdx.x; asm volatile("" : "+v"(t_)); X.tid = t_; X.lane = t_ & 63; } while (0)
#define IN(k) ((((PHMASK) >> (k)) & 1u) && lo <= (k) && (k) < hi)
#define BOTH(k) (IN(k) && ((k) + 1) < hi)

#define x_in (AIN(0))
#define c_in (AIN(1))
#define ctx_in (AIN(2))
#define cctx_in (AIN(3))
#define mods0 ((float*)(ws + WS_MODS))
#define mods1 ((float*)(ws + WS_MODS) + 3 * MODW)
#define lamv ((float*)(ws + WS_LAM))
#define CSTAB ((float*)(ws + WS_LAM + 4096))
#define GTAB ((float*)(ws + WS_LAM + 4096 + 16384))
#define WT_EIN ((bf16*)(ws + WS_WT_EIN))
#define WT_EOUT ((bf16*)(ws + WS_WT_EOUT))
#define WT_EF1 ((bf16*)(ws + WS_WT_EF1))
#define WT_EF2 ((bf16*)(ws + WS_WT_EF2))
#define WT_OIN ((bf16*)(ws + WS_WT_OIN))
#define WT_OOUT ((bf16*)(ws + WS_WT_OOUT))
#define WT_X1 ((bf16*)(ws + WS_WT_X1))
#define WT_X2 ((bf16*)(ws + WS_WT_X2))
#define H ((bf16*)(ws + WS_H))
#define Z ((bf16*)(ws + WS_Z))
#define QKV ((bf16*)(ws + WS_QKV))
#define PB ((float*)(ws + WS_PB))
#define OALL ((bf16*)(ws + WS_OALL))
#define X1 ((float*)(ws + WS_X1))
#define X3 ((float*)(ws + WS_X3))
#define ACT ((bf16*)(ws + WS_ACT))
#define XS ((bf16*)(ws + WS_XS))
#define ACT2 ((bf16*)(ws + WS_ACT2))
#define YS ((bf16*)(ws + WS_YS))
#define PART ((float*)(ws + WS_PART))
#define EID ((int*)(ws + RT_EID))
#define EGATE ((float*)(ws + RT_GATE))
#define POS ((int*)(ws + RT_POS))
#define ROWTOK ((int*)(ws + RT_ROWTOK))
#define ROWGATE ((float*)(ws + WS_RGATE))
#define TILE_E ((int*)(ws + RT_TILE_E))
#define NTILES ((int*)(ws + RT_NTILES))

    if (IN(0)) { REFRESH_X();
    REP(0) { if (rep_) __syncthreads();
    {
        mod_fill_silu(X, c_in, cctx_in);
        for (int task = X.c; task < MOD_TASKS; task += X.G) { const int l = task / (MODW / 32); mod_task(X, task, l ? AIN(24) : AIN(6), l ? AIN(25) : AIN(7), l ? mods1 : mods0); }
        if (X.c == (X.G > 1 ? X.G - 2 : 0)) {
            for (int idx = X.tid; idx < 2048; idx += NWAVES * 64) { const int pp = idx >> 5, i = idx & 31; const float inv = exp2f(-(float)i * (13.287712379549449f / 32.0f)); float sn, cs; sincosf((float)pp * inv, &sn, &cs);
                CSTAB[idx] = cs; CSTAB[2048 + idx] = sn; }
            for (int idx = X.tid; idx < 6 * 128; idx += NWAVES * 64) { const int gi = idx >> 7, j = idx & 127;
                const float* src = gi == 0 ? AIN(10) : gi == 1 ? AIN(11) : gi == 2 ? AIN(13) : gi == 3 ? AIN(14) : gi == 4 ? AIN(28) : AIN(29); GTAB[idx] = src[j]; }
        }
        if (X.c == X.G - 1 && X.wave == 0) {
            for (int h = 0; h < 4; ++h) { const float* q1 = AIN(15) + h * 128; const float* k1 = AIN(16) + h * 128; const float* q2 = AIN(17) + h * 128; const float* k2 = AIN(18) + h * 128;
                const float s1 = wave_sum(q1[X.lane] * k1[X.lane] + q1[X.lane + 64] * k1[X.lane + 64]); const float s2 = wave_sum(q2[X.lane] * k2[X.lane] + q2[X.lane + 64] * k2[X.lane + 64]);
                if (X.lane == 0) lamv[h] = expf(s1) - expf(s2) + LAM_INIT; }
        }
        LAS float* scr = (LAS float*)(X.lds + X.wave * 16896);
        constexpr int I0 = (D / 64) * (EVEN_IN / 64), I1 = I0 + (D / 64) * (D / 64), I2 = I1 + (D / 128) * (2 * DFF / 32), I3 = I2 + (DFF / 64) * (D / 64), I4 = I3 + (D / 64) * (ODD_IN / 64), I5 = I4 + (D / 64) * (D / 64);
        constexpr int NITEMS = I1;
        constexpr int NA = (NITEMS * 3 / 4) & ~7, CHA = 8, CHB = 2;
        unsigned* wq = (unsigned*)(ctl + CW_WORK);
#define GRAB(word, n) grab_items(wq + 64 * (word), (n), X.lane)
#define DO_ITEM(it_) do { int r_ = (it_); \
            if (r_ < I0) { transpose_item(AIN(8), D, EVEN_IN, WT_EIN, r_, 2, scr, X.lane); } \
            else { transpose_item(AIN(9), D, D, WT_EOUT, r_ - I0, 0, scr, X.lane); } } while (0)
        {
            constexpr int CH = 2;
            volatile LAS int* tk = (volatile LAS int*)(X.lds + 139264);
            int par = 0; int nxt = 0; if (X.tid == 0) nxt = (int)__hip_atomic_fetch_add(wq, (unsigned)(8 * CH), __ATOMIC_RELAXED, __HIP_MEMORY_SCOPE_AGENT);
            for (;;) {
                if (X.tid == 0) { tk[par] = nxt; nxt = (int)__hip_atomic_fetch_add(wq, (unsigned)(8 * CH), __ATOMIC_RELAXED, __HIP_MEMORY_SCOPE_AGENT); }
                __syncthreads();
                const int base = tk[par]; par ^= 1;
                if (base >= NITEMS) break;
#pragma unroll 1
                for (int i = 0; i < CH; ++i) { const int it = base + X.wave + 8 * i; if (it < NITEMS) DO_ITEM(it); }
            }
        }
#undef GRAB
#undef DO_ITEM
    }
    }
    if (BOTH(0)) GRID_BAR_K(0);
    }
    if (IN(1)) { REFRESH_X();
    REP(1) { if (rep_) __syncthreads();
    norm_mod_rows<false>(X, x_in, ctx_in, MR, AIN(4), mods0, 0, 1, H, nullptr, nullptr, nullptr);
    }
    if (BOTH(1)) GRID_BAR_K(1);
    }
    if (IN(2)) { REFRESH_X();
    REP(2) { if (rep_) __syncthreads();
    { pg8::Gemm g{H, WT_EIN, MR, EVEN_IN, D}; pg8::StaticOrder S; S.init(MR, EVEN_IN, D / 64, X.G, X.c); pg8::EpiSlotsNR E{QKV, NSLOT0, KVR, 0, GTAB, CSTAB, (PG8_LAS float*)(X.lds + RING_BYTES)};
      pg8::gemm_phase<pg8::EpiSlotsNR, pg8::StaticOrder, true, true>(X.lds, g, S, E); }
    drain_deferred(X, ctl, ws, 4 * idle_units((MR / 256) * (EVEN_IN / 256), X.G, X.c), NDEF);
    }
    if (BOTH(2)) GRID_BAR_K(2);
    }
    if (IN(4)) { REFRESH_X();
    REP(4) { if (rep_) __syncthreads();
    {
        const att::bf16* Q0 = (const att::bf16*)QKV;
        int atid = threadIdx.x; asm volatile("" : "+v"(atid));
        for (int u = X.c; u < 544; u += X.G) {
            const bool isl = u < 512; const int b = isl ? (u >> 8) : ((u - 512) >> 4), vh = isl ? ((u >> 4) & 15) : ((u - 512) & 15), qb = isl ? (u & 15) : 16;
            const int hb = vh >> 2, map = (vh >> 1) & 1, half = vh & 1;
            const att::bf16* Qp = Q0 + ((size_t)(b * NSLOT0 + 12 + 2 * hb + map) * KVR + qb * 256) * 128;
            const att::bf16* Kp = Q0 + ((size_t)(b * NSLOT0 + 20 + 2 * hb + map) * KVR) * 128;
            const att::bf16* Vp = Q0 + ((size_t)(b * NSLOT0 + 28 + 2 * hb + half) * KVR) * 128;
            float* Op = PB + ((size_t)(b * 16 + vh) * KVR + qb * 256) * 128;
            att::attn_unit<false, false>(Qp, Kp, Vp, (void*)Op, 128, 0, isl ? 68 : 0, isl ? 68 : 4, qb * 256, -1e30f, 0.f, (char*)lds, atid);
        }
        const int ca = (X.c + X.G - 32) % X.G;
        for (int u = ca; u < 272; u += X.G) {
            const bool isl = u < 256; const int b = isl ? (u >> 7) : ((u - 256) >> 3), h = isl ? ((u >> 4) & 7) : ((u - 256) & 7), qb = isl ? (u & 15) : 16;
            const int q0 = qb * 256; const int klo = isl ? (q0 >= 128 ? q0 - 128 : 0) : 0; const int khi = (q0 + 384) < SEQ ? (q0 + 384) : SEQ; const int nt1 = isl ? ((khi - klo) >> 6) : 0;
            const att::bf16* Qp = Q0 + ((size_t)(b * NSLOT0 + h) * KVR + q0) * 128;
            const att::bf16* Kp = Q0 + ((size_t)(b * NSLOT0 + 8 + (h >> 2)) * KVR) * 128;
            const att::bf16* Vp = Q0 + ((size_t)(b * NSLOT0 + 10 + (h >> 2)) * KVR) * 128;
            bf16* Op = OALL + (size_t)(isl ? (b * SEQ + q0) : (TL + b * CTXL)) * D + h * 128;
            const float sink = AIN(12)[h];
            att::attn_unit<true, true>(Qp, Kp, Vp, (void*)Op, D, klo, nt1, nt1 + 4, q0, sink * (1.0f / att::SCALE), 1.f, (char*)lds, atid);
        }
    }
    }
    if (BOTH(4)) GRID_BAR_K(4);
    }
    if (IN(5)) { REFRESH_X();
    REP(5) { if (rep_) __syncthreads();
    b_combine(X, PB, lamv, AIN(19), OALL);
    }
    if (BOTH(5)) GRID_BAR_K(5);
    }
    if (IN(6)) { REFRESH_X();
    REP(6) { if (rep_) __syncthreads();
    { pg8::Gemm g{OALL, WT_EOUT, MR, D, D}; pg8::TailOrder S; S.init(TL / 256, TC / 256, D / 256, D / 64, X.G, X.c, nullptr); pg8::EpiRes E{x_in, ctx_in, X1, D, mods0 + 2 * D, MODW, PART, TL, TC, 1.0f};
      pg8::gemm_phase<pg8::EpiRes, pg8::TailOrder, true, true>(X.lds, g, S, E); }
    }
    if (BOTH(6)) GRID_BAR_K(6);
    }
    if (IN(7)) { REFRESH_X();
    REP(7) { if (rep_) __syncthreads();
    { int Sp, pp; pg8::tail_split(X.G, (TC / 256) * (D / 256), D / 64, Sp, pp);
      norm_mod_rows<false, true, true>(X, X1, ctx_in, MR, AIN(5), mods0, 3, 4, H, nullptr, nullptr, nullptr, PART, Sp, mods0 + 2 * MODW + 2 * D, X1 + (size_t)TL * D); }
    drain_deferred(X, ctl, ws, 1 << 20, DN1);
    }
    if (BOTH(7)) GRID_BAR_K(7);
    }
    if (IN(8)) { REFRESH_X();
    REP(8) { if (rep_) __syncthreads();
    { pg8::Gemm g{H, WT_EF1, MR, 2 * DFF, D}; pg8::StaticOrder S; S.init(MR, 2 * DFF, D / 128, X.G, X.c); pg8::EpiSwiglu E{ACT, DFF, 1.0f / W8_SCALE};
      pg8::gemm_phase<pg8::EpiSwiglu, pg8::StaticOrder, true, true, true>(X.lds, g, S, E); }
    drain_deferred(X, ctl, ws, 2 * idle_units((MR / 256) * (2 * DFF / 256), X.G, X.c), NDEF);
    drain_deferred(X, ctl, ws, 1 << 20, DN2);
    }
    if (BOTH(8)) GRID_BAR_K(8);
    }
    if (IN(9)) { REFRESH_X();
    REP(9) { if (rep_) __syncthreads();
    { pg8::Gemm g{ACT, WT_EF2, MR, D, DFF}; pg8::TailOrder S; S.init(TL / 256, TC / 256, D / 256, DFF / 64, X.G, X.c, nullptr); pg8::EpiRes E{X1, X1 + (size_t)TL * D, X1, D, mods0 + 5 * D, MODW, PART, TL, TC, 1.0f};
      pg8::gemm_phase<pg8::EpiRes, pg8::TailOrder, true, true>(X.lds, g, S, E); }
    }
    if (BOTH(9)) GRID_BAR_K(9);
    }
    if (IN(10)) { REFRESH_X();
    REP(10) { if (rep_) __syncthreads();
    { int Sp, pp; pg8::tail_split(X.G, (TC / 256) * (D / 256), DFF / 64, Sp, pp);
      norm_mod_rows<false, true>(X, X1, X1 + (size_t)TL * D, MR, AIN(22), mods1, 0, 1, H, nullptr, nullptr, nullptr, PART, Sp, mods0 + 2 * MODW + 5 * D, nullptr); }
    drain_deferred(X, ctl, ws, 1 << 20, DN3);
    }
    if (BOTH(10)) GRID_BAR_K(10);
    }
    if (IN(11)) { REFRESH_X();
    REP(11) { if (rep_) __syncthreads();
    { pg8::Gemm g{H, WT_OIN, MR, ODD_IN, D}; pg8::StaticOrder S; S.init(MR, ODD_IN, D / 64, X.G, X.c); pg8::EpiSlotsNR E{QKV, NSLOT1, KVR, 1, GTAB, CSTAB, (PG8_LAS float*)(X.lds + RING_BYTES)};
      pg8::gemm_phase<pg8::EpiSlotsNR, pg8::StaticOrder, true, true>(X.lds, g, S, E); }
    drain_deferred(X, ctl, ws, 4 * idle_units((MR / 256) * (ODD_IN / 256), X.G, X.c), NDEF);
    }
    if (BOTH(11)) GRID_BAR_K(11);
    }
    if (IN(13)) { REFRESH_X();
    REP(13) { if (rep_) __syncthreads();
    {
        const att::bf16* Q0 = (const att::bf16*)QKV;
        int atid = threadIdx.x; asm volatile("" : "+v"(atid));
        for (int u = X.c; u < 512; u += X.G) {
            const int b = u >> 8, h = (u >> 4) & 15, qb = u & 15;
            const att::bf16* Qp = Q0 + ((size_t)(b * NSLOT1 + h) * KVR + qb * 256) * 128;
            const att::bf16* Kp = Q0 + ((size_t)(b * NSLOT1 + 16 + (h >> 2)) * KVR) * 128;
            const att::bf16* Vp = Q0 + ((size_t)(b * NSLOT1 + 20 + (h >> 2)) * KVR) * 128;
            bf16* Op = OALL + (size_t)(b * SEQ + qb * 256) * D + h * 128;
            const int ntc = 68 + (X.G >> 20);
            att::attn_unit<false, true>(Qp, Kp, Vp, (void*)Op, D, 0, ntc, ntc, qb * 256, -1e30f, 0.f, (char*)lds, atid);
        }
    }
    drain_deferred(X, ctl, ws, 1 << 20, DN4);
    }
    if (BOTH(13)) GRID_BAR_K(13);
    }
    if (IN(14)) { REFRESH_X();
    REP(14) { if (rep_) __syncthreads();
    { pg8::Gemm g{OALL, WT_OOUT, TL, D, D}; pg8::StaticOrder S; S.init(TL, D, D / 64, X.G, X.c); pg8::EpiRes E{X1, X1, X3, D, mods1 + 2 * D, MODW, nullptr, 0, 0, 1.0f};
      pg8::gemm_phase<pg8::EpiRes, pg8::StaticOrder, true, true>(X.lds, g, S, E); }
    }
    if (BOTH(14)) GRID_BAR_K(14);
    }
    if (IN(15)) { REFRESH_X();
    REP(15) { if (rep_) __syncthreads();
    norm_route_rows(X, X3, AIN(23), mods1, 3, 4, AIN(30), (unsigned*)(ctl + CW_GCNT), (unsigned char*)XS, POS, ROWGATE);
    drain_deferred(X, ctl, ws, 1 << 20, NQ1);
    }
    if (BOTH(15)) GRID_BAR_K(15);
    }
    if (IN(17)) { REFRESH_X();
    REP(17) { if (rep_) __syncthreads();
    { const int nt = build_moe_tables(X, (const unsigned*)(ctl + CW_GCNT)); const int* te_ = (const int*)(lds + TAB_OFF); pg8::Gemm g{XS, WT_X1, XROWS, 2 * DFE, D}; pg8::TailOrder S; S.init(nt, 0, 2 * DFE / 256, D / 128, X.G, X.c, te_, te_ + MAXT); pg8::EpiSwiglu8 E{ACT2, DFE, 1.0f / W8_SCALE};
      pg8::gemm_phase<pg8::EpiSwiglu8, pg8::TailOrder, true, true, true>(X.lds, g, S, E); }
    drain_deferred(X, ctl, ws, 1 << 20, NDEF);
    }
    if (BOTH(17)) GRID_BAR_K(17);
    }
    if (IN(18)) { REFRESH_X();
    REP(18) { if (rep_) __syncthreads();
    { const int nt = build_moe_tables(X, (const unsigned*)(ctl + CW_GCNT)); const int* te_ = (const int*)(lds + TAB_OFF); pg8::Gemm g{ACT2, WT_X2, XROWS, D, DFE}; pg8::TailOrder S; S.init(MOE_MAIN_TILES, nt - MOE_MAIN_TILES, D / 256, DFE / 128, X.G, X.c, te_, te_ + MAXT); pg8::EpiRowScale E{(pg8::bf16_t*)YS, D, ROWGATE, PART, MOE_MAIN_ROWS, (nt - MOE_MAIN_TILES) * 256, 1.0f / W8_SCALE};
      pg8::gemm_phase<pg8::EpiRowScale, pg8::TailOrder, true, true, true>(X.lds, g, S, E); }
    }
    if (BOTH(18)) GRID_BAR_K(18);
    }
    if (IN(19)) { REFRESH_X();
    REP(19) { if (rep_) __syncthreads();
    { const int nt = build_moe_tables(X, (const unsigned*)(ctl + CW_GCNT)); moe_final(X, X3, YS, POS, mods1, args.out, PART, nt); }
#ifdef PROBE_SEL
    if (stamper) { TS[38] = __builtin_amdgcn_s_memrealtime(); TS[39] = TS[38];
        unsigned long long workmask_sum = 0, bar_sum = 0;
        for (int k = 0; k < 20; ++k) { const unsigned long long st = k == 0 ? TS[63] : TS[2 * k - 1]; const unsigned long long w = TS[2 * k] - st, bw = TS[2 * k + 1] - TS[2 * k];
            if ((PROBE_WORK_MASK >> k) & 1u) workmask_sum += w; if ((PROBE_BAR_MASK >> k) & 1u) bar_sum += bw; }
        const unsigned long long spin = (workmask_sum + bar_sum) * (unsigned long long)(PROBE_AMP);
        const unsigned long long t0_ = __builtin_amdgcn_s_memrealtime(); while (__builtin_amdgcn_s_memrealtime() - t0_ < spin) __builtin_amdgcn_s_sleep(8); }
#endif
    }
    }
}

extern "C" void kernel_launch(void* const* d_in, const int* in_sizes, int n_in, void* d_out, int out_size, void* d_ws, size_t ws_size, hipStream_t stream) {
    static int grid = 0;
    if (grid == 0) {
        if (n_in != 33 || in_sizes[0] != TL * D || out_size != TL * D || ws_size < WS_END) { fprintf(stderr, "kernel_launch: unexpected shapes (n_in %d, in0 %d, out %d, ws %zu)\n", n_in, n_in > 0 ? in_sizes[0] : -1, out_size, ws_size); grid = -1; return; }
        int dev = 0, cus = 0, per_cu = 0;
        if (hipGetDevice(&dev) != hipSuccess || hipDeviceGetAttribute(&cus, hipDeviceAttributeMultiprocessorCount, dev) != hipSuccess) { grid = -1; return; }
        if (hipFuncSetAttribute((const void*)fwd_kernel, hipFuncAttributeMaxDynamicSharedMemorySize, LDS_BYTES) != hipSuccess) { fprintf(stderr, "kernel_launch: hipFuncSetAttribute failed\n"); grid = -1; return; }
        if (hipOccupancyMaxActiveBlocksPerMultiprocessor(&per_cu, (const void*)fwd_kernel, NWAVES * 64, LDS_BYTES) != hipSuccess || per_cu < 1) { fprintf(stderr, "kernel_launch: occupancy query says %d blocks per CU\n", per_cu); }
        (void)hipGetLastError();
        grid = cus;
    }
    if (grid < 0) return;
    constexpr int NL = sizeof(kLaunches) / sizeof(kLaunches[0]);
    if (hipMemsetAsync((char*)d_ws + WS_CTL, 0, NL == 1 ? (size_t)65536 : CTL_ZERO_BYTES, stream) != hipSuccess) return;
    Args a{};
    for (int i = 0; i < 33; ++i) a.in[i] = (const float*)d_in[i];
    a.out = (float*)d_out; a.ws = (unsigned char*)d_ws;
    for (int li = 0; li < NL; ++li) {
        a.ph_lo = kLaunches[li].lo; a.ph_hi = kLaunches[li].hi; a.li = li; a.pad = 0;
        hipLaunchKernelGGL(fwd_kernel, dim3(grid), dim3(NWAVES * 64), LDS_BYTES, stream, a);
        const hipError_t le = hipPeekAtLastError();
        if (le != hipSuccess) { fprintf(stderr, "kernel_launch: launch %d failed: %s\n", li, hipGetErrorName(le)); break; }
    }
}
```

```cpp
#include <hip/hip_runtime.h>
#include <hip/hip_bf16.h>
#include <cstdio>
#include <cstdint>

namespace pg8 {
#define PG8_LAS __attribute__((address_space(3)))
typedef unsigned short bf16_t;
typedef short bf16x8 __attribute__((ext_vector_type(8)));
typedef float f32x4 __attribute__((ext_vector_type(4)));
typedef unsigned u32x4 __attribute__((ext_vector_type(4)));
constexpr int BM = 256, BK = 64, HALF = 128, HTB = HALF * BK * 2  , STAGE_BYTES = 8 * HTB, NXCD = 8, WGM = 8;

__host__ __device__ __forceinline__ int lds_byte(int r, int c) { const int st = (r >> 4) * 2 + (c >> 5), rr = r & 15, cc = c & 31, ob = rr * 64 + cc * 2; return st * 1024 + (ob ^ (((ob >> 9) & 1) << 5)); }
__host__ __device__ __forceinline__ void stage_rc(int b, int& R, int& C) { const int st = b / 1024, sb = b % 1024, swz = sb ^ (((sb >> 9) & 1) << 5); R = (st >> 1) * 16 + swz / 64; C = (st & 1) * 32 + (swz % 64) / 2; }
__host__ __device__ __forceinline__ int perm32(int rho) { const int n = rho >> 4, i = rho & 15; return 8 * (i >> 2) + 4 * n + (i & 3); }

struct Unit { int pm, pn, pnb, kt0, nkt, part, lt; };
struct Gemm { const void* A; const void* Bt; int M, N, K; };

struct StaticOrder {
    int nM, nN, nwg, G, c, KT;
    __host__ __device__ __forceinline__ void init(int M, int N, int KT_, int G_, int c_) { nM = M / BM; nN = N / BM; nwg = nM * nN; G = G_; c = c_; KT = KT_; }
    __host__ __device__ __forceinline__ bool next(int i, Unit& u) const {
        const long L = (long)i * G + c; if (L >= nwg) return false;
        int wgid = (int)L; { const int q = nwg / NXCD, r = nwg % NXCD, xcd = wgid % NXCD, off = wgid / NXCD; wgid = (xcd < r ? xcd * (q + 1) : r * (q + 1) + (xcd - r) * q) + off; }
        const int nig = WGM * nN, gid = wgid / nig, fm = gid * WGM, gsz = (nM - fm) < WGM ? (nM - fm) : WGM;
        u.pm = fm + ((wgid % nig) % gsz); u.pn = (wgid % nig) / gsz; u.pnb = u.pn; u.kt0 = 0; u.nkt = KT; u.part = -1; u.lt = u.pm; return true;
    }
    __device__ __forceinline__ void a_ready(const Unit&) const {}
    __device__ __forceinline__ void done(const Unit&) const {}
};
__host__ __device__ __forceinline__ void tail_split(int G, int T, int KT, int& Sp, int& ppair) {
    if (T <= 0) { Sp = 0; ppair = 0; return; }
    int S = G / T; if (S < 1) S = 1; const int pairs = KT >> 1; ppair = (pairs + S - 1) / S; if (ppair < 2) ppair = 2; Sp = (pairs + ppair - 1) / ppair;
}
struct TailOrder {
    StaticOrder so; int T, Sp, ppair; const int* tile_e; const int* tile_p;
    __device__ __forceinline__ void init(int nMm, int nTm, int nN, int KT, int G_, int c_, const int* te, const int* tp = nullptr) { so.nM = nMm; so.nN = nN; so.nwg = nMm * nN; so.G = G_; so.c = c_; so.KT = KT; T = nTm * nN; tile_e = te; tile_p = tp; tail_split(G_, T, KT, Sp, ppair); }
    __device__ __forceinline__ bool next(int i, Unit& u) const {
        const int nm = so.c < so.nwg ? (so.nwg - so.c + so.G - 1) / so.G : 0;
        const int cc = so.G - 1 - so.c;
        int pm, pn, kt0 = 0, nkt = so.KT, part = -1;
        if (i < nm) { Unit t; so.next(i, t); pm = t.pm; pn = t.pn; }
        else if (i == nm && cc < T * Sp) { const int tu = cc / Sp, j = cc - tu * Sp; pm = so.nM + tu / so.nN; pn = tu % so.nN; kt0 = 2 * ppair * j; nkt = (so.KT - kt0) < 2 * ppair ? (so.KT - kt0) : 2 * ppair; part = j; }
        else return false;
        int e = 0; if (tile_e) e = __builtin_amdgcn_readfirstlane(tile_e[pm]);
        u.lt = pm; if (tile_p) pm = __builtin_amdgcn_readfirstlane(tile_p[pm]);
        u.pm = pm; u.pn = pn; u.pnb = e * so.nN + pn; u.kt0 = kt0; u.nkt = nkt; u.part = part; return true;
    }
    __device__ __forceinline__ void a_ready(const Unit&) const {}
    __device__ __forceinline__ void done(const Unit&) const {}
};

__device__ __forceinline__ unsigned cvt_pk_bf16(float lo, float hi) { unsigned r; asm volatile("v_cvt_pk_bf16_f32 %0, %1, %2" : "=v"(r) : "v"(lo), "v"(hi)); return r; }

struct EpiBf16 {
    static constexpr bool PERM = true, AFTER_DRAIN = false;
    bf16_t* O; int ldc; float scale;
    __device__ __forceinline__ void operator()(const f32x4 (&acc)[2][2][4][2], const Unit& u, int wr, int wc, int fr, int fq) const {
        const int row0 = u.pm * BM + wr * 64 + fr; const int col0 = u.pn * BM + wc * 32 + 8 * fq;
#pragma unroll
        for (int ai = 0; ai < 2; ++ai)
#pragma unroll
            for (int m = 0; m < 4; ++m) { bf16_t* rowp = O + (size_t)(row0 + ai * HALF + m * 16) * ldc + col0;
#pragma unroll
                for (int bj = 0; bj < 2; ++bj) { const f32x4 v0 = acc[ai][bj][m][0] * scale, v1 = acc[ai][bj][m][1] * scale;
                    u32x4 w; w.x = cvt_pk_bf16(v0[0], v0[1]); w.y = cvt_pk_bf16(v0[2], v0[3]); w.z = cvt_pk_bf16(v1[0], v1[1]); w.w = cvt_pk_bf16(v1[2], v1[3]);
                    *(u32x4*)(rowp + bj * HALF) = w; } }
    }
};
struct EpiSlots {
    static constexpr bool PERM = true, AFTER_DRAIN = false;
    bf16_t* QKV; int NG; int kvr;
    __device__ __forceinline__ void operator()(const f32x4 (&acc)[2][2][4][2], const Unit& u, int wr, int wc, int fr, int fq) const {
        const int prow = u.pm * BM; const bool lat = prow < 8192; const int b = lat ? (prow >> 12) : ((prow - 8192) >> 8); const int pos0 = lat ? (prow & 4095) : 4096;
        const int rl0 = wr * 64 + fr;
#pragma unroll
        for (int bj = 0; bj < 2; ++bj) { bf16_t* gbase = QKV + ((size_t)(b * NG + 2 * u.pn + bj) * kvr + pos0 + rl0) * 128 + wc * 32 + 8 * fq;
#pragma unroll
            for (int ai = 0; ai < 2; ++ai)
#pragma unroll
                for (int m = 0; m < 4; ++m) { const f32x4 v0 = acc[ai][bj][m][0], v1 = acc[ai][bj][m][1];
                    u32x4 w; w.x = cvt_pk_bf16(v0[0], v0[1]); w.y = cvt_pk_bf16(v0[2], v0[3]); w.z = cvt_pk_bf16(v1[0], v1[1]); w.w = cvt_pk_bf16(v1[2], v1[3]);
                    *(u32x4*)(gbase + (size_t)(ai * HALF + m * 16) * 128) = w; } }
    }
};
struct EpiSlotsNR {
    static constexpr bool PERM = true, AFTER_DRAIN = false;
    bf16_t* QKV; int NG, kvr, cfg; const float* gtab; const float* cst;
    PG8_LAS float* xl;
    __device__ __forceinline__ void operator()(const f32x4 (&acc)[2][2][4][2], const Unit& u, int wr, int wc, int fr, int fq) const {
        const int prow = u.pm * BM; const bool lat = prow < 8192; const int b = lat ? (prow >> 12) : ((prow - 8192) >> 8); const int pos0 = lat ? (prow & 4095) : 4096;
        const int rl0 = wr * 64 + fr, g0 = 2 * u.pn;
        const bool isv = cfg == 0 ? (g0 == 10 || g0 >= 28) : (g0 >= 20);
        if (isv) {
#pragma unroll
            for (int bj = 0; bj < 2; ++bj) { bf16_t* gbase = QKV + ((size_t)(b * NG + g0 + bj) * kvr + pos0 + rl0) * 128 + wc * 32 + 8 * fq;
#pragma unroll
                for (int ai = 0; ai < 2; ++ai)
#pragma unroll
                    for (int m = 0; m < 4; ++m) { const f32x4 v0 = acc[ai][bj][m][0], v1 = acc[ai][bj][m][1];
                        u32x4 w; w.x = cvt_pk_bf16(v0[0], v0[1]); w.y = cvt_pk_bf16(v0[2], v0[3]); w.z = cvt_pk_bf16(v1[0], v1[1]); w.w = cvt_pk_bf16(v1[2], v1[3]);
                        *(u32x4*)(gbase + (size_t)(ai * HALF + m * 16) * 128) = w; } }
            return;
        }
        const int gi = cfg == 0 ? (g0 < 8 ? 0 : (g0 < 10 ? 1 : (g0 < 20 ? 2 : 3))) : (g0 < 16 ? 4 : 5); const float* gp = gtab + gi * 128;
#pragma unroll
        for (int bj = 0; bj < 2; ++bj)
#pragma unroll
            for (int ai = 0; ai < 2; ++ai)
#pragma unroll
                for (int m = 0; m < 4; ++m) { const f32x4 a = acc[ai][bj][m][0], c = acc[ai][bj][m][1];
                    float s = ((a[0] * a[0] + a[1] * a[1]) + (a[2] * a[2] + a[3] * a[3])) + ((c[0] * c[0] + c[1] * c[1]) + (c[2] * c[2] + c[3] * c[3]));
                    s += __shfl_xor(s, 16); s += __shfl_xor(s, 32);
                    if (fq == 0) xl[((bj * 256 + ai * HALF + rl0 + m * 16) << 2) + wc] = s; }
        asm volatile("s_waitcnt lgkmcnt(0)" ::: "memory"); __builtin_amdgcn_s_barrier(); asm volatile("" ::: "memory");
        const int pi = wc >> 1, idx0 = 16 * (wc & 1) + 4 * fq;
        const f32x4 ga = *(const f32x4*)(gp + (2 * pi) * 32 + idx0), gb = *(const f32x4*)(gp + (2 * pi + 1) * 32 + idx0);
#pragma unroll
        for (int ai = 0; ai < 2; ++ai)
#pragma unroll
            for (int m = 0; m < 4; ++m) { const int rl = rl0 + ai * HALF + m * 16; const int pos = pos0 + rl; const int pp = pi ? (pos & 63) : (pos >> 6);
                f32x4 c4 = {1.f, 1.f, 1.f, 1.f}, s4 = {0.f, 0.f, 0.f, 0.f};
                if (lat) { c4 = *(const f32x4*)(cst + pp * 32 + idx0); s4 = *(const f32x4*)(cst + 2048 + pp * 32 + idx0); }
#pragma unroll
                for (int bj = 0; bj < 2; ++bj) { const f32x4 t = *(const PG8_LAS f32x4*)(xl + ((bj * 256 + rl) << 2));
                    const float rs = __builtin_amdgcn_rsqf(((t[0] + t[1]) + (t[2] + t[3])) * (1.0f / 128.0f) + 1e-6f);
                    const f32x4 v0 = acc[ai][bj][m][0] * rs * ga, v1 = acc[ai][bj][m][1] * rs * gb;
                    const f32x4 o0 = v0 * c4 - v1 * s4, o1 = v1 * c4 + v0 * s4;
                    bf16_t* dst = QKV + ((size_t)(b * NG + g0 + bj) * kvr + pos) * 128 + (2 * pi) * 32 + idx0;
                    typedef unsigned u32x2 __attribute__((ext_vector_type(2)));
                    u32x2 w0, w1; w0.x = cvt_pk_bf16(o0[0], o0[1]); w0.y = cvt_pk_bf16(o0[2], o0[3]); w1.x = cvt_pk_bf16(o1[0], o1[1]); w1.y = cvt_pk_bf16(o1[2], o1[3]);
                    *(u32x2*)dst = w0; *(u32x2*)(dst + 32) = w1; } }
    }
};
__device__ __forceinline__ float clamp448(float x) { return __builtin_amdgcn_fmed3f(x, -448.f, 448.f); }
__device__ __forceinline__ unsigned pk4_fp8(float a, float b, float c, float d) {
    int w = __builtin_amdgcn_cvt_pk_fp8_f32(clamp448(a), clamp448(b), 0, false); w = __builtin_amdgcn_cvt_pk_fp8_f32(clamp448(c), clamp448(d), w, true); return (unsigned)w; }
__device__ __forceinline__ float silu_mul(float g, float u) { return g * u * __builtin_amdgcn_rcpf(1.0f + __builtin_amdgcn_exp2f(-1.4426950408889634f * g)); }
__device__ __forceinline__ f32x4 silu_mul4(f32x4 g, f32x4 u, float nls  , float s2  ) {
    const f32x4 t = g * nls;
    f32x4 e; e[0] = __builtin_amdgcn_exp2f(t[0]); e[1] = __builtin_amdgcn_exp2f(t[1]); e[2] = __builtin_amdgcn_exp2f(t[2]); e[3] = __builtin_amdgcn_exp2f(t[3]);
    const f32x4 d = e + 1.0f;
    f32x4 r; r[0] = __builtin_amdgcn_rcpf(d[0]); r[1] = __builtin_amdgcn_rcpf(d[1]); r[2] = __builtin_amdgcn_rcpf(d[2]); r[3] = __builtin_amdgcn_rcpf(d[3]);
    return (g * u) * (r * s2);
}
template <bool OUT8> struct EpiSwigluT {
    static constexpr bool PERM = true, AFTER_DRAIN = false;
    void* O; int ldc; float scale;
    __device__ __forceinline__ void operator()(const f32x4 (&acc)[2][2][4][2], const Unit& u, int wr, int wc, int fr, int fq) const {
        const int row0 = u.pm * BM + wr * 64 + fr; const int col0 = u.pn * HALF + wc * 32 + 8 * fq;
        const float nls = -1.4426950408889634f * scale, s2 = scale * scale;
#pragma unroll
        for (int ai = 0; ai < 2; ++ai)
#pragma unroll
            for (int m = 0; m < 4; ++m) { const size_t eo = (size_t)(row0 + ai * HALF + m * 16) * ldc + col0;
                const f32x4 a = silu_mul4(acc[ai][0][m][0], acc[ai][1][m][0], nls, s2), b = silu_mul4(acc[ai][0][m][1], acc[ai][1][m][1], nls, s2);
                if constexpr (OUT8) { typedef unsigned u32x2 __attribute__((ext_vector_type(2))); u32x2 w; w.x = pk4_fp8(a[0], a[1], a[2], a[3]); w.y = pk4_fp8(b[0], b[1], b[2], b[3]); *(u32x2*)((unsigned char*)O + eo) = w; }
                else { u32x4 w; w.x = cvt_pk_bf16(a[0], a[1]); w.y = cvt_pk_bf16(a[2], a[3]); w.z = cvt_pk_bf16(b[0], b[1]); w.w = cvt_pk_bf16(b[2], b[3]); *(u32x4*)((bf16_t*)O + eo) = w; } }
    }
};
typedef EpiSwigluT<false> EpiSwiglu; typedef EpiSwigluT<true> EpiSwiglu8;
struct EpiRes {
    static constexpr bool PERM = false, AFTER_DRAIN = false;
    const float* base_lat; const float* base_ctx; float* out; int ldc; const float* gate; int gate_stride;
    float* part; int part_row0, part_rows; float scale;
    __device__ __forceinline__ void operator()(const f32x4 (&acc)[2][2][4][2], const Unit& u, int wr, int wc, int fr, int fq) const {
        if (u.part >= 0) {
            float* pp = part + ((long)u.part * part_rows + (u.lt * BM - part_row0)) * (long)ldc; const int rl0 = wr * 64 + fr, col0 = u.pn * BM + wc * 32 + 4 * fq;
#pragma unroll
            for (int ai = 0; ai < 2; ++ai)
#pragma unroll
                for (int m = 0; m < 4; ++m) { const size_t ro = (size_t)(rl0 + ai * HALF + m * 16) * ldc;
#pragma unroll
                    for (int bj = 0; bj < 2; ++bj)
#pragma unroll
                        for (int n = 0; n < 2; ++n) *(f32x4*)(pp + ro + col0 + bj * HALF + 16 * n) = acc[ai][bj][m][n] * scale; }
            return;
        }
        const int prow = u.pm * BM; const int cond = prow < 4096 ? 0 : (prow < 8192 ? 1 : 2);
        const float* bp = prow < 8192 ? base_lat + (size_t)prow * ldc : base_ctx + (size_t)(prow - 8192) * ldc;
        float* op = out + (size_t)prow * ldc; const float* gp = gate + (size_t)cond * gate_stride;
        const int rl0 = wr * 64 + fr, col0 = u.pn * BM + wc * 32 + 4 * fq;
        f32x4 gv[2][2];
#pragma unroll
        for (int bj = 0; bj < 2; ++bj)
#pragma unroll
            for (int n = 0; n < 2; ++n) gv[bj][n] = *(const f32x4*)(gp + col0 + bj * HALF + 16 * n) * scale;
#pragma unroll
        for (int ai = 0; ai < 2; ++ai)
#pragma unroll
            for (int m = 0; m < 4; ++m) { const size_t ro = (size_t)(rl0 + ai * HALF + m * 16) * ldc;
#pragma unroll
                for (int bj = 0; bj < 2; ++bj)
#pragma unroll
                    for (int n = 0; n < 2; ++n) { const int col = col0 + bj * HALF + 16 * n; const f32x4 b = *(const f32x4*)(bp + ro + col);
                        *(f32x4*)(op + ro + col) = b + gv[bj][n] * acc[ai][bj][m][n]; } }
    }
};
struct EpiRowScale {
    static constexpr bool PERM = true, AFTER_DRAIN = false;
    bf16_t* out; int ldc; const float* rs; float* part; int part_row0, part_rows; float scale;
    __device__ __forceinline__ void operator()(const f32x4 (&acc)[2][2][4][2], const Unit& u, int wr, int wc, int fr, int fq) const {
        const int row0 = u.pm * BM + wr * 64 + fr, col0 = u.pn * BM + wc * 32 + 8 * fq;
#pragma unroll
        for (int ai = 0; ai < 2; ++ai)
#pragma unroll
            for (int m = 0; m < 4; ++m) { const int row = row0 + ai * HALF + m * 16; const float s = rs[row] * scale;
                if (u.part >= 0) { float* rp = part + ((long)u.part * part_rows - part_row0 + (row - u.pm * BM) + u.lt * BM) * (long)ldc + col0;
#pragma unroll
                    for (int bj = 0; bj < 2; ++bj) { *(f32x4*)(rp + bj * HALF) = acc[ai][bj][m][0] * s; *(f32x4*)(rp + bj * HALF + 4) = acc[ai][bj][m][1] * s; } }
                else { bf16_t* rp = out + (size_t)row * ldc + col0;
#pragma unroll
                    for (int bj = 0; bj < 2; ++bj) { const f32x4 v0 = acc[ai][bj][m][0] * s, v1 = acc[ai][bj][m][1] * s;
                        u32x4 w; w.x = cvt_pk_bf16(v0[0], v0[1]); w.y = cvt_pk_bf16(v0[2], v0[3]); w.z = cvt_pk_bf16(v1[0], v1[1]); w.w = cvt_pk_bf16(v1[2], v1[3]);
                        *(u32x4*)(rp + bj * HALF) = w; } } }
    }
};

typedef int v8i __attribute__((ext_vector_type(8)));
__device__ __forceinline__ v8i cat8(bf16x8 a, bf16x8 b) { struct P { bf16x8 a, b; } p{a, b}; return __builtin_bit_cast(v8i, p); }
template <class Epi, class Sched, bool ALIGN_EPI = false, bool SP2 = false, bool FP8 = false>
__device__ __forceinline__ void gemm_phase(PG8_LAS unsigned char* lds, const Gemm g, const Sched& S, const Epi& E) {
    int tid = threadIdx.x; asm volatile("" : "+v"(tid));
    const int wid = __builtin_amdgcn_readfirstlane(tid >> 6), lane = tid & 63, wr = wid >> 2, wc = wid & 3, fr = lane & 15, fq = lane >> 4;
    const int K = g.K; const int pitch = FP8 ? K : K * 2;
    unsigned voffA[2], voffB[2];
#pragma unroll
    for (int i = 0; i < 2; ++i) { int R, C; stage_rc(tid * 16 + i * 8192, R, C); const int Rb = Epi::PERM ? ((R & ~31) + perm32(R & 31)) : R;
        voffA[i] = (unsigned)(R * pitch + C * 2); voffB[i] = (unsigned)(Rb * pitch + C * 2); }
    const size_t kstep = (size_t)(BK * 2);
    const size_t hstep = (size_t)HALF * pitch;
    const size_t tstep = 2 * hstep;
    const unsigned ldsw = (unsigned)wid * 1024u;
    const int aoff = lds_byte(wr * 64 + fr, fq * 8), boff = lds_byte(wc * 32 + fr, fq * 8);
#define PG8_SA(b, h) (((b) * 2 + (h)) * HTB)
#define PG8_SB(b, h) ((4 + (b) * 2 + (h)) * HTB)
#define PG8_STAGE(bufoff, gbase, voff) do { _Pragma("unroll") for (int _i = 0; _i < 2; ++_i) \
        __builtin_amdgcn_global_load_lds((const unsigned*)((const char*)(gbase) + (voff)[_i]), (PG8_LAS unsigned*)(lds + (bufoff) + ldsw + _i * 8192), 16, 0, 0); } while (0)
#define PG8_LDA(dst, b, h) do { _Pragma("unroll") for (int m = 0; m < 4; ++m) _Pragma("unroll") for (int k = 0; k < 2; ++k) dst[m][k] = *(const PG8_LAS bf16x8*)(lds + PG8_SA(b, h) + aoff + m * 2048 + k * 1024); } while (0)
#define PG8_LDB(dst, b, h) do { _Pragma("unroll") for (int n = 0; n < 2; ++n) _Pragma("unroll") for (int k = 0; k < 2; ++k) dst[n][k] = *(const PG8_LAS bf16x8*)(lds + PG8_SB(b, h) + boff + n * 2048 + k * 1024); } while (0)
#define PG8_MMA(ai, bj, At, Bt) do { __builtin_amdgcn_s_setprio(1); if constexpr (FP8) { _Pragma("unroll") for (int m = 0; m < 4; ++m) _Pragma("unroll") for (int n = 0; n < 2; ++n) \
        asm volatile("v_mfma_f32_16x16x128_f8f6f4 %0, %1, %2, %0" : "+v"(acc[ai][bj][m][n]) : "v"(cat8(Bt[n][0], Bt[n][1])), "v"(cat8(At[m][0], At[m][1]))); } \
      else { _Pragma("unroll") for (int m = 0; m < 4; ++m) _Pragma("unroll") for (int n = 0; n < 2; ++n) _Pragma("unroll") for (int k = 0; k < 2; ++k) \
        acc[ai][bj][m][n] = __builtin_amdgcn_mfma_f32_16x16x32_bf16(Bt[n][k], At[m][k], acc[ai][bj][m][n], 0, 0, 0); } __builtin_amdgcn_s_setprio(0); } while (0)
#define PG8_WAIT_V(n) asm volatile("s_waitcnt vmcnt(" #n ")" ::: "memory")
#define PG8_WAIT_L(n) asm volatile("s_waitcnt lgkmcnt(" #n ")" ::: "memory")
#define PG8_BAR __builtin_amdgcn_s_barrier()
#define PG8_SCHED __builtin_amdgcn_sched_barrier(0)
    Unit cur, nxt; int ui = 0;
    if (!S.next(0, cur)) return;
    f32x4 acc[2][2][4][2];
#pragma unroll
    for (int a = 0; a < 2; ++a)
#pragma unroll
        for (int b = 0; b < 2; ++b)
#pragma unroll
            for (int m = 0; m < 4; ++m)
#pragma unroll
                for (int n = 0; n < 2; ++n) acc[a][b][m][n] = (f32x4){0.f, 0.f, 0.f, 0.f};
    bf16x8 At[4][2], B0[2][2], B1[2][2];
    const char* cA = (const char*)g.A + (size_t)cur.pm * tstep + (size_t)cur.kt0 * kstep; const char* cB = (const char*)g.Bt + (size_t)cur.pnb * tstep + (size_t)cur.kt0 * kstep;
    S.a_ready(cur);
    if constexpr (SP2) {
        PG8_STAGE(PG8_SB(0, 0), cB, voffB); PG8_STAGE(PG8_SB(0, 1), cB + hstep, voffB); PG8_STAGE(PG8_SA(0, 0), cA, voffA); PG8_STAGE(PG8_SA(0, 1), cA + hstep, voffA);
        if (wr == 1) PG8_BAR;
        PG8_WAIT_V(2); PG8_BAR;
        PG8_STAGE(PG8_SB(1, 0), cB + kstep, voffB); PG8_STAGE(PG8_SA(1, 0), cA + kstep, voffA); PG8_STAGE(PG8_SB(1, 1), cB + hstep + kstep, voffB);
        PG8_WAIT_V(6); PG8_BAR;
    } else {
        PG8_STAGE(PG8_SB(0, 0), cB, voffB); PG8_STAGE(PG8_SA(0, 0), cA, voffA); PG8_STAGE(PG8_SB(0, 1), cB + hstep, voffB); PG8_STAGE(PG8_SA(0, 1), cA + hstep, voffA);
        if (wr == 1) PG8_BAR;
        PG8_WAIT_V(4); PG8_BAR;
        PG8_STAGE(PG8_SB(1, 0), cB + kstep, voffB); PG8_STAGE(PG8_SA(1, 0), cA + kstep, voffA); PG8_STAGE(PG8_SB(1, 1), cB + hstep + kstep, voffB);
        PG8_WAIT_V(6); PG8_BAR;
    }
    for (;;) {
        const bool has_next = S.next(ui + 1, nxt);
        const char* nA = has_next ? (const char*)g.A + (size_t)nxt.pm * tstep + (size_t)nxt.kt0 * kstep : cA; const char* nB = has_next ? (const char*)g.Bt + (size_t)nxt.pnb * tstep + (size_t)nxt.kt0 * kstep : cB;
        const int nt = cur.nkt;
        for (int t = 0; t < nt; t += 2) {
            const bool last = (t == nt - 2);
            const char* a1 = cA + (size_t)(t + 1) * kstep;
            const char* a2 = last ? nA : cA + (size_t)(t + 2) * kstep; const char* b2 = last ? nB : cB + (size_t)(t + 2) * kstep;
            const char* a3 = a2 + kstep; const char* b3 = b2 + kstep;
            if (last && has_next) S.a_ready(nxt);
            if constexpr (SP2) {
            PG8_LDB(B0, 0, 0); PG8_LDB(B1, 0, 1); PG8_SCHED; PG8_LDA(At, 0, 0); PG8_STAGE(PG8_SA(1, 1), a1 + hstep, voffA);
            PG8_WAIT_V(8); PG8_WAIT_L(0); PG8_BAR; PG8_MMA(0, 0, At, B0); PG8_MMA(0, 1, At, B1); PG8_BAR; PG8_SCHED;
            PG8_LDA(At, 0, 1); PG8_STAGE(PG8_SB(0, 0), b2, voffB); PG8_STAGE(PG8_SB(0, 1), b2 + hstep, voffB); PG8_STAGE(PG8_SA(0, 0), a2, voffA);
            PG8_WAIT_V(8); PG8_WAIT_L(0); PG8_BAR; PG8_MMA(1, 0, At, B0); PG8_MMA(1, 1, At, B1); PG8_BAR; PG8_SCHED;
            PG8_LDB(B0, 1, 0); PG8_LDB(B1, 1, 1); PG8_SCHED; PG8_LDA(At, 1, 0); PG8_STAGE(PG8_SA(0, 1), a2 + hstep, voffA);
            PG8_WAIT_V(8); PG8_WAIT_L(0); PG8_BAR; PG8_MMA(0, 0, At, B0); PG8_MMA(0, 1, At, B1); PG8_BAR; PG8_SCHED;
            PG8_LDA(At, 1, 1); PG8_STAGE(PG8_SB(1, 0), b3, voffB); PG8_STAGE(PG8_SB(1, 1), b3 + hstep, voffB); PG8_STAGE(PG8_SA(1, 0), a3, voffA);
            PG8_WAIT_V(8); PG8_WAIT_L(0); PG8_BAR; PG8_MMA(1, 0, At, B0); PG8_MMA(1, 1, At, B1); PG8_BAR; PG8_SCHED;
            } else {
            PG8_LDB(B0, 0, 0); PG8_SCHED; PG8_LDA(At, 0, 0); PG8_STAGE(PG8_SA(1, 1), a1 + hstep, voffA);
            PG8_WAIT_L(8); PG8_BAR; PG8_WAIT_L(0); PG8_MMA(0, 0, At, B0); PG8_BAR; PG8_SCHED;
            PG8_LDB(B1, 0, 1); PG8_STAGE(PG8_SB(0, 0), b2, voffB);
            PG8_BAR; PG8_WAIT_L(0); PG8_MMA(0, 1, At, B1); PG8_BAR;
            PG8_LDA(At, 0, 1); PG8_STAGE(PG8_SA(0, 0), a2, voffA);
            PG8_BAR; PG8_WAIT_L(0); PG8_MMA(1, 0, At, B0); PG8_BAR; PG8_SCHED;
            PG8_STAGE(PG8_SB(0, 1), b2 + hstep, voffB);
            PG8_WAIT_V(6); PG8_BAR; PG8_MMA(1, 1, At, B1); PG8_BAR;
            PG8_LDB(B0, 1, 0); PG8_SCHED; PG8_LDA(At, 1, 0); PG8_STAGE(PG8_SA(0, 1), a2 + hstep, voffA);
            PG8_WAIT_L(8); PG8_BAR; PG8_WAIT_L(0); PG8_MMA(0, 0, At, B0); PG8_BAR; PG8_SCHED;
            PG8_LDB(B1, 1, 1); PG8_STAGE(PG8_SB(1, 0), b3, voffB);
            PG8_BAR; PG8_WAIT_L(0); PG8_MMA(0, 1, At, B1); PG8_BAR;
            PG8_LDA(At, 1, 1); PG8_STAGE(PG8_SA(1, 0), a3, voffA);
            PG8_BAR; PG8_WAIT_L(0); PG8_MMA(1, 0, At, B0); PG8_BAR; PG8_SCHED;
            PG8_STAGE(PG8_SB(1, 1), b3 + hstep, voffB);
            PG8_WAIT_V(6); PG8_BAR; PG8_MMA(1, 1, At, B1); PG8_BAR;
            }
        }
        if constexpr (FP8) asm volatile("s_nop 15\n\ts_nop 15" ::: "memory");
        if constexpr (ALIGN_EPI) { if (wr == 0) PG8_BAR; }
        if constexpr (!Epi::AFTER_DRAIN) { E(acc, cur, wr, wc, fr, fq); S.done(cur); }
        if (!has_next) break;
#pragma unroll
        for (int a = 0; a < 2; ++a)
#pragma unroll
            for (int b = 0; b < 2; ++b)
#pragma unroll
                for (int m = 0; m < 4; ++m)
#pragma unroll
                    for (int n = 0; n < 2; ++n) acc[a][b][m][n] = (f32x4){0.f, 0.f, 0.f, 0.f};
        cur = nxt; cA = nA; cB = nB; ++ui;
        if constexpr (ALIGN_EPI) { if (wr == 1) PG8_BAR; }
    }
    PG8_WAIT_V(0);
    if constexpr (!ALIGN_EPI) { if (wr == 0) PG8_BAR; }
    PG8_BAR;
    if constexpr (Epi::AFTER_DRAIN) { E.fused(acc, cur, wr, wc, fr, fq, lds, wid, lane); S.done(cur); }
#undef PG8_SA
#undef PG8_SB
#undef PG8_STAGE
#undef PG8_LDA
#undef PG8_LDB
#undef PG8_MMA
#undef PG8_WAIT_V
#undef PG8_WAIT_L
#undef PG8_BAR
#undef PG8_SCHED
}
}


namespace att {
using bf16 = __hip_bfloat16;
constexpr int   D = 128, NW = 8, QBLK = 32, KVBLK = 64;
constexpr float SCALE = 0.088388347648318440f;
constexpr float THR = 8.f;
constexpr int LDQ = 128, LDK = 128;
constexpr size_t SHM_V = KVBLK * D * 2, SHM_K = KVBLK * D * 2, SHM_ATTN = 2 * SHM_V + 2 * SHM_K + NW * 64 * 4;
using bf16x8 = __attribute__((ext_vector_type(8))) short;
using s16x4  = __attribute__((ext_vector_type(4))) short;
using f32x16 = __attribute__((ext_vector_type(16))) float;
using u32x4  = __attribute__((ext_vector_type(4))) unsigned;
#define KSWZ(row, colB) ((row) * 256 + ((colB) ^ (((row) & 7) << 4)))
#define SBAR() __builtin_amdgcn_sched_barrier(0)
__device__ __forceinline__ int crow(int r, int hi) { return (r & 3) + 8 * (r >> 2) + 4 * hi; }
__device__ __forceinline__ unsigned cvtpk(float lo, float hi) {
  unsigned r; asm volatile("v_cvt_pk_bf16_f32 %0, %1, %2" : "=v"(r) : "v"(lo), "v"(hi)); return r;
}
__device__ __forceinline__ void partialSM(f32x16& p0, f32x16& p1, float& m_reg, float& mn, float& alpha) {
  constexpr float C = SCALE * 1.4426950408889634f;
  float pmax = p0[0];
#pragma unroll
  for (int r = 1; r < 16; ++r) pmax = fmaxf(pmax, p0[r]);
#pragma unroll
  for (int r = 0; r < 16; ++r) pmax = fmaxf(pmax, p1[r]);
  { auto rr = __builtin_amdgcn_permlane32_swap(__float_as_uint(pmax), __float_as_uint(pmax), false, false);
    pmax = fmaxf(__uint_as_float(rr[0]), __uint_as_float(rr[1])); }
  if (__builtin_expect(__all(pmax - m_reg <= THR / SCALE), 1)) { mn = m_reg; alpha = 1.f; }
  else { mn = fmaxf(m_reg, pmax); alpha = __builtin_amdgcn_exp2f((m_reg - mn) * C); m_reg = mn; }
  float mnC = -mn * C;
#pragma unroll
  for (int r = 0; r < 16; ++r) p0[r] = fmaf(p0[r], C, mnC);
#pragma unroll
  for (int r = 0; r < 16; ++r) p1[r] = fmaf(p1[r], C, mnC);
#pragma unroll
  for (int r = 0; r < 16; ++r) p0[r] = __builtin_amdgcn_exp2f(p0[r]);
}
__device__ __forceinline__ void finishSM(f32x16& p0, f32x16& p1, float alpha, float& l_reg, bf16x8& pa0, bf16x8& pa1, bf16x8& pa2, bf16x8& pa3) {
#pragma unroll
  for (int r = 0; r < 16; ++r) p1[r] = __builtin_amdgcn_exp2f(p1[r]);
  float ps = 0;
#pragma unroll
  for (int r = 0; r < 16; ++r) ps += p0[r];
#pragma unroll
  for (int r = 0; r < 16; ++r) ps += p1[r];
  { auto rr = __builtin_amdgcn_permlane32_swap(__float_as_uint(ps), __float_as_uint(ps), false, false);
    ps = __uint_as_float(rr[0]) + __uint_as_float(rr[1]); }
  l_reg = l_reg * alpha + ps;
#define PK4(P, BASE, OUT) do { unsigned a0 = cvtpk(P[BASE + 0], P[BASE + 1]), a1 = cvtpk(P[BASE + 2], P[BASE + 3]);   \
    unsigned b0 = cvtpk(P[BASE + 4], P[BASE + 5]), b1 = cvtpk(P[BASE + 6], P[BASE + 7]);                              \
    auto r0 = __builtin_amdgcn_permlane32_swap(a0, b0, false, false); auto r1 = __builtin_amdgcn_permlane32_swap(a1, b1, false, false); \
    u32x4 w = {r0[0], r1[0], r0[1], r1[1]}; OUT = *reinterpret_cast<bf16x8*>(&w); } while (0)
  PK4(p0, 0, pa0); PK4(p0, 8, pa1); PK4(p1, 0, pa2); PK4(p1, 8, pa3);
#undef PK4
}
__device__ __forceinline__ void qkt(f32x16& p0, f32x16& p1, const bf16* Ks, const bf16x8* qr, int r32, int hi) {
  p0 = f32x16{}; p1 = f32x16{};
#pragma unroll
  for (int d0 = 0; d0 < 8; ++d0) { int cb = (d0 * 16 + hi * 8) * 2;
    bf16x8 b0 = *reinterpret_cast<const bf16x8*>((const char*)Ks + KSWZ(r32, cb));
    bf16x8 b1 = *reinterpret_cast<const bf16x8*>((const char*)Ks + KSWZ(32 + r32, cb));
    p0 = __builtin_amdgcn_mfma_f32_32x32x16_bf16(b0, qr[d0], p0, 0, 0, 0);
    p1 = __builtin_amdgcn_mfma_f32_32x32x16_bf16(b1, qr[d0], p1, 0, 0, 0); }
}
__device__ __forceinline__ void maskt(f32x16& p0, f32x16& p1, int kbase, int qpos, int hi) {
#pragma unroll
  for (int r = 0; r < 16; ++r) { const int d0 = qpos - (kbase + crow(r, hi)); const int d1 = d0 - 32;
    if (d0 > 128 || d0 < -128) p0[r] = -1e30f;
    if (d1 > 128 || d1 < -128) p1[r] = -1e30f; }
}
__device__ __forceinline__ int v_st(int k, int c) { const int kk = (k & ~0xC) | ((k & 4) << 1) | ((k & 8) >> 1); return ((kk >> 3) * 4 + (c >> 5)) * 512 + ((kk & 7) * 32 + (c & 31)) * 2; }
__device__ __forceinline__ int v_rd_base(int lane) { return ((lane & 3) << 3) | (((lane >> 2) & 3) << 6) | (((lane >> 4) & 1) << 5) | (((lane >> 5) & 1) << 8); }
constexpr int v_rd_off(int d0, int ks, int half) { return d0 * 512 + ks * 4096 + half * 2048; }
template <int OFF> __device__ __forceinline__ s16x4 tr_read(int vb) {
  s16x4 r; asm volatile("ds_read_b64_tr_b16 %0, %1 offset:%2" : "=&v"(r) : "v"(vb), "i"(OFF) : "memory"); return r;
}
template <int D0> __device__ __forceinline__ void pv_one(f32x16& od, int vb, bf16x8 pa0, bf16x8 pa1, bf16x8 pa2, bf16x8 pa3) {
  const s16x4 l0 = tr_read<v_rd_off(D0, 0, 0)>(vb), h0 = tr_read<v_rd_off(D0, 0, 1)>(vb), l1 = tr_read<v_rd_off(D0, 1, 0)>(vb), h1 = tr_read<v_rd_off(D0, 1, 1)>(vb);
  const s16x4 l2 = tr_read<v_rd_off(D0, 2, 0)>(vb), h2 = tr_read<v_rd_off(D0, 2, 1)>(vb), l3 = tr_read<v_rd_off(D0, 3, 0)>(vb), h3 = tr_read<v_rd_off(D0, 3, 1)>(vb);
  asm volatile("s_waitcnt lgkmcnt(0)" ::: "memory"); SBAR();
#define PK(L, H) (bf16x8){L[0], L[1], L[2], L[3], H[0], H[1], H[2], H[3]}
  od = __builtin_amdgcn_mfma_f32_32x32x16_bf16(pa0, PK(l0, h0), od, 0, 0, 0);
  od = __builtin_amdgcn_mfma_f32_32x32x16_bf16(pa1, PK(l1, h1), od, 0, 0, 0);
  od = __builtin_amdgcn_mfma_f32_32x32x16_bf16(pa2, PK(l2, h2), od, 0, 0, 0);
  od = __builtin_amdgcn_mfma_f32_32x32x16_bf16(pa3, PK(l3, h3), od, 0, 0, 0);
#undef PK
}
__device__ __forceinline__ void pv_d0(f32x16* o, int vb, bf16x8 pa0, bf16x8 pa1, bf16x8 pa2, bf16x8 pa3) {
  pv_one<0>(o[0], vb, pa0, pa1, pa2, pa3); pv_one<1>(o[1], vb, pa0, pa1, pa2, pa3); pv_one<2>(o[2], vb, pa0, pa1, pa2, pa3); pv_one<3>(o[3], vb, pa0, pa1, pa2, pa3);
}

template <bool MASK, bool OUT_BF16>
__device__ __forceinline__ void attn_unit(const bf16* __restrict__ Qb, const bf16* __restrict__ Kh, const bf16* __restrict__ Vh, void* __restrict__ Ob, int ldo,
                                          int klo, int nt1, int NT, int qpos0, float m_init, float l_init, char* lds, const int tid  ) {
  const int wid = tid >> 6, lane = tid & 63, r32 = lane & 31, hi = lane >> 5;
  bf16* V_lds = (bf16*)lds; bf16* K_lds = (bf16*)(lds + 2 * SHM_V);
  float* ws = (float*)(lds + 2 * SHM_V + 2 * SHM_K) + wid * 64; float* li_l = ws; float* al_l = ws + 32;
  float m_reg = m_init, l_reg = l_init; f32x16 o[4] = {}; bf16x8 qr[8];
  const bf16* Qw = Qb + (long)(wid * QBLK + r32) * LDQ + hi * 8;
#pragma unroll
  for (int d0 = 0; d0 < 8; ++d0) qr[d0] = *reinterpret_cast<const bf16x8*>(Qw + d0 * 16);
  const int sr = tid >> 4, sc = (tid & 15) * 8, vst0 = v_st(sr, sc), vst1 = v_st(32 + sr, sc);
  const int vb0 = (int)(uintptr_t)V_lds + v_rd_base(lane);
  struct { bf16x8 vs0, vs1, ks0, ks1; } sr_[2];
#define KROW(t) ((t) < nt1 ? klo + (t) * KVBLK : 4096 + ((t) - nt1) * KVBLK)
#define SLOAD(i, t) do { const int k0_ = KROW(t); sr_[i].vs0 = *reinterpret_cast<const bf16x8*>(&Vh[(long)(k0_ + sr) * LDK + sc]); sr_[i].vs1 = *reinterpret_cast<const bf16x8*>(&Vh[(long)(k0_ + 32 + sr) * LDK + sc]); \
    sr_[i].ks0 = *reinterpret_cast<const bf16x8*>(&Kh[(long)(k0_ + sr) * LDK + sc]); sr_[i].ks1 = *reinterpret_cast<const bf16x8*>(&Kh[(long)(k0_ + 32 + sr) * LDK + sc]); } while (0)
#define SWRITE(b, i) do { *(bf16x8*)((char*)V_lds + (b) * SHM_V + vst0) = sr_[i].vs0;          \
    *(bf16x8*)((char*)V_lds + (b) * SHM_V + vst1) = sr_[i].vs1; int kc = sc * 2;               \
    *(bf16x8*)((char*)K_lds + (b) * SHM_K + KSWZ(sr, kc)) = sr_[i].ks0;                       \
    *(bf16x8*)((char*)K_lds + (b) * SHM_K + KSWZ(32 + sr, kc)) = sr_[i].ks1; } while (0)
#define SWAIT() asm volatile("s_waitcnt vmcnt(4)" ::: "memory")
#define RESC(a) do { if (__any((a) < 1.f)) { if (hi == 0) al_l[r32] = (a); asm volatile("s_waitcnt lgkmcnt(0)" ::: "memory"); \
    _Pragma("unroll") for (int d = 0; d < 4; ++d) _Pragma("unroll") for (int r = 0; r < 16; ++r) o[d][r] *= al_l[crow(r, hi)]; } } while (0)
#define MASKT(P0, P1, t) do { if (MASK) { if ((t) < nt1) maskt(P0, P1, klo + (t) * KVBLK, qpos0 + wid * QBLK + r32, hi); } } while (0)
  f32x16 pA0, pA1, pB0, pB1; float mnA, mnB, alA, alB; bf16x8 pa0, pa1, pa2, pa3;
  constexpr int SE = 0, SO = 1;
  SLOAD(SE, 0); asm volatile("s_waitcnt vmcnt(0)" ::: "memory"); SWRITE(0, SE); __syncthreads();
  qkt(pA0, pA1, K_lds, qr, r32, hi); MASKT(pA0, pA1, 0); partialSM(pA0, pA1, m_reg, mnA, alA);
  SLOAD(SO, 1); if (2 < NT) SLOAD(SE, 2);
  SWAIT(); SWRITE(1, SO); __syncthreads();
  for (int j = 1; j + 1 < NT; j += 2) {
    SBAR(); qkt(pB0, pB1, (bf16*)((char*)K_lds + SHM_K), qr, r32, hi);
    finishSM(pA0, pA1, alA, l_reg, pa0, pa1, pa2, pa3); SBAR();
    SLOAD(SO, j + 2); SBAR();
    pv_d0(o, vb0, pa0, pa1, pa2, pa3); MASKT(pB0, pB1, j); partialSM(pB0, pB1, m_reg, mnB, alB);
    __syncthreads(); SWAIT(); SWRITE(0, SE);
    RESC(alB); __syncthreads();
    SBAR(); qkt(pA0, pA1, K_lds, qr, r32, hi);
    finishSM(pB0, pB1, alB, l_reg, pa0, pa1, pa2, pa3); SBAR();
    if (j + 3 < NT) SLOAD(SE, j + 3); SBAR();
    pv_d0(o, vb0 + (int)SHM_V, pa0, pa1, pa2, pa3); MASKT(pA0, pA1, j + 1); partialSM(pA0, pA1, m_reg, mnA, alA);
    __syncthreads(); SWAIT(); SWRITE(1, SO);
    RESC(alA); __syncthreads();
  }
  SBAR(); qkt(pB0, pB1, (bf16*)((char*)K_lds + SHM_K), qr, r32, hi);
  finishSM(pA0, pA1, alA, l_reg, pa0, pa1, pa2, pa3); SBAR();
  pv_d0(o, vb0, pa0, pa1, pa2, pa3); MASKT(pB0, pB1, NT - 1); partialSM(pB0, pB1, m_reg, mnB, alB);
  __syncthreads(); RESC(alB);
  finishSM(pB0, pB1, alB, l_reg, pa0, pa1, pa2, pa3); SBAR();
  pv_d0(o, vb0 + (int)SHM_V, pa0, pa1, pa2, pa3);
  if (hi == 0) li_l[r32] = l_reg; asm volatile("s_waitcnt lgkmcnt(0)" ::: "memory");
  float rli[16];
#pragma unroll
  for (int r = 0; r < 16; ++r) rli[r] = __builtin_amdgcn_rcpf(li_l[crow(r, hi)]);
  if constexpr (OUT_BF16) {
    bf16* Ow = (bf16*)Ob + (long)(wid * QBLK) * ldo;
#pragma unroll
    for (int r = 0; r < 16; ++r) { int orow = crow(r, hi);
#pragma unroll
      for (int d0 = 0; d0 < 4; ++d0) { const float ov = o[d0][r] * rli[r]; ((unsigned short*)Ow)[(long)orow * ldo + d0 * 32 + r32] = (unsigned short)cvtpk(ov, ov); } }
  } else {
    float* Ow = (float*)Ob + (long)(wid * QBLK) * ldo;
#pragma unroll
    for (int r = 0; r < 16; ++r) { int orow = crow(r, hi);
#pragma unroll
      for (int d0 = 0; d0 < 4; ++d0) Ow[(long)orow * ldo + d0 * 32 + r32] = o[d0][r] * rli[r]; }
  }
  __syncthreads();
#undef KROW
#undef SLOAD
#undef SWRITE
#undef SWAIT
#undef RESC
#undef MASKT
}
#undef KSWZ
#undef SBAR
}

constexpr int NWAVES = 8;
constexpr int D = 2048, NB = 2, SEQ = 4096, CTXL = 256;
constexpr int TL = NB * SEQ, TC = NB * CTXL, MR = TL + TC;
constexpr int KVR = SEQ + CTXL;
constexpr int EVEN_IN = 4608, ODD_IN = 3072, DFF = 5632, DFE = 7168, NE = 8, MODW = 6 * D;
constexpr int NSLOT0 = 36, NSLOT1 = 24;
constexpr int MAXT = 72, RTILES = 32, RROWS = RTILES * 256, XROWS = NE * RROWS;
constexpr float EPS = 1e-6f;
constexpr float LAM_INIT = 0.2f;

constexpr size_t MiB = 1u << 20;
constexpr size_t WS_CTL = 0, CTL_ZERO_BYTES = 1 * MiB;
constexpr size_t WS_MODS = 1 * MiB;
constexpr size_t WS_LAM = WS_MODS + 512 * 1024;
constexpr size_t WS_ROUTE = 2 * MiB;
constexpr size_t RT_EID = WS_ROUTE, RT_GATE = WS_ROUTE + 64 * 1024, RT_POS = WS_ROUTE + 128 * 1024, RT_ROWTOK = WS_ROUTE + 192 * 1024, RT_ROWGATE = WS_ROUTE + 272 * 1024,
                 RT_TILE_E = WS_ROUTE + 352 * 1024, RT_NTILES = WS_ROUTE + 353 * 1024;
constexpr size_t WS_WT_EIN = 4 * MiB, WS_WT_EOUT = 22 * MiB, WS_WT_EF1 = 30 * MiB, WS_WT_EF2 = 74 * MiB, WS_WT_OIN = 96 * MiB, WS_WT_OOUT = 108 * MiB,
                 WS_WT_X1 = 116 * MiB, WS_WT_X2 = 564 * MiB;
constexpr size_t WS_H = 788 * MiB, WS_Z = 822 * MiB, WS_QKV = 900 * MiB, WS_PB = 978 * MiB, WS_OALL = 1046 * MiB, WS_X1 = 1080 * MiB, WS_X3 = 1148 * MiB,
                 WS_ACT = 1212 * MiB, WS_XS = 1306 * MiB, WS_ACT2 = 1434 * MiB, WS_YS = 1882 * MiB, WS_PART = 2138 * MiB, WS_RGATE = 2202 * MiB, WS_END = 2203 * MiB;
static_assert(WS_WT_EIN + (size_t)EVEN_IN * D * 2 <= WS_WT_EOUT && WS_WT_EF1 + (size_t)2 * DFF * D * 2 <= WS_WT_EF2 && WS_WT_EF2 + (size_t)D * DFF * 2 <= WS_WT_OIN &&
              WS_WT_OIN + (size_t)ODD_IN * D * 2 <= WS_WT_OOUT && WS_WT_X1 + (size_t)NE * 2 * DFE * D * 2 <= WS_WT_X2 && WS_WT_X2 + (size_t)NE * D * DFE * 2 <= WS_H &&
              WS_H + (size_t)MR * D * 2 <= WS_Z && WS_Z + (size_t)MR * EVEN_IN * 2 <= WS_QKV && WS_QKV + (size_t)NB * NSLOT0 * KVR * 128 * 2 <= WS_PB &&
              WS_PB + (size_t)NB * 16 * KVR * 128 * 4 <= WS_OALL && WS_OALL + (size_t)MR * D * 2 <= WS_X1 && WS_X1 + (size_t)MR * D * 4 <= WS_X3 && WS_X3 + (size_t)TL * D * 4 <= WS_ACT &&
              WS_ACT + (size_t)MR * DFF * 2 <= WS_XS && WS_XS + (size_t)XROWS * D <= WS_ACT2 && WS_ACT2 + (size_t)XROWS * DFE <= WS_YS && WS_YS + (size_t)XROWS * D * 2 <= WS_PART && WS_PART + 64 * MiB <= WS_RGATE && WS_RGATE + (size_t)XROWS * 4 <= WS_END, "d_ws map");
constexpr int CW_BAR = 4096, CW_WORK = 8192, CW_GCNT = 8192 + 256;
constexpr int TAB_OFF = 139520;

constexpr int RING_BYTES = 131072;
constexpr int LDSCTL_OFF = 143360, MISC_OFF = LDSCTL_OFF + 320;
constexpr int LDS_BYTES = 147456;

#define GAS __attribute__((address_space(1)))
#define LAS __attribute__((address_space(3)))
typedef unsigned short bf16;
typedef unsigned v4u __attribute__((ext_vector_type(4)));
typedef unsigned v2u __attribute__((ext_vector_type(2)));
typedef float f32x4 __attribute__((ext_vector_type(4)));
typedef GAS unsigned gu32;
#define RLX_AGENT __ATOMIC_RELAXED, __HIP_MEMORY_SCOPE_AGENT
#define LDS_WAIT() asm volatile("s_waitcnt lgkmcnt(0)" ::: "memory")
#define VM_WAIT() asm volatile("s_waitcnt vmcnt(0)" ::: "memory")
__device__ __forceinline__ unsigned f2bf(float f) { unsigned u = __builtin_bit_cast(unsigned, f); return (u + 0x7fffu + ((u >> 16) & 1u)) >> 16; }
__device__ __forceinline__ unsigned pk2(float lo, float hi) { return f2bf(lo) | (f2bf(hi) << 16); }
using pg8::pk4_fp8;
constexpr float W8_SCALE = 64.f;
__device__ __forceinline__ float bflo(unsigned w) { return __builtin_bit_cast(float, w << 16); }
__device__ __forceinline__ float bfhi(unsigned w) { return __builtin_bit_cast(float, w & 0xffff0000u); }
__device__ __forceinline__ float wave_sum(float v) {
#pragma unroll
    for (int o = 1; o < 64; o <<= 1) v += __shfl_xor(v, o);
    return v;
}

#define XB_TMO      128
#define XB_XCNT(j)  (256  + 64 * (j))
#define XB_XSUB(j)  (1280 + 64 * (j))
#define XB_XGEN(j)  (2304 + 64 * (j))
#define XB_TOP      3328
#define XB_TOPGEN   3392
#define XCD_BAR_WORDS 3456
#define XB_SPIN_CAP (1u << 18)

__device__ __forceinline__ unsigned xb_ld(unsigned* p)              { return __hip_atomic_load(p, __ATOMIC_RELAXED, __HIP_MEMORY_SCOPE_AGENT); }
__device__ __forceinline__ unsigned xb_add(unsigned* p, unsigned v) { return __hip_atomic_fetch_add(p, v, __ATOMIC_RELAXED, __HIP_MEMORY_SCOPE_AGENT); }
__device__ __forceinline__ unsigned xb_xcc_id() { return (unsigned)__builtin_amdgcn_s_getreg((3 << 11) | 20) & 0xFu; }
#define XB_SPIN(cond, bar) do { unsigned _sp = 0; while (cond) { __builtin_amdgcn_s_sleep(1); \
    if ((++_sp & 255u) == 0u) { if (xb_ld(&(bar)[XB_TMO])) break; if (_sp > XB_SPIN_CAP) { atomicAdd(&(bar)[XB_TMO], 1u); break; } } } } while (0)

struct XcdBarrier {
    unsigned* bar; unsigned x;
    volatile LAS unsigned* st;
};

__device__ __forceinline__ XcdBarrier xcd_barrier_post(unsigned* bar, volatile LAS unsigned* st) {
    XcdBarrier b; b.bar = bar; b.x = xb_xcc_id(); b.st = st;
    if (threadIdx.x == 0) (void)xb_add(&bar[XB_XCNT(b.x)], 1u);
    return b;
}
__device__ __forceinline__ void xcd_barrier_complete(unsigned* bar, unsigned x, unsigned& nloc, unsigned& nx) {
    const unsigned G = gridDim.x * gridDim.y * gridDim.z;
    unsigned sum, cnt, mine, sp = 0u;
    for (;;) {
        sum = 0u; cnt = 0u; mine = 0u;
#pragma unroll
        for (unsigned j = 0; j < 16; ++j) { const unsigned c = xb_ld(&bar[XB_XCNT(j)]); sum += c; cnt += (c > 0u) ? 1u : 0u; mine = (j == x) ? c : mine; }
        if (sum == G) break;
        __builtin_amdgcn_s_sleep(1);
        if ((++sp & 255u) == 0u) { if (xb_ld(&bar[XB_TMO])) break; if (sp > XB_SPIN_CAP) { atomicAdd(&bar[XB_TMO], 1u); break; } }
    }
    nloc = mine > 0u ? mine : 1u; nx = cnt > 0u ? cnt : 1u;
}

__device__ __forceinline__ void xcd_barrier(const XcdBarrier& b) {
    asm volatile("s_waitcnt vmcnt(0)" ::: "memory");
    __syncthreads();
    if (threadIdx.x == 0) {
        unsigned* bar = b.bar;
        __builtin_amdgcn_s_waitcnt(0);
        unsigned nloc = b.st[0], nx = b.st[1];
        if (nloc == 0u) { xcd_barrier_complete(bar, b.x, nloc, nx); b.st[0] = nloc; b.st[1] = nx; }
        const unsigned old = xb_add(&bar[XB_XSUB(b.x)], 1u);
        const unsigned gen = old / nloc;
        if (old + 1u == (gen + 1u) * nloc) {
            __builtin_amdgcn_fence(__ATOMIC_RELEASE, "agent");
            asm volatile("s_waitcnt vmcnt(0)" ::: "memory");
            const unsigned og = xb_add(&bar[XB_TOP], 1u);
            const unsigned tg = og / nx;
            if (og + 1u == (tg + 1u) * nx) xb_add(&bar[XB_TOPGEN], 1u);
            else XB_SPIN(xb_ld(&bar[XB_TOPGEN]) == tg, bar);
            __builtin_amdgcn_fence(__ATOMIC_ACQUIRE, "agent");
            xb_add(&bar[XB_XGEN(b.x)], 1u);
            asm volatile("s_waitcnt vmcnt(0)" ::: "memory");
        } else {
            XB_SPIN(xb_ld(&bar[XB_XGEN(b.x)]) == gen, bar);
            __builtin_amdgcn_fence(__ATOMIC_ACQUIRE, "agent");
            asm volatile("s_waitcnt vmcnt(0)" ::: "memory");
        }
    }
    __syncthreads();
}


struct Ctx {
    LAS unsigned char* lds; int tid, lane, wave, G, c, gw, NGW;
};

__device__ __forceinline__ void transpose_item(const float* __restrict__ W, int K, int N, bf16* __restrict__ WT, int q, int kind, LAS float* scr, int lane) {
    const int nblk = N >> 6, kb = q / nblk, nb = q - kb * nblk, k0 = kb * 64, n0 = nb * 64;
    int dest0 = n0;
    if (kind == 1) { const int hf = N >> 1; const int j = n0 < hf ? n0 : n0 - hf; dest0 = (j >> 7) * 256 + (j & 127) + (n0 < hf ? 0 : 128); }
    bool rperm = false; if (kind >= 2) { const int g = n0 >> 7; rperm = kind == 2 ? !(g == 10 || g == 11 || g >= 28) : (g < 20); }
    const int l16 = lane & 15, kq = lane >> 4;
    f32x4 v[16];
#pragma unroll
    for (int i = 0; i < 16; ++i) v[i] = __builtin_nontemporal_load((const f32x4*)(W + (size_t)(k0 + 4 * i + kq) * N + n0 + 4 * l16));
#pragma unroll
    for (int i = 0; i < 16; ++i) { LAS float* p = scr + (4 * i + kq) * 65 + 4 * l16; p[0] = v[i].x; p[1] = v[i].y; p[2] = v[i].z; p[3] = v[i].w; }
    LDS_WAIT(); asm volatile("" ::: "memory");
    const int c = lane & 7, nn = lane >> 3;
#pragma unroll
    for (int jj = 0; jj < 8; ++jj) { const int n = nn + 8 * jj; const LAS float* s = scr + (8 * c) * 65 + n;
        v4u o; o.x = pk2(s[0 * 65], s[1 * 65]); o.y = pk2(s[2 * 65], s[3 * 65]); o.z = pk2(s[4 * 65], s[5 * 65]); o.w = pk2(s[6 * 65], s[7 * 65]);
        const int idx_ = n & 31; const int nd = rperm ? (32 * (idx_ >> 4) + 8 * ((idx_ >> 2) & 3) + 4 * (n >> 5) + (idx_ & 3)) : n;
        __builtin_nontemporal_store(o, (v4u*)(WT + (size_t)(dest0 + nd) * K + k0 + 8 * c)); }
    LDS_WAIT(); asm volatile("" ::: "memory");
}

__device__ __forceinline__ void transpose_item8(const float* __restrict__ W, int K, int N, unsigned char* __restrict__ WT, int q, int kind, LAS float* scr, int lane) {
    const int nblk = N >> 5, kb = q / nblk, nb = q - kb * nblk, k0 = kb * 128, n0 = nb * 32;
    int dest0 = n0;
    if (kind) { const int hf = N >> 1; const int j = n0 < hf ? n0 : n0 - hf; dest0 = (j >> 7) * 256 + (j & 127) + (n0 < hf ? 0 : 128); }
    const int l8 = lane & 7, kq = lane >> 3;
    f32x4 v[16];
#pragma unroll
    for (int i = 0; i < 16; ++i) v[i] = __builtin_nontemporal_load((const f32x4*)(W + (size_t)(k0 + 8 * i + kq) * N + n0 + 4 * l8));
#pragma unroll
    for (int i = 0; i < 16; ++i) { LAS float* p = scr + (8 * i + kq) * 33 + 4 * l8; p[0] = v[i].x; p[1] = v[i].y; p[2] = v[i].z; p[3] = v[i].w; }
    LDS_WAIT(); asm volatile("" ::: "memory");
    const int c = lane & 7, nn = lane >> 3;
#pragma unroll
    for (int jj = 0; jj < 4; ++jj) { const int n = nn + 8 * jj; const LAS float* s = scr + (16 * c) * 33 + n;
        v4u o; o.x = pk4_fp8(s[0 * 33] * W8_SCALE, s[1 * 33] * W8_SCALE, s[2 * 33] * W8_SCALE, s[3 * 33] * W8_SCALE); o.y = pk4_fp8(s[4 * 33] * W8_SCALE, s[5 * 33] * W8_SCALE, s[6 * 33] * W8_SCALE, s[7 * 33] * W8_SCALE);
        o.z = pk4_fp8(s[8 * 33] * W8_SCALE, s[9 * 33] * W8_SCALE, s[10 * 33] * W8_SCALE, s[11 * 33] * W8_SCALE); o.w = pk4_fp8(s[12 * 33] * W8_SCALE, s[13 * 33] * W8_SCALE, s[14 * 33] * W8_SCALE, s[15 * 33] * W8_SCALE);
        __builtin_nontemporal_store(o, (v4u*)(WT + (size_t)(dest0 + n) * K + k0 + 16 * c)); }
    LDS_WAIT(); asm volatile("" ::: "memory");
}

constexpr int MOD_TASKS = 2 * (MODW / 32);
__device__ __forceinline__ void mod_fill_silu(const Ctx& X, const float* cvec, const float* cctx) {
    LAS float* S = (LAS float*)X.lds;
    for (int idx = X.tid; idx < 3 * 2048; idx += NWAVES * 64) { const int i = idx >> 11, k = idx & 2047; const float cv = i < 2 ? cvec[i * 2048 + k] : cctx[k]; S[idx] = cv / (1.f + expf(-cv)); }
    __syncthreads();
}
__device__ __forceinline__ void mod_task(const Ctx& X, int task, const float* Wm, const float* bm, float* mods_l) {
    const int ch = task % (MODW / 32);
    LAS float* S = (LAS float*)X.lds;
    LAS float* R = S + 3 * 2048;
    const int kq = X.lane >> 3, c4 = X.lane & 7;
    f32x4 a0 = {0.f, 0.f, 0.f, 0.f}, a1 = a0, a2 = a0;
    const float* wp = Wm + (size_t)(X.wave * 256 + kq) * MODW + ch * 32 + 4 * c4;
    for (int k = 0; k < 256; k += 64) {
        f32x4 w[8];
#pragma unroll
        for (int u = 0; u < 8; ++u) w[u] = __builtin_nontemporal_load((const f32x4*)(wp + (size_t)(k + 8 * u) * MODW));
#pragma unroll
        for (int u = 0; u < 8; ++u) { const int kk = X.wave * 256 + k + 8 * u + kq; a0 += w[u] * S[kk]; a1 += w[u] * S[2048 + kk]; a2 += w[u] * S[4096 + kk]; }
    }
#pragma unroll
    for (int j = 0; j < 4; ++j) {
#pragma unroll
        for (int o = 8; o < 64; o <<= 1) { a0[j] += __shfl_xor(a0[j], o); a1[j] += __shfl_xor(a1[j], o); a2[j] += __shfl_xor(a2[j], o); } }
    if (kq == 0) {
#pragma unroll
        for (int j = 0; j < 4; ++j) { R[(X.wave * 3 + 0) * 32 + 4 * c4 + j] = a0[j]; R[(X.wave * 3 + 1) * 32 + 4 * c4 + j] = a1[j]; R[(X.wave * 3 + 2) * 32 + 4 * c4 + j] = a2[j]; } }
    __syncthreads();
    if (X.tid < 96) { const int i = X.tid >> 5, col = X.tid & 31; float s = 0.f;
#pragma unroll
        for (int w = 0; w < 8; ++w) s += R[(w * 3 + i) * 32 + col];
        mods_l[(size_t)i * MODW + ch * 32 + col] = s + bm[ch * 32 + col]; }
    __syncthreads();
}

template <bool ROUTER, bool PSUM = false, bool OUT8 = false>
__device__ __forceinline__ void norm_mod_rows(const Ctx& X, const float* src_lat, const float* src_ctx, int nrows, const float* gain, const float* mods_l, int sh_i, int sc_i, bf16* H,
                                              const float* wrouter, int* eid, float* egate, const float* part = nullptr, int Sp = 0, const float* pgate = nullptr, float* wb = nullptr) {
    LAS float* WR = (LAS float*)X.lds;
    if (ROUTER) { for (int idx = X.tid; idx < 8 * 2048; idx += NWAVES * 64) { const int k = idx >> 3, e = idx & 7; WR[e * 2048 + k] = wrouter[idx]; } __syncthreads(); }
    int first = X.gw, stride = X.NGW, limit = nrows;
    if (PSUM && (X.NGW >> 2) == TC && nrows == MR) {
        if ((X.gw & 3) == 0) { first = TL + (X.gw >> 2); limit = first + 1; stride = 1 << 28; }
        else { first = X.gw - (X.gw >> 2) - 1; stride = X.NGW - (X.NGW >> 2); limit = TL; }
    }
    f32x4 vn[8];
    if (first < limit) { const float* xr = first < TL ? src_lat + (size_t)first * D : src_ctx + (size_t)(first - TL) * D;
#pragma unroll
        for (int j = 0; j < 8; ++j) vn[j] = __builtin_nontemporal_load((const f32x4*)(xr + 4 * X.lane + 256 * j)); }
    for (int row = first; row < limit; row += stride) {
        const int cond = row < SEQ ? 0 : (row < TL ? 1 : 2);
        const float* shp = mods_l + (size_t)cond * MODW + sh_i * D; const float* scp = mods_l + (size_t)cond * MODW + sc_i * D;
        f32x4 v[8]; float ss = 0.f;
#pragma unroll
        for (int j = 0; j < 8; ++j) v[j] = vn[j];
        { const int nr = row + stride; if (nr < limit) { const float* xr = nr < TL ? src_lat + (size_t)nr * D : src_ctx + (size_t)(nr - TL) * D;
#pragma unroll
            for (int j = 0; j < 8; ++j) vn[j] = __builtin_nontemporal_load((const f32x4*)(xr + 4 * X.lane + 256 * j)); } }
        if (PSUM) { if (row >= TL) {
            f32x4 a[8];
#pragma unroll
            for (int j = 0; j < 8; ++j) a[j] = (f32x4){0.f, 0.f, 0.f, 0.f};
            { int p = 0;
              for (; p + 2 <= Sp; p += 2) { const float* pr = part + ((size_t)p * TC + (row - TL)) * D + 4 * X.lane; f32x4 t[2][8];
#pragma unroll
                  for (int q = 0; q < 2; ++q)
#pragma unroll
                      for (int j = 0; j < 8; ++j) t[q][j] = __builtin_nontemporal_load((const f32x4*)(pr + (size_t)q * TC * D + 256 * j));
#pragma unroll
                  for (int j = 0; j < 8; ++j) a[j] += t[0][j] + t[1][j]; }
              for (; p < Sp; ++p) { const float* pr = part + ((size_t)p * TC + (row - TL)) * D + 4 * X.lane;
#pragma unroll
                  for (int j = 0; j < 8; ++j) a[j] += __builtin_nontemporal_load((const f32x4*)(pr + 256 * j)); } }
#pragma unroll
            for (int j = 0; j < 8; ++j) { v[j] += a[j] * *(const f32x4*)(pgate + 4 * X.lane + 256 * j); if (wb) *(f32x4*)(wb + (size_t)(row - TL) * D + 4 * X.lane + 256 * j) = v[j]; }
        } }
#pragma unroll
        for (int j = 0; j < 8; ++j) ss += (v[j].x * v[j].x + v[j].y * v[j].y) + (v[j].z * v[j].z + v[j].w * v[j].w);
        const float rstd = 1.0f / sqrtf(wave_sum(ss) * (1.f / D) + EPS);
#pragma unroll
        for (int j = 0; j < 8; ++j) { const int col = 4 * X.lane + 256 * j; const f32x4 g = *(const f32x4*)(gain + col), sc = *(const f32x4*)(scp + col), sh = *(const f32x4*)(shp + col);
            v[j] = (v[j] * rstd * g) * (sc + 1.0f) + sh;
            if (OUT8) { *(unsigned*)((unsigned char*)H + (size_t)row * D + col) = pk4_fp8(v[j].x, v[j].y, v[j].z, v[j].w); }
            else { v2u o; o.x = pk2(v[j].x, v[j].y); o.y = pk2(v[j].z, v[j].w); *(v2u*)(H + (size_t)row * D + col) = o; } }
        if (ROUTER) {
            float v1 = -3.0e38f, v2 = -3.0e38f; int i1 = 0, i2 = 0;
#pragma unroll 1
            for (int e = 0; e < 8; ++e) { float a = 0.f;
#pragma unroll
                for (int j = 0; j < 8; ++j) { const f32x4 w = *(const LAS f32x4*)(WR + e * 2048 + 4 * X.lane + 256 * j); a += (v[j].x * w.x + v[j].y * w.y) + (v[j].z * w.z + v[j].w * w.w); }
                const float s = wave_sum(a);
                if (s > v1) { v2 = v1; i2 = i1; v1 = s; i1 = e; } else if (s > v2) { v2 = s; i2 = e; } }
            const float ex = expf(v2 - v1), g1 = 1.f / (1.f + ex), g2 = ex / (1.f + ex);
            if (X.lane == 0) { eid[row * 2] = i1; eid[row * 2 + 1] = i2; egate[row * 2] = g1; egate[row * 2 + 1] = g2; }
        }
    }
}

template <int NG>
__device__ __forceinline__ void qkv_post(const Ctx& X, const bf16* z, bf16* QKV, const float* qn_a, const float* kn_a, const float* qn_b, const float* kn_b) {
    typedef float f32x2 __attribute__((ext_vector_type(2)));
    LAS f32x2* CS = (LAS f32x2*)X.lds;
    for (int idx = X.tid; idx < 2048; idx += NWAVES * 64) { const int p = idx >> 5, i = idx & 31; const float inv = exp2f(-(float)i * (13.287712379549449f / 32.0f)); const float a = (float)p * inv;
        float sn, cs; sincosf(a, &sn, &cs); CS[idx] = (f32x2){cs, sn}; }
    __syncthreads();
    const int l16 = X.lane & 15, gq = X.lane >> 4, chunk = l16 >> 2;
    v4u rawn = {0u, 0u, 0u, 0u};
    if (X.gw < MR) rawn = *(const v4u*)(z + (size_t)X.gw * (NG * 128) + gq * 128 + 8 * l16);
    for (int row = X.gw; row < MR; row += X.NGW) {
        const bool lat = row < TL; const int b = lat ? (row >> 12) : ((row - TL) >> 8); const int pos = lat ? (row & 4095) : (SEQ + ((row - TL) & 255));
        const int p = (chunk < 2) ? (pos >> 6) : (pos & 63);
#pragma unroll 1
        for (int it = 0; it < NG / 4; ++it) {
            const int g = it * 4 + gq;
            const float* gp; bool hn;
            if (NG == NSLOT0) { hn = !(g == 10 || g == 11 || g >= 28); gp = g < 8 ? qn_a : (g < 12 ? kn_a : (g < 20 ? qn_b : kn_b)); }
            else { hn = g < 20; gp = g < 16 ? qn_a : kn_a; }
            const v4u raw = rawn;
            { const bool same = it + 1 < NG / 4; const int nrow = same ? row : row + X.NGW, ng = same ? g + 4 : gq; if (nrow < MR) rawn = *(const v4u*)(z + (size_t)nrow * (NG * 128) + ng * 128 + 8 * l16); }
            float v[8] = {bflo(raw.x), bfhi(raw.x), bflo(raw.y), bfhi(raw.y), bflo(raw.z), bfhi(raw.z), bflo(raw.w), bfhi(raw.w)};
            float ss = 0.f;
#pragma unroll
            for (int j = 0; j < 8; ++j) ss += v[j] * v[j];
            ss += __shfl_xor(ss, 1); ss += __shfl_xor(ss, 2); ss += __shfl_xor(ss, 4); ss += __shfl_xor(ss, 8);
            const float rs = 1.0f / sqrtf(ss * (1.f / 128.f) + EPS);
            const f32x4 ga = *(const f32x4*)(gp + 8 * l16), gb = *(const f32x4*)(gp + 8 * l16 + 4);
            const float gg[8] = {ga.x, ga.y, ga.z, ga.w, gb.x, gb.y, gb.z, gb.w};
#pragma unroll
            for (int j = 0; j < 8; ++j) v[j] = hn ? v[j] * rs * gg[j] : v[j];
            float o[8];
#pragma unroll
            for (int j = 0; j < 8; ++j) { const float pv = __shfl_xor(v[j], 4); const f32x2 cs = CS[p * 32 + 8 * (l16 & 3) + j];
                const float rot = (chunk & 1) ? (v[j] * cs.x + pv * cs.y) : (v[j] * cs.x - pv * cs.y); o[j] = (hn && lat) ? rot : v[j]; }
            v4u w; w.x = pk2(o[0], o[1]); w.y = pk2(o[2], o[3]); w.z = pk2(o[4], o[5]); w.w = pk2(o[6], o[7]);
            *(v4u*)(QKV + ((size_t)(b * NG + g) * KVR + pos) * 128 + 8 * l16) = w;
        }
    }
}

template <int NG>
__device__ __forceinline__ void k_post(const Ctx& X, bf16* QKV, const float* kn_a, const float* kn_b, const float* cs_lds) {
    constexpr int NK = (NG == NSLOT0) ? 10 : 4;
    const int l16 = X.lane & 15, rq = X.lane >> 4, chunk = l16 >> 2;
    for (int item = X.gw; item < NB * NK * (KVR / 4); item += X.NGW) {
        const int p4 = item % (KVR / 4), t = item / (KVR / 4), kgi = t % NK, b = t / NK;
        const int g = (NG == NSLOT0) ? (kgi < 2 ? 8 + kgi : 18 + kgi) : 16 + kgi;
        const float* gp = (NG == NSLOT0) ? (kgi < 2 ? kn_a : kn_b) : kn_a;
        const int pos = p4 * 4 + rq; const bool lat = pos < SEQ; const int p = (chunk < 2) ? (pos >> 6) : (pos & 63);
        bf16* ptr = QKV + ((size_t)(b * NG + g) * KVR + pos) * 128 + 8 * l16;
        const v4u raw = *(const v4u*)ptr;
        float v[8] = {bflo(raw.x), bfhi(raw.x), bflo(raw.y), bfhi(raw.y), bflo(raw.z), bfhi(raw.z), bflo(raw.w), bfhi(raw.w)};
        float ss = 0.f;
#pragma unroll
        for (int j = 0; j < 8; ++j) ss += v[j] * v[j];
        ss += __shfl_xor(ss, 1); ss += __shfl_xor(ss, 2); ss += __shfl_xor(ss, 4); ss += __shfl_xor(ss, 8);
        const float rs = 1.0f / sqrtf(ss * (1.f / 128.f) + EPS);
        const f32x4 ga = *(const f32x4*)(gp + 8 * l16), gb = *(const f32x4*)(gp + 8 * l16 + 4);
        const float gg[8] = {ga.x, ga.y, ga.z, ga.w, gb.x, gb.y, gb.z, gb.w};
        float o[8];
#pragma unroll
        for (int j = 0; j < 8; ++j) { v[j] = v[j] * rs * gg[j]; const float pv = __shfl_xor(v[j], 4); const int ci = (lat ? p : 0) * 32 + 8 * (l16 & 3) + j; const float c = cs_lds[ci * 2], sn = cs_lds[ci * 2 + 1];
            const float rot = (chunk & 1) ? (v[j] * c + pv * sn) : (v[j] * c - pv * sn); o[j] = lat ? rot : v[j]; }
        v4u w; w.x = pk2(o[0], o[1]); w.y = pk2(o[2], o[3]); w.z = pk2(o[4], o[5]); w.w = pk2(o[6], o[7]);
        *(v4u*)ptr = w;
    }
}
constexpr int CS_OFF = 98304;
__device__ __forceinline__ void build_cs(const Ctx& X) {
    LAS float* CS = (LAS float*)(X.lds + CS_OFF);
    for (int idx = X.tid; idx < 2048; idx += NWAVES * 64) { const int p = idx >> 5, i = idx & 31; const float inv = exp2f(-(float)i * (13.287712379549449f / 32.0f)); const float a = (float)p * inv;
        float sn, cs; sincosf(a, &sn, &cs); CS[idx * 2] = cs; CS[idx * 2 + 1] = sn; }
    __syncthreads();
}

__device__ __forceinline__ void b_combine(const Ctx& X, const float* PB, const float* lamv, const float* subln, bf16* OALL) {
    const int half = X.lane >> 5, d4 = (X.lane & 31) * 4;
    f32x4 n1, n2;
#define BC_LOAD(item_, d1, d2) do { const int row_ = (item_) >> 2, hb_ = (item_) & 3; const bool lat_ = row_ < TL; const int b_ = lat_ ? (row_ >> 12) : ((row_ - TL) >> 8); const int pos_ = lat_ ? (row_ & 4095) : (SEQ + ((row_ - TL) & 255)); \
        d1 = __builtin_nontemporal_load((const f32x4*)(PB + ((size_t)(b_ * 16 + (hb_ * 2 + 0) * 2 + half) * KVR + pos_) * 128 + d4)); d2 = __builtin_nontemporal_load((const f32x4*)(PB + ((size_t)(b_ * 16 + (hb_ * 2 + 1) * 2 + half) * KVR + pos_) * 128 + d4)); } while (0)
    if (X.gw < MR * 4) BC_LOAD(X.gw, n1, n2);
    for (int item = X.gw; item < MR * 4; item += X.NGW) {
        const int row = item >> 2, hb = item & 3;
        const f32x4 o1 = n1, o2 = n2;
        if (item + X.NGW < MR * 4) BC_LOAD(item + X.NGW, n1, n2);
        const float lam = lamv[hb];
        const f32x4 v = o1 - o2 * lam;
        const float ss = wave_sum((v.x * v.x + v.y * v.y) + (v.z * v.z + v.w * v.w));
        const float rs = (1.0f - LAM_INIT) / sqrtf(ss * (1.f / 256.f) + EPS);
        const f32x4 g = *(const f32x4*)(subln + half * 128 + d4);
        const f32x4 y = v * rs * g;
        v2u o; o.x = pk2(y.x, y.y); o.y = pk2(y.z, y.w);
        *(v2u*)(OALL + (size_t)row * D + 1024 + hb * 256 + half * 128 + d4) = o;
    }
#undef BC_LOAD
}

__device__ __forceinline__ void moe_route(const Ctx& X, const int* eid, const float* egate, const bf16* H, bf16* XS, int* pos, int* rowtok, float* rowgate, int* tile_e, int* ntiles) {
    LAS int* tot = (LAS int*)X.lds;
    LAS int* pre = tot + 8;
    LAS int* base = tot + 16;
    LAS int* dst = tot + 64;
    const int tpw = (TL + X.G - 1) / X.G, t0 = X.c * tpw, t1 = (t0 + tpw) < TL ? (t0 + tpw) : TL;
    if (X.tid < 16) tot[X.tid] = 0;
    __syncthreads();
    {
        int ct[8], cp[8];
#pragma unroll
        for (int e = 0; e < 8; ++e) { ct[e] = 0; cp[e] = 0; }
        for (int idx = X.tid; idx < 2 * TL; idx += NWAVES * 64) { const int e = eid[idx]; const bool before = (idx >> 1) < t0;
#pragma unroll
            for (int ee = 0; ee < 8; ++ee) { ct[ee] += __popcll(__ballot(e == ee)); cp[ee] += __popcll(__ballot(e == ee && before)); } }
        if (X.lane == 0) {
#pragma unroll
            for (int e = 0; e < 8; ++e) { __hip_atomic_fetch_add(&tot[e], ct[e], __ATOMIC_RELAXED, __HIP_MEMORY_SCOPE_WORKGROUP); __hip_atomic_fetch_add(&pre[e], cp[e], __ATOMIC_RELAXED, __HIP_MEMORY_SCOPE_WORKGROUP); } }
    }
    __syncthreads();
    if (X.tid == 0) { int acc = 0; for (int e = 0; e < 8; ++e) { base[e] = acc; acc += (tot[e] + 255) & ~255; }
        if (X.c == 0) { *ntiles = acc >> 8; for (int e = 0; e < 8; ++e) { const int nt = (tot[e] + 255) >> 8; for (int i = 0; i < nt; ++i) tile_e[(base[e] >> 8) + i] = e; } } }
    __syncthreads();
    if (X.wave == 0) {
        int run[8];
#pragma unroll
        for (int e = 0; e < 8; ++e) run[e] = 0;
        const int n_ent = 2 * (t1 - t0);
        for (int b0 = 0; b0 < n_ent; b0 += 64) {
            const int li = b0 + X.lane; const bool valid = li < n_ent; const int idx = 2 * t0 + li; const int e = valid ? eid[idx] : -1;
            int rank = 0;
#pragma unroll
            for (int ee = 0; ee < 8; ++ee) { const unsigned long long m = __ballot(e == ee); if (e == ee) rank = run[ee] + __popcll(m & ((1ull << X.lane) - 1ull)); run[ee] += __popcll(m); }
            if (valid) { const int d = base[e] + pre[e] + rank; dst[li] = d; pos[idx] = d; rowtok[d] = idx >> 1; rowgate[d] = egate[idx]; }
        }
    }
    __syncthreads();
    { const int n_tok = t1 - t0;
      for (int tb = X.wave * 4; tb < n_tok; tb += NWAVES * 4) {
          v4u rbuf[4][2];
#pragma unroll
          for (int i = 0; i < 4; ++i) { const int tk_ = (tb + i) < n_tok ? (tb + i) : (n_tok - 1); const v4u* s_ = (const v4u*)((const unsigned char*)H + (size_t)(t0 + tk_) * D) + X.lane;
              rbuf[i][0] = s_[0]; rbuf[i][1] = s_[64]; }
#pragma unroll
          for (int i = 0; i < 4; ++i) if (tb + i < n_tok) {
#pragma unroll
              for (int k = 0; k < 2; ++k) { const int d = dst[2 * (tb + i) + k]; v4u* o_ = (v4u*)((unsigned char*)XS + (size_t)d * D) + X.lane;
                  __builtin_nontemporal_store(rbuf[i][0], o_); __builtin_nontemporal_store(rbuf[i][1], o_ + 64); } } } }
    if (X.c < 8) { const int e = X.c; const int r0 = base[e] + tot[e], r1 = base[e] + ((tot[e] + 255) & ~255);
        for (int r = r0 + X.wave; r < r1; r += NWAVES) { if (X.lane == 0) { rowtok[r] = -1; rowgate[r] = 0.f; }
            v4u* o = (v4u*)((unsigned char*)XS + (size_t)r * D) + X.lane; const v4u zz = {0u, 0u, 0u, 0u};
#pragma unroll
            for (int j = 0; j < 2; ++j) o[64 * j] = zz; } }
    __syncthreads();
}

__device__ __forceinline__ void norm_route_rows(const Ctx& X, const float* X3, const float* gain, const float* mods_l, int sh_i, int sc_i, const float* wrouter, unsigned* gcnt, unsigned char* xs, int* pos, float* rowgate) {
    LAS float* WR = (LAS float*)X.lds;
    LAS int* ENT_E = (LAS int*)(X.lds + 65536);
    LAS float* ENT_G = (LAS float*)(X.lds + 65536 + 256);
    LAS int* ENT_P = (LAS int*)(X.lds + 65536 + 512);
    LAS int* BASE = (LAS int*)(X.lds + 65536 + 768);
    for (int idx = X.tid; idx < 8 * 2048; idx += NWAVES * 64) { const int k = idx >> 3, e = idx & 7; WR[e * 2048 + k] = wrouter[idx]; }
    __syncthreads();
    const int rpw = (TL + X.NGW - 1) / X.NGW;
    for (int p0 = 0; p0 < rpw; p0 += 4) {
        unsigned pk[4][8]; f32x4 nxt[8];
        { const int row = X.gw + p0 * X.NGW; const float* xr = X3 + (size_t)(row < TL ? row : X.gw) * D;
#pragma unroll
          for (int j = 0; j < 8; ++j) nxt[j] = __builtin_nontemporal_load((const f32x4*)(xr + 4 * X.lane + 256 * j)); }
#pragma unroll
        for (int i = 0; i < 4; ++i) {
            const int row = X.gw + (p0 + i) * X.NGW; const bool valid = (p0 + i) < rpw && row < TL;
            int i1 = -1, i2 = -1; float g1 = 0.f, g2 = 0.f;
            f32x4 cur[8];
#pragma unroll
            for (int j = 0; j < 8; ++j) cur[j] = nxt[j];
            if (i < 3) { const int rn = X.gw + (p0 + i + 1) * X.NGW; const float* xr = X3 + (size_t)(((p0 + i + 1) < rpw && rn < TL) ? rn : X.gw) * D;
#pragma unroll
                for (int j = 0; j < 8; ++j) nxt[j] = __builtin_nontemporal_load((const f32x4*)(xr + 4 * X.lane + 256 * j)); }
            if (valid) {
                const int cond = row < SEQ ? 0 : 1;
                const float* shp = mods_l + (size_t)cond * MODW + sh_i * D; const float* scp = mods_l + (size_t)cond * MODW + sc_i * D;
                f32x4 v[8]; float ss = 0.f;
#pragma unroll
                for (int j = 0; j < 8; ++j) v[j] = cur[j];
#pragma unroll
                for (int j = 0; j < 8; ++j) ss += (v[j].x * v[j].x + v[j].y * v[j].y) + (v[j].z * v[j].z + v[j].w * v[j].w);
                const float rstd = 1.0f / sqrtf(wave_sum(ss) * (1.f / D) + EPS);
#pragma unroll
                for (int j = 0; j < 8; ++j) { const int col = 4 * X.lane + 256 * j; const f32x4 g = *(const f32x4*)(gain + col), sc = *(const f32x4*)(scp + col), sh = *(const f32x4*)(shp + col);
                    v[j] = (v[j] * rstd * g) * (sc + 1.0f) + sh; pk[i][j] = pk4_fp8(v[j].x, v[j].y, v[j].z, v[j].w); }
                float v1 = -3.0e38f, v2 = -3.0e38f; i1 = 0; i2 = 0;
#pragma unroll 1
                for (int e = 0; e < 8; ++e) { float a = 0.f;
#pragma unroll
                    for (int j = 0; j < 8; ++j) { const f32x4 w = *(const LAS f32x4*)(WR + e * 2048 + 4 * X.lane + 256 * j); a += (v[j].x * w.x + v[j].y * w.y) + (v[j].z * w.z + v[j].w * w.w); }
                    const float sl = wave_sum(a);
                    if (sl > v1) { v2 = v1; i2 = i1; v1 = sl; i1 = e; } else if (sl > v2) { v2 = sl; i2 = e; } }
                const float ex = expf(v2 - v1); g1 = 1.f / (1.f + ex); g2 = ex / (1.f + ex);
            } else {
#pragma unroll
                for (int j = 0; j < 8; ++j) pk[i][j] = 0u;
            }
            if (X.lane == 0) { const int sl2 = 2 * (8 * i + X.wave); ENT_E[sl2] = i1; ENT_E[sl2 + 1] = i2; ENT_G[sl2] = g1; ENT_G[sl2 + 1] = g2; }
        }
        __syncthreads();
        if (X.wave == 0) {
            const int e = ENT_E[X.lane]; int rank = 0, mycnt = 0;
#pragma unroll
            for (int ee = 0; ee < 8; ++ee) { const unsigned long long m = __ballot(e == ee); const int c = __popcll(m); if (e == ee) rank = __popcll(m & ((1ull << X.lane) - 1ull)); if (X.lane == ee) mycnt = c; }
            if (X.lane < 8) { int b = 0; if (mycnt > 0) b = (int)__hip_atomic_fetch_add(gcnt + 64 * X.lane, (unsigned)mycnt, __ATOMIC_RELAXED, __HIP_MEMORY_SCOPE_AGENT); BASE[X.lane] = b; }
            LDS_WAIT(); asm volatile("" ::: "memory");
            if (e >= 0) { const int phys = e * RROWS + BASE[e] + rank; ENT_P[X.lane] = phys;
                const int slot = X.lane >> 1; const int row = (X.c * NWAVES + (slot & 7)) + (p0 + (slot >> 3)) * X.NGW;
                pos[2 * row + (X.lane & 1)] = phys; rowgate[phys] = ENT_G[X.lane]; }
        }
        __syncthreads();
#pragma unroll
        for (int i = 0; i < 4; ++i) {
            const int sl2 = 2 * (8 * i + X.wave);
#pragma unroll
            for (int k = 0; k < 2; ++k) if (ENT_E[sl2 + k] >= 0) { unsigned* o = (unsigned*)(xs + (size_t)ENT_P[sl2 + k] * D) + X.lane;
#pragma unroll
                for (int j = 0; j < 8; ++j) o[64 * j] = pk[i][j]; }
        }
        __syncthreads();
    }
}
__device__ __forceinline__ int build_moe_tables(const Ctx& X, const unsigned* gcnt) {
    LAS int* TE = (LAS int*)(X.lds + TAB_OFF); LAS int* TP = TE + MAXT; LAS int* PRE = TP + MAXT;
    if (X.tid == 0) { int acc = 0;
        for (int e = 0; e < NE; ++e) { const int nt = ((int)gcnt[64 * e] + 255) >> 8; PRE[e] = acc; for (int j = 0; j < nt; ++j) { TE[acc + j] = e; TP[acc + j] = e * RTILES + j; } acc += nt; }
        PRE[NE] = acc; }
    __syncthreads();
    return __builtin_amdgcn_readfirstlane(PRE[NE]);
}
constexpr int MOE_MAIN_TILES = 64, MOE_MAIN_ROWS = MOE_MAIN_TILES * 256;
__device__ __forceinline__ void moe_final(const Ctx& X, const float* X3, const bf16* YS, const int* pos, const float* mods_l, float* out, const float* part, int ntiles) {
    const LAS int* PRE = (const LAS int*)(X.lds + TAB_OFF) + 2 * MAXT;
    int Sp, ppair; const int tail_rows = (ntiles - MOE_MAIN_TILES) * 256; pg8::tail_split(X.G, (ntiles - MOE_MAIN_TILES) * (D / 256), DFE / 128, Sp, ppair);
    int np0 = 0, np1 = 0; if (X.gw < TL) { np0 = pos[2 * X.gw]; np1 = pos[2 * X.gw + 1]; }
    for (int row = X.gw; row < TL; row += X.NGW) {
        const int p0 = np0, p1 = np1; const float* gp = mods_l + (size_t)(row >> 12) * MODW + 5 * D;
        const int l0 = (PRE[p0 >> 13] + ((p0 & (RROWS - 1)) >> 8)) * 256 + (p0 & 255), l1 = (PRE[p1 >> 13] + ((p1 & (RROWS - 1)) >> 8)) * 256 + (p1 & 255);
        if (row + X.NGW < TL) { np0 = pos[2 * (row + X.NGW)]; np1 = pos[2 * (row + X.NGW) + 1]; }
        f32x4 a[8], b[8];
        if (l0 < MOE_MAIN_ROWS) {
#pragma unroll
            for (int j = 0; j < 8; ++j) { const v2u w = __builtin_nontemporal_load((const v2u*)(YS + (size_t)p0 * D + 4 * X.lane + 256 * j)); a[j] = (f32x4){bflo(w.x), bfhi(w.x), bflo(w.y), bfhi(w.y)}; }
        } else {
#pragma unroll
            for (int j = 0; j < 8; ++j) a[j] = (f32x4){0.f, 0.f, 0.f, 0.f};
            { int p = 0;
              for (; p + 2 <= Sp; p += 2) { const float* pr = part + ((size_t)p * tail_rows + (l0 - MOE_MAIN_ROWS)) * D + 4 * X.lane; f32x4 t[2][8];
#pragma unroll
                  for (int q = 0; q < 2; ++q)
#pragma unroll
                      for (int j = 0; j < 8; ++j) t[q][j] = __builtin_nontemporal_load((const f32x4*)(pr + (size_t)q * tail_rows * D + 256 * j));
#pragma unroll
                  for (int j = 0; j < 8; ++j) a[j] += t[0][j] + t[1][j]; }
              for (; p < Sp; ++p) { const float* pr = part + ((size_t)p * tail_rows + (l0 - MOE_MAIN_ROWS)) * D + 4 * X.lane;
#pragma unroll
                  for (int j = 0; j < 8; ++j) a[j] += __builtin_nontemporal_load((const f32x4*)(pr + 256 * j)); } }
        }
        if (l1 < MOE_MAIN_ROWS) {
#pragma unroll
            for (int j = 0; j < 8; ++j) { const v2u w = __builtin_nontemporal_load((const v2u*)(YS + (size_t)p1 * D + 4 * X.lane + 256 * j)); b[j] = (f32x4){bflo(w.x), bfhi(w.x), bflo(w.y), bfhi(w.y)}; }
        } else {
#pragma unroll
            for (int j = 0; j < 8; ++j) b[j] = (f32x4){0.f, 0.f, 0.f, 0.f};
            { int p = 0;
              for (; p + 2 <= Sp; p += 2) { const float* pr = part + ((size_t)p * tail_rows + (l1 - MOE_MAIN_ROWS)) * D + 4 * X.lane; f32x4 t[2][8];
#pragma unroll
                  for (int q = 0; q < 2; ++q)
#pragma unroll
                      for (int j = 0; j < 8; ++j) t[q][j] = __builtin_nontemporal_load((const f32x4*)(pr + (size_t)q * tail_rows * D + 256 * j));
#pragma unroll
                  for (int j = 0; j < 8; ++j) b[j] += t[0][j] + t[1][j]; }
              for (; p < Sp; ++p) { const float* pr = part + ((size_t)p * tail_rows + (l1 - MOE_MAIN_ROWS)) * D + 4 * X.lane;
#pragma unroll
                  for (int j = 0; j < 8; ++j) b[j] += __builtin_nontemporal_load((const f32x4*)(pr + 256 * j)); } }
        }
#pragma unroll
        for (int j = 0; j < 8; ++j) { const int col = 4 * X.lane + 256 * j; const f32x4 x = __builtin_nontemporal_load((const f32x4*)(X3 + (size_t)row * D + col)), g = *(const f32x4*)(gp + col);
            __builtin_nontemporal_store(x + g * (a[j] + b[j]), (f32x4*)(out + (size_t)row * D + col)); }
    }
}

__device__ __forceinline__ int grab_items(unsigned* head, int n, int lane) {
    int v = 0; if (lane == 0) v = (int)__hip_atomic_fetch_add(head, (unsigned)n, __ATOMIC_RELAXED, __HIP_MEMORY_SCOPE_AGENT);
    return __builtin_amdgcn_readfirstlane(v);
}
__device__ __forceinline__ int idle_units(int nunits, int G, int c) { const int maxu = (nunits + G - 1) / G, mine = c < nunits ? (nunits - c + G - 1) / G : 0; return maxu - mine; }
__device__ __forceinline__ const float* arg_in(int i) {
    auto kp = __builtin_amdgcn_kernarg_segment_ptr();
    asm volatile("" : "+s"(kp));
    return ((const float* const __attribute__((address_space(4)))*)kp)[i];
}
#define AIN(i) arg_in(i)
#ifndef ST_QUOTA
#define ST_QUOTA 4
#endif
constexpr int DN1 = (D / 128) * (2 * DFF / 32), DN2 = DN1 + (DFF / 64) * (D / 64), DN3 = DN2 + (D / 64) * (ODD_IN / 64), DN4 = DN3 + (D / 64) * (D / 64);
constexpr int PX1_ITEMS = (D / 128) * (2 * DFE / 32), PX2_ITEMS = (DFE / 128) * (D / 32), NQ1 = DN4 + NE * PX1_ITEMS, NDEF = NQ1 + NE * PX2_ITEMS;
static_assert(DN1 % 16 == 0 && DN2 % 16 == 0 && DN3 % 16 == 0 && DN4 % 16 == 0 && NQ1 % 16 == 0 && NDEF % 16 == 0, "deferred queue sections");
__device__ __forceinline__ void def_item(int it, unsigned char* ws, LAS float* scr, int lane) {
    if (it < DN1 || it >= DN4) {
        const float* W; unsigned char* WT; int K, N, q, kind;
        if (it < DN1) { W = AIN(20); WT = ws + WS_WT_EF1; K = D; N = 2 * DFF; q = it; kind = 1; }
        else { const int r0 = it - DN4; const bool up = r0 < NE * PX1_ITEMS; const int r = up ? r0 : r0 - NE * PX1_ITEMS; const int per = up ? PX1_ITEMS : PX2_ITEMS; const int e = r / per; q = r - e * per;
            W = (up ? AIN(31) : AIN(32)) + (size_t)e * ((size_t)D * DFE * (up ? 2 : 1)); WT = ws + (up ? WS_WT_X1 : WS_WT_X2) + (size_t)e * ((size_t)D * DFE * (up ? 2 : 1));
            K = up ? D : DFE; N = up ? 2 * DFE : D; kind = up ? 1 : 0; }
        transpose_item8(W, K, N, WT, q, kind, scr, lane);
    } else {
        const float* W; bf16* WT; int K, N, q, kind;
        if (it < DN2) { W = AIN(21); WT = (bf16*)(ws + WS_WT_EF2); K = DFF; N = D; q = it - DN1; kind = 0; }
        else if (it < DN3) { W = AIN(26); WT = (bf16*)(ws + WS_WT_OIN); K = D; N = ODD_IN; q = it - DN2; kind = 3; }
        else { W = AIN(27); WT = (bf16*)(ws + WS_WT_OOUT); K = D; N = D; q = it - DN3; kind = 0; }
        transpose_item(W, K, N, WT, q, kind, scr, lane);
    }
}
__device__ __forceinline__ void drain_deferred(const Ctx& X, gu32* ctl, unsigned char* ws, int max_batches, int limit) {
    unsigned* head = (unsigned*)(ctl + CW_WORK + 64);
    volatile LAS int* tk = (volatile LAS int*)(X.lds + 139264);
    volatile LAS unsigned* seen = (volatile LAS unsigned*)(X.lds + MISC_OFF + 4 * (8 + 5));
    int dt = threadIdx.x; asm volatile("" : "+v"(dt));
    const int dlane = dt & 63, dwave = __builtin_amdgcn_readfirstlane(dt >> 6);
    LAS float* scr = (LAS float*)(X.lds + dwave * 16896);
    int par = 0;
    for (int b = 0; b < max_batches; ++b) {
        if (dt == 0) { int t = NDEF; unsigned sn = seen[0];
            if (sn < (unsigned)limit && limit < NDEF) { const unsigned h = __hip_atomic_load(head, __ATOMIC_RELAXED, __HIP_MEMORY_SCOPE_AGENT); sn = h > sn ? h : sn; }
            if (sn < (unsigned)limit) { t = (int)__hip_atomic_fetch_add(head, 16u, __ATOMIC_RELAXED, __HIP_MEMORY_SCOPE_AGENT); sn = (unsigned)t + 16u; }
            seen[0] = sn; tk[par] = t; }
        __syncthreads();
        const int base = tk[par]; par ^= 1;
        if (base >= NDEF) break;
#pragma unroll 1
        for (int i = 0; i < 2; ++i) { const int it = base + dwave + 8 * i; if (it < NDEF) def_item(it, ws, scr, dlane); }
    }
    __syncthreads();
}
__device__ __forceinline__ void xcd_barrier_h(const XcdBarrier& b, const Ctx& X, gu32* ctl, unsigned char* ws) {
    asm volatile("s_waitcnt vmcnt(0)" ::: "memory");
    __syncthreads();
    if (threadIdx.x == 0) {
        unsigned* bar = b.bar;
        __builtin_amdgcn_s_waitcnt(0);
        unsigned nloc = b.st[0], nx = b.st[1];
        if (nloc == 0u) { xcd_barrier_complete(bar, b.x, nloc, nx); b.st[0] = nloc; b.st[1] = nx; }
        const unsigned old = xb_add(&bar[XB_XSUB(b.x)], 1u);
        const unsigned gen = old / nloc;
        if (old + 1u == (gen + 1u) * nloc) {
            __builtin_amdgcn_fence(__ATOMIC_RELEASE, "agent");
            asm volatile("s_waitcnt vmcnt(0)" ::: "memory");
            const unsigned og = xb_add(&bar[XB_TOP], 1u);
            const unsigned tg = og / nx;
            if (og + 1u == (tg + 1u) * nx) xb_add(&bar[XB_TOPGEN], 1u);
            else XB_SPIN(xb_ld(&bar[XB_TOPGEN]) == tg, bar);
            __builtin_amdgcn_fence(__ATOMIC_ACQUIRE, "agent");
            xb_add(&bar[XB_XGEN(b.x)], 1u);
            asm volatile("s_waitcnt vmcnt(0)" ::: "memory");
            b.st[2] = 0u;
        } else { b.st[2] = 1u; b.st[3] = gen; }
    }
    __syncthreads();
    if (b.st[2]) {
        unsigned* head = (unsigned*)(ctl + CW_WORK + 64);
        int ht = threadIdx.x; asm volatile("" : "+v"(ht));
        const int hlane = ht & 63, hwave = __builtin_amdgcn_readfirstlane(ht >> 6);
        LAS float* scr = (LAS float*)(X.lds + hwave * 16896);
        int par = 0;
        for (;;) {
            if (ht == 0) {
                unsigned* bar = b.bar; const unsigned gen = b.st[3], nloc = b.st[0], nx = b.st[1];
                int cmd = -1; unsigned sp = 0u;
                for (;;) {
                    if (xb_ld(&bar[XB_XGEN(b.x)]) != gen) break;
                    if (b.st[4] == 0u) {
                        const unsigned la = xb_ld(&bar[XB_XSUB(b.x)]) - gen * nloc;
                        bool go = la + 1u <= nloc;
                        if (!go && la == nloc) go = (xb_ld(&bar[XB_TOP]) - gen * nx) + 1u <= nx;
                        if (go) { const int t = (int)__hip_atomic_fetch_add(head, 8u, __ATOMIC_RELAXED, __HIP_MEMORY_SCOPE_AGENT); b.st[5] = (unsigned)t + 8u; if (t < NDEF) { cmd = t; break; } b.st[4] = 1u; }
                    }
                    __builtin_amdgcn_s_sleep(1);
                    if ((++sp & 255u) == 0u) { if (xb_ld(&bar[XB_TMO])) break; if (sp > XB_SPIN_CAP) { atomicAdd(&bar[XB_TMO], 1u); break; } }
                }
                b.st[6 + par] = (unsigned)cmd;
            }
            __syncthreads();
            const int cmd = (int)b.st[6 + par]; par ^= 1;
            if (cmd < 0) break;
            const int it = cmd + hwave; if (it < NDEF) def_item(it, ws, scr, hlane);
        }
        if (threadIdx.x == 0) {
            __builtin_amdgcn_fence(__ATOMIC_ACQUIRE, "agent");
            asm volatile("s_waitcnt vmcnt(0)" ::: "memory");
        }
        __syncthreads();
    }
}
constexpr int NPHASE = 20;
#ifndef PHMASK
#define PHMASK 0xFFFFFu
#endif
#ifndef PHDUP
#define PHDUP 0u
#endif
#define REP(k) _Pragma("unroll") for (int rep_ = 0; rep_ < ((((PHDUP) >> (k)) & 1u) ? 2 : 1); ++rep_)
#ifndef MK_LAUNCHES
#define MK_LAUNCHES {{0, NPHASE}}
#endif
struct PhRange { int lo, hi; };
constexpr PhRange kLaunches[] = MK_LAUNCHES;
struct Args { const float* in[33]; float* out; unsigned char* ws; int ph_lo, ph_hi, li, pad; };
__global__ void __launch_bounds__(NWAVES * 64, 2) fwd_kernel(Args args) {
    extern __shared__ __attribute__((aligned(16))) unsigned char lds[];
    Ctx X;
    X.lds = (LAS unsigned char*)lds; X.tid = threadIdx.x; X.lane = X.tid & 63; X.wave = __builtin_amdgcn_readfirstlane(X.tid >> 6);
    X.G = gridDim.x; X.c = blockIdx.x; X.gw = X.c * NWAVES + X.wave; X.NGW = X.G * NWAVES;
    unsigned char* ws = args.ws;
    gu32* ctl = (gu32*)(ws + WS_CTL);
    volatile LAS unsigned* MISC = (volatile LAS unsigned*)(X.lds + MISC_OFF);
    for (int u = X.tid; u < (LDS_BYTES - LDSCTL_OFF) / 4; u += NWAVES * 64) ((LAS unsigned*)(X.lds + LDSCTL_OFF))[u] = 0u;
    __syncthreads();
    const int lo = args.ph_lo, hi = args.ph_hi;
    XcdBarrier bar; bar.bar = (unsigned*)(ctl + CW_BAR) + args.li * XCD_BAR_WORDS; bar.x = 0; bar.st = nullptr;
    if (hi - lo > 1) bar = xcd_barrier_post((unsigned*)(ctl + CW_BAR) + args.li * XCD_BAR_WORDS, MISC + 8);
#ifdef PROBE_SEL
#define stamper (blockIdx.x == PROBE_BLK && threadIdx.x == 0)
#define TS ((volatile LAS unsigned long long*)(X.lds + LDSCTL_OFF + 1024))
    if (stamper) TS[63] = __builtin_amdgcn_s_memrealtime();
#define GRID_BAR_K(k) do { if (stamper) TS[2 * (k)] = __builtin_amdgcn_s_memrealtime(); xcd_barrier_h(bar, X, ctl, ws); if (stamper) TS[2 * (k) + 1] = __builtin_amdgcn_s_memrealtime(); } while (0)
#else
#define GRID_BAR_K(k) xcd_barrier_h(bar, X, ctl, ws)
#endif
#define GRID_BAR() xcd_barrier(bar)
#define REFRESH_X() do { int t_ = threadIdx.x; asm volatile("" : "+v"(t_)); X.tid = t_; X.lane = t_ & 63; } while (0)
#define IN(k) ((((PHMASK) >> (k)) & 1u) && lo <= (k) && (k) < hi)
#define BOTH(k) (IN(k) && ((k) + 1) < hi)

#define x_in (AIN(0))
#define c_in (AIN(1))
#define ctx_in (AIN(2))
#define cctx_in (AIN(3))
#define mods0 ((float*)(ws + WS_MODS))
#define mods1 ((float*)(ws + WS_MODS) + 3 * MODW)
#define lamv ((float*)(ws + WS_LAM))
#define CSTAB ((float*)(ws + WS_LAM + 4096))
#define GTAB ((float*)(ws + WS_LAM + 4096 + 16384))
#define WT_EIN ((bf16*)(ws + WS_WT_EIN))
#define WT_EOUT ((bf16*)(ws + WS_WT_EOUT))
#define WT_EF1 ((bf16*)(ws + WS_WT_EF1))
#define WT_EF2 ((bf16*)(ws + WS_WT_EF2))
#define WT_OIN ((bf16*)(ws + WS_WT_OIN))
#define WT_OOUT ((bf16*)(ws + WS_WT_OOUT))
#define WT_X1 ((bf16*)(ws + WS_WT_X1))
#define WT_X2 ((bf16*)(ws + WS_WT_X2))
#define H ((bf16*)(ws + WS_H))
#define Z ((bf16*)(ws + WS_Z))
#define QKV ((bf16*)(ws + WS_QKV))
#define PB ((float*)(ws + WS_PB))
#define OALL ((bf16*)(ws + WS_OALL))
#define X1 ((float*)(ws + WS_X1))
#define X3 ((float*)(ws + WS_X3))
#define ACT ((bf16*)(ws + WS_ACT))
#define XS ((bf16*)(ws + WS_XS))
#define ACT2 ((bf16*)(ws + WS_ACT2))
#define YS ((bf16*)(ws + WS_YS))
#define PART ((float*)(ws + WS_PART))
#define EID ((int*)(ws + RT_EID))
#define EGATE ((float*)(ws + RT_GATE))
#define POS ((int*)(ws + RT_POS))
#define ROWTOK ((int*)(ws + RT_ROWTOK))
#define ROWGATE ((float*)(ws + WS_RGATE))
#define TILE_E ((int*)(ws + RT_TILE_E))
#define NTILES ((int*)(ws + RT_NTILES))

    if (IN(0)) { REFRESH_X();
    REP(0) { if (rep_) __syncthreads();
    {
        mod_fill_silu(X, c_in, cctx_in);
        for (int task = X.c; task < MOD_TASKS; task += X.G) { const int l = task / (MODW / 32); mod_task(X, task, l ? AIN(24) : AIN(6), l ? AIN(25) : AIN(7), l ? mods1 : mods0); }
        if (X.c == (X.G > 1 ? X.G - 2 : 0)) {
            for (int idx = X.tid; idx < 2048; idx += NWAVES * 64) { const int pp = idx >> 5, i = idx & 31; const float inv = exp2f(-(float)i * (13.287712379549449f / 32.0f)); float sn, cs; sincosf((float)pp * inv, &sn, &cs);
                CSTAB[idx] = cs; CSTAB[2048 + idx] = sn; }
            for (int idx = X.tid; idx < 6 * 128; idx += NWAVES * 64) { const int gi = idx >> 7, j = idx & 127;
                const float* src = gi == 0 ? AIN(10) : gi == 1 ? AIN(11) : gi == 2 ? AIN(13) : gi == 3 ? AIN(14) : gi == 4 ? AIN(28) : AIN(29); GTAB[idx] = src[j]; }
        }
        if (X.c == X.G - 1 && X.wave == 0) {
            for (int h = 0; h < 4; ++h) { const float* q1 = AIN(15) + h * 128; const float* k1 = AIN(16) + h * 128; const float* q2 = AIN(17) + h * 128; const float* k2 = AIN(18) + h * 128;
                const float s1 = wave_sum(q1[X.lane] * k1[X.lane] + q1[X.lane + 64] * k1[X.lane + 64]); const float s2 = wave_sum(q2[X.lane] * k2[X.lane] + q2[X.lane + 64] * k2[X.lane + 64]);
                if (X.lane == 0) lamv[h] = expf(s1) - expf(s2) + LAM_INIT; }
        }
        LAS float* scr = (LAS float*)(X.lds + X.wave * 16896);
        constexpr int I0 = (D / 64) * (EVEN_IN / 64), I1 = I0 + (D / 64) * (D / 64), I2 = I1 + (D / 128) * (2 * DFF / 32), I3 = I2 + (DFF / 64) * (D / 64), I4 = I3 + (D / 64) * (ODD_IN / 64), I5 = I4 + (D / 64) * (D / 64);
        constexpr int NITEMS = I1;
        constexpr int NA = (NITEMS * 3 / 4) & ~7, CHA = 8, CHB = 2;
        unsigned* wq = (unsigned*)(ctl + CW_WORK);
#define GRAB(word, n) grab_items(wq + 64 * (word), (n), X.lane)
#define DO_ITEM(it_) do { int r_ = (it_); \
            if (r_ < I0) { transpose_item(AIN(8), D, EVEN_IN, WT_EIN, r_, 2, scr, X.lane); } \
            else { transpose_item(AIN(9), D, D, WT_EOUT, r_ - I0, 0, scr, X.lane); } } while (0)
        {
            constexpr int CH = 2;
            volatile LAS int* tk = (volatile LAS int*)(X.lds + 139264);
            int par = 0; int nxt = 0; if (X.tid == 0) nxt = (int)__hip_atomic_fetch_add(wq, (unsigned)(8 * CH), __ATOMIC_RELAXED, __HIP_MEMORY_SCOPE_AGENT);
            for (;;) {
                if (X.tid == 0) { tk[par] = nxt; nxt = (int)__hip_atomic_fetch_add(wq, (unsigned)(8 * CH), __ATOMIC_RELAXED, __HIP_MEMORY_SCOPE_AGENT); }
                __syncthreads();
                const int base = tk[par]; par ^= 1;
                if (base >= NITEMS) break;
#pragma unroll 1
                for (int i = 0; i < CH; ++i) { const int it = base + X.wave + 8 * i; if (it < NITEMS) DO_ITEM(it); }
            }
        }
#undef GRAB
#undef DO_ITEM
    }
    }
    if (BOTH(0)) GRID_BAR_K(0);
    }
    if (IN(1)) { REFRESH_X();
    REP(1) { if (rep_) __syncthreads();
    norm_mod_rows<false>(X, x_in, ctx_in, MR, AIN(4), mods0, 0, 1, H, nullptr, nullptr, nullptr);
    }
    if (BOTH(1)) GRID_BAR_K(1);
    }
    if (IN(2)) { REFRESH_X();
    REP(2) { if (rep_) __syncthreads();
    { pg8::Gemm g{H, WT_EIN, MR, EVEN_IN, D}; pg8::StaticOrder S; S.init(MR, EVEN_IN, D / 64, X.G, X.c); pg8::EpiSlotsNR E{QKV, NSLOT0, KVR, 0, GTAB, CSTAB, (PG8_LAS float*)(X.lds + RING_BYTES)};
      pg8::gemm_phase<pg8::EpiSlotsNR, pg8::StaticOrder, true, true>(X.lds, g, S, E); }
    drain_deferred(X, ctl, ws, 4 * idle_units((MR / 256) * (EVEN_IN / 256), X.G, X.c), NDEF);
    }
    if (BOTH(2)) GRID_BAR_K(2);
    }
    if (IN(4)) { REFRESH_X();
    REP(4) { if (rep_) __syncthreads();
    {
        const att::bf16* Q0 = (const att::bf16*)QKV;
        int atid = threadIdx.x; asm volatile("" : "+v"(atid));
        for (int u = X.c; u < 544; u += X.G) {
            const bool isl = u < 512; const int b = isl ? (u >> 8) : ((u - 512) >> 4), vh = isl ? ((u >> 4) & 15) : ((u - 512) & 15), qb = isl ? (u & 15) : 16;
            const int hb = vh >> 2, map = (vh >> 1) & 1, half = vh & 1;
            const att::bf16* Qp = Q0 + ((size_t)(b * NSLOT0 + 12 + 2 * hb + map) * KVR + qb * 256) * 128;
            const att::bf16* Kp = Q0 + ((size_t)(b * NSLOT0 + 20 + 2 * hb + map) * KVR) * 128;
            const att::bf16* Vp = Q0 + ((size_t)(b * NSLOT0 + 28 + 2 * hb + half) * KVR) * 128;
            float* Op = PB + ((size_t)(b * 16 + vh) * KVR + qb * 256) * 128;
            att::attn_unit<false, false>(Qp, Kp, Vp, (void*)Op, 128, 0, isl ? 68 : 0, isl ? 68 : 4, qb * 256, -1e30f, 0.f, (char*)lds, atid);
        }
        const int ca = (X.c + X.G - 32) % X.G;
        for (int u = ca; u < 272; u += X.G) {
            const bool isl = u < 256; const int b = isl ? (u >> 7) : ((u - 256) >> 3), h = isl ? ((u >> 4) & 7) : ((u - 256) & 7), qb = isl ? (u & 15) : 16;
            const int q0 = qb * 256; const int klo = isl ? (q0 >= 128 ? q0 - 128 : 0) : 0; const int khi = (q0 + 384) < SEQ ? (q0 + 384) : SEQ; const int nt1 = isl ? ((khi - klo) >> 6) : 0;
            const att::bf16* Qp = Q0 + ((size_t)(b * NSLOT0 + h) * KVR + q0) * 128;
            const att::bf16* Kp = Q0 + ((size_t)(b * NSLOT0 + 8 + (h >> 2)) * KVR) * 128;
            const att::bf16* Vp = Q0 + ((size_t)(b * NSLOT0 + 10 + (h >> 2)) * KVR) * 128;
            bf16* Op = OALL + (size_t)(isl ? (b * SEQ + q0) : (TL + b * CTXL)) * D + h * 128;
            const float sink = AIN(12)[h];
            att::attn_unit<true, true>(Qp, Kp, Vp, (void*)Op, D, klo, nt1, nt1 + 4, q0, sink * (1.0f / att::SCALE), 1.f, (char*)lds, atid);
        }
    }
    }
    if (BOTH(4)) GRID_BAR_K(4);
    }
    if (IN(5)) { REFRESH_X();
    REP(5) { if (rep_) __syncthreads();
    b_combine(X, PB, lamv, AIN(19), OALL);
    }
    if (BOTH(5)) GRID_BAR_K(5);
    }
    if (IN(6)) { REFRESH_X();
    REP(6) { if (rep_) __syncthreads();
    { pg8::Gemm g{OALL, WT_EOUT, MR, D, D}; pg8::TailOrder S; S.init(TL / 256, TC / 256, D / 256, D / 64, X.G, X.c, nullptr); pg8::EpiRes E{x_in, ctx_in, X1, D, mods0 + 2 * D, MODW, PART, TL, TC, 1.0f};
      pg8::gemm_phase<pg8::EpiRes, pg8::TailOrder, true, true>(X.lds, g, S, E); }
    }
    if (BOTH(6)) GRID_BAR_K(6);
    }
    if (IN(7)) { REFRESH_X();
    REP(7) { if (rep_) __syncthreads();
    { int Sp, pp; pg8::tail_split(X.G, (TC / 256) * (D / 256), D / 64, Sp, pp);
      norm_mod_rows<false, true, true>(X, X1, ctx_in, MR, AIN(5), mods0, 3, 4, H, nullptr, nullptr, nullptr, PART, Sp, mods0 + 2 * MODW + 2 * D, X1 + (size_t)TL * D); }
    drain_deferred(X, ctl, ws, 1 << 20, DN1);
    }
    if (BOTH(7)) GRID_BAR_K(7);
    }
    if (IN(8)) { REFRESH_X();
    REP(8) { if (rep_) __syncthreads();
    { pg8::Gemm g{H, WT_EF1, MR, 2 * DFF, D}; pg8::StaticOrder S; S.init(MR, 2 * DFF, D / 128, X.G, X.c); pg8::EpiSwiglu E{ACT, DFF, 1.0f / W8_SCALE};
      pg8::gemm_phase<pg8::EpiSwiglu, pg8::StaticOrder, true, true, true>(X.lds, g, S, E); }
    drain_deferred(X, ctl, ws, 2 * idle_units((MR / 256) * (2 * DFF / 256), X.G, X.c), NDEF);
    drain_deferred(X, ctl, ws, 1 << 20, DN2);
    }
    if (BOTH(8)) GRID_BAR_K(8);
    }
    if (IN(9)) { REFRESH_X();
    REP(9) { if (rep_) __syncthreads();
    { pg8::Gemm g{ACT, WT_EF2, MR, D, DFF}; pg8::TailOrder S; S.init(TL / 256, TC / 256, D / 256, DFF / 64, X.G, X.c, nullptr); pg8::EpiRes E{X1, X1 + (size_t)TL * D, X1, D, mods0 + 5 * D, MODW, PART, TL, TC, 1.0f};
      pg8::gemm_phase<pg8::EpiRes, pg8::TailOrder, true, true>(X.lds, g, S, E); }
    }
    if (BOTH(9)) GRID_BAR_K(9);
    }
    if (IN(10)) { REFRESH_X();
    REP(10) { if (rep_) __syncthreads();
    { int Sp, pp; pg8::tail_split(X.G, (TC / 256) * (D / 256), DFF / 64, Sp, pp);
      norm_mod_rows<false, true>(X, X1, X1 + (size_t)TL * D, MR, AIN(22), mods1, 0, 1, H, nullptr, nullptr, nullptr, PART, Sp, mods0 + 2 * MODW + 5 * D, nullptr); }
    drain_deferred(X, ctl, ws, 1 << 20, DN3);
    }
    if (BOTH(10)) GRID_BAR_K(10);
    }
    if (IN(11)) { REFRESH_X();
    REP(11) { if (rep_) __syncthreads();
    { pg8::Gemm g{H, WT_OIN, MR, ODD_IN, D}; pg8::StaticOrder S; S.init(MR, ODD_IN, D / 64, X.G, X.c); pg8::EpiSlotsNR E{QKV, NSLOT1, KVR, 1, GTAB, CSTAB, (PG8_LAS float*)(X.lds + RING_BYTES)};
      pg8::gemm_phase<pg8::EpiSlotsNR, pg8::StaticOrder, true, true>(X.lds, g, S, E); }
    drain_deferred(X, ctl, ws, 4 * idle_units((MR / 256) * (ODD_IN / 256), X.G, X.c), NDEF);
    }
    if (BOTH(11)) GRID_BAR_K(11);
    }
    if (IN(13)) { REFRESH_X();
    REP(13) { if (rep_) __syncthreads();
    if (((X.c >> 3) & 1) == 0) drain_deferred(X, ctl, ws, ST_QUOTA, NDEF);
    {
        const att::bf16* Q0 = (const att::bf16*)QKV;
        int atid = threadIdx.x; asm volatile("" : "+v"(atid));
        for (int u = X.c; u < 512; u += X.G) {
            const int b = u >> 8, h = (u >> 4) & 15, qb = u & 15;
            const att::bf16* Qp = Q0 + ((size_t)(b * NSLOT1 + h) * KVR + qb * 256) * 128;
            const att::bf16* Kp = Q0 + ((size_t)(b * NSLOT1 + 16 + (h >> 2)) * KVR) * 128;
            const att::bf16* Vp = Q0 + ((size_t)(b * NSLOT1 + 20 + (h >> 2)) * KVR) * 128;
            bf16* Op = OALL + (size_t)(b * SEQ + qb * 256) * D + h * 128;
            const int ntc = 68 + (X.G >> 20);
            att::attn_unit<false, true>(Qp, Kp, Vp, (void*)Op, D, 0, ntc, ntc, qb * 256, -1e30f, 0.f, (char*)lds, atid);
        }
    }
    if (((X.c >> 3) & 1) == 1) drain_deferred(X, ctl, ws, ST_QUOTA, NDEF);
    drain_deferred(X, ctl, ws, 1 << 20, DN4);
    }
    if (BOTH(13)) GRID_BAR_K(13);
    }
    if (IN(14)) { REFRESH_X();
    REP(14) { if (rep_) __syncthreads();
    { pg8::Gemm g{OALL, WT_OOUT, TL, D, D}; pg8::StaticOrder S; S.init(TL, D, D / 64, X.G, X.c); pg8::EpiRes E{X1, X1, X3, D, mods1 + 2 * D, MODW, nullptr, 0, 0, 1.0f};
      pg8::gemm_phase<pg8::EpiRes, pg8::StaticOrder, true, true>(X.lds, g, S, E); }
    }
    if (BOTH(14)) GRID_BAR_K(14);
    }
    if (IN(15)) { REFRESH_X();
    REP(15) { if (rep_) __syncthreads();
    norm_route_rows(X, X3, AIN(23), mods1, 3, 4, AIN(30), (unsigned*)(ctl + CW_GCNT), (unsigned char*)XS, POS, ROWGATE);
    drain_deferred(X, ctl, ws, 1 << 20, NQ1);
    }
    if (BOTH(15)) GRID_BAR_K(15);
    }
    if (IN(17)) { REFRESH_X();
    REP(17) { if (rep_) __syncthreads();
    { const int nt = build_moe_tables(X, (const unsigned*)(ctl + CW_GCNT)); const int* te_ = (const int*)(lds + TAB_OFF); pg8::Gemm g{XS, WT_X1, XROWS, 2 * DFE, D}; pg8::TailOrder S; S.init(nt, 0, 2 * DFE / 256, D / 128, X.G, X.c, te_, te_ + MAXT); pg8::EpiSwiglu8 E{ACT2, DFE, 1.0f / W8_SCALE};
      pg8::gemm_phase<pg8::EpiSwiglu8, pg8::TailOrder, true, true, true>(X.lds, g, S, E); }
    drain_deferred(X, ctl, ws, 1 << 20, NDEF);
    }
    if (BOTH(17)) GRID_BAR_K(17);
    }
    if (IN(18)) { REFRESH_X();
    REP(18) { if (rep_) __syncthreads();
    { const int nt = build_moe_tables(X, (const unsigned*)(ctl + CW_GCNT)); const int* te_ = (const int*)(lds + TAB_OFF); pg8::Gemm g{ACT2, WT_X2, XROWS, D, DFE}; pg8::TailOrder S; S.init(MOE_MAIN_TILES, nt - MOE_MAIN_TILES, D / 256, DFE / 128, X.G, X.c, te_, te_ + MAXT); pg8::EpiRowScale E{(pg8::bf16_t*)YS, D, ROWGATE, PART, MOE_MAIN_ROWS, (nt - MOE_MAIN_TILES) * 256, 1.0f / W8_SCALE};
      pg8::gemm_phase<pg8::EpiRowScale, pg8::TailOrder, true, true, true>(X.lds, g, S, E); }
    }
    if (BOTH(18)) GRID_BAR_K(18);
    }
    if (IN(19)) { REFRESH_X();
    REP(19) { if (rep_) __syncthreads();
    { const int nt = build_moe_tables(X, (const unsigned*)(ctl + CW_GCNT)); moe_final(X, X3, YS, POS, mods1, args.out, PART, nt); }
#ifdef PROBE_SEL
    if (stamper) { TS[38] = __builtin_amdgcn_s_memrealtime(); TS[39] = TS[38];
        unsigned long long workmask_sum = 0, bar_sum = 0;
        for (int k = 0; k < 20; ++k) { const unsigned long long st = k == 0 ? TS[63] : TS[2 * k - 1]; const unsigned long long w = TS[2 * k] - st, bw = TS[2 * k + 1] - TS[2 * k];
            if ((PROBE_WORK_MASK >> k) & 1u) workmask_sum += w; if ((PROBE_BAR_MASK >> k) & 1u) bar_sum += bw; }
        const unsigned long long spin = (workmask_sum + bar_sum) * (unsigned long long)(PROBE_AMP);
        const unsigned long long t0_ = __builtin_amdgcn_s_memrealtime(); while (__builtin_amdgcn_s_memrealtime() - t0_ < spin) __builtin_amdgcn_s_sleep(8); }
#endif
    }
    }
}

extern "C" void kernel_launch(void* const* d_in, const int* in_sizes, int n_in, void* d_out, int out_size, void* d_ws, size_t ws_size, hipStream_t stream) {
    static int grid = 0;
    if (grid == 0) {
        if (n_in != 33 || in_sizes[0] != TL * D || out_size != TL * D || ws_size < WS_END) { fprintf(stderr, "kernel_launch: unexpected shapes (n_in %d, in0 %d, out %d, ws %zu)\n", n_in, n_in > 0 ? in_sizes[0] : -1, out_size, ws_size); grid = -1; return; }
        int dev = 0, cus = 0, per_cu = 0;
        if (hipGetDevice(&dev) != hipSuccess || hipDeviceGetAttribute(&cus, hipDeviceAttributeMultiprocessorCount, dev) != hipSuccess) { grid = -1; return; }
        if (hipFuncSetAttribute((const void*)fwd_kernel, hipFuncAttributeMaxDynamicSharedMemorySize, LDS_BYTES) != hipSuccess) { fprintf(stderr, "kernel_launch: hipFuncSetAttribute failed\n"); grid = -1; return; }
        if (hipOccupancyMaxActiveBlocksPerMultiprocessor(&per_cu, (const void*)fwd_kernel, NWAVES * 64, LDS_BYTES) != hipSuccess || per_cu < 1) { fprintf(stderr, "kernel_launch: occupancy query says %d blocks per CU\n", per_cu); }
        (void)hipGetLastError();
        grid = cus;
    }
    if (grid < 0) return;
    constexpr int NL = sizeof(kLaunches) / sizeof(kLaunches[0]);
    if (hipMemsetAsync((char*)d_ws + WS_CTL, 0, NL == 1 ? (size_t)65536 : CTL_ZERO_BYTES, stream) != hipSuccess) return;
    Args a{};
    for (int i = 0; i < 33; ++i) a.in[i] = (const float*)d_in[i];
    a.out = (float*)d_out; a.ws = (unsigned char*)d_ws;
    for (int li = 0; li < NL; ++li) {
        a.ph_lo = kLaunches[li].lo; a.ph_hi = kLaunches[li].hi; a.li = li; a.pad = 0;
        hipLaunchKernelGGL(fwd_kernel, dim3(grid), dim3(NWAVES * 64), LDS_BYTES, stream, a);
        const hipError_t le = hipPeekAtLastError();
        if (le != hipSuccess) { fprintf(stderr, "kernel_launch: launch %d failed: %s\n", li, hipGetErrorName(le)); break; }
    }
}
```
